# Optimizing an MI355X kernel written in HIP

```python
import jax, jax.numpy as jnp
from jax import lax
import numpy as np

D_MODEL = 2048
BATCH = 4
SEQ = 8192
DEPTH = 1

PLE_DIM = 256
RMS_EPS = 1e-6

MLA_HEADS = 8
MLA_NOPE = 128
MLA_ROPE = 64
MLA_QK = MLA_NOPE + MLA_ROPE
MLA_V = 128
MLA_Q_LORA = 512
MLA_KV_LORA = 256
ROPE_THETA = 10000.0
Q_BLOCK = 128

RW_HEADS = 16
RW_HEAD = 64
RW_C = RW_HEADS * RW_HEAD
RW_DECAY_LORA = 64
RW_A_LORA = 64
RW_GATE_LORA = 160
RW_GN_EPS = 64e-5

MIX_WIDTH = MLA_HEADS * MLA_V + RW_C

MLA_COLS = MLA_Q_LORA + MLA_KV_LORA + MLA_ROPE
RW_COLS = 3 * RW_C + RW_DECAY_LORA + RW_A_LORA + RW_GATE_LORA
IN_COLS = MLA_COLS + RW_COLS

N_EXPERTS = 64
TOP_K = 8
N_GROUPS = 8
TOPK_GROUPS = 4
EXPERT_DIM = 512
SHARED_DIM = 512
ROUTED_SCALE = 2.5

kernel_name = "hymba_mla_rwkv7_moe_ple_layer"


def rms_norm(x, g, eps=RMS_EPS):
    x32 = x.astype(jnp.float32)
    y = x32 * lax.rsqrt(jnp.mean(x32 * x32, axis=-1, keepdims=True) + eps)
    return (y * g.astype(jnp.float32)).astype(x.dtype)


def rope(x, positions):
    half = x.shape[-1] // 2
    inv = ROPE_THETA ** (-jnp.arange(half, dtype=jnp.float32) / half)
    ang = positions.astype(jnp.float32)[..., None] * inv
    cos = jnp.cos(ang)[:, :, None, :]
    sin = jnp.sin(ang)[:, :, None, :]
    x1 = x[..., :half].astype(jnp.float32)
    x2 = x[..., half:].astype(jnp.float32)
    out = jnp.concatenate([x1 * cos - x2 * sin, x2 * cos + x1 * sin], axis=-1)
    return out.astype(x.dtype)


def causal_block_attention(q, k, v):
    B, T, H, _ = q.shape
    dv = v.shape[-1]
    scale = MLA_QK ** -0.5
    kidx = jnp.arange(T)

    def one_block(start):
        qb = lax.dynamic_slice_in_dim(q, start, Q_BLOCK, axis=1)
        s = jnp.einsum('bqhd,bkhd->bhqk', qb, k, preferred_element_type=jnp.float32) * scale
        qidx = start + jnp.arange(Q_BLOCK)
        s = jnp.where(kidx[None, :] <= qidx[:, None], s, -jnp.inf)
        pr = jax.nn.softmax(s, axis=-1)
        return jnp.einsum('bhqk,bkhd->bqhd', pr.astype(v.dtype), v)

    out = lax.map(one_block, jnp.arange(T // Q_BLOCK) * Q_BLOCK)
    return out.transpose(1, 0, 2, 3, 4).reshape(B, T, H * dv)


def mla_mixer(c_q, c_kv, k_pe, positions, g_qa, w_uq, g_kva, w_ukv, g_qn, g_kn):
    B, T, _ = c_q.shape
    q = (rms_norm(c_q, g_qa) @ w_uq).reshape(B, T, MLA_HEADS, MLA_QK)
    kv = (rms_norm(c_kv, g_kva) @ w_ukv).reshape(B, T, MLA_HEADS, MLA_NOPE + MLA_V)
    k_nope, v = kv[..., :MLA_NOPE], kv[..., MLA_NOPE:]
    k_pe_h = jnp.broadcast_to(k_pe[:, :, None, :], (B, T, MLA_HEADS, MLA_ROPE))
    k = jnp.concatenate([k_nope, k_pe_h], axis=-1)
    q = rms_norm(q, g_qn)
    k = rms_norm(k, g_kn)
    q = jnp.concatenate([q[..., :MLA_NOPE], rope(q[..., MLA_NOPE:], positions)], axis=-1)
    k = jnp.concatenate([k[..., :MLA_NOPE], rope(k[..., MLA_NOPE:], positions)], axis=-1)
    return causal_block_attention(q, k, v)


def token_shift(z):
    return jnp.pad(z, ((0, 0), (1, 0), (0, 0)))[:, :-1]


def rwkv7_mixer(z, mu, w0, w_w2, a0, a_w2, g_w2, k_k, k_a, r_k, ln_w, ln_b):
    B, T, _ = z.shape
    f32 = jnp.float32
    z = z + (token_shift(z) - z) * mu
    cuts = [RW_C, 2 * RW_C, 3 * RW_C, 3 * RW_C + RW_DECAY_LORA, 3 * RW_C + RW_DECAY_LORA + RW_A_LORA]
    r, k, v, wl, al, gl = jnp.split(z, cuts, axis=-1)
    w = -jax.nn.softplus(-(w0 + jnp.tanh(wl) @ w_w2)) - 0.5
    decay = jnp.exp(-jnp.exp(w.astype(f32)))
    a = jax.nn.sigmoid(a0 + al @ a_w2)
    g = jax.nn.sigmoid(gl) @ g_w2
    heads = lambda t: t.reshape(B, T, RW_HEADS, RW_HEAD).astype(f32)
    kk = heads(k * k_k)
    kk = kk / jnp.maximum(jnp.sqrt(jnp.sum(kk * kk, axis=-1, keepdims=True)), 1e-12)
    k = k * (1 + (a - 1) * k_a)
    r_h, k_h, v_h, a_h, w_h = heads(r), heads(k), heads(v), heads(a), heads(decay)

    def step(S, inp):
        r_t, w_t, k_t, v_t, kk_t, a_t = inp
        sa = jnp.einsum('bhij,bhj->bhi', S, -kk_t)
        S = S * w_t[:, :, None, :] + sa[..., None] * (kk_t * a_t)[:, :, None, :] + v_t[..., None] * k_t[:, :, None, :]
        y = jnp.einsum('bhij,bhj->bhi', S, r_t)
        return S, y

    xs = tuple(t.transpose(1, 0, 2, 3) for t in (r_h, w_h, k_h, v_h, kk, a_h))
    S0 = jnp.zeros((B, RW_HEADS, RW_HEAD, RW_HEAD), f32)
    _, y = lax.scan(step, S0, xs)
    y = y.transpose(1, 0, 2, 3)
    mean = jnp.mean(y, axis=-1, keepdims=True)
    var = jnp.mean(jnp.square(y - mean), axis=-1, keepdims=True)
    y = ((y - mean) * lax.rsqrt(var + RW_GN_EPS)).reshape(B, T, RW_C)
    y = y * ln_w.astype(f32) + ln_b.astype(f32)
    bonus = jnp.sum(r_h * k_h * r_k.astype(f32), axis=-1, keepdims=True) * v_h
    out = (y + bonus.reshape(B, T, RW_C)) * g.astype(f32)
    return out.astype(z.dtype)


def moe(hn, w_router, router_bias, w_gate, w_up, w_down, ws_gate, ws_up, ws_down):
    f32 = jnp.float32
    shp = hn.shape
    x = hn.reshape(-1, shp[-1])
    scores = jax.nn.sigmoid((x @ w_router).astype(f32))
    biased = scores + router_bias.astype(f32)
    grp = biased.reshape(-1, N_GROUPS, N_EXPERTS // N_GROUPS)
    group_score = jnp.sum(lax.top_k(grp, 2)[0], axis=-1)
    _, gidx = lax.top_k(group_score, TOPK_GROUPS)
    gmask = jnp.sum(jax.nn.one_hot(gidx, N_GROUPS, dtype=f32), axis=1) > 0
    emask = jnp.repeat(gmask, N_EXPERTS // N_GROUPS, axis=-1)
    _, eidx = lax.top_k(jnp.where(emask, biased, -jnp.inf), TOP_K)
    wts = jnp.take_along_axis(scores, eidx, axis=-1)
    wts = wts / jnp.sum(wts, axis=-1, keepdims=True) * ROUTED_SCALE
    combine = jnp.einsum('nk,nke->ne', wts, jax.nn.one_hot(eidx, N_EXPERTS, dtype=f32))

    def expert(acc, ew):
        wg, wu, wd, c = ew
        hmid = jax.nn.silu(x @ wg) * (x @ wu)
        return acc + c[:, None] * (hmid @ wd).astype(f32), None

    routed, _ = lax.scan(expert, jnp.zeros(x.shape, f32), (w_gate, w_up, w_down, combine.T))
    shared = (jax.nn.silu(x @ ws_gate) * (x @ ws_up)) @ ws_down
    return (routed.astype(x.dtype) + shared).reshape(shp)


def setup_inputs(seed: int = 0) -> dict:
    key = jax.random.key(seed)
    ks = iter(jax.random.split(key, 48))
    f32 = jnp.float32
    L, D = DEPTH, D_MODEL

    def nrm(shape, scale):
        return jax.random.normal(next(ks), shape, f32) * scale

    x = nrm((BATCH, SEQ, D), 1.0)
    p = nrm((DEPTH, BATCH, SEQ, PLE_DIM), 1.0)
    offs = jax.random.randint(next(ks), (BATCH, 1), 0, 1024, dtype=jnp.int32)
    positions = offs + jnp.arange(SEQ, dtype=jnp.int32)[None, :]
    return {
        "x": x,
        "p": p,
        "positions": positions,
        "g_mix": 1.0 + nrm((L, D), 0.02),
        "w_in": nrm((L, D, IN_COLS), D ** -0.5),
        "mla_g_qa": 1.0 + nrm((L, MLA_Q_LORA), 0.02),
        "mla_w_uq": nrm((L, MLA_Q_LORA, MLA_HEADS * MLA_QK), MLA_Q_LORA ** -0.5),
        "mla_g_kva": 1.0 + nrm((L, MLA_KV_LORA), 0.02),
        "mla_w_ukv": nrm((L, MLA_KV_LORA, MLA_HEADS * (MLA_NOPE + MLA_V)), MLA_KV_LORA ** -0.5),
        "mla_g_qn": 1.0 + nrm((L, MLA_QK), 0.02),
        "mla_g_kn": 1.0 + nrm((L, MLA_QK), 0.02),
        "rw_mu": jax.random.uniform(next(ks), (L, RW_COLS), f32, 0.0, 1.0),
        "rw_w0": jax.random.uniform(next(ks), (L, RW_C), f32, -6.0, -1.0),
        "rw_w_w2": nrm((L, RW_DECAY_LORA, RW_C), 0.1 * RW_DECAY_LORA ** -0.5),
        "rw_a0": nrm((L, RW_C), 0.1),
        "rw_a_w2": nrm((L, RW_A_LORA, RW_C), 0.1 * RW_A_LORA ** -0.5),
        "rw_g_w2": nrm((L, RW_GATE_LORA, RW_C), RW_GATE_LORA ** -0.5),
        "rw_k_k": 0.85 + nrm((L, RW_C), 0.02),
        "rw_k_a": 1.0 + nrm((L, RW_C), 0.02),
        "rw_r_k": nrm((L, RW_HEADS, RW_HEAD), 0.1),
        "rw_ln_w": 1.0 + nrm((L, RW_C), 0.02),
        "rw_ln_b": nrm((L, RW_C), 0.02),
        "w_out": nrm((L, MIX_WIDTH, D), MIX_WIDTH ** -0.5),
        "g_ffn": 1.0 + nrm((L, D), 0.02),
        "w_router": nrm((L, D, N_EXPERTS), D ** -0.5),
        "router_bias": nrm((L, N_EXPERTS), 0.01),
        "w_gate": nrm((L, N_EXPERTS, D, EXPERT_DIM), D ** -0.5),
        "w_up": nrm((L, N_EXPERTS, D, EXPERT_DIM), D ** -0.5),
        "w_down": nrm((L, N_EXPERTS, EXPERT_DIM, D), EXPERT_DIM ** -0.5),
        "ws_gate": nrm((L, D, SHARED_DIM), D ** -0.5),
        "ws_up": nrm((L, D, SHARED_DIM), D ** -0.5),
        "ws_down": nrm((L, SHARED_DIM, D), SHARED_DIM ** -0.5),
        "g_ple_in": 1.0 + nrm((L, D), 0.02),
        "w_ple_gate": nrm((L, D, D), D ** -0.5),
        "b_ple_gate": nrm((L, D), 0.02),
        "w_ple_proj": nrm((L, PLE_DIM, D), PLE_DIM ** -0.5),
        "g_ple_out": 1.0 + nrm((L, D), 0.02),
    }


def reference(x, p, positions, g_mix, w_in, mla_g_qa, mla_w_uq, mla_g_kva, mla_w_ukv, mla_g_qn, mla_g_kn,
              rw_mu, rw_w0, rw_w_w2, rw_a0, rw_a_w2, rw_g_w2, rw_k_k, rw_k_a, rw_r_k, rw_ln_w, rw_ln_b,
              w_out, g_ffn, w_router, router_bias, w_gate, w_up, w_down, ws_gate, ws_up, ws_down,
              g_ple_in, w_ple_gate, b_ple_gate, w_ple_proj, g_ple_out):
    h = x
    for i in range(DEPTH):
        xn = rms_norm(h, g_mix[i])
        proj = xn @ w_in[i]
        c_q = proj[..., :MLA_Q_LORA]
        c_kv = proj[..., MLA_Q_LORA:MLA_Q_LORA + MLA_KV_LORA]
        k_pe = proj[..., MLA_Q_LORA + MLA_KV_LORA:MLA_COLS]
        z_rw = proj[..., MLA_COLS:]
        y_mla = mla_mixer(c_q, c_kv, k_pe, positions, mla_g_qa[i], mla_w_uq[i], mla_g_kva[i],
                          mla_w_ukv[i], mla_g_qn[i], mla_g_kn[i])
        y_rw = rwkv7_mixer(z_rw, rw_mu[i], rw_w0[i], rw_w_w2[i], rw_a0[i], rw_a_w2[i], rw_g_w2[i],
                           rw_k_k[i], rw_k_a[i], rw_r_k[i], rw_ln_w[i], rw_ln_b[i])
        h = h + jnp.concatenate([y_mla, y_rw], axis=-1) @ w_out[i]
        h = h + moe(rms_norm(h, g_ffn[i]), w_router[i], router_bias[i], w_gate[i], w_up[i], w_down[i],
                    ws_gate[i], ws_up[i], ws_down[i])
        gate = jax.nn.sigmoid(rms_norm(h, g_ple_in[i]) @ w_ple_gate[i] + b_ple_gate[i])
        h = h + rms_norm((p[i] @ w_ple_proj[i]) * gate, g_ple_out[i])
    return h
```

```cpp
#include <hip/hip_runtime.h>
#include <hip/hip_bf16.h>
#include <cstdio>
#include <cstdint>

#ifndef N_LAUNCH_MODE
#define N_LAUNCH_MODE 1
#endif

#define LAS __attribute__((address_space(3)))
typedef unsigned short bf16_t;
typedef short bf16x8 __attribute__((ext_vector_type(8)));
typedef float f32x4 __attribute__((ext_vector_type(4)));
typedef float f32x16 __attribute__((ext_vector_type(16)));
typedef unsigned u32x4 __attribute__((ext_vector_type(4)));
typedef unsigned u32x2 __attribute__((ext_vector_type(2)));
typedef int i32x2 __attribute__((ext_vector_type(2)));
#ifndef PROBE_NOSTORE
#define PROBE_NOSTORE 0
#endif
typedef int i32x8 __attribute__((ext_vector_type(8)));
typedef _Float16 h16;
typedef _Float16 h16x8 __attribute__((ext_vector_type(8)));
typedef _Float16 h16x4 __attribute__((ext_vector_type(4)));

constexpr int NT = 32768, DM = 2048, SEQ = 8192, NB = 4;
constexpr int ZW = 4352;
constexpr int ZC_KPE = 768, ZC_WL = 832, ZC_AL = 896, ZC_GL = 960, ZC_R = 1280, ZC_K = 2304, ZC_V = 3328;
constexpr int QW = 1536;
constexpr int LORA_K = 384, LORA_N = 3072;
constexpr int NEXP = 64, NE1 = 65;
constexpr int NCHUNK = 4, CH_TOK = NT / NCHUNK;
static_assert(CH_TOK % 256 == 0, "shared-expert row tiles must have no padding rows");
constexpr int MAXT = CH_TOK * 8 / 256 + 64 + CH_TOK / 256;
constexpr float RMS_EPS = 1e-6f;
constexpr float QSCALE = 0.07216878364870322f * 1.4426950408889634f;

constexpr size_t MiB = 1ull << 20;
constexpr size_t WS_CTL = 0;
constexpr size_t CTL_BAR = 0;
constexpr size_t CTL_CNT = 64 * 1024;
constexpr size_t CTL_ZERO_BYTES = 128 * 1024;
constexpr size_t WS_SMALL = 1 * MiB;
constexpr size_t OFF_WT_IN = WS_SMALL;
constexpr size_t OFF_WT_UQ = OFF_WT_IN + (size_t)ZW * 2048 * 2;
constexpr size_t OFF_WT_UKV = OFF_WT_UQ + (size_t)1536 * 512 * 2;
constexpr size_t OFF_WT_LORA = OFF_WT_UKV + (size_t)2048 * 256 * 2;
constexpr size_t OFF_WT_OUT = OFF_WT_LORA + (size_t)LORA_N * LORA_K * 2;
constexpr size_t OFF_WT_PG = OFF_WT_OUT + (size_t)2048 * 2048 * 2;
constexpr size_t OFF_WT_PP = OFF_WT_PG + (size_t)2048 * 2048 * 2;
constexpr size_t OFF_WT_RKV = OFF_WT_IN + (size_t)1280 * 2048;
constexpr size_t OFF_WRF = OFF_WT_PP + (size_t)2048 * 256 * 2;
constexpr size_t OFF_SSQP = OFF_WRF + (size_t)2048 * 64 * 4;
constexpr size_t OFF_TOPW = OFF_SSQP + (size_t)NT * 12 * 4;
constexpr size_t OFF_LIST = OFF_TOPW + (size_t)NT * 8 * 4;
constexpr size_t OFF_ROPE = OFF_LIST + (size_t)NCHUNK * NE1 * CH_TOK * 4;
constexpr size_t OFF_SMALL_END = OFF_ROPE + (size_t)NT * 64 * 4;
constexpr size_t WS_XN = 64 * MiB;
static_assert(OFF_SMALL_END <= WS_XN, "small region overflow");
constexpr size_t WS_BIG = WS_XN + 128 * MiB;
constexpr size_t OFF_Z = WS_BIG;
constexpr size_t OFF_R1 = OFF_Z + 272 * MiB;
constexpr size_t OFF_QB = OFF_R1;
constexpr size_t OFF_KB = OFF_QB + (size_t)NT * QW * 2;
constexpr size_t OFF_VB = OFF_KB + (size_t)NT * QW * 2;
constexpr size_t OFF_ALORA = OFF_R1 + 256 * MiB;
constexpr size_t OFF_LB = OFF_R1;
constexpr size_t OFF_DER = OFF_R1 + 256 * MiB;
constexpr size_t DER_STRIDE = (size_t)NT * 1024 * 2;
constexpr size_t OFF_MIX_END = OFF_DER + 6 * DER_STRIDE;
constexpr size_t OFF_WE1 = WS_BIG;
constexpr size_t OFF_WE2 = OFF_WE1 + (size_t)NE1 * 1024 * 2048;
constexpr size_t OFF_XN3 = WS_XN + 64 * MiB;
constexpr size_t OFF_HMID = OFF_WE2 + (size_t)NE1 * 2048 * 512;
constexpr size_t OFF_YPART = OFF_HMID + (size_t)NCHUNK * MAXT * 256 * 512;
constexpr size_t YPART_BYTES = (size_t)(CH_TOK * 8 + 16) * 2048;
constexpr size_t OFF_PB = OFF_YPART + 2 * YPART_BYTES;
constexpr size_t OFF_PP = OFF_PB + (size_t)NT * 256 * 2;
constexpr size_t OFF_U = OFF_PP + (size_t)NT * 2048 * 2;
constexpr size_t OFF_SSQU = OFF_U + (size_t)NT * 2048 * 2;
constexpr size_t OFF_RINFO = OFF_SSQU + (size_t)NT * 32 * 4;
constexpr size_t OFF_MOE_END = OFF_RINFO + (size_t)NCHUNK * MAXT * 256 * 8;
constexpr size_t WS_END = (OFF_MIX_END > OFF_MOE_END ? OFF_MIX_END : OFF_MOE_END);
static_assert(WS_END <= 1140 * MiB, "workspace budget");

__device__ __forceinline__ unsigned cvt_pk_bf16(float lo, float hi) { unsigned r; asm volatile("v_cvt_pk_bf16_f32 %0, %1, %2" : "=v"(r) : "v"(lo), "v"(hi)); return r; }
__device__ __forceinline__ bf16_t f2bf(float f) { return (bf16_t)(cvt_pk_bf16(f, 0.f) & 0xffffu); }
__device__ __forceinline__ float bf2f(bf16_t b) { return __uint_as_float(((unsigned)b) << 16); }
__device__ __forceinline__ float bflo(unsigned w) { return __uint_as_float(w << 16); }
__device__ __forceinline__ float bfhi(unsigned w) { return __uint_as_float(w & 0xffff0000u); }
__device__ __forceinline__ u32x4 pack8(f32x4 a, f32x4 b) { return (u32x4){cvt_pk_bf16(a[0], a[1]), cvt_pk_bf16(a[2], a[3]), cvt_pk_bf16(b[0], b[1]), cvt_pk_bf16(b[2], b[3])}; }
__device__ __forceinline__ unsigned pk_fp8x4(float a, float b, float c2, float d) { unsigned w = 0; a = fminf(fmaxf(a, -448.f), 448.f); b = fminf(fmaxf(b, -448.f), 448.f); c2 = fminf(fmaxf(c2, -448.f), 448.f); d = fminf(fmaxf(d, -448.f), 448.f); w = __builtin_amdgcn_cvt_pk_fp8_f32(a, b, w, false); w = __builtin_amdgcn_cvt_pk_fp8_f32(c2, d, w, true); return w; }
__device__ __forceinline__ void unpack8(const u32x4 w, float (&f)[8]) { f[0] = bflo(w[0]); f[1] = bfhi(w[0]); f[2] = bflo(w[1]); f[3] = bfhi(w[1]); f[4] = bflo(w[2]); f[5] = bfhi(w[2]); f[6] = bflo(w[3]); f[7] = bfhi(w[3]); }
__device__ __forceinline__ u32x4 packf8(const float (&f)[8]) { return (u32x4){cvt_pk_bf16(f[0], f[1]), cvt_pk_bf16(f[2], f[3]), cvt_pk_bf16(f[4], f[5]), cvt_pk_bf16(f[6], f[7])}; }
__device__ __forceinline__ float wave_sum(float v) { for (int o = 32; o >= 1; o >>= 1) v += __shfl_xor(v, o); return v; }
__device__ __forceinline__ float rlane(float x, int j) { return __int_as_float(__builtin_amdgcn_readlane(__float_as_int(x), j)); }
__device__ __forceinline__ float sigmoidf_(float x) { return __builtin_amdgcn_rcpf(1.0f + __builtin_amdgcn_exp2f(-1.44269504f * x)); }

#define DPP_ADD(x, ctrl) ((x) + __int_as_float(__builtin_amdgcn_update_dpp(0, __float_as_int(x), (ctrl), 0xF, 0xF, true)))
__device__ __forceinline__ void reduce8_fq(const float (&s)[8], float& o0, float& o1) {
    float t[4];
#pragma unroll
    for (int i = 0; i < 4; ++i) { auto r = __builtin_amdgcn_permlane32_swap(__float_as_uint(s[i]), __float_as_uint(s[i + 4]), false, false); t[i] = __uint_as_float(r[0]) + __uint_as_float(r[1]); }
    { auto r = __builtin_amdgcn_permlane16_swap(__float_as_uint(t[0]), __float_as_uint(t[2]), false, false); o0 = __uint_as_float(r[0]) + __uint_as_float(r[1]); }
    { auto r = __builtin_amdgcn_permlane16_swap(__float_as_uint(t[1]), __float_as_uint(t[3]), false, false); o1 = __uint_as_float(r[0]) + __uint_as_float(r[1]); }
}
__device__ __forceinline__ float allred8(float x) { x = DPP_ADD(x, 0xB1); x = DPP_ADD(x, 0x4E); x = DPP_ADD(x, 0x141); return x; }

namespace pg8 {
constexpr int BM = 256, BK = 64, HALF = 128, HTB = HALF * BK * 2, STAGE_BYTES = 8 * HTB;
__host__ __device__ __forceinline__ int lds_byte(int r, int c) { const int st = (r >> 4) * 2 + (c >> 5), rr = r & 15, cc = c & 31, ob = rr * 64 + cc * 2; return st * 1024 + (ob ^ (((ob >> 9) & 1) << 5)); }
__host__ __device__ __forceinline__ void stage_rc(int b, int& R, int& C) { const int st = b / 1024, sb = b % 1024, swz = sb ^ (((sb >> 9) & 1) << 5); R = (st >> 1) * 16 + swz / 64; C = (st & 1) * 32 + (swz % 64) / 2; }
__host__ __device__ __forceinline__ int perm32(int rho) { const int n = rho >> 4, i = rho & 15; return 8 * (i >> 2) + 4 * n + (i & 3); }

constexpr int GT_INT = 2624, GM_BYTE = 10760, GT_MAX = 1280;
struct Unit { int pm, pn, e, row0, cnt, chunk, arow, b1, b2, b3; };
struct Gemm { const bf16_t* A; const bf16_t* Bt; int lda, ldb, K; int noepi = 0; };

struct DenseOrder {
    static constexpr bool GATHER = false;
    int nM, nN, nwg, G, c;
    __device__ void init(int M, int N, int G_, int c_) { nM = M / BM; nN = N / BM; nwg = nM * nN; G = G_; c = c_; }
    __device__ bool next(int i, Unit& u) const {
        const long L = (long)i * G + c; if (L >= nwg) return false;
        int wgid = (int)L; { const int q = nwg / 8, r = nwg % 8, xcd = wgid % 8, off = wgid / 8; wgid = (xcd < r ? xcd * (q + 1) : r * (q + 1) + (xcd - r) * q) + off; }
        const int nig = 8 * nN, gid = wgid / nig, fm = gid * 8, gsz = (nM - fm) < 8 ? (nM - fm) : 8;
        u.pm = fm + ((wgid % nig) % gsz); u.pn = (wgid % nig) / gsz; u.e = 0; u.row0 = 0; u.cnt = 0; u.chunk = 0; return true;
    }
    __device__ __forceinline__ unsigned a_base(const Gemm& g, const Unit& u) const { return (unsigned)u.pm * (unsigned)(BM * 2) * (unsigned)g.lda; }
    __device__ __forceinline__ unsigned b_base(const Gemm& g, const Unit& u) const { return (unsigned)u.pn * (unsigned)(BM * 2) * (unsigned)g.ldb; }
    __device__ __forceinline__ unsigned row_off(const Gemm& g, const Unit& u, int lr) const { return (unsigned)lr * (unsigned)g.lda * 2u; }
};

template <bool GATHER_> struct MoeOrder {
    static constexpr bool GATHER = GATHER_;
    const LAS int* tab; const int* list; int ncol, G, c, c0, c1, nb_rows, skip_shared;
    __device__ bool next(int i, Unit& u) const {
        const int t0 = __builtin_amdgcn_readfirstlane(tab[2048 + c0]); int ntile = __builtin_amdgcn_readfirstlane(tab[2048 + c1]) - t0; if (skip_shared) ntile = __builtin_amdgcn_readfirstlane(tab[512 * c0 + NEXP]); int ti, pn;
        if (G == 256) { const int x = c & 7, slot = c >> 3, rt = 32 / ncol; ti = i * 8 * rt + x * rt + slot / ncol; pn = slot % ncol; if (ti >= ntile) return false; }
        else { const int L = i * G + c; if (L >= ntile * ncol) return false; ti = L / ncol; pn = L % ncol; }
        const int tg = t0 + ti; int k = c0; while (k + 1 < c1 && __builtin_amdgcn_readfirstlane(tab[2048 + k + 1]) <= tg) ++k;
        const int tl = tg - __builtin_amdgcn_readfirstlane(tab[2048 + k]); const LAS int* tk = tab + 512 * k;
        const int e = __builtin_amdgcn_readfirstlane(tk[144 + tl]);
        u.pm = tg; u.pn = pn; u.e = e; u.chunk = k; u.row0 = __builtin_amdgcn_readfirstlane((tl - tk[e]) * BM); u.cnt = __builtin_amdgcn_readfirstlane(tk[72 + e]);
        if (!GATHER) { int pc = 0; for (int kk = 0; kk < k; ++kk) pc += __builtin_amdgcn_readfirstlane(tab[512 * kk + 72 + e]);
            u.arow = __builtin_amdgcn_readfirstlane(tab[GT_INT + e]) * BM + pc + u.row0; }
        return true;
    }
    __device__ __forceinline__ unsigned a_base(const Gemm& g, const Unit& u) const { return GATHER ? 0u : (unsigned)u.arow * 2u * (unsigned)g.lda; }
    __device__ __forceinline__ unsigned b_base(const Gemm& g, const Unit& u) const { return ((unsigned)u.e * (unsigned)nb_rows + (unsigned)u.pn * BM) * (unsigned)g.ldb * 2u; }
    __device__ __forceinline__ int row_ent(const Gemm& g, const Unit& u, int lr) const { return 0; }
    __device__ __forceinline__ void prefetch_rows(const Gemm&, const Unit&, int, LAS unsigned char*) const {}
    __device__ __forceinline__ int row_ent_lds(LAS unsigned char*, int) const { return 0; }
    __device__ __forceinline__ unsigned row_fin(const Gemm& g, const Unit& u, int lr, int) const { return row_off(g, u, lr); }
    __device__ __forceinline__ unsigned row_off(const Gemm& g, const Unit& u, int lr) const {
        if (!GATHER) return (unsigned)lr * (unsigned)g.lda * 2u;
        const int pos = u.row0 + lr; int tl = 0;
        if (pos < u.cnt) tl = u.e == NEXP ? pos : (list[((size_t)u.chunk * NE1 + u.e) * CH_TOK + pos] >> 3);
        const unsigned tok = (unsigned)u.chunk * CH_TOK + (unsigned)tl;
        return tok * (unsigned)g.lda * 2u;
    }
};

struct MoeOrderG1 {
    static constexpr bool GATHER = true;
    const LAS int* tab; const int* list; int G, c, nb_rows;
    __device__ bool next(int i, Unit& u) const {
        static_assert(NCHUNK == 4, "chunk boundaries b1..b3");
        const int ntile = __builtin_amdgcn_readfirstlane(tab[GT_INT + NE1]); constexpr int ncol = 4, rt = 32 / ncol; int ti, pn;
        if (G == 256) { const int x = c & 7, slot = c >> 3; ti = i * 8 * rt + x * rt + slot / ncol; pn = slot % ncol; if (ti >= ntile) return false; }
        else { const int L = i * G + c; if (L >= ntile * ncol) return false; ti = L / ncol; pn = L % ncol; }
        const int e = __builtin_amdgcn_readfirstlane((int)((const LAS unsigned char*)tab)[GM_BYTE + ti]);
        const int n0 = __builtin_amdgcn_readfirstlane(tab[72 + e]), n1 = __builtin_amdgcn_readfirstlane(tab[512 + 72 + e]), n2 = __builtin_amdgcn_readfirstlane(tab[1024 + 72 + e]), n3 = __builtin_amdgcn_readfirstlane(tab[1536 + 72 + e]);
        u.pm = ti; u.pn = pn; u.e = e; u.chunk = 0; u.row0 = (ti - __builtin_amdgcn_readfirstlane(tab[GT_INT + e])) * BM; u.b1 = n0; u.b2 = n0 + n1; u.b3 = n0 + n1 + n2; u.cnt = n0 + n1 + n2 + n3; u.arow = 0; return true;
    }
    __device__ __forceinline__ unsigned a_base(const Gemm& g, const Unit& u) const { return 0u; }
    __device__ __forceinline__ unsigned b_base(const Gemm& g, const Unit& u) const { return ((unsigned)u.e * (unsigned)nb_rows + (unsigned)u.pn * BM) * (unsigned)g.ldb * 2u; }
    __device__ __forceinline__ unsigned row_off(const Gemm& g, const Unit& u, int lr) const {
        return row_fin(g, u, lr, row_ent(g, u, lr));
    }
    __device__ __forceinline__ int row_ent(const Gemm& g, const Unit& u, int lr) const {
        const int pos = u.row0 + lr; const bool valid = pos < u.cnt;
        const int k = (pos >= u.b1) + (pos >= u.b2) + (pos >= u.b3); int base = pos >= u.b1 ? u.b1 : 0; base = pos >= u.b2 ? u.b2 : base; base = pos >= u.b3 ? u.b3 : base;
        const int idx = (valid && u.e != NEXP) ? (k * NE1 + u.e) * CH_TOK + (pos - base) : 0;
        return list[idx];
    }
    static constexpr int LDS_GL = STAGE_BYTES + 8448;
    __device__ __forceinline__ void prefetch_rows(const Gemm& g, const Unit& u, int wid, LAS unsigned char* lds) const {
        if (wid < 4) { int l_ = threadIdx.x; asm volatile("" : "+v"(l_)); const int lr = wid * 64 + (l_ & 63);
            const int pos = u.row0 + lr; const bool valid = pos < u.cnt;
            const int k = (pos >= u.b1) + (pos >= u.b2) + (pos >= u.b3); int base = pos >= u.b1 ? u.b1 : 0; base = pos >= u.b2 ? u.b2 : base; base = pos >= u.b3 ? u.b3 : base;
            const int idx = (valid && u.e != NEXP) ? (k * NE1 + u.e) * CH_TOK + (pos - base) : 0;
            const int* gp = list + idx; const unsigned ldsa = (unsigned)(size_t)(lds + LDS_GL + wid * 256);
            asm volatile("s_mov_b32 m0, %0\n\ts_nop 0\n\tglobal_load_lds_dword %1, off" :: "s"(ldsa), "v"(gp) : "memory", "m0"); } }
    __device__ __forceinline__ int row_ent_lds(LAS unsigned char* lds, int lr) const { return *(const LAS int*)(lds + LDS_GL + lr * 4); }
    __device__ __forceinline__ unsigned row_fin(const Gemm& g, const Unit& u, int lr, int ent) const {
        const int pos = u.row0 + lr; const bool valid = pos < u.cnt;
        const int k = (pos >= u.b1) + (pos >= u.b2) + (pos >= u.b3); int base = pos >= u.b1 ? u.b1 : 0; base = pos >= u.b2 ? u.b2 : base; base = pos >= u.b3 ? u.b3 : base;
        const int tl = u.e == NEXP ? pos - base : (ent >> 3);
        const unsigned tok = valid ? (unsigned)k * CH_TOK + (unsigned)tl : 0u;
        return tok * (unsigned)g.lda * 2u;
    }
};

template <class...> using void_t_ = void;
template <class E, class = void> struct EpiScale { static constexpr int A = 0x7f7f7f7f, B = 0x7f7f7f7f; };
template <class E> struct EpiScale<E, void_t_<decltype(E::SCALE_A)>> { static constexpr int A = E::SCALE_A, B = E::SCALE_B; };
template <class Epi, class Sched>
__device__ __forceinline__ void gemm_phase(LAS unsigned char* lds, const Gemm g, const Sched& S, const Epi& E) {
    int tid_ = threadIdx.x; asm volatile("" : "+v"(tid_));
    const int tid = tid_, wid = __builtin_amdgcn_readfirstlane(tid >> 6), lane = tid & 63, wr = wid >> 2, wc = wid & 3, fr = lane & 15, fq = lane >> 4;
    int K_ = g.K; asm volatile("" : "+s"(K_));
    const int K = K_, nt = K / BK;
    int Rr[2]; unsigned cA2[2], voffB[2];
#pragma unroll
    for (int i = 0; i < 2; ++i) { int R, C; stage_rc(tid * 16 + i * 8192, R, C); const int Rb = Epi::PERM == 2 ? (64 * (R >> 5) + 16 * ((R >> 2) & 3) + 4 * ((R >> 4) & 1) + (R & 3)) : Epi::PERM == 1 ? ((R & ~31) + perm32(R & 31)) : R;
        Rr[i] = R; cA2[i] = (unsigned)C * 2u; voffB[i] = (unsigned)(Rb * g.ldb + C) * 2u; }
    const unsigned kstep = (unsigned)(BK * 2);
    const unsigned hstepB = (unsigned)(Epi::PERM == 2 ? 8 : HALF) * (unsigned)g.ldb * 2u;
    const char* const Ab = (const char*)g.A; const char* const Bb = (const char*)g.Bt;
    const unsigned ldsw = (unsigned)wid * 1024u;
    const int aoff = lds_byte(wr * 64 + fr, fq * 8), boff = lds_byte(wc * 32 + fr, fq * 8);
#define PG8_SA(b, h) (((b) * 2 + (h)) * HTB)
#define PG8_SB(b, h) ((4 + (b) * 2 + (h)) * HTB)
#define PG8_STAGE_B(bufoff, gbase, h) do { _Pragma("unroll") for (int _i = 0; _i < 2; ++_i) \
        __builtin_amdgcn_global_load_lds((const unsigned*)(Bb + (size_t)((gbase) + (unsigned)(h) * hstepB + voffB[_i])), (LAS unsigned*)(lds + (bufoff) + ldsw + _i * 8192), 16, 0, 0); } while (0)
#define PG8_STAGE_A(bufoff, gbase, V, h) do { _Pragma("unroll") for (int _i = 0; _i < 2; ++_i) \
        __builtin_amdgcn_global_load_lds((const unsigned*)(Ab + (size_t)((gbase) + (V)[h][_i])), (LAS unsigned*)(lds + (bufoff) + ldsw + _i * 8192), 16, 0, 0); } while (0)
#define PG8_LDA(dst, b, h) do { _Pragma("unroll") for (int m = 0; m < 4; ++m) _Pragma("unroll") for (int k = 0; k < 2; ++k) dst[m][k] = *(const LAS bf16x8*)(lds + PG8_SA(b, h) + aoff + m * 2048 + k * 1024); } while (0)
#define PG8_LDB(dst, b, h) do { _Pragma("unroll") for (int n = 0; n < 2; ++n) _Pragma("unroll") for (int k = 0; k < 2; ++k) dst[n][k] = *(const LAS bf16x8*)(lds + PG8_SB(b, h) + boff + n * 2048 + k * 1024); } while (0)
#define PG8_MMA(ai, bj, At, Bt) do { __builtin_amdgcn_s_setprio(1); _Pragma("unroll") for (int m = 0; m < 4; ++m) _Pragma("unroll") for (int n = 0; n < 2; ++n) { \
        if constexpr (Epi::FP8) { i32x8 bv_, av_; { const u32x4 b0_ = *(const u32x4*)&Bt[n][0], b1_ = *(const u32x4*)&Bt[n][1], a0_ = *(const u32x4*)&At[m][0], a1_ = *(const u32x4*)&At[m][1]; \
                bv_ = (i32x8){(int)b0_[0], (int)b0_[1], (int)b0_[2], (int)b0_[3], (int)b1_[0], (int)b1_[1], (int)b1_[2], (int)b1_[3]}; av_ = (i32x8){(int)a0_[0], (int)a0_[1], (int)a0_[2], (int)a0_[3], (int)a1_[0], (int)a1_[1], (int)a1_[2], (int)a1_[3]}; } \
            acc[ai][bj][m][n] = __builtin_amdgcn_mfma_scale_f32_16x16x128_f8f6f4(bv_, av_, acc[ai][bj][m][n], 0, 0, 0, EpiScale<Epi>::A, 0, EpiScale<Epi>::B); } \
        else { _Pragma("unroll") for (int k = 0; k < 2; ++k) acc[ai][bj][m][n] = __builtin_amdgcn_mfma_f32_16x16x32_bf16(Bt[n][k], At[m][k], acc[ai][bj][m][n], 0, 0, 0); } } \
        __builtin_amdgcn_s_setprio(0); } while (0)
#define PG8_WAIT_V(n) asm volatile("s_waitcnt vmcnt(" #n ")" ::: "memory")
#define PG8_WAIT_L(n) asm volatile("s_waitcnt lgkmcnt(" #n ")" ::: "memory")
#define PG8_BAR __builtin_amdgcn_s_barrier()
#define PG8_SCHED __builtin_amdgcn_sched_barrier(0)
#define PG8_ROWS(V, u, FROM_LDS) do { if constexpr (Sched::GATHER) { int ent_[2][2]; \
            _Pragma("unroll") for (int _h = 0; _h < 2; ++_h) _Pragma("unroll") for (int _i = 0; _i < 2; ++_i) ent_[_h][_i] = (FROM_LDS) ? S.row_ent_lds(lds, _h * HALF + Rr[_i]) : S.row_ent(g, (u), _h * HALF + Rr[_i]); \
            asm volatile("" : "+v"(ent_[0][0]), "+v"(ent_[0][1]), "+v"(ent_[1][0]), "+v"(ent_[1][1]));        \
            _Pragma("unroll") for (int _h = 0; _h < 2; ++_h) _Pragma("unroll") for (int _i = 0; _i < 2; ++_i) (V)[_h][_i] = S.row_fin(g, (u), _h * HALF + Rr[_i], ent_[_h][_i]) + cA2[_i]; } \
        else { _Pragma("unroll") for (int _h = 0; _h < 2; ++_h) _Pragma("unroll") for (int _i = 0; _i < 2; ++_i) (V)[_h][_i] = S.row_off(g, (u), _h * HALF + Rr[_i]) + cA2[_i]; } } while (0)
    Unit cur, nxt; int ui = 0;
    if (!S.next(0, cur)) return;
    f32x4 acc[2][2][4][2];
    bf16x8 At[4][2], B0[2][2], B1[2][2];
    unsigned vA[2][2];
    PG8_ROWS(vA, cur, 0);
    unsigned cA = S.a_base(g, cur), cB = S.b_base(g, cur);
    PG8_STAGE_B(PG8_SB(0, 0), cB, 0); PG8_STAGE_A(PG8_SA(0, 0), cA, vA, 0); PG8_STAGE_B(PG8_SB(0, 1), cB, 1); PG8_STAGE_A(PG8_SA(0, 1), cA, vA, 1);
    if (wr == 1) PG8_BAR;
    PG8_WAIT_V(4); PG8_BAR;
    PG8_STAGE_B(PG8_SB(1, 0), cB + kstep, 0); PG8_STAGE_A(PG8_SA(1, 0), cA + kstep, vA, 0); PG8_STAGE_B(PG8_SB(1, 1), cB + kstep, 1);
    PG8_WAIT_V(6); PG8_BAR;
#pragma unroll
    for (int a = 0; a < 2; ++a)
#pragma unroll
        for (int b = 0; b < 2; ++b)
#pragma unroll
            for (int m = 0; m < 4; ++m)
#pragma unroll
                for (int n = 0; n < 2; ++n) acc[a][b][m][n] = (f32x4){0.f, 0.f, 0.f, 0.f};
    for (;;) {
        const bool has_next = S.next(ui + 1, nxt);
        const unsigned nA = has_next ? S.a_base(g, nxt) : cA, nB = has_next ? S.b_base(g, nxt) : cB;
#pragma nounroll
        for (int t = 0; t < nt; t += 2) {
            const bool last = (t == nt - 2);
            if constexpr (Epi::PREFETCH) { if (last) E.prefetch(cur, wid, lds); }
            if constexpr (Sched::GATHER) { if (t == 0 && has_next) S.prefetch_rows(g, nxt, wid, lds); }
            asm volatile("" : "+v"(vA[0][0]), "+v"(vA[0][1]), "+v"(vA[1][0]), "+v"(vA[1][1]), "+v"(voffB[0]), "+v"(voffB[1]));
            const unsigned a1 = cA + (unsigned)(t + 1) * kstep;
            const unsigned a2 = last ? nA : cA + (unsigned)(t + 2) * kstep, b2 = last ? nB : cB + (unsigned)(t + 2) * kstep;
            const unsigned a3 = a2 + kstep, b3 = b2 + kstep;
            PG8_LDB(B0, 0, 0); PG8_SCHED; PG8_LDA(At, 0, 0); PG8_STAGE_A(PG8_SA(1, 1), a1, vA, 1);
            if (Sched::GATHER) { if (last && has_next) PG8_ROWS(vA, nxt, 1); }
            PG8_WAIT_L(8); PG8_BAR; PG8_WAIT_L(0); PG8_MMA(0, 0, At, B0); PG8_BAR; PG8_SCHED;
            PG8_LDB(B1, 0, 1); PG8_STAGE_B(PG8_SB(0, 0), b2, 0);
            PG8_BAR; PG8_WAIT_L(0); PG8_MMA(0, 1, At, B1); PG8_BAR;
            PG8_LDA(At, 0, 1); PG8_STAGE_A(PG8_SA(0, 0), a2, vA, 0);
            PG8_BAR; PG8_WAIT_L(0); PG8_MMA(1, 0, At, B0); PG8_BAR; PG8_SCHED;
            PG8_STAGE_B(PG8_SB(0, 1), b2, 1);
            PG8_WAIT_V(6); PG8_BAR; PG8_MMA(1, 1, At, B1); PG8_BAR;
            PG8_LDB(B0, 1, 0); PG8_SCHED; PG8_LDA(At, 1, 0); PG8_STAGE_A(PG8_SA(0, 1), a2, vA, 1);
            PG8_WAIT_L(8); PG8_BAR; PG8_WAIT_L(0); PG8_MMA(0, 0, At, B0); PG8_BAR; PG8_SCHED;
            PG8_LDB(B1, 1, 1); PG8_STAGE_B(PG8_SB(1, 0), b3, 0);
            PG8_BAR; PG8_WAIT_L(0); PG8_MMA(0, 1, At, B1); PG8_BAR;
            PG8_LDA(At, 1, 1); PG8_STAGE_A(PG8_SA(1, 0), a3, vA, 0);
            PG8_BAR; PG8_WAIT_L(0); PG8_MMA(1, 0, At, B0); PG8_BAR; PG8_SCHED;
            PG8_STAGE_B(PG8_SB(1, 1), b3, 1);
            PG8_WAIT_V(6); PG8_BAR; PG8_MMA(1, 1, At, B1); PG8_BAR;
        }
        { int z_ = 0; asm volatile("" : "+v"(z_));
          if (PROBE_NOSTORE && g.noepi) { asm volatile("" :: "v"(acc[0][0][0][0]), "v"(acc[1][1][3][1]), "v"(acc[0][1][2][1]), "v"(acc[1][0][1][0])); }
          else if constexpr (Epi::PREFETCH) E.epi(acc, cur, wr, wc, fr + z_, fq + z_, lds); else E(acc, cur, wr, wc, fr + z_, fq + z_); }
        if (!has_next) break;
#pragma unroll
        for (int a = 0; a < 2; ++a)
#pragma unroll
            for (int b = 0; b < 2; ++b)
#pragma unroll
                for (int m = 0; m < 4; ++m)
#pragma unroll
                    for (int n = 0; n < 2; ++n) acc[a][b][m][n] = (f32x4){0.f, 0.f, 0.f, 0.f};
        cur = nxt; cA = nA; cB = nB; ++ui;
    }
    PG8_WAIT_V(0);
    if (wr == 0) PG8_BAR;
    PG8_BAR;
#undef PG8_SA
#undef PG8_SB
#undef PG8_STAGE_A
#undef PG8_STAGE_B
#undef PG8_LDA
#undef PG8_LDB
#undef PG8_MMA
#undef PG8_WAIT_V
#undef PG8_WAIT_L
#undef PG8_BAR
#undef PG8_SCHED
#undef PG8_ROWS
}
}
using pg8::Unit;
constexpr int LDS_STAGE_BYTES = pg8::STAGE_BYTES;
typedef f32x4 AccT[2][2][4][2];

struct EpiProj {
    static constexpr int PERM = 1; static constexpr bool FP8 = true, PREFETCH = false;
    static constexpr int SCALE_A = 0x7b7b7b7b, SCALE_B = 0x79797979;
    bf16_t* Z; float* ssqp;
    __device__ __forceinline__ void operator()(const AccT& acc, const Unit& u, int wr, int wc, int fr, int fq) const {
        const int row0 = u.pm * 256 + wr * 64 + fr, col0 = u.pn * 256 + wc * 32 + 8 * fq;
        const bool st = u.pn <= 2; const int slot = u.pn * 4 + wc;
#pragma unroll
        for (int ai = 0; ai < 2; ++ai)
#pragma unroll
            for (int m = 0; m < 4; ++m) { const int row = row0 + ai * 128 + m * 16; bf16_t* rp = Z + (size_t)row * ZW + col0;
#pragma unroll
                for (int bj = 0; bj < 2; ++bj) *(u32x4*)(rp + bj * 128) = pack8(acc[ai][bj][m][0], acc[ai][bj][m][1]); }
        if (st) { float sv[8];
#pragma unroll
            for (int ai = 0; ai < 2; ++ai)
#pragma unroll
                for (int m = 0; m < 4; ++m) { float s = 0.f;
#pragma unroll
                    for (int bj = 0; bj < 2; ++bj) { const f32x4 v0 = acc[ai][bj][m][0], v1 = acc[ai][bj][m][1];
                        s += v0[0] * v0[0] + v0[1] * v0[1] + v0[2] * v0[2] + v0[3] * v0[3] + v1[0] * v1[0] + v1[1] * v1[1] + v1[2] * v1[2] + v1[3] * v1[3]; }
                    sv[ai * 4 + m] = s; }
            float o0, o1; reduce8_fq(sv, o0, o1);
            const int r0 = 2 * fq, r1 = 2 * fq + 1;
            ssqp[(size_t)(row0 + (r0 >> 2) * 128 + (r0 & 3) * 16) * 12 + slot] = o0; ssqp[(size_t)(row0 + (r1 >> 2) * 128 + (r1 & 3) * 16) * 12 + slot] = o1; }
    }
};
struct EpiQup {
    static constexpr int PERM = 1; static constexpr bool FP8 = false, PREFETCH = false;
    bf16_t* Q; const float* ssqp;
    __device__ __forceinline__ void operator()(const AccT& acc, const Unit& u, int wr, int wc, int fr, int fq) const {
        const int row0 = u.pm * 256 + wr * 64 + fr, col0 = u.pn * 256 + wc * 32 + 8 * fq;
        float scv[2][4];
#pragma unroll
        for (int ai = 0; ai < 2; ++ai)
#pragma unroll
            for (int m = 0; m < 4; ++m) { const int row = row0 + ai * 128 + m * 16; const f32x4 p0 = *(const f32x4*)(ssqp + (size_t)row * 12), p1 = *(const f32x4*)(ssqp + (size_t)row * 12 + 4); scv[ai][m] = rsqrtf((((p0[0] + p0[1]) + (p0[2] + p0[3])) + ((p1[0] + p1[1]) + (p1[2] + p1[3]))) * (1.0f / 512.0f) + RMS_EPS); }
#pragma unroll
        for (int ai = 0; ai < 2; ++ai)
#pragma unroll
            for (int m = 0; m < 4; ++m) { const int row = row0 + ai * 128 + m * 16; const float sc = scv[ai][m]; bf16_t* rp = Q + (size_t)row * QW + col0;
#pragma unroll
                for (int bj = 0; bj < 2; ++bj) *(u32x4*)(rp + bj * 128) = pack8(acc[ai][bj][m][0] * sc, acc[ai][bj][m][1] * sc); }
    }
};
struct EpiKV {
    static constexpr int PERM = 1; static constexpr bool FP8 = false, PREFETCH = false;
    bf16_t* Kb; bf16_t* Vb; const float* ssqp;
    __device__ __forceinline__ void operator()(const AccT& acc, const Unit& u, int wr, int wc, int fr, int fq) const {
        const int row0 = u.pm * 256 + wr * 64 + fr, c0 = wc * 32 + 8 * fq;
        float scv[2][4];
#pragma unroll
        for (int ai = 0; ai < 2; ++ai)
#pragma unroll
            for (int m = 0; m < 4; ++m) { const int row = row0 + ai * 128 + m * 16; const f32x4 p2 = *(const f32x4*)(ssqp + (size_t)row * 12 + 8); scv[ai][m] = rsqrtf(((p2[0] + p2[1]) + (p2[2] + p2[3])) * (1.0f / 256.0f) + RMS_EPS); }
#pragma unroll
        for (int ai = 0; ai < 2; ++ai)
#pragma unroll
            for (int m = 0; m < 4; ++m) { const int row = row0 + ai * 128 + m * 16; const float sc = scv[ai][m];
                *(u32x4*)(Kb + (size_t)row * QW + u.pn * 192 + c0) = pack8(acc[ai][0][m][0] * sc, acc[ai][0][m][1] * sc);
                *(u32x4*)(Vb + (size_t)row * 1024 + u.pn * 128 + c0) = pack8(acc[ai][1][m][0] * sc, acc[ai][1][m][1] * sc); }
    }
};
struct EpiPlain {
    static constexpr int PERM = 1; static constexpr bool FP8 = false, PREFETCH = false;
    bf16_t* O; int ld;
    __device__ __forceinline__ void operator()(const AccT& acc, const Unit& u, int wr, int wc, int fr, int fq) const {
        const int row0 = u.pm * 256 + wr * 64 + fr, col0 = u.pn * 256 + wc * 32 + 8 * fq;
#pragma unroll
        for (int ai = 0; ai < 2; ++ai)
#pragma unroll
            for (int m = 0; m < 4; ++m) { bf16_t* rp = O + (size_t)(row0 + ai * 128 + m * 16) * ld + col0;
#pragma unroll
                for (int bj = 0; bj < 2; ++bj) *(u32x4*)(rp + bj * 128) = pack8(acc[ai][bj][m][0], acc[ai][bj][m][1]); }
    }
};
struct EpiWout {
    static constexpr int PERM = 0; static constexpr bool FP8 = true, PREFETCH = false;
    static constexpr int SCALE_A = 0x7b7b7b7b, SCALE_B = 0x79797979;
    const float* X; float* H;
    __device__ __forceinline__ void operator()(const AccT& acc, const Unit& u, int wr, int wc, int fr, int fq) const {
        const int row0 = u.pm * 256 + wr * 64 + fr, col0 = u.pn * 256 + wc * 32 + 4 * fq;
#pragma unroll
        for (int ai = 0; ai < 2; ++ai) { f32x4 xv[4][2][2];
#pragma unroll
            for (int m = 0; m < 4; ++m)
#pragma unroll
                for (int bj = 0; bj < 2; ++bj)
#pragma unroll
                    for (int n = 0; n < 2; ++n) xv[m][bj][n] = *(const f32x4*)(X + (size_t)(row0 + ai * 128 + m * 16) * DM + col0 + bj * 128 + n * 16);
#pragma unroll
            for (int m = 0; m < 4; ++m)
#pragma unroll
                for (int bj = 0; bj < 2; ++bj)
#pragma unroll
                    for (int n = 0; n < 2; ++n) *(f32x4*)(H + (size_t)(row0 + ai * 128 + m * 16) * DM + col0 + bj * 128 + n * 16) = xv[m][bj][n] + acc[ai][bj][m][n]; }
    }
};
struct EpiMoe1 {
    static constexpr int PERM = 1; static constexpr bool FP8 = true, PREFETCH = false;
    unsigned char* Hmid;
    __device__ __forceinline__ void operator()(const AccT& acc, const Unit& u, int wr, int wc, int fr, int fq) const {
        const int row0 = u.pm * 256 + wr * 64 + fr, c0 = u.pn * 128 + wc * 32 + 8 * fq; constexpr float SC = 1.0f / 1024.0f;
#pragma unroll
        for (int ai = 0; ai < 2; ++ai)
#pragma unroll
            for (int m = 0; m < 4; ++m) { float h0[4], h1[4];
#pragma unroll
                for (int j = 0; j < 4; ++j) { const float a0 = acc[ai][0][m][0][j], a1 = acc[ai][0][m][1][j];
                    h0[j] = a0 * acc[ai][1][m][0][j] * (SC * SC * 4.0f) * __builtin_amdgcn_rcpf(1.0f + __builtin_amdgcn_exp2f(a0 * (-SC * 1.44269504f)));
                    h1[j] = a1 * acc[ai][1][m][1][j] * (SC * SC * 4.0f) * __builtin_amdgcn_rcpf(1.0f + __builtin_amdgcn_exp2f(a1 * (-SC * 1.44269504f))); }
                u32x2 w; w.x = pk_fp8x4(h0[0], h0[1], h0[2], h0[3]); w.y = pk_fp8x4(h1[0], h1[1], h1[2], h1[3]);
                *(u32x2*)(Hmid + (size_t)(row0 + ai * 128 + m * 16) * 512 + c0) = w; }
    }
};
struct EpiMoe2 {
    static constexpr int PERM = 2; static constexpr bool FP8 = true, PREFETCH = true;
    static constexpr int LDS_RI = LDS_STAGE_BYTES + 8448;
    unsigned char* Y; const i32x2* rinfo; float* H; int chunk, nostore;
    __device__ __forceinline__ void prefetch(const Unit& u, int wid, LAS unsigned char* lds) const {
        if (wid < 2) { int l_ = threadIdx.x; asm volatile("" : "+v"(l_));
            const unsigned ldsa = (unsigned)(size_t)(lds + LDS_RI + wid * 1024); const i32x2* gp = rinfo + (size_t)u.pm * 256 + wid * 128 + (l_ & 63) * 2;
            asm volatile("s_mov_b32 m0, %0\n\ts_nop 0\n\tglobal_load_lds_dwordx4 %1, off" :: "s"(ldsa), "v"(gp) : "memory", "m0"); } }
    __device__ __forceinline__ void epi(const AccT& acc, const Unit& u, int wr, int wc, int fr, int fq, LAS unsigned char* lds) const {
        const int lr0 = wr * 64 + fr, col0 = u.pn * 256 + wc * 64 + 16 * fq; const LAS i32x2* rp0 = (const LAS i32x2*)(lds + LDS_RI) + lr0;
        if (u.e != NEXP) {
#pragma unroll
            for (int ai = 0; ai < 2; ++ai)
#pragma unroll
                for (int m = 0; m < 4; ++m) { const i32x2 ri = rp0[ai * 128 + m * 16]; const float w = __int_as_float(ri.y) * 16.0f; unsigned char* rp = Y + (size_t)ri.x * DM + col0;
                    u32x4 w8;
#pragma unroll
                    for (int bj = 0; bj < 2; ++bj) { const f32x4 y0 = acc[ai][bj][m][0] * w, y1 = acc[ai][bj][m][1] * w;
                        w8[2 * bj] = __builtin_amdgcn_cvt_pk_fp8_f32(y0[2], y0[3], __builtin_amdgcn_cvt_pk_fp8_f32(y0[0], y0[1], 0, false), true);
                        w8[2 * bj + 1] = __builtin_amdgcn_cvt_pk_fp8_f32(y1[2], y1[3], __builtin_amdgcn_cvt_pk_fp8_f32(y1[0], y1[1], 0, false), true); }
                    if (nostore && PROBE_NOSTORE) asm volatile("" :: "v"(w8)); else *(u32x4*)rp = w8; }
        } else {
#pragma unroll
            for (int ai = 0; ai < 2; ++ai) { f32x4 hv[4][2][2]; i32x2 ri[4];
#pragma unroll
                for (int m = 0; m < 4; ++m) { ri[m] = rp0[ai * 128 + m * 16]; const float* hp = H + ((size_t)chunk * CH_TOK + (size_t)(-2 - ri[m].x)) * DM + col0;
#pragma unroll
                    for (int bj = 0; bj < 2; ++bj) { hv[m][bj][0] = *(const f32x4*)(hp + bj * 8); hv[m][bj][1] = *(const f32x4*)(hp + bj * 8 + 4); } }
#pragma unroll
                for (int m = 0; m < 4; ++m) { const float w = __int_as_float(ri[m].y); float* hp = H + ((size_t)chunk * CH_TOK + (size_t)(-2 - ri[m].x)) * DM + col0;
#pragma unroll
                    for (int bj = 0; bj < 2; ++bj) { *(f32x4*)(hp + bj * 8) = hv[m][bj][0] + acc[ai][bj][m][0] * w; *(f32x4*)(hp + bj * 8 + 4) = hv[m][bj][1] + acc[ai][bj][m][1] * w; } } }
        }
    }
};
struct EpiGate {
    static constexpr int PERM = 1; static constexpr bool FP8 = true, PREFETCH = false;
    const bf16_t* PP; const float* bias; bf16_t* U; float* ssq_u; int noepi;
    __device__ __forceinline__ void operator()(const AccT& acc, const Unit& u, int wr, int wc, int fr, int fq) const {
        if (noepi && PROBE_NOSTORE) { asm volatile("" :: "v"(acc[0][0][0][0][0]), "v"(acc[1][1][3][1][3])); return; }
        const int row0 = u.pm * 256 + wr * 64 + fr, col0 = u.pn * 256 + wc * 32 + 8 * fq;
        float ssr[2][4];
#pragma unroll
        for (int ai = 0; ai < 2; ++ai)
#pragma unroll
            for (int m = 0; m < 4; ++m) ssr[ai][m] = 0.f;
        u32x4 ppr[2][2][4];
        f32x4 bb[2][2];
#pragma unroll
        for (int bj = 0; bj < 2; ++bj) { bb[bj][0] = *(const f32x4*)(bias + col0 + bj * 128); bb[bj][1] = *(const f32x4*)(bias + col0 + bj * 128 + 4); }
#pragma unroll
        for (int bj = 0; bj < 2; ++bj) { const f32x4 b0 = bb[bj][0], b1 = bb[bj][1];
#pragma unroll
            for (int ai = 0; ai < 2; ++ai)
#pragma unroll
                for (int m = 0; m < 4; ++m) ppr[bj][ai][m] = *(const u32x4*)(PP + (size_t)(row0 + ai * 128 + m * 16) * DM + col0 + bj * 128);
#pragma unroll
            for (int ai = 0; ai < 2; ++ai)
#pragma unroll
                for (int m = 0; m < 4; ++m) { const size_t off = (size_t)(row0 + ai * 128 + m * 16) * DM + col0 + bj * 128; float pp[8]; unpack8(ppr[bj][ai][m], pp);
                    const f32x4 a0 = acc[ai][bj][m][0] * (1.0f / 1024.0f) + b0, a1 = acc[ai][bj][m][1] * (1.0f / 1024.0f) + b1; float uu[8]; float s = 0.f;
#pragma unroll
                    for (int e = 0; e < 4; ++e) { uu[e] = pp[e] * sigmoidf_(a0[e]); uu[4 + e] = pp[4 + e] * sigmoidf_(a1[e]); }
#pragma unroll
                    for (int e = 0; e < 8; ++e) s += uu[e] * uu[e];
                    *(u32x4*)(U + off) = packf8(uu); ssr[ai][m] += s; } }
        { float sv[8];
#pragma unroll
          for (int r = 0; r < 8; ++r) sv[r] = ssr[r >> 2][r & 3];
          float o0, o1; reduce8_fq(sv, o0, o1); const int r0 = 2 * fq, r1 = 2 * fq + 1;
          ssq_u[(size_t)(row0 + (r0 >> 2) * 128 + (r0 & 3) * 16) * 32 + u.pn * 4 + wc] = o0; ssq_u[(size_t)(row0 + (r1 >> 2) * 128 + (r1 & 3) * 16) * 32 + u.pn * 4 + wc] = o1; }
    }
};

#define XB_TMO      128
#define XB_XCNT(j)  (256  + 64 * (j))
#define XB_XSUB(j)  (1280 + 64 * (j))
#define XB_XGEN(j)  (2304 + 64 * (j))
#define XB_TOP      3328
#define XB_TOPGEN   3392
#define XCD_BAR_WORDS 3456
#define XB_SPIN_CAP (1u << 22)
__device__ __forceinline__ unsigned xb_ld(unsigned* p)              { return __hip_atomic_load(p, __ATOMIC_RELAXED, __HIP_MEMORY_SCOPE_AGENT); }
__device__ __forceinline__ unsigned xb_add(unsigned* p, unsigned v) { return __hip_atomic_fetch_add(p, v, __ATOMIC_RELAXED, __HIP_MEMORY_SCOPE_AGENT); }
__device__ __forceinline__ unsigned xb_xcc_id() { return (unsigned)__builtin_amdgcn_s_getreg((3 << 11) | 20) & 0xFu; }
#define XB_SPIN(cond, bar) do { unsigned _sp = 0; while (cond) { __builtin_amdgcn_s_sleep(1); \
    if ((++_sp & 255u) == 0u) { if (xb_ld(&(bar)[XB_TMO])) break; if (_sp > XB_SPIN_CAP) { atomicAdd(&(bar)[XB_TMO], 1u); break; } } } } while (0)
struct XcdBarrier { unsigned* bar; unsigned x; volatile LAS unsigned* st; };
__device__ __forceinline__ XcdBarrier xcd_barrier_post(unsigned* bar, volatile LAS unsigned* st) {
    XcdBarrier b; b.bar = bar; b.x = xb_xcc_id(); b.st = st;
    if (threadIdx.x == 0) (void)xb_add(&bar[XB_XCNT(b.x)], 1u);
    return b;
}
__device__ __forceinline__ void xcd_barrier_complete(unsigned* bar, unsigned x, unsigned& nloc, unsigned& nx) {
    const unsigned G = gridDim.x * gridDim.y * gridDim.z;
    unsigned sum, cnt, mine, sp = 0u;
    for (;;) {
        sum = 0u; cnt = 0u; mine = 0u;
#pragma unroll
        for (unsigned j = 0; j < 16; ++j) { const unsigned c = xb_ld(&bar[XB_XCNT(j)]); sum += c; cnt += (c > 0u) ? 1u : 0u; mine = (j == x) ? c : mine; }
        if (sum == G) break;
        __builtin_amdgcn_s_sleep(1);
        if ((++sp & 255u) == 0u) { if (xb_ld(&bar[XB_TMO])) break; if (sp > XB_SPIN_CAP) { atomicAdd(&bar[XB_TMO], 1u); break; } }
    }
    nloc = mine > 0u ? mine : 1u; nx = cnt > 0u ? cnt : 1u;
}
__device__ __forceinline__ void xcd_barrier(const XcdBarrier& b) {
    asm volatile("s_waitcnt vmcnt(0)" ::: "memory");
    __syncthreads();
    if (threadIdx.x == 0) {
        unsigned* bar = b.bar;
        __builtin_amdgcn_s_waitcnt(0);
        unsigned nloc = b.st[0], nx = b.st[1];
        if (nloc == 0u) { xcd_barrier_complete(bar, b.x, nloc, nx); b.st[0] = nloc; b.st[1] = nx; }
        const unsigned old = xb_add(&bar[XB_XSUB(b.x)], 1u);
        const unsigned gen = old / nloc;
        if (old + 1u == (gen + 1u) * nloc) {
            __builtin_amdgcn_fence(__ATOMIC_RELEASE, "agent");
            asm volatile("s_waitcnt vmcnt(0)" ::: "memory");
            const unsigned og = xb_add(&bar[XB_TOP], 1u);
            const unsigned tg = og / nx;
            if (og + 1u == (tg + 1u) * nx) xb_add(&bar[XB_TOPGEN], 1u);
            else XB_SPIN(xb_ld(&bar[XB_TOPGEN]) == tg, bar);
            __builtin_amdgcn_fence(__ATOMIC_ACQUIRE, "agent");
            xb_add(&bar[XB_XGEN(b.x)], 1u);
            asm volatile("s_waitcnt vmcnt(0)" ::: "memory");
        } else {
            XB_SPIN(xb_ld(&bar[XB_XGEN(b.x)]) == gen, bar);
            __builtin_amdgcn_fence(__ATOMIC_ACQUIRE, "agent");
            asm volatile("s_waitcnt vmcnt(0)" ::: "memory");
        }
    }
    __syncthreads();
}

struct Args { const void* in[37]; float* out; unsigned char* ws; int ph_lo, ph_hi; };
enum { I_X = 0, I_P, I_POS, I_GMIX, I_WIN, I_GQA, I_WUQ, I_GKVA, I_WUKV, I_GQN, I_GKN, I_MU, I_W0, I_WW2, I_A0, I_AW2, I_GW2, I_KK, I_KA, I_RK, I_LNW, I_LNB,
       I_WOUT, I_GFFN, I_WR, I_RBIAS, I_WG, I_WU, I_WD, I_SG, I_SU, I_SD, I_GPIN, I_WPG, I_BPG, I_WPP, I_GPOUT };

typedef const __attribute__((address_space(4))) Args KArgs;
struct Ctx { int tid, lane, wid, gw, nw; LAS unsigned char* lds; };

__device__ __forceinline__ int in_map(int n) {
    if (n < 832) return n; if (n < 896) return 3904 + (n - 832); if (n < 960) return 3968 + (n - 896); if (n < 1120) return 4032 + (n - 960); if (n < 1280) return -1; return 832 + (n - 1280);
}
template <int MODE, bool OUT8 = false>
__device__ __forceinline__ void convert_weight(const Ctx& c, const float* src0, const float* src1, int ld_src, const float* g, bf16_t* dst, int K, int Nd, int blk, int nblk) {
    LAS float* tile = (LAS float*)c.lds;
    const int tk = K / 64, ntile = tk * (Nd / 128);
    const int n4 = c.tid & 31, kr = c.tid >> 5, sc = c.tid & 7, sn = c.tid >> 3;
    f32x4 v[4];
#define CW_LOAD(t_) do { const int n0_ = ((t_) / tk) * 128, k0_ = ((t_) % tk) * 64, n_ = n0_ + 4 * n4; const float* sp_ = nullptr; \
        if (MODE == 0) sp_ = src0 + n_; \
        if (MODE == 1) { const int cc_ = in_map(n_); sp_ = cc_ >= 0 ? src0 + cc_ : nullptr; } \
        if (MODE == 2) { const int half_ = (n_ >> 7) & 1, cc_ = (n_ >> 8) * 128 + (n_ & 127); sp_ = (half_ ? src1 : src0) + cc_; } \
        _Pragma("unroll") for (int i = 0; i < 4; ++i) { const int k_ = k0_ + kr + 16 * i; v[i] = sp_ ? *(const f32x4*)(sp_ + (size_t)k_ * ld_src) : (f32x4){0.f, 0.f, 0.f, 0.f}; if (g) v[i] *= g[k_]; if (OUT8) v[i] *= 64.0f; } } while (0)
    int t = blk; if (t < ntile) CW_LOAD(t);
    for (; t < ntile; t += nblk) {
#pragma unroll
        for (int i = 0; i < 4; ++i)
#pragma unroll
            for (int e = 0; e < 4; ++e) tile[(kr + 16 * i) * 129 + 4 * n4 + e] = v[i][e];
        __syncthreads();
        const int n0 = (t / tk) * 128, k0 = (t % tk) * 64;
        if (t + nblk < ntile) CW_LOAD(t + nblk);
#pragma unroll
        for (int i = 0; i < 2; ++i) { const int nl = sn + 64 * i; float f[8];
#pragma unroll
            for (int j = 0; j < 8; ++j) f[j] = tile[(8 * sc + j) * 129 + nl];
            if (OUT8) { u32x2 w8; w8.x = pk_fp8x4(f[0], f[1], f[2], f[3]); w8.y = pk_fp8x4(f[4], f[5], f[6], f[7]); *(u32x2*)((unsigned char*)dst + (size_t)(n0 + nl) * K + k0 + 8 * sc) = w8; }
            else *(u32x4*)(dst + (size_t)(n0 + nl) * K + k0 + 8 * sc) = (u32x4){cvt_pk_bf16(f[0], f[1]), cvt_pk_bf16(f[2], f[3]), cvt_pk_bf16(f[4], f[5]), cvt_pk_bf16(f[6], f[7])}; }
        __syncthreads();
    }
#undef CW_LOAD
}

__device__ __forceinline__ void rownorm_bf16(const float* src, bf16_t* dst, int lane) {
    f32x4 v[8]; float ss = 0.f;
#pragma unroll
    for (int i = 0; i < 8; ++i) { v[i] = *(const f32x4*)(src + (i * 64 + lane) * 4); ss += v[i][0] * v[i][0] + v[i][1] * v[i][1] + v[i][2] * v[i][2] + v[i][3] * v[i][3]; }
    ss = wave_sum(ss); const float rs = rsqrtf(ss * (1.0f / DM) + RMS_EPS);
#pragma unroll
    for (int i = 0; i < 8; ++i) { u32x2 w; w.x = cvt_pk_bf16(v[i][0] * rs, v[i][1] * rs); w.y = cvt_pk_bf16(v[i][2] * rs, v[i][3] * rs); *(u32x2*)(dst + (i * 64 + lane) * 4) = w; }
}

__device__ __forceinline__ void rownorm_both(const float* src, bf16_t* dst, unsigned char* dst8, int lane) {
    f32x4 v[8]; float ss = 0.f;
#pragma unroll
    for (int i = 0; i < 8; ++i) { v[i] = *(const f32x4*)(src + (i * 64 + lane) * 4); ss += v[i][0] * v[i][0] + v[i][1] * v[i][1] + v[i][2] * v[i][2] + v[i][3] * v[i][3]; }
    ss = wave_sum(ss); const float rs = rsqrtf(ss * (1.0f / DM) + RMS_EPS), rs8 = rs * 16.0f;
#pragma unroll
    for (int i = 0; i < 8; ++i) { u32x2 w; w.x = cvt_pk_bf16(v[i][0] * rs, v[i][1] * rs); w.y = cvt_pk_bf16(v[i][2] * rs, v[i][3] * rs); *(u32x2*)(dst + (i * 64 + lane) * 4) = w;
        *(unsigned*)(dst8 + (i * 64 + lane) * 4) = pk_fp8x4(v[i][0] * rs8, v[i][1] * rs8, v[i][2] * rs8, v[i][3] * rs8); }
}
__device__ __forceinline__ void rownorm_fp8(const float* src, unsigned char* dst, int lane) {
    f32x4 v[8]; float ss = 0.f;
#pragma unroll
    for (int i = 0; i < 8; ++i) { v[i] = *(const f32x4*)(src + (i * 64 + lane) * 4); ss += v[i][0] * v[i][0] + v[i][1] * v[i][1] + v[i][2] * v[i][2] + v[i][3] * v[i][3]; }
    ss = wave_sum(ss); const float rs = rsqrtf(ss * (1.0f / DM) + RMS_EPS) * 16.0f;
#pragma unroll
    for (int i = 0; i < 8; ++i) *(unsigned*)(dst + (i * 64 + lane) * 4) = pk_fp8x4(v[i][0] * rs, v[i][1] * rs, v[i][2] * rs, v[i][3] * rs);
}
__device__ __forceinline__ void phase_prep(const Ctx& c, KArgs* a) {
    unsigned char* ws = a->ws;
    { const float* x = (const float*)a->in[I_X]; bf16_t* xn = (bf16_t*)(ws + WS_XN);
      unsigned char* xn8 = (unsigned char*)a->out;
      for (int r = c.gw; r < NT; r += c.nw) rownorm_both(x + (size_t)r * DM, xn + (size_t)r * DM, xn8 + (size_t)r * DM, c.lane); }
    convert_weight<1, true>(c, (const float*)a->in[I_WIN], nullptr, 4192, (const float*)a->in[I_GMIX], (bf16_t*)(ws + OFF_WT_IN), 2048, ZC_R, blockIdx.x, gridDim.x);
    convert_weight<0>(c, (const float*)a->in[I_WIN] + 832, nullptr, 4192, (const float*)a->in[I_GMIX], (bf16_t*)(ws + OFF_WT_RKV), 2048, ZW - ZC_R, blockIdx.x, gridDim.x);
}
template <int PART  >
__device__ __forceinline__ void phase_prep_late(const Ctx& c, KArgs* a, int blk, int nblk) {
    unsigned char* ws = a->ws;
    if (PART == 0 || PART == 2) {
    { const int gt = blk * 512 + c.tid, nthr = nblk * 512;
      int* cnt = (int*)(ws + CTL_CNT); for (int i = gt; i < NCHUNK * NE1; i += nthr) cnt[i] = ((i % NE1) == NEXP) ? CH_TOK : 0; }
    { float* rt = (float*)(ws + OFF_ROPE); const int* pos = (const int*)a->in[I_POS]; const int gt = blk * 512 + c.tid, nthr = nblk * 512;
      for (int i = gt; i < NT * 32; i += nthr) { const int tok = i >> 5, fi = i & 31; const float inv_f = (float)exp2(-(double)fi * (13.287712379549449 / 32.0));
          const float ang = (float)pos[tok] * inv_f; double xr = (double)ang; xr -= 6.283185307179586 * rint(xr * 0.15915494309189535); const float rr = (float)xr;
          rt[2 * i] = __cosf(rr); rt[2 * i + 1] = __sinf(rr); } }
    }
    if (PART == 0 || PART == 2) { convert_weight<0>(c, (const float*)a->in[I_WUQ], nullptr, 1536, (const float*)a->in[I_GQA], (bf16_t*)(ws + OFF_WT_UQ), 512, 1536, blk, nblk);
    convert_weight<0>(c, (const float*)a->in[I_WUKV], nullptr, 2048, (const float*)a->in[I_GKVA], (bf16_t*)(ws + OFF_WT_UKV), 256, 2048, blk, nblk); }
    if (PART == 1 || PART == 2) convert_weight<0, true>(c, (const float*)a->in[I_WOUT], nullptr, 2048, nullptr, (bf16_t*)(ws + OFF_WT_OUT), 2048, 2048, blk, nblk);
    if (PART == 3 || PART == 2) {
    convert_weight<0, true>(c, (const float*)a->in[I_WPG], nullptr, 2048, (const float*)a->in[I_GPIN], (bf16_t*)(ws + OFF_WT_PG), 2048, 2048, blk, nblk);
    convert_weight<0>(c, (const float*)a->in[I_WPP], nullptr, 2048, nullptr, (bf16_t*)(ws + OFF_WT_PP), 256, 2048, blk, nblk); }
    if (PART == 0 || PART == 2) {
    { bf16_t* wl = (bf16_t*)(ws + OFF_WT_LORA); const float* ww2 = (const float*)a->in[I_WW2]; const float* aw2 = (const float*)a->in[I_AW2]; const float* gw2 = (const float*)a->in[I_GW2];
      const int gt = blk * 512 + c.tid, nthr = nblk * 512;
      for (int i = gt; i < LORA_N * LORA_K; i += nthr) { const int n = i / LORA_K, k = i % LORA_K; float v = 0.f;
          if (n < 1024) { if (k < 64) v = ww2[k * 1024 + n]; }
          else if (n < 2048) { if (k >= 64 && k < 128) v = aw2[(k - 64) * 1024 + (n - 1024)]; }
          else { if (k >= 128 && k < 288) v = gw2[(k - 128) * 1024 + (n - 2048)]; }
          wl[i] = f2bf(v); } }
    { u32x4* wf = (u32x4*)(ws + OFF_WRF); const float* wr = (const float*)a->in[I_WR]; const float* gf = (const float*)a->in[I_GFFN];
      const int gt = blk * 512 + c.tid, nthr = nblk * 512;
      for (int i = gt; i < 64 * 4 * 64; i += nthr) { const int l = i & 63, cc = (i >> 6) & 3, s = i >> 8; const int k0 = 32 * s + 8 * (l >> 4), n = 16 * cc + (l & 15);
          float w[8], lo[8];
#pragma unroll
          for (int j = 0; j < 8; ++j) w[j] = wr[(k0 + j) * 64 + n] * gf[k0 + j];
          const u32x4 hi = packf8(w); float h[8]; unpack8(hi, h);
#pragma unroll
          for (int j = 0; j < 8; ++j) lo[j] = w[j] - h[j];
          wf[((s * 4 + cc) * 2 + 0) * 64 + l] = hi; wf[((s * 4 + cc) * 2 + 1) * 64 + l] = packf8(lo); } }
    }
}

__device__ __forceinline__ void phase_finalize_qk(const Ctx& c, KArgs* a) {
    unsigned char* ws = a->ws; bf16_t* Qb = (bf16_t*)(ws + OFF_QB); bf16_t* Kb = (bf16_t*)(ws + OFF_KB); const bf16_t* Z = (const bf16_t*)(ws + OFF_Z); const float* rt = (const float*)(ws + OFF_ROPE);
    const float* gqn = (const float*)a->in[I_GQN]; const float* gkn = (const float*)a->in[I_GKN];
    const int lane = c.lane, h = lane >> 3, sx = lane & 7; const bool lowh = sx < 4;
    float gq[3][8], gk[3][8];
#pragma unroll
    for (int p = 0; p < 3; ++p)
#pragma unroll
        for (int e = 0; e < 8; ++e) { gq[p][e] = gqn[64 * p + 8 * sx + e]; gk[p][e] = gkn[64 * p + 8 * sx + e]; }
    for (int tok = c.gw; tok < NT; tok += c.nw) {
        float cs[8], sn[8];
        { const float* rp = rt + (size_t)tok * 64 + 16 * (sx & 3);
#pragma unroll
          for (int e4 = 0; e4 < 4; ++e4) { const f32x4 t4 = *(const f32x4*)(rp + 4 * e4); cs[2 * e4] = t4[0]; sn[2 * e4] = t4[1]; cs[2 * e4 + 1] = t4[2]; sn[2 * e4 + 1] = t4[3]; } }
        bf16_t* qp = Qb + (size_t)tok * QW + h * 192 + 8 * sx; bf16_t* kp = Kb + (size_t)tok * QW + h * 192 + 8 * sx;
        const u32x4 q0 = *(const u32x4*)qp, q1 = *(const u32x4*)(qp + 64), q2 = *(const u32x4*)(qp + 128);
        const u32x4 k0 = *(const u32x4*)kp, k1 = *(const u32x4*)(kp + 64), k2 = *(const u32x4*)(Z + (size_t)tok * ZW + ZC_KPE + 8 * sx);
        float f[3][8];
        unpack8(q0, f[0]); unpack8(q1, f[1]); unpack8(q2, f[2]);
        { float ss = 0.f;
#pragma unroll
          for (int p = 0; p < 3; ++p)
#pragma unroll
              for (int e = 0; e < 8; ++e) ss += f[p][e] * f[p][e];
          ss = allred8(ss); const float rs = rsqrtf(ss * (1.0f / 192.0f) + RMS_EPS) * QSCALE;
#pragma unroll
          for (int p = 0; p < 3; ++p)
#pragma unroll
              for (int e = 0; e < 8; ++e) f[p][e] *= rs * gq[p][e];
#pragma unroll
          for (int e = 0; e < 8; ++e) { const float oth = __shfl_xor(f[2][e], 4); f[2][e] = lowh ? (f[2][e] * cs[e] - oth * sn[e]) : (f[2][e] * cs[e] + oth * sn[e]); }
          *(u32x4*)qp = packf8(f[0]); *(u32x4*)(qp + 64) = packf8(f[1]); *(u32x4*)(qp + 128) = packf8(f[2]); }
        unpack8(k0, f[0]); unpack8(k1, f[1]); unpack8(k2, f[2]);
        { float ss = 0.f;
#pragma unroll
          for (int p = 0; p < 3; ++p)
#pragma unroll
              for (int e = 0; e < 8; ++e) ss += f[p][e] * f[p][e];
          ss = allred8(ss); const float rs = rsqrtf(ss * (1.0f / 192.0f) + RMS_EPS);
#pragma unroll
          for (int p = 0; p < 3; ++p)
#pragma unroll
              for (int e = 0; e < 8; ++e) f[p][e] *= rs * gk[p][e];
#pragma unroll
          for (int e = 0; e < 8; ++e) { const float oth = __shfl_xor(f[2][e], 4); f[2][e] = lowh ? (f[2][e] * cs[e] - oth * sn[e]) : (f[2][e] * cs[e] + oth * sn[e]); }
          *(u32x4*)kp = packf8(f[0]); *(u32x4*)(kp + 64) = packf8(f[1]); *(u32x4*)(kp + 128) = packf8(f[2]); }
    }
}

__device__ __forceinline__ int crow(int r, int hi) { return (r & 3) + 8 * (r >> 2) + 4 * hi; }
__device__ __forceinline__ void phase_attn_v1(const Ctx& c, KArgs* a) {
    unsigned char* ws = a->ws; const bf16_t* Qb = (const bf16_t*)(ws + OFF_QB); const bf16_t* Kb = (const bf16_t*)(ws + OFF_KB); const bf16_t* Vb = (const bf16_t*)(ws + OFF_VB);
    bf16_t* Ym = (bf16_t*)(ws + WS_XN);
    const int lane = c.lane, r32 = lane & 31, hi = lane >> 5;
    for (int it = c.gw; it < 8192; it += c.nw) {
        const int qb = 255 - (it >> 5), bh = it & 31, b = bh >> 3, h = bh & 7, q0 = qb * 32;
        const size_t tb = (size_t)b * SEQ;
        bf16x8 qr[12];
        { const bf16_t* qp = Qb + (tb + q0 + r32) * QW + h * 192 + hi * 8;
#pragma unroll
          for (int d0 = 0; d0 < 12; ++d0) qr[d0] = *(const bf16x8*)(qp + d0 * 16); }
        float m_reg = -1e30f, l_reg = 0.f; f32x16 o[4];
#pragma unroll
        for (int d = 0; d < 4; ++d)
#pragma unroll
            for (int r = 0; r < 16; ++r) o[d][r] = 0.f;
        const int ntile = (q0 + 31) / 64 + 1;
        for (int kt = 0; kt < ntile; ++kt) {
            const int kb = kt * 64;
            f32x16 p0, p1;
#pragma unroll
            for (int r = 0; r < 16; ++r) { p0[r] = 0.f; p1[r] = 0.f; }
            { const bf16_t* kp = Kb + (tb + kb + r32) * QW + h * 192 + hi * 8;
#pragma unroll
              for (int d0 = 0; d0 < 12; ++d0) { const bf16x8 b0 = *(const bf16x8*)(kp + d0 * 16); const bf16x8 b1 = *(const bf16x8*)(kp + (size_t)32 * QW + d0 * 16);
                  p0 = __builtin_amdgcn_mfma_f32_32x32x16_bf16(b0, qr[d0], p0, 0, 0, 0); p1 = __builtin_amdgcn_mfma_f32_32x32x16_bf16(b1, qr[d0], p1, 0, 0, 0); } }
            if (kb + 63 > q0) {
                const int dq = q0 + r32 - kb - 4 * hi; const float NEG = -__builtin_inff();
#pragma unroll
                for (int r = 0; r < 16; ++r) { const int cc = (r & 3) + 8 * (r >> 2); if (dq - cc < 0) p0[r] = NEG; if (dq - cc - 32 < 0) p1[r] = NEG; }
            }
            float pmax = p0[0];
#pragma unroll
            for (int r = 1; r < 16; ++r) pmax = fmaxf(pmax, p0[r]);
#pragma unroll
            for (int r = 0; r < 16; ++r) pmax = fmaxf(pmax, p1[r]);
            pmax = fmaxf(pmax, __shfl_xor(pmax, 32));
            const float mn = fmaxf(m_reg, pmax); const float alpha = __builtin_amdgcn_exp2f(m_reg - mn); m_reg = mn;
            float ps = 0.f;
#pragma unroll
            for (int r = 0; r < 16; ++r) { p0[r] = __builtin_amdgcn_exp2f(p0[r] - mn); p1[r] = __builtin_amdgcn_exp2f(p1[r] - mn); ps += p0[r] + p1[r]; }
            ps += __shfl_xor(ps, 32);
            l_reg = l_reg * alpha + ps;
#pragma unroll
            for (int r = 0; r < 16; ++r) { const float ar = __shfl(alpha, crow(r, hi));
#pragma unroll
                for (int d = 0; d < 4; ++d) o[d][r] *= ar; }
            bf16x8 pa0, pa1, pa2, pa3;
#define PK4(P, B_, OUT) do { unsigned a0 = cvt_pk_bf16(P[B_ + 0], P[B_ + 1]), a1 = cvt_pk_bf16(P[B_ + 2], P[B_ + 3]); \
        unsigned b0 = cvt_pk_bf16(P[B_ + 4], P[B_ + 5]), b1 = cvt_pk_bf16(P[B_ + 6], P[B_ + 7]); \
        auto r0 = __builtin_amdgcn_permlane32_swap(a0, b0, false, false); auto r1 = __builtin_amdgcn_permlane32_swap(a1, b1, false, false); \
        u32x4 w = {r0[0], r1[0], r0[1], r1[1]}; OUT = *reinterpret_cast<bf16x8*>(&w); } while (0)
            PK4(p0, 0, pa0); PK4(p0, 8, pa1); PK4(p1, 0, pa2); PK4(p1, 8, pa3);
#undef PK4
            const bf16_t* vp = Vb + (tb + kb + 8 * hi) * 1024 + h * 128 + r32;
#pragma unroll
            for (int d0 = 0; d0 < 4; ++d0) {
#pragma unroll
                for (int ks = 0; ks < 4; ++ks) { bf16x8 vf;
#pragma unroll
                    for (int j = 0; j < 8; ++j) vf[j] = (short)vp[(size_t)(16 * ks + j) * 1024 + d0 * 32];
                    const bf16x8 pa = ks == 0 ? pa0 : (ks == 1 ? pa1 : (ks == 2 ? pa2 : pa3));
                    o[d0] = __builtin_amdgcn_mfma_f32_32x32x16_bf16(pa, vf, o[d0], 0, 0, 0); } }
        }
        const float li = 1.0f / l_reg;
#pragma unroll
        for (int r = 0; r < 16; ++r) { const int orow = crow(r, hi); const float lr = __shfl(li, orow);
            bf16_t* op = Ym + (tb + q0 + orow) * DM + h * 128 + r32;
#pragma unroll
            for (int d0 = 0; d0 < 4; ++d0) op[d0 * 32] = f2bf(o[d0][r] * lr); }
    }
}

constexpr int AT_SHM_V = 64 * 128 * 2, AT_SHM_K = 64 * 192 * 2, AT_OFF_K = 2 * AT_SHM_V, AT_OFF_WS = AT_OFF_K + 2 * AT_SHM_K;
#define KSWZ192(row, colB) ((row) * 384 + ((colB) ^ (((row) & 7) << 4)))
__device__ __forceinline__ int v_st(int k, int c) { const int kk = (k & ~0xC) | ((k & 4) << 1) | ((k & 8) >> 1); return ((kk >> 3) * 4 + (c >> 5)) * 512 + ((kk & 7) * 32 + (c & 31)) * 2; }
__device__ __forceinline__ int v_rd_base(int lane) { return ((lane & 3) << 3) | (((lane >> 2) & 3) << 6) | (((lane >> 4) & 1) << 5) | (((lane >> 5) & 1) << 8); }
typedef short s16x4 __attribute__((ext_vector_type(4)));
__device__ __forceinline__ void attn_qblock(LAS unsigned char* lds, const bf16_t* Qb, const bf16_t* Kb, const bf16_t* Vb, bf16_t* Ym, int b, int h, int qblk, int tid_in, int wid) {
    int tid = tid_in; asm volatile("" : "+v"(tid));
    const int lane = tid & 63, r32 = lane & 31, hi = lane >> 5;
    const size_t tb = (size_t)b * SEQ; const int q0 = qblk * 256, qlo = q0 + wid * 32;
    LAS unsigned char* V_lds = lds; LAS unsigned char* K_lds = lds + AT_OFF_K;
    LAS float* wsf = (LAS float*)(lds + AT_OFF_WS) + wid * 64;
    bf16x8 qr[12];
    { const bf16_t* qp = Qb + (tb + qlo + r32) * QW + h * 192 + hi * 8;
#pragma unroll
      for (int d0 = 0; d0 < 12; ++d0) qr[d0] = *(const bf16x8*)(qp + d0 * 16); }
    unsigned kgo[3], vgo[2];
#pragma unroll
    for (int i = 0; i < 3; ++i) { const int L = tid + 512 * i, row = L / 24, cB = ((L % 24) * 16) ^ ((row & 7) << 4); kgo[i] = (unsigned)(row * QW * 2 + cB); }
#pragma unroll
    for (int i = 0; i < 2; ++i) { const int L = tid + 512 * i, kk = (L >> 7) * 8 + ((L & 31) >> 2), k = (kk & ~0xC) | ((kk & 4) << 1) | ((kk & 8) >> 1), cc = ((L >> 5) & 3) * 32 + (L & 3) * 8; vgo[i] = (unsigned)(k * 1024 * 2 + cc * 2); }
    const char* Kg = (const char*)(Kb + tb * QW + h * 192); const char* Vg = (const char*)(Vb + tb * 1024 + h * 128);
    const int vb0 = (int)(uintptr_t)V_lds + v_rd_base(lane);
    int kb4[4];
#pragma unroll
    for (int dd = 0; dd < 4; ++dd) kb4[dd] = r32 * 384 + ((dd * 32 + hi * 16) ^ ((r32 & 7) << 4));
    const int NT_ = (q0 + 255) / 64 + 1;
#define AT_STAGE(t_, buf_) do { const size_t gk_ = (size_t)(t_) * 64 * QW * 2, gv_ = (size_t)(t_) * 64 * 1024 * 2; \
        _Pragma("unroll") for (int i = 0; i < 3; ++i) __builtin_amdgcn_global_load_lds((const unsigned*)(Kg + gk_ + kgo[i]), (LAS unsigned*)(K_lds + (buf_) * AT_SHM_K + (512 * i + wid * 64) * 16), 16, 0, 0); \
        _Pragma("unroll") for (int i = 0; i < 2; ++i) __builtin_amdgcn_global_load_lds((const unsigned*)(Vg + gv_ + vgo[i]), (LAS unsigned*)(V_lds + (buf_) * AT_SHM_V + (512 * i + wid * 64) * 16), 16, 0, 0); } while (0)
    __syncthreads();
    AT_STAGE(0, 0);
    float m_reg = -1e30f, l_reg = 0.f; f32x16 o[4];
#pragma unroll
    for (int d = 0; d < 4; ++d)
#pragma unroll
        for (int r = 0; r < 16; ++r) o[d][r] = 0.f;
    for (int t = 0; t < NT_; ++t) {
        const int buf = t & 1, kb = t * 64;
        asm volatile("s_waitcnt vmcnt(0)" ::: "memory"); __syncthreads();
        if (t + 1 < NT_) AT_STAGE(t + 1, buf ^ 1);
        f32x16 p0, p1;
#pragma unroll
        for (int r = 0; r < 16; ++r) { p0[r] = 0.f; p1[r] = 0.f; }
        { const int kab = (int)(uintptr_t)K_lds + buf * AT_SHM_K; const int ka0 = kab + kb4[0], ka1 = kab + kb4[1], ka2 = kab + kb4[2], ka3 = kab + kb4[3];
          bf16x8 kf[3][2];
#define KRD(dst, areg, off) asm volatile("ds_read_b128 %0, %1 offset:%2" : "=&v"(dst) : "v"(areg), "i"(off) : "memory")
#define KRD2(set, d0) do { if (((d0) & 3) == 0) { KRD(kf[set][0], ka0, ((d0) >> 2) * 128); KRD(kf[set][1], ka0, ((d0) >> 2) * 128 + 32 * 384); } \
                           else if (((d0) & 3) == 1) { KRD(kf[set][0], ka1, ((d0) >> 2) * 128); KRD(kf[set][1], ka1, ((d0) >> 2) * 128 + 32 * 384); } \
                           else if (((d0) & 3) == 2) { KRD(kf[set][0], ka2, ((d0) >> 2) * 128); KRD(kf[set][1], ka2, ((d0) >> 2) * 128 + 32 * 384); } \
                           else { KRD(kf[set][0], ka3, ((d0) >> 2) * 128); KRD(kf[set][1], ka3, ((d0) >> 2) * 128 + 32 * 384); } } while (0)
#define KWAIT(n) do { asm volatile("s_waitcnt lgkmcnt(" #n ")" ::: "memory"); __builtin_amdgcn_sched_barrier(0); } while (0)
#define KSTEP(d0, W) do { if ((d0) + 2 < 12) KRD2(((d0) + 2) % 3, (d0) + 2); W; \
              p0 = __builtin_amdgcn_mfma_f32_32x32x16_bf16(kf[(d0) % 3][0], qr[d0], p0, 0, 0, 0); p1 = __builtin_amdgcn_mfma_f32_32x32x16_bf16(kf[(d0) % 3][1], qr[d0], p1, 0, 0, 0); } while (0)
          KRD2(0, 0); KRD2(1, 1);
          KSTEP(0, KWAIT(4)); KSTEP(1, KWAIT(4)); KSTEP(2, KWAIT(4)); KSTEP(3, KWAIT(4)); KSTEP(4, KWAIT(4)); KSTEP(5, KWAIT(4));
          KSTEP(6, KWAIT(4)); KSTEP(7, KWAIT(4)); KSTEP(8, KWAIT(4)); KSTEP(9, KWAIT(4)); KSTEP(10, KWAIT(2)); KSTEP(11, KWAIT(0));
#undef KSTEP
#undef KWAIT
#undef KRD2
#undef KRD
        }
        if (kb + 63 > qlo) { const int dq = qlo + r32 - kb - 4 * hi; const float NEG = -__builtin_inff();
#pragma unroll
            for (int r = 0; r < 16; ++r) { const int cc = (r & 3) + 8 * (r >> 2); if (dq - cc < 0) p0[r] = NEG; if (dq - cc - 32 < 0) p1[r] = NEG; } }
        float pmax = p0[0];
#pragma unroll
        for (int r = 1; r < 16; ++r) pmax = fmaxf(pmax, p0[r]);
#pragma unroll
        for (int r = 0; r < 16; ++r) pmax = fmaxf(pmax, p1[r]);
        { auto rr = __builtin_amdgcn_permlane32_swap(__float_as_uint(pmax), __float_as_uint(pmax), false, false); pmax = fmaxf(__uint_as_float(rr[0]), __uint_as_float(rr[1])); }
        float alpha = 1.f;
        if (!__all(pmax - m_reg <= 11.5f)) { const float mn = fmaxf(m_reg, pmax); alpha = __builtin_amdgcn_exp2f(m_reg - mn); m_reg = mn; }
        float ps = 0.f;
#pragma unroll
        for (int r = 0; r < 16; ++r) { p0[r] = __builtin_amdgcn_exp2f(p0[r] - m_reg); p1[r] = __builtin_amdgcn_exp2f(p1[r] - m_reg); ps += p0[r] + p1[r]; }
        { auto rr = __builtin_amdgcn_permlane32_swap(__float_as_uint(ps), __float_as_uint(ps), false, false); ps = __uint_as_float(rr[0]) + __uint_as_float(rr[1]); }
        l_reg = l_reg * alpha + ps;
        if (__any(alpha < 1.f)) { if (hi == 0) wsf[r32] = alpha; asm volatile("s_waitcnt lgkmcnt(0)" ::: "memory");
#pragma unroll
            for (int r = 0; r < 16; ++r) { const float ar = wsf[crow(r, hi)];
#pragma unroll
                for (int d = 0; d < 4; ++d) o[d][r] *= ar; } }
        bf16x8 pa0, pa1, pa2, pa3;
#define PK4(P, B_, OUT) do { unsigned a0 = cvt_pk_bf16(P[B_ + 0], P[B_ + 1]), a1 = cvt_pk_bf16(P[B_ + 2], P[B_ + 3]); \
        unsigned b0 = cvt_pk_bf16(P[B_ + 4], P[B_ + 5]), b1 = cvt_pk_bf16(P[B_ + 6], P[B_ + 7]); \
        auto r0 = __builtin_amdgcn_permlane32_swap(a0, b0, false, false); auto r1 = __builtin_amdgcn_permlane32_swap(a1, b1, false, false); \
        u32x4 w = {r0[0], r1[0], r0[1], r1[1]}; OUT = *reinterpret_cast<bf16x8*>(&w); } while (0)
        PK4(p0, 0, pa0); PK4(p0, 8, pa1); PK4(p1, 0, pa2); PK4(p1, 8, pa3);
#undef PK4
#define TRRD(dst, off) asm volatile("ds_read_b64_tr_b16 %0, %1 offset:%2" : "=&v"(dst) : "v"(vbb), "i"(off) : "memory")
#define PV_RD(S_, d0) do { constexpr int b_ = (d0) * 512; TRRD(S_##l0, b_); TRRD(S_##h0, b_ + 2048); TRRD(S_##l1, b_ + 4096); TRRD(S_##h1, b_ + 6144); TRRD(S_##l2, b_ + 8192); TRRD(S_##h2, b_ + 10240); TRRD(S_##l3, b_ + 12288); TRRD(S_##h3, b_ + 14336); } while (0)
#define PV_MM(S_, d0) do { \
        o[d0] = __builtin_amdgcn_mfma_f32_32x32x16_bf16(pa0, (bf16x8){S_##l0[0], S_##l0[1], S_##l0[2], S_##l0[3], S_##h0[0], S_##h0[1], S_##h0[2], S_##h0[3]}, o[d0], 0, 0, 0); \
        o[d0] = __builtin_amdgcn_mfma_f32_32x32x16_bf16(pa1, (bf16x8){S_##l1[0], S_##l1[1], S_##l1[2], S_##l1[3], S_##h1[0], S_##h1[1], S_##h1[2], S_##h1[3]}, o[d0], 0, 0, 0); \
        o[d0] = __builtin_amdgcn_mfma_f32_32x32x16_bf16(pa2, (bf16x8){S_##l2[0], S_##l2[1], S_##l2[2], S_##l2[3], S_##h2[0], S_##h2[1], S_##h2[2], S_##h2[3]}, o[d0], 0, 0, 0); \
        o[d0] = __builtin_amdgcn_mfma_f32_32x32x16_bf16(pa3, (bf16x8){S_##l3[0], S_##l3[1], S_##l3[2], S_##l3[3], S_##h3[0], S_##h3[1], S_##h3[2], S_##h3[3]}, o[d0], 0, 0, 0); } while (0)
#define PV_WAIT(n) do { asm volatile("s_waitcnt lgkmcnt(" #n ")" ::: "memory"); __builtin_amdgcn_sched_barrier(0); } while (0)
        { const int vbb = vb0 + buf * AT_SHM_V; s16x4 Al0, Al1, Al2, Al3, Ah0, Ah1, Ah2, Ah3, Bl0, Bl1, Bl2, Bl3, Bh0, Bh1, Bh2, Bh3;
          PV_RD(A, 0); PV_RD(B, 1); PV_WAIT(8); PV_MM(A, 0);
          PV_RD(A, 2); PV_WAIT(8); PV_MM(B, 1);
          PV_RD(B, 3); PV_WAIT(8); PV_MM(A, 2);
          PV_WAIT(0); PV_MM(B, 3); }
#undef PV_RD
#undef PV_MM
#undef PV_WAIT
#undef TRRD
    }
#undef AT_STAGE
    if (hi == 0) wsf[32 + r32] = 1.0f / l_reg;
    asm volatile("s_waitcnt lgkmcnt(0)" ::: "memory");
    int lane_e = lane; asm volatile("" : "+v"(lane_e));
    const int r32e = lane_e & 31, hie = lane_e >> 5;
    unsigned char* Ow = (unsigned char*)Ym + (size_t)(tb + qlo) * DM + h * 128;
#pragma unroll
    for (int r = 0; r < 16; ++r) { const int orow = crow(r, hie); const float li = wsf[32 + orow] * 16.0f;
#pragma unroll
        for (int d0 = 0; d0 < 4; ++d0) { const float v = o[d0][r] * li; const float v1 = __shfl_xor(v, 1), v2 = __shfl_xor(v, 2), v3 = __shfl_xor(v1, 2);
            if ((r32e & 3) == 0) *(unsigned*)(Ow + (size_t)orow * DM + d0 * 32 + r32e) = pk_fp8x4(v, v1, v2, v3); } }
}
__device__ __forceinline__ void phase_attn_v2(const Ctx& c, KArgs* a) {
    unsigned char* ws = a->ws; const bf16_t* Qb = (const bf16_t*)(ws + OFF_QB); const bf16_t* Kb = (const bf16_t*)(ws + OFF_KB); const bf16_t* Vb = (const bf16_t*)(ws + OFF_VB);
    bf16_t* Ym = (bf16_t*)(ws + WS_XN);
    for (int it = blockIdx.x; it < 512; it += gridDim.x) {
        const int rnd = it >> 8, bb = it & 255, xcd = bb & 7, slot = bb >> 3; const int bh = rnd * 16 + xcd * 2 + (slot >> 4), y = slot & 15;
        attn_qblock(c.lds, Qb, Kb, Vb, Ym, bh >> 3, bh & 7, 31 - y, c.tid, c.wid);
        attn_qblock(c.lds, Qb, Kb, Vb, Ym, bh >> 3, bh & 7, y, c.tid, c.wid);
    }
}

__device__ __forceinline__ void phase_lora_prep(const Ctx& c, KArgs* a) {
    unsigned char* ws = a->ws; const bf16_t* Z = (const bf16_t*)(ws + OFF_Z); bf16_t* AL = (bf16_t*)(ws + OFF_ALORA); const float* mu = (const float*)a->in[I_MU];
    const int gt = blockIdx.x * 512 + c.tid, nthr = gridDim.x * 512;
    for (int i = gt; i < NT * 48; i += nthr) { const int tok = i / 48, ck = i % 48; float f[8];
        if (ck < 36) { const int k0 = 8 * ck; float cu[8], pv[8];
            unpack8(*(const u32x4*)(Z + (size_t)tok * ZW + ZC_WL + k0), cu);
            if (tok % SEQ) unpack8(*(const u32x4*)(Z + (size_t)(tok - 1) * ZW + ZC_WL + k0), pv); else {
#pragma unroll
                for (int e = 0; e < 8; ++e) pv[e] = 0.f; }
            const f32x4 m0 = *(const f32x4*)(mu + 3072 + k0), m1 = *(const f32x4*)(mu + 3072 + k0 + 4);
#pragma unroll
            for (int e = 0; e < 8; ++e) { const float x = cu[e] + (pv[e] - cu[e]) * (e < 4 ? m0[e & 3] : m1[e & 3]); f[e] = ck < 8 ? (1.0f - 2.0f * __builtin_amdgcn_rcpf(1.0f + __builtin_amdgcn_exp2f(2.885390082f * x))) : (ck < 16 ? x : sigmoidf_(x)); }
        } else {
#pragma unroll
            for (int e = 0; e < 8; ++e) f[e] = 0.f; }
        *(u32x4*)(AL + (size_t)tok * LORA_K + 8 * ck) = packf8(f); }
}
__device__ __forceinline__ void phase_scan_prep(const Ctx& c, KArgs* a) {
    unsigned char* ws = a->ws; const bf16_t* Z = (const bf16_t*)(ws + OFF_Z); const bf16_t* Lb = (const bf16_t*)(ws + OFF_LB);
    h16* D0 = (h16*)(ws + OFF_DER); const size_t DS = (size_t)NT * 1024;
    const float* mu = (const float*)a->in[I_MU]; const float* w0 = (const float*)a->in[I_W0]; const float* a0 = (const float*)a->in[I_A0];
    const float* kkp = (const float*)a->in[I_KK]; const float* kap = (const float*)a->in[I_KA];
    const int lane = c.lane, half = c.gw & 1, ch0 = (half * 8 + (lane >> 3)) * 64 + 8 * (lane & 7);
    float mur[8], muk[8], muv[8], cw0[8], ca0[8], ckk[8], cka[8];
#pragma unroll
    for (int e = 0; e < 8; ++e) { mur[e] = mu[ch0 + e]; muk[e] = mu[1024 + ch0 + e]; muv[e] = mu[2048 + ch0 + e]; cw0[e] = w0[ch0 + e]; ca0[e] = a0[ch0 + e]; ckk[e] = kkp[ch0 + e]; cka[e] = kap[ch0 + e]; }
    u32x4 nxa[8], nxb[8];
#define SP_LOAD(nx, it_) do { const int tk_ = (it_) >> 1; const bf16_t* zr_ = Z + (size_t)tk_ * ZW + ch0; const bf16_t* zp_ = (tk_ % SEQ) == 0 ? zr_ : zr_ - ZW; \
        nx[0] = *(const u32x4*)(zr_ + ZC_R); nx[1] = *(const u32x4*)(zr_ + ZC_K); nx[2] = *(const u32x4*)(zr_ + ZC_V); nx[3] = *(const u32x4*)(zp_ + ZC_R); nx[4] = *(const u32x4*)(zp_ + ZC_K); nx[5] = *(const u32x4*)(zp_ + ZC_V); \
        nx[6] = *(const u32x4*)(Lb + (size_t)tk_ * LORA_N + ch0); nx[7] = *(const u32x4*)(Lb + (size_t)tk_ * LORA_N + 1024 + ch0); } while (0)
    if (c.gw < NT * 2) SP_LOAD(nxa, c.gw);
    if (c.gw + c.nw < NT * 2) SP_LOAD(nxb, c.gw + c.nw);
#define SP_ITEM(nx, it) do { const int tok = (it) >> 1; \
        const bool first = (tok % SEQ) == 0; \
        float rc[8], kc[8], vc[8], rp[8], kp[8], vp[8], lw[8], la[8]; \
        unpack8(nx[0], rc); unpack8(nx[1], kc); unpack8(nx[2], vc); unpack8(nx[3], rp); unpack8(nx[4], kp); unpack8(nx[5], vp); unpack8(nx[6], lw); unpack8(nx[7], la); \
        if ((it) + 2 * c.nw < NT * 2) SP_LOAD(nx, (it) + 2 * c.nw); \
        sp_item(tok, first, rc, kc, vc, rp, kp, vp, lw, la); } while (0)
    auto sp_item = [&](int tok, bool first, const float (&rc)[8], const float (&kc)[8], const float (&vc)[8], const float (&rp)[8], const float (&kp)[8], const float (&vp)[8], const float (&lw)[8], const float (&la)[8]) __attribute__((always_inline)) {
        h16x8 o_ld, o_kk, o_b, o_km, o_r, o_v; float kt[8], av[8], ss = 0.f;
#pragma unroll
        for (int e = 0; e < 8; ++e) { const float pr = first ? 0.f : rp[e], pk = first ? 0.f : kp[e], pvv = first ? 0.f : vp[e];
            const float r = rc[e] + (pr - rc[e]) * mur[e], k = kc[e] + (pk - kc[e]) * muk[e], v = vc[e] + (pvv - vc[e]) * muv[e];
            const float xw = -(cw0[e] + lw[e]); const float spl = fmaxf(xw, 0.f) + 0.69314718f * __builtin_amdgcn_logf(1.0f + __builtin_amdgcn_exp2f(-1.44269504f * fabsf(xw)));
            const float ld = -__builtin_amdgcn_exp2f((-spl - 0.5f) * 1.44269504f);
            av[e] = sigmoidf_(ca0[e] + la[e]); kt[e] = k * ckk[e]; ss += kt[e] * kt[e];
            o_ld[e] = (h16)ld; o_km[e] = (h16)(k * (1.0f + (av[e] - 1.0f) * cka[e])); o_r[e] = (h16)r; o_v[e] = (h16)v; }
        ss = allred8(ss); const float rn = ss > 1e-24f ? __builtin_amdgcn_rsqf(ss) : 1e12f;
#pragma unroll
        for (int e = 0; e < 8; ++e) { const float kk = kt[e] * rn; o_kk[e] = (h16)kk; o_b[e] = (h16)(kk * av[e]); }
        const size_t o = (size_t)tok * 1024 + ch0;
        *(h16x8*)(D0 + o) = o_ld; *(h16x8*)(D0 + DS + o) = o_kk; *(h16x8*)(D0 + 2 * DS + o) = o_b; *(h16x8*)(D0 + 3 * DS + o) = o_km; *(h16x8*)(D0 + 4 * DS + o) = o_r; *(h16x8*)(D0 + 5 * DS + o) = o_v; };
    for (int it = c.gw; it < NT * 2; it += 2 * c.nw) { SP_ITEM(nxa, it); if (it + c.nw < NT * 2) SP_ITEM(nxb, it + c.nw); }
#undef SP_ITEM
#undef SP_LOAD
}
constexpr int SC_L = 256, SC_NC = SEQ / SC_L;
constexpr size_t OFF_YRAW = OFF_Z;
constexpr size_t OFF_PM = OFF_Z + 128 * MiB;
constexpr size_t OFF_HM = OFF_PM + 32 * MiB;
constexpr size_t OFF_ST = OFF_HM + 32 * MiB;
static_assert(OFF_ST + 32 * MiB <= OFF_R1, "scan buffers overflow Z region");
constexpr size_t OFF_Q16 = OFF_Z;
constexpr size_t OFF_Y016 = OFF_Z + 64 * MiB;
struct ScanRaw { h16x8 ld, kk, bb, km, r, v; };
__device__ __forceinline__ ScanRaw scan_load(const h16* pj, const h16* pi, size_t DS, int t) {
    ScanRaw q; const size_t o = (size_t)t * 1024;
    q.ld = *(const h16x8*)(pj + o); q.kk = *(const h16x8*)(pj + DS + o); q.bb = *(const h16x8*)(pj + 2 * DS + o);
    q.km = *(const h16x8*)(pj + 3 * DS + o); q.r = *(const h16x8*)(pj + 4 * DS + o); q.v = *(const h16x8*)(pi + o);
    return q;
}
__device__ __forceinline__ void phase_scan_p1(const Ctx& c, KArgs* a) {
    unsigned char* ws = a->ws; const h16* D0 = (const h16*)(ws + OFF_DER); const size_t DS = (size_t)NT * 1024; float* Pm = (float*)(ws + OFF_PM); float* Hm = (float*)(ws + OFF_HM);
    h16* Q16 = (h16*)(ws + OFF_Q16); h16* Y016 = (h16*)(ws + OFF_Y016);
    const int lane = c.lane, la = lane >> 3, lb = lane & 7;
    for (int it = c.gw; it < 64 * SC_NC; it += c.nw) {
        const int bh = it & 63, ch = it >> 6, b = bh >> 4, h = bh & 15;
        const size_t tok0 = (size_t)b * SEQ + (size_t)ch * SC_L;
        float SP[8][8], SH[8][8];
#pragma unroll
        for (int i = 0; i < 8; ++i)
#pragma unroll
            for (int j = 0; j < 8; ++j) { SP[i][j] = (la == lb && i == j) ? 1.f : 0.f; SH[i][j] = 0.f; }
        h16* qo = Q16 + tok0 * 1024 + h * 64 + 8 * la; h16* yo = Y016 + tok0 * 1024 + h * 64 + 8 * la;
        LAS unsigned char* ring = c.lds + c.wid * 4096;
        const h16* gsrc = D0 + (size_t)((lane >> 3) < 5 ? (lane >> 3) : 5) * DS + tok0 * 1024 + h * 64 + 8 * (lane & 7);
#define SC_DMA(t_) __builtin_amdgcn_global_load_lds((const unsigned*)(gsrc + (size_t)((t_) < SC_L ? (t_) : SC_L - 1) * 1024), (LAS unsigned*)(ring + ((t_) & 3) * 1024), 16, 0, 0)
        SC_DMA(0); SC_DMA(1); SC_DMA(2);
#pragma unroll 1
        for (int t = 0; t < SC_L; ++t) {
            if (t < 3) asm volatile("s_waitcnt vmcnt(0)" ::: "memory"); else asm volatile("s_waitcnt vmcnt(8)" ::: "memory");
            SC_DMA(t + 3);
            ScanRaw cr; { const LAS unsigned char* sl = ring + (t & 3) * 1024;
                cr.ld = *(const LAS h16x8*)(sl + 16 * lb); cr.kk = *(const LAS h16x8*)(sl + 128 + 16 * lb); cr.bb = *(const LAS h16x8*)(sl + 256 + 16 * lb);
                cr.km = *(const LAS h16x8*)(sl + 384 + 16 * lb); cr.r = *(const LAS h16x8*)(sl + 512 + 16 * lb); cr.v = *(const LAS h16x8*)(sl + 640 + 16 * la); }
            float w[8], kk[8], bb[8];
#pragma unroll
            for (int j = 0; j < 8; ++j) { w[j] = __expf((float)cr.ld[j]); kk[j] = (float)cr.kk[j]; bb[j] = (float)cr.bb[j]; }
            float dp[8], dh[8];
#pragma unroll
            for (int i = 0; i < 8; ++i) { float s0 = 0.f, s1 = 0.f;
#pragma unroll
                for (int j = 0; j < 8; ++j) { s0 += SP[i][j] * kk[j]; s1 += SH[i][j] * kk[j]; }
                dp[i] = s0; dh[i] = s1; }
#pragma unroll
            for (int i = 0; i < 8; ++i) { dp[i] = -allred8(dp[i]); dh[i] = -allred8(dh[i]); }
            float qv[8], yv[8];
#pragma unroll
            for (int i = 0; i < 8; ++i) { const float vi = (float)cr.v[i]; float s0 = 0.f, s1 = 0.f;
#pragma unroll
                for (int j = 0; j < 8; ++j) { const float rj = (float)cr.r[j];
                    SP[i][j] = SP[i][j] * w[j] + dp[i] * bb[j]; SH[i][j] = SH[i][j] * w[j] + (dh[i] * bb[j] + vi * (float)cr.km[j]);
                    s0 += SP[i][j] * rj; s1 += SH[i][j] * rj; }
                qv[i] = s0; yv[i] = s1; }
#pragma unroll
            for (int i = 0; i < 8; ++i) { qv[i] = allred8(qv[i]); yv[i] = allred8(yv[i]); }
            if (lb == 0) { h16x8 hq, hy;
#pragma unroll
                for (int i = 0; i < 8; ++i) { hq[i] = (h16)qv[i]; hy[i] = (h16)yv[i]; }
                *(h16x8*)(qo + (size_t)t * 1024) = hq; *(h16x8*)(yo + (size_t)t * 1024) = hy; }
        }
#undef SC_DMA
        asm volatile("s_waitcnt vmcnt(0)" ::: "memory");
        { float* dst = Hm + ((size_t)bh * SC_NC + ch) * 4096 + ((((la >> 1) * 4 + (lb >> 1)) * 64 + 2 * (lb & 1) * 16 + 8 * (la & 1)) * 4);
#pragma unroll
          for (int i = 0; i < 8; ++i)
#pragma unroll
              for (int j = 0; j < 8; ++j) dst[((j >> 2) * 16 + i) * 4 + (j & 3)] = SH[i][j]; }
        { float* dst = Pm + ((size_t)bh * SC_NC + ch) * 4096 + ((((lb >> 1) * 4 + (la >> 1)) * 64 + 2 * (la & 1) * 16 + 8 * (lb & 1)) * 4);
#pragma unroll
          for (int i = 0; i < 8; ++i)
#pragma unroll
              for (int j = 0; j < 8; ++j) dst[((i >> 2) * 16 + j) * 4 + (i & 3)] = SP[i][j]; }
    }
}
typedef short s16x4_t __attribute__((ext_vector_type(4)));
#define P1M_MFMA16(a, b, c) __builtin_amdgcn_mfma_f32_16x16x16f16((a), (b), (c), 0, 0, 0)
#define P1M_MFMA32(a, b, c) __builtin_amdgcn_mfma_f32_16x16x32_f16((a), (b), (c), 0, 0, 0)
__device__ __forceinline__ h16x4 cvt_h4(const f32x4 v) { return (h16x4){(h16)v[0], (h16)v[1], (h16)v[2], (h16)v[3]}; }
__device__ __forceinline__ float row_pfx(float x) {
    x += __int_as_float(__builtin_amdgcn_update_dpp(0, __float_as_int(x), 0x111, 0xF, 0xF, false));
    x += __int_as_float(__builtin_amdgcn_update_dpp(0, __float_as_int(x), 0x112, 0xF, 0xF, false));
    x += __int_as_float(__builtin_amdgcn_update_dpp(0, __float_as_int(x), 0x114, 0xF, 0xF, false));
    x += __int_as_float(__builtin_amdgcn_update_dpp(0, __float_as_int(x), 0x118, 0xF, 0xF, false));
    return x; }
__device__ __forceinline__ float row_sum16(float x) {
    x = DPP_ADD(x, 0xB1); x = DPP_ADD(x, 0x4E); x = DPP_ADD(x, 0x141); x = DPP_ADD(x, 0x140); return x; }
#define P1M_TR(dst, addr) asm volatile("ds_read_b64_tr_b16 %0, %1" : "=v"(dst) : "v"(addr) : "memory")
#define P1M_WAITL() do { asm volatile("s_waitcnt lgkmcnt(0)" ::: "memory"); __builtin_amdgcn_sched_barrier(0); } while (0)
__device__ __forceinline__ void phase_scan_p1m(const Ctx& c, KArgs* a) {
    unsigned char* ws = a->ws; const h16* D0 = (const h16*)(ws + OFF_DER); const size_t DS = (size_t)NT * 1024; float* Pm = (float*)(ws + OFF_PM); float* Hm = (float*)(ws + OFF_HM);
    h16* Q16 = (h16*)(ws + OFF_Q16); h16* Y016 = (h16*)(ws + OFF_Y016);
    const int lane = c.lane;
    LAS unsigned char* wl = c.lds + c.wid * 16640;
    const int wb = (int)(uintptr_t)wl;
    constexpr int IMG_KT = 0, IMG_BH = 2048, IMG_KH = 4096, IMG_RT = 6144, IMG_BB = 8192, IMG_KB = 10240, IMG_V = 12288, SM_M = 14336, SM_TT = 15360, SM_NT = 15872;
    constexpr int SM_ARB = IMG_BH, SM_ARK = IMG_BH + 512, SM_GAM = 16384, IMG_RP = IMG_KH, STG_Q = IMG_KT, STG_Y = IMG_RT;
    for (int itk = c.gw; itk < 64 * SC_NC; itk += c.nw) {
        const int bh = itk & 63, ch = itk >> 6, b = bh >> 4, h = bh & 15;
        const size_t tok0 = (size_t)b * SEQ + (size_t)ch * SC_L;
        f32x4 PT[4][4], SHT[4][4];
        { int lz = lane; asm volatile("" : "+v"(lz));
#pragma unroll
          for (int kt = 0; kt < 4; ++kt)
#pragma unroll
              for (int ct = 0; ct < 4; ++ct) { SHT[kt][ct] = (f32x4){0.f, 0.f, 0.f, 0.f};
#pragma unroll
                  for (int rg = 0; rg < 4; ++rg) PT[kt][ct][rg] = (kt == ct && 4 * (lz >> 4) + rg == (lz & 15)) ? 1.f : 0.f; } }
#pragma unroll 1
        for (int sc = 0; sc < SC_L / 16; ++sc) {
            int lq = lane; asm volatile("" : "+v"(lq)); const int r16 = lq & 15, gq = lq >> 4;
            const size_t go = (tok0 + 16 * sc + r16) * 1024 + h * 64 + 16 * gq;
            { const h16x8 v0 = *(const h16x8*)(D0 + 5 * DS + go), v1 = *(const h16x8*)(D0 + 5 * DS + go + 8);
              *(LAS h16x8*)(wl + IMG_V + gq * 512 + r16 * 32) = v0; *(LAS h16x8*)(wl + IMG_V + gq * 512 + r16 * 32 + 16) = v1; }
#pragma unroll
            for (int p = 0; p < 2; ++p) { float ep[8], em[8], ex[8], eb[8];
                { const h16x8 a0 = *(const h16x8*)(D0 + go + 8 * p);
#pragma unroll
                  for (int e = 0; e < 8; ++e) { const float ld = (float)a0[e]; const float lw = row_pfx(ld), tot = row_sum16(ld); if (r16 == 15) *(LAS float*)(wl + SM_GAM + (16 * gq + 8 * p + e) * 4) = __expf(tot);
                      ep[e] = __expf(lw); em[e] = __expf(-lw); ex[e] = __expf(lw - ld); eb[e] = __expf(tot - lw); } }
                const int io = gq * 512 + r16 * 32 + 16 * p;
                { const h16x8 x = *(const h16x8*)(D0 + DS + go + 8 * p); h16x8 o;
#pragma unroll
                  for (int e = 0; e < 8; ++e) o[e] = (h16)((float)x[e] * ex[e]);
                  *(LAS h16x8*)(wl + IMG_KT + io) = o; }
                { const h16x8 x = *(const h16x8*)(D0 + 2 * DS + go + 8 * p); h16x8 o, o2;
#pragma unroll
                  for (int e = 0; e < 8; ++e) { o[e] = (h16)((float)x[e] * em[e]); o2[e] = (h16)((float)x[e] * eb[e]); }
                  *(LAS h16x8*)(wl + IMG_BH + io) = o; *(LAS h16x8*)(wl + IMG_BB + io) = o2; }
                { const h16x8 x = *(const h16x8*)(D0 + 3 * DS + go + 8 * p); h16x8 o, o2;
#pragma unroll
                  for (int e = 0; e < 8; ++e) { o[e] = (h16)((float)x[e] * em[e]); o2[e] = (h16)((float)x[e] * eb[e]); }
                  *(LAS h16x8*)(wl + IMG_KH + io) = o; *(LAS h16x8*)(wl + IMG_KB + io) = o2; }
                { const h16x8 x = *(const h16x8*)(D0 + 4 * DS + go + 8 * p); h16x8 o;
#pragma unroll
                  for (int e = 0; e < 8; ++e) o[e] = (h16)((float)x[e] * ep[e]);
                  *(LAS h16x8*)(wl + IMG_RT + io) = o; } }
            asm volatile("s_waitcnt lgkmcnt(0)" ::: "memory");
            { f32x4 m_ = {0.f, 0.f, 0.f, 0.f}, n_ = m_, rb = m_, rk = m_;
#pragma unroll
              for (int kk2 = 0; kk2 < 2; ++kk2) { const int ro = (2 * kk2 + (gq >> 1)) * 512 + r16 * 32 + (gq & 1) * 16;
                  const h16x8 aK = *(const LAS h16x8*)(wl + IMG_KT + ro), aR = *(const LAS h16x8*)(wl + IMG_RT + ro), bB = *(const LAS h16x8*)(wl + IMG_BH + ro), bK = *(const LAS h16x8*)(wl + IMG_KH + ro);
                  m_ = P1M_MFMA32(aK, bB, m_); n_ = P1M_MFMA32(aK, bK, n_); rb = P1M_MFMA32(aR, bB, rb); rk = P1M_MFMA32(aR, bK, rk); }
              h16x4 nT, rbT, rkT;
#pragma unroll
              for (int rg = 0; rg < 4; ++rg) { const int t = 4 * gq + rg; const bool lo = t > r16, le = t >= r16;
                  *(LAS float*)(wl + SM_M + (t * 16 + r16) * 4) = lo ? m_[rg] : 0.f; nT[rg] = (h16)(lo ? n_[rg] : 0.f); rbT[rg] = (h16)(le ? rb[rg] : 0.f); rkT[rg] = (h16)(le ? rk[rg] : 0.f); }
              *(LAS h16x4*)(wl + SM_NT + r16 * 32 + gq * 8) = nT; *(LAS h16x4*)(wl + SM_ARB + r16 * 32 + gq * 8) = rbT; *(LAS h16x4*)(wl + SM_ARK + r16 * 32 + gq * 8) = rkT;
            }
            asm volatile("s_waitcnt lgkmcnt(0)" ::: "memory");
            { float x[16];
#pragma unroll
              for (int t = 0; t < 16; ++t) { float acc = (t == r16) ? 1.f : 0.f;
#pragma unroll
                  for (int s4 = 0; s4 < (t + 3) / 4; ++s4) { const f32x4 mr = *(const LAS f32x4*)(wl + SM_M + (t * 16 + 4 * s4) * 4);
#pragma unroll
                      for (int e = 0; e < 4; ++e) if (4 * s4 + e < t) acc -= mr[e] * x[4 * s4 + e]; }
                  x[t] = acc; }
              h16x8 t0, t1;
#pragma unroll
              for (int e = 0; e < 8; ++e) { t0[e] = (h16)x[e]; t1[e] = (h16)x[8 + e]; }
              if (gq == 0) { *(LAS h16x8*)(wl + SM_TT + r16 * 32) = t0; *(LAS h16x8*)(wl + SM_TT + r16 * 32 + 16) = t1; } }
            asm volatile("s_waitcnt lgkmcnt(0)" ::: "memory");
            const int la8 = wb + 8 * lq;
            s16x4_t rT, rN, rArb, rArk, rK[4], rV[4];
            P1M_TR(rT, la8 + SM_TT); P1M_TR(rN, la8 + SM_NT); P1M_TR(rArb, la8 + SM_ARB); P1M_TR(rArk, la8 + SM_ARK);
#pragma unroll
            for (int j4 = 0; j4 < 4; ++j4) { P1M_TR(rK[j4], la8 + IMG_KT + j4 * 512); P1M_TR(rV[j4], la8 + IMG_V + j4 * 512); }
            P1M_WAITL();
            const h16x4 aT = *(h16x4*)&rT, aN = *(h16x4*)&rN, aArb = *(h16x4*)&rArb, aArk = *(h16x4*)&rArk;
            h16x4 kcH[4], zH[4], bV[4];
            const f32x4 zero4 = {0.f, 0.f, 0.f, 0.f};
#pragma unroll
            for (int j4 = 0; j4 < 4; ++j4) { bV[j4] = *(h16x4*)&rV[j4];
                kcH[j4] = cvt_h4(P1M_MFMA16(aT, *(h16x4*)&rK[j4], zero4));
                const h16x4 nvH = cvt_h4(P1M_MFMA16(aN, bV[j4], zero4)); zH[j4] = cvt_h4(P1M_MFMA16(aT, nvH, zero4)); }
            { s16x4_t rR[4];
#pragma unroll
              for (int j4 = 0; j4 < 4; ++j4) P1M_TR(rR[j4], la8 + IMG_RT + j4 * 512);
              P1M_WAITL();
#pragma unroll
              for (int j4 = 0; j4 < 4; ++j4) { const h16x4 rt = *(h16x4*)&rR[j4]; const f32x4 ak = P1M_MFMA16(aArb, kcH[j4], zero4);
                  const f32x4 rp = (f32x4){(float)rt[0], (float)rt[1], (float)rt[2], (float)rt[3]} - ak;
                  *(LAS h16x4*)(wl + IMG_RP + j4 * 512 + r16 * 32 + gq * 8) = cvt_h4(rp); } }
            { s16x4_t rRp[4];
              asm volatile("s_waitcnt lgkmcnt(0)" ::: "memory");
#pragma unroll
              for (int j4 = 0; j4 < 4; ++j4) P1M_TR(rRp[j4], la8 + IMG_RP + j4 * 512);
              P1M_WAITL();
#pragma unroll
              for (int ct = 0; ct < 4; ++ct) { f32x4 qv = zero4, yv = P1M_MFMA16(aArk, bV[ct], zero4) - P1M_MFMA16(aArb, zH[ct], zero4);
#pragma unroll
                  for (int kt = 0; kt < 4; ++kt) { const h16x4 aR = *(h16x4*)&rRp[kt]; qv = P1M_MFMA16(aR, cvt_h4(PT[kt][ct]), qv); yv = P1M_MFMA16(aR, cvt_h4(SHT[kt][ct]), yv); }
#pragma unroll
                  for (int rg = 0; rg < 4; ++rg) { *(LAS h16*)(wl + STG_Q + (4 * gq + rg) * 128 + (16 * ct + r16) * 2) = (h16)qv[rg]; *(LAS h16*)(wl + STG_Y + (4 * gq + rg) * 128 + (16 * ct + r16) * 2) = (h16)yv[rg]; } } }
            { h16x4 GT[4][4];
              s16x4_t rBB[4], rKB[4];
#pragma unroll
              for (int j4 = 0; j4 < 4; ++j4) { P1M_TR(rBB[j4], la8 + IMG_BB + j4 * 512); P1M_TR(rKB[j4], la8 + IMG_KB + j4 * 512); }
              float gdiag[4];
#pragma unroll
              for (int j4 = 0; j4 < 4; ++j4) gdiag[j4] = *(const LAS float*)(wl + SM_GAM + (16 * j4 + r16) * 4);
              P1M_WAITL();
#pragma unroll
              for (int ta = 0; ta < 4; ++ta)
#pragma unroll
                  for (int tb = 0; tb < 4; ++tb) { f32x4 g4 = P1M_MFMA16(kcH[ta], *(h16x4*)&rBB[tb], zero4);
#pragma unroll
                      for (int rg = 0; rg < 4; ++rg) g4[rg] = ((ta == tb && 4 * gq + rg == r16) ? gdiag[tb] : 0.f) - g4[rg];
                      GT[ta][tb] = cvt_h4(g4); }
#pragma unroll
              for (int ct = 0; ct < 4; ++ct) { h16x4 pH[4], sH[4];
#pragma unroll
                  for (int kt = 0; kt < 4; ++kt) { pH[kt] = cvt_h4(PT[kt][ct]); sH[kt] = cvt_h4(SHT[kt][ct]); }
#pragma unroll
                  for (int tb = 0; tb < 4; ++tb) { f32x4 hs = P1M_MFMA16(*(h16x4*)&rKB[tb], bV[ct], zero4) - P1M_MFMA16(*(h16x4*)&rBB[tb], zH[ct], zero4); f32x4 pp = zero4;
#pragma unroll
                      for (int ta = 0; ta < 4; ++ta) { pp = P1M_MFMA16(GT[ta][tb], pH[ta], pp); hs = P1M_MFMA16(GT[ta][tb], sH[ta], hs); }
                      PT[tb][ct] = pp; SHT[tb][ct] = hs; } } }
            asm volatile("s_waitcnt lgkmcnt(0)" ::: "memory");
#pragma unroll
            for (int p = 0; p < 2; ++p) { const int id = lq + 64 * p, row = id >> 3, part = id & 7; const size_t o = (tok0 + 16 * sc + row) * 1024 + h * 64 + part * 8;
                *(h16x8*)(Q16 + o) = *(const LAS h16x8*)(wl + STG_Q + id * 16); *(h16x8*)(Y016 + o) = *(const LAS h16x8*)(wl + STG_Y + id * 16); }
            asm volatile("s_waitcnt lgkmcnt(0)" ::: "memory");
        }
        { int lz = lane; asm volatile("" : "+v"(lz)); const int r16z = lz & 15, gqz = lz >> 4;
          float* hd = Hm + ((size_t)bh * SC_NC + ch) * 4096 + lz * 4; float* pb = Pm + ((size_t)bh * SC_NC + ch) * 4096 + ((r16z >> 2) * 16 + 4 * gqz) * 4 + (r16z & 3);
#pragma unroll
          for (int kt = 0; kt < 4; ++kt)
#pragma unroll
              for (int ct = 0; ct < 4; ++ct) { *(f32x4*)(hd + (ct * 4 + kt) * 256) = SHT[kt][ct];
#pragma unroll
                  for (int rg = 0; rg < 4; ++rg) pb[(kt * 4 + ct) * 256 + rg * 4] = PT[kt][ct][rg]; } }
    }
}

__device__ __forceinline__ void phase_scan_p2(const Ctx& c, KArgs* a) {
    if (c.wid != 0) return;
    unsigned char* ws = a->ws; const float* Pm = (const float*)(ws + OFF_PM); const float* Hm = (const float*)(ws + OFF_HM); float* ST = (float*)(ws + OFF_ST);
    const int lane = c.lane, q = lane >> 4, cc = lane & 15;
    for (int w = blockIdx.x; w < 256; w += gridDim.x) { const int bh = w >> 2, itl = w & 3;
        f32x4 st[4];
#pragma unroll
        for (int jt = 0; jt < 4; ++jt) st[jt] = (f32x4){0.f, 0.f, 0.f, 0.f};
        for (int ch = 0; ch < SC_NC; ++ch) {
            float* sp = ST + ((size_t)bh * SC_NC + ch) * 4096;
#pragma unroll
            for (int jt = 0; jt < 4; ++jt)
#pragma unroll
                for (int rg = 0; rg < 4; ++rg) sp[(16 * jt + 4 * q + rg) * 64 + 16 * itl + cc] = st[jt][rg];
            if (ch == SC_NC - 1) break;
            const float* pp = Pm + ((size_t)bh * SC_NC + ch) * 4096; const float* hp = Hm + ((size_t)bh * SC_NC + ch) * 4096;
            f32x4 nw[4];
#pragma unroll
            for (int jtp = 0; jtp < 4; ++jtp) nw[jtp] = *(const f32x4*)(hp + ((itl * 4 + jtp) * 64 + lane) * 4);
#pragma unroll
            for (int jtp = 0; jtp < 4; ++jtp)
#pragma unroll
                for (int jt = 0; jt < 4; ++jt) { const f32x4 av = *(const f32x4*)(pp + ((jtp * 4 + jt) * 64 + lane) * 4);
                    nw[jtp] = __builtin_amdgcn_mfma_f32_16x16x16f16(cvt_h4(av), cvt_h4(st[jt]), nw[jtp], 0, 0, 0); }
#pragma unroll
            for (int jt = 0; jt < 4; ++jt) st[jt] = nw[jt];
        }
    }
}
__device__ __forceinline__ float red_kq(float x) { x += __shfl_xor(x, 16); x += __shfl_xor(x, 32); return x; }
__device__ __forceinline__ void phase_scan_p3(const Ctx& c, KArgs* a) {
    unsigned char* ws = a->ws; const h16* D0 = (const h16*)(ws + OFF_DER); const size_t DS = (size_t)NT * 1024; const float* ST = (const float*)(ws + OFF_ST);
    const h16* Q16 = (const h16*)(ws + OFF_Q16); const h16* Y016 = (const h16*)(ws + OFF_Y016); const bf16_t* Lb = (const bf16_t*)(ws + OFF_LB); bf16_t* Ym = (bf16_t*)(ws + WS_XN);
    const float* rk = (const float*)a->in[I_RK]; const float* lnw = (const float*)a->in[I_LNW]; const float* lnb = (const float*)a->in[I_LNB];
    const int lane = c.lane, kq = lane >> 4, cc = lane & 15;
    for (int itk = c.gw; itk < 64 * SC_NC; itk += c.nw) {
        const int bh = itk & 63, ch = itk >> 6, b = bh >> 4, h = bh & 15;
        const size_t tok0 = (size_t)b * SEQ + (size_t)ch * SC_L;
        const float* sp = ST + ((size_t)bh * SC_NC + ch) * 4096;
        h16x4 sa[4][4];
#pragma unroll
        for (int itl = 0; itl < 4; ++itl)
#pragma unroll
            for (int s4 = 0; s4 < 4; ++s4)
#pragma unroll
                for (int e = 0; e < 4; ++e) sa[itl][s4][e] = (h16)sp[(16 * s4 + 4 * kq + e) * 64 + 16 * itl + cc];
        float crk[4][4], clw[4][4], clb[4][4];
#pragma unroll
        for (int itl = 0; itl < 4; ++itl)
#pragma unroll
            for (int e = 0; e < 4; ++e) { const int chn = h * 64 + 16 * itl + 4 * kq + e; crk[itl][e] = rk[chn]; clw[itl][e] = lnw[chn]; clb[itl][e] = lnb[chn]; }
#pragma unroll 1
        for (int tt = 0; tt < SC_L / 16; ++tt) { const size_t tok = tok0 + 16 * tt + cc; const size_t ob = tok * 1024 + h * 64 + 4 * kq;
            f32x4 acc[4]; h16x4 qa[4];
#pragma unroll
            for (int s4 = 0; s4 < 4; ++s4) qa[s4] = *(const h16x4*)(Q16 + ob + 16 * s4);
#pragma unroll
            for (int itl = 0; itl < 4; ++itl) { const h16x4 t4 = *(const h16x4*)(Y016 + ob + 16 * itl); acc[itl] = (f32x4){(float)t4[0], (float)t4[1], (float)t4[2], (float)t4[3]}; }
#pragma unroll
            for (int s4 = 0; s4 < 4; ++s4)
#pragma unroll
                for (int itl = 0; itl < 4; ++itl) acc[itl] = __builtin_amdgcn_mfma_f32_16x16x16f16(sa[itl][s4], qa[s4], acc[itl], 0, 0, 0);
            float sm = 0.f, bd = 0.f; h16x4 hv[4]; float g[4][4];
#pragma unroll
            for (int itl = 0; itl < 4; ++itl) { const h16x4 hr = *(const h16x4*)(D0 + 4 * DS + ob + 16 * itl), hk = *(const h16x4*)(D0 + 3 * DS + ob + 16 * itl); hv[itl] = *(const h16x4*)(D0 + 5 * DS + ob + 16 * itl);
                const u32x2 gw = *(const u32x2*)(Lb + tok * LORA_N + 2048 + h * 64 + 4 * kq + 16 * itl); g[itl][0] = bflo(gw.x); g[itl][1] = bfhi(gw.x); g[itl][2] = bflo(gw.y); g[itl][3] = bfhi(gw.y);
#pragma unroll
                for (int e = 0; e < 4; ++e) { sm += acc[itl][e]; bd += (float)hr[e] * (float)hk[e] * crk[itl][e]; } }
            sm = red_kq(sm); bd = red_kq(bd); const float mean = sm * (1.0f / 64.0f); float vs = 0.f;
#pragma unroll
            for (int itl = 0; itl < 4; ++itl)
#pragma unroll
                for (int e = 0; e < 4; ++e) { acc[itl][e] -= mean; vs += acc[itl][e] * acc[itl][e]; }
            vs = red_kq(vs); const float rstd = rsqrtf(vs * (1.0f / 64.0f) + 64e-5f);
#pragma unroll
            for (int itl = 0; itl < 4; ++itl) { float f[4];
#pragma unroll
                for (int e = 0; e < 4; ++e) f[e] = (acc[itl][e] * rstd * clw[itl][e] + clb[itl][e] + bd * (float)hv[itl][e]) * g[itl][e];
                *(unsigned*)((unsigned char*)Ym + (size_t)tok * DM + 1024 + h * 64 + 4 * kq + 16 * itl) = pk_fp8x4(f[0] * 16.0f, f[1] * 16.0f, f[2] * 16.0f, f[3] * 16.0f); }
        }
    }
}

__device__ __forceinline__ void phase_router(const Ctx& c, KArgs* a) {
    unsigned char* ws = a->ws; const float* H = a->out; bf16_t* xn2 = (bf16_t*)(ws + WS_XN); const u32x4* wf = (const u32x4*)(ws + OFF_WRF);
    const float* rbias = (const float*)a->in[I_RBIAS]; float* topw = (float*)(ws + OFF_TOPW); int* list = (int*)(ws + OFF_LIST); int* cnt = (int*)(ws + CTL_CNT);
    const int lane = c.lane, r16 = lane & 15, q = lane >> 4;
    LAS float* lg = (LAS float*)(c.lds) + c.wid * 1088;
    const float bias_e = rbias[lane];
    for (int it = c.gw; it < NT / 16; it += c.nw) { const int tok0 = it * 16;
        f32x4 acc[4];
#pragma unroll
        for (int cc = 0; cc < 4; ++cc) acc[cc] = (f32x4){0.f, 0.f, 0.f, 0.f};
        float ss = 0.f; const float* hp = H + (size_t)(tok0 + r16) * DM + 8 * q;
#pragma unroll 2
        for (int s = 0; s < 64; ++s) { const f32x4 x0 = *(const f32x4*)(hp + 32 * s), x1 = *(const f32x4*)(hp + 32 * s + 4);
            ss += x0[0] * x0[0] + x0[1] * x0[1] + x0[2] * x0[2] + x0[3] * x0[3] + x1[0] * x1[0] + x1[1] * x1[1] + x1[2] * x1[2] + x1[3] * x1[3];
            const u32x4 ahi = pack8(x0, x1); float h[8]; unpack8(ahi, h);
            const u32x4 alo = pack8((f32x4){x0[0] - h[0], x0[1] - h[1], x0[2] - h[2], x0[3] - h[3]}, (f32x4){x1[0] - h[4], x1[1] - h[5], x1[2] - h[6], x1[3] - h[7]});
            const bf16x8 ah = __builtin_bit_cast(bf16x8, ahi), al = __builtin_bit_cast(bf16x8, alo);
            const u32x4* wp = wf + (size_t)s * 512 + lane;
#pragma unroll
            for (int cc = 0; cc < 4; ++cc) { const bf16x8 bh = __builtin_bit_cast(bf16x8, wp[(cc * 2 + 0) * 64]), bl = __builtin_bit_cast(bf16x8, wp[(cc * 2 + 1) * 64]);
                acc[cc] = __builtin_amdgcn_mfma_f32_16x16x32_bf16(ah, bh, acc[cc], 0, 0, 0); acc[cc] = __builtin_amdgcn_mfma_f32_16x16x32_bf16(ah, bl, acc[cc], 0, 0, 0); acc[cc] = __builtin_amdgcn_mfma_f32_16x16x32_bf16(al, bh, acc[cc], 0, 0, 0); } }
        ss += __shfl_xor(ss, 16); ss += __shfl_xor(ss, 32);
        if (q == 0) lg[1024 + r16] = ss;
#pragma unroll
        for (int cc = 0; cc < 4; ++cc)
#pragma unroll
            for (int rg = 0; rg < 4; ++rg) lg[(4 * q + rg) * 64 + 16 * cc + r16] = acc[cc][rg];
        asm volatile("s_waitcnt lgkmcnt(0)" ::: "memory");
#pragma unroll 4
        for (int tt = 0; tt < 16; ++tt) { const int tok = tok0 + tt; const int chunk = tok / CH_TOK, tl = tok % CH_TOK;
            const float rs = rsqrtf(lg[1024 + tt] * (1.0f / DM) + RMS_EPS);
            const float sc = sigmoidf_(lg[tt * 64 + lane] * rs); const float bs = sc + bias_e;
            float m1 = bs; m1 = fmaxf(m1, __shfl_xor(m1, 1)); m1 = fmaxf(m1, __shfl_xor(m1, 2)); m1 = fmaxf(m1, __shfl_xor(m1, 4));
            const unsigned long long eq = __ballot(bs == m1); const unsigned grp = (unsigned)(eq >> (lane & ~7)) & 0xffu; const int first = (lane & ~7) + (__ffs(grp) - 1);
            float m2 = (lane == first) ? -__builtin_inff() : bs; m2 = fmaxf(m2, __shfl_xor(m2, 1)); m2 = fmaxf(m2, __shfl_xor(m2, 2)); m2 = fmaxf(m2, __shfl_xor(m2, 4));
            const float gs = m1 + m2; const int g = lane >> 3; int grank = 0;
#pragma unroll
            for (int gp = 0; gp < 8; ++gp) { const float o = rlane(gs, gp * 8); grank += (o > gs || (o == gs && gp < g)) ? 1 : 0; }
            const float mv = grank < 4 ? bs : -__builtin_inff(); int rank = 0;
#pragma unroll
            for (int e = 0; e < 64; ++e) { const float o = rlane(mv, e); rank += (o > mv || (o == mv && e < lane)) ? 1 : 0; }
            const bool sel = (grank < 4) && (rank < 8);
            const float wsum = wave_sum(sel ? sc : 0.f);
            if (sel) { topw[(size_t)tok * 8 + rank] = sc / wsum * 2.5f;
                const int p = atomicAdd(cnt + chunk * NE1 + lane, 1); list[((size_t)chunk * NE1 + lane) * CH_TOK + p] = tl * 8 + rank; }
        }
        asm volatile("s_waitcnt lgkmcnt(0)" ::: "memory");
        for (int tt = 0; tt < 16; ++tt) rownorm_fp8(H + (size_t)(tok0 + tt) * DM, (unsigned char*)xn2 + (size_t)(tok0 + tt) * DM, lane);
    }
}
__device__ __forceinline__ void phase_expert_weights(const Ctx& c, KArgs* a) {
    unsigned char* ws = a->ws; const float* gf = (const float*)a->in[I_GFFN];
    bf16_t* we1 = (bf16_t*)(ws + OFF_WE1); bf16_t* we2 = (bf16_t*)(ws + OFF_WE2);
    { LAS float* tile = (LAS float*)c.lds; const int n4 = c.tid & 31, kr = c.tid >> 5, sc = c.tid & 7, sn = c.tid >> 3; const int ntile = NE1 * 384;
      const float* wgp = (const float*)a->in[I_WG]; const float* wup = (const float*)a->in[I_WU]; const float* wdp = (const float*)a->in[I_WD];
      const float* sgp = (const float*)a->in[I_SG]; const float* sup = (const float*)a->in[I_SU]; const float* sdp = (const float*)a->in[I_SD];
      f32x4 va[4], vb[4];
#define EW_LOAD(v, T_) do { const int e_ = (T_) / 384, r_ = (T_) % 384; \
        if (r_ < 256) { const int n_ = (r_ >> 5) * 128 + 4 * n4, k0_ = (r_ & 31) * 64, half_ = (n_ >> 7) & 1, cc_ = (n_ >> 8) * 128 + (n_ & 127); \
            const float* sp_ = (e_ < NEXP ? (half_ ? wup : wgp) + (size_t)e_ * 2048 * 512 : (half_ ? sup : sgp)) + cc_; \
            _Pragma("unroll") for (int i = 0; i < 4; ++i) { const int k_ = k0_ + kr + 16 * i; v[i] = *(const f32x4*)(sp_ + (size_t)k_ * 512) * (gf[k_] * 64.0f); } } \
        else { const int t2_ = r_ - 256, n_ = (t2_ >> 3) * 128 + 4 * n4, k0_ = (t2_ & 7) * 64; const float* sp_ = (e_ < NEXP ? wdp + (size_t)e_ * 512 * 2048 : sdp) + n_; \
            _Pragma("unroll") for (int i = 0; i < 4; ++i) v[i] = *(const f32x4*)(sp_ + (size_t)(k0_ + kr + 16 * i) * 2048) * 64.0f; } } while (0)
#define EW_STEP(v, T_) do { \
          _Pragma("unroll") for (int i = 0; i < 4; ++i) _Pragma("unroll") for (int e = 0; e < 4; ++e) tile[(kr + 16 * i) * 129 + 4 * n4 + e] = v[i][e]; \
          __syncthreads(); \
          const int e_ = (T_) / 384, r_ = (T_) % 384; const bool up = r_ < 256; const int t2 = r_ - 256; \
          const int n0 = up ? (r_ >> 5) * 128 : (t2 >> 3) * 128, k0 = up ? (r_ & 31) * 64 : (t2 & 7) * 64, Kd = up ? 2048 : 512; \
          unsigned char* dst = up ? (unsigned char*)we1 + (size_t)e_ * 1024 * 2048 : (unsigned char*)we2 + (size_t)e_ * 2048 * 512; \
          if ((T_) + 2 * (int)gridDim.x < ntile) EW_LOAD(v, (T_) + 2 * (int)gridDim.x); \
          _Pragma("unroll") for (int i = 0; i < 2; ++i) { const int nl = sn + 64 * i; float f[8]; \
              _Pragma("unroll") for (int j = 0; j < 8; ++j) f[j] = tile[(8 * sc + j) * 129 + nl]; \
              u32x2 w8; w8.x = pk_fp8x4(f[0], f[1], f[2], f[3]); w8.y = pk_fp8x4(f[4], f[5], f[6], f[7]); *(u32x2*)(dst + (size_t)(n0 + nl) * Kd + k0 + 8 * sc) = w8; } \
          __syncthreads(); } while (0)
      int T = blockIdx.x; if (T < ntile) EW_LOAD(va, T); if (T + (int)gridDim.x < ntile) EW_LOAD(vb, T + (int)gridDim.x);
      for (; T < ntile; T += 2 * gridDim.x) { EW_STEP(va, T); if (T + (int)gridDim.x < ntile) EW_STEP(vb, T + (int)gridDim.x); }
#undef EW_STEP
#undef EW_LOAD
    }
    { const float* p = (const float*)a->in[I_P]; bf16_t* pb = (bf16_t*)(ws + OFF_PB); const int gt = blockIdx.x * 512 + c.tid, nthr = gridDim.x * 512;
      for (size_t i = gt; i < (size_t)NT * 256 / 4; i += nthr) { const f32x4 v = *(const f32x4*)(p + i * 4); u32x2 w; w.x = cvt_pk_bf16(v[0], v[1]); w.y = cvt_pk_bf16(v[2], v[3]); *(u32x2*)(pb + i * 4) = w; } }
}
__device__ __forceinline__ void phase_combine(const Ctx& c, KArgs* a, int chunk) {
    unsigned char* ws = a->ws; float* H = a->out; const bf16_t* Y = (const bf16_t*)(ws + OFF_YPART + (size_t)(chunk & 1) * YPART_BYTES); bf16_t* xn3 = (bf16_t*)(ws + OFF_XN3);
    const int lane = c.lane;
    for (int tl = c.gw; tl < CH_TOK; tl += c.nw) { const int tok = chunk * CH_TOK + tl; float* hp = H + (size_t)tok * DM;
        float v[4][8];
#pragma unroll
        for (int i = 0; i < 4; ++i) { const f32x4 h0 = *(const f32x4*)(hp + (i * 64 + lane) * 8), h1 = *(const f32x4*)(hp + (i * 64 + lane) * 8 + 4);
            v[i][0] = h0[0]; v[i][1] = h0[1]; v[i][2] = h0[2]; v[i][3] = h0[3]; v[i][4] = h1[0]; v[i][5] = h1[1]; v[i][6] = h1[2]; v[i][7] = h1[3]; }
#pragma unroll 4
        for (int k = 0; k < 8; ++k) { const unsigned char* yp = (const unsigned char*)Y + ((size_t)tl * 8 + k) * DM;
#pragma unroll
            for (int i = 0; i < 4; ++i) { const u32x2 w8 = *(const u32x2*)(yp + (i * 64 + lane) * 8);
                const auto f0 = __builtin_amdgcn_cvt_pk_f32_fp8((int)w8.x, false), f1 = __builtin_amdgcn_cvt_pk_f32_fp8((int)w8.x, true), f2 = __builtin_amdgcn_cvt_pk_f32_fp8((int)w8.y, false), f3 = __builtin_amdgcn_cvt_pk_f32_fp8((int)w8.y, true);
                v[i][0] += f0[0] * (1.0f / 16.0f); v[i][1] += f0[1] * (1.0f / 16.0f); v[i][2] += f1[0] * (1.0f / 16.0f); v[i][3] += f1[1] * (1.0f / 16.0f);
                v[i][4] += f2[0] * (1.0f / 16.0f); v[i][5] += f2[1] * (1.0f / 16.0f); v[i][6] += f3[0] * (1.0f / 16.0f); v[i][7] += f3[1] * (1.0f / 16.0f); } }
        float ss = 0.f;
#pragma unroll
        for (int i = 0; i < 4; ++i) { *(f32x4*)(hp + (i * 64 + lane) * 8) = (f32x4){v[i][0], v[i][1], v[i][2], v[i][3]}; *(f32x4*)(hp + (i * 64 + lane) * 8 + 4) = (f32x4){v[i][4], v[i][5], v[i][6], v[i][7]};
#pragma unroll
            for (int e = 0; e < 8; ++e) ss += v[i][e] * v[i][e]; }
        ss = wave_sum(ss); const float rs = rsqrtf(ss * (1.0f / DM) + RMS_EPS) * 16.0f; unsigned char* xp = (unsigned char*)xn3 + (size_t)tok * DM;
#pragma unroll
        for (int i = 0; i < 4; ++i) { u32x2 w8; w8.x = pk_fp8x4(v[i][0] * rs, v[i][1] * rs, v[i][2] * rs, v[i][3] * rs); w8.y = pk_fp8x4(v[i][4] * rs, v[i][5] * rs, v[i][6] * rs, v[i][7] * rs);
            *(u32x2*)(xp + (i * 64 + lane) * 8) = w8; } }
}
__device__ __forceinline__ void phase_final(const Ctx& c, KArgs* a, int tok0, int tok1) {
    unsigned char* ws = a->ws; float* H = a->out; const bf16_t* U = (const bf16_t*)(ws + OFF_U); const float* ssq = (const float*)(ws + OFF_SSQU); const float* gp = (const float*)a->in[I_GPOUT];
    const int lane = c.lane;
    for (int tok = tok0 + c.gw; tok < tok1; tok += c.nw) { const float rs = rsqrtf(wave_sum(lane < 32 ? ssq[(size_t)tok * 32 + lane] : 0.f) * (1.0f / DM) + RMS_EPS); float* hp = H + (size_t)tok * DM; const bf16_t* up = U + (size_t)tok * DM;
#pragma unroll
        for (int i = 0; i < 4; ++i) { const int cc = (i * 64 + lane) * 8; f32x4 h0 = *(const f32x4*)(hp + cc), h1 = *(const f32x4*)(hp + cc + 4); const f32x4 g0 = *(const f32x4*)(gp + cc), g1 = *(const f32x4*)(gp + cc + 4);
            float f[8]; unpack8(*(const u32x4*)(up + cc), f);
            h0[0] += f[0] * rs * g0[0]; h0[1] += f[1] * rs * g0[1]; h0[2] += f[2] * rs * g0[2]; h0[3] += f[3] * rs * g0[3];
            h1[0] += f[4] * rs * g1[0]; h1[1] += f[5] * rs * g1[1]; h1[2] += f[6] * rs * g1[2]; h1[3] += f[7] * rs * g1[3];
            *(f32x4*)(hp + cc) = h0; *(f32x4*)(hp + cc + 4) = h1; } }
}

constexpr int LDS_STAGE = pg8::STAGE_BYTES;
constexpr int LDS_MISC = LDS_STAGE;
constexpr int LDS_BYTES = LDS_STAGE + 12288;
enum { PH_PREP = 0, PH_PROJ, PH_UP, PH_FINQK, PH_ATTN, PH_LORA, PH_SCANPREP, PH_SCAN1, PH_SCAN2, PH_SCAN3, PH_WOUT, PH_ROUTER, PH_MOE0  , PH_GATE = PH_MOE0 + 2 + NCHUNK  , PH_FINAL, PH_COUNT };

__device__ __forceinline__ int tile_expert(const LAS int* starts, int t) { int lo = 0, hi = NE1; while (hi - lo > 1) { const int mid = (lo + hi) >> 1; if (starts[mid] <= t) lo = mid; else hi = mid; } return lo; }
__device__ __forceinline__ void moe_tables(const Ctx& c, KArgs* a, bool build_rinfo) {
    LAS int* tb = (LAS int*)(c.lds + LDS_MISC); const int* cnt = (const int*)(a->ws + CTL_CNT);
    __syncthreads();
    for (int i = c.tid; i < NCHUNK * NE1; i += 512) { int v = cnt[i]; v = v < 0 ? 0 : (v > CH_TOK ? CH_TOK : v); tb[512 * (i / NE1) + 72 + (i % NE1)] = v; }
    __syncthreads();
    if (c.wid <= NCHUNK) {
        int n = 0, n64 = 0;
        if (c.wid < NCHUNK) { n = tb[512 * c.wid + 72 + c.lane]; n64 = tb[512 * c.wid + 72 + NEXP]; }
        else { for (int k = 0; k < NCHUNK; ++k) { n += tb[512 * k + 72 + c.lane]; n64 += tb[512 * k + 72 + NEXP]; } }
        const int t = (n + 255) >> 8; int incl = t;
#pragma unroll
        for (int o = 1; o < 64; o <<= 1) { const int v = __shfl_up(incl, o); if (c.lane >= o) incl += v; }
        const int tot = __shfl(incl, 63); LAS int* st = c.wid < NCHUNK ? tb + 512 * c.wid : tb + pg8::GT_INT;
        st[c.lane] = incl - t; if (c.lane == 0) { st[NEXP] = tot; st[NE1] = tot + ((n64 + 255) >> 8); } }
    __syncthreads();
    if (c.tid == 0) { int s = 0; for (int k = 0; k < NCHUNK; ++k) { tb[2048 + k] = s; s += tb[512 * k + NE1]; } tb[2048 + NCHUNK] = s; }
    if (build_rinfo) for (int t = c.tid; t < pg8::GT_MAX; t += 512) if (t < tb[pg8::GT_INT + NE1]) ((LAS unsigned char*)tb)[pg8::GM_BYTE + t] = (unsigned char)tile_expert(tb + pg8::GT_INT, t);
    for (int i = c.tid; i < NCHUNK * MAXT; i += 512) { const int k = i / MAXT, t = i % MAXT; const LAS int* tk = tb + 512 * k; if (t < tk[NE1]) tb[512 * k + 144 + t] = tile_expert(tk, t); }
    __syncthreads();
    if (build_rinfo) {
        int2* ri = (int2*)(a->ws + OFF_RINFO); const int* list = (const int*)(a->ws + OFF_LIST); const float* topw = (const float*)(a->ws + OFF_TOPW);
        const int ntall = tb[2048 + NCHUNK];
        for (int idx = blockIdx.x * 512 + c.tid; idx < ntall * 256; idx += gridDim.x * 512) { const int tg = idx >> 8; int k = 0; while (k + 1 < NCHUNK && tb[2048 + k + 1] <= tg) ++k;
            const LAS int* tk = tb + 512 * k; const int ti = tg - tb[2048 + k], e = tk[144 + ti], pos = (ti - tk[e]) * 256 + (idx & 255); int2 v; v.x = CH_TOK * 8; v.y = 0;
            if (pos < tk[72 + e]) { if (e == NEXP) { v.x = -2 - pos; v.y = __float_as_int(1.0f / 256.0f); }
                else { const int ent = list[((size_t)k * NE1 + e) * CH_TOK + pos]; v.x = ent; v.y = __float_as_int(topw[(size_t)k * CH_TOK * 8 + ent] * (1.0f / 256.0f)); } }
            ri[idx] = v; }
    }
}

__global__ void __launch_bounds__(512, 2) fwd(Args a_in) {
    extern __shared__ __attribute__((aligned(16))) unsigned char lds_raw[];
    const int G = gridDim.x, bid = blockIdx.x;
#define KARG ({ KArgs* kp_ = (KArgs*)__builtin_amdgcn_kernarg_segment_ptr(); asm volatile("" : "+s"(kp_)); kp_; })
#define XBW ((volatile LAS unsigned*)((LAS unsigned char*)lds_raw + LDS_MISC + 12272))
    { KArgs* k0 = KARG; if (k0->ph_hi - k0->ph_lo > 1) { if (threadIdx.x == 0) { XBW[0] = 0u; XBW[1] = 0u; XBW[2] = 0u; XBW[3] = 0u; } __syncthreads(); (void)xcd_barrier_post((unsigned*)(k0->ws + CTL_BAR), XBW); } }
#define GRID_BAR_NOW() do { KArgs* kb_ = KARG; XcdBarrier bar_; bar_.bar = (unsigned*)(kb_->ws + CTL_BAR); bar_.x = xb_xcc_id(); bar_.st = XBW; xcd_barrier(bar_); } while (0)
#ifndef PROBE_MASK
#define PROBE_MASK 0ull
#endif
#ifndef PROBE_EW
#define PROBE_EW 0
#endif
#define DUP(k) ((int)((PROBE_MASK >> (k)) & 1ull))
#define GRID_BAR(k) do { KArgs* kq_ = KARG; if ((k) + 1 < kq_->ph_hi && kq_->ph_lo <= (k)) GRID_BAR_NOW(); } while (0)
#define PHASE_ARGS KArgs* ap_ = (KArgs*)__builtin_amdgcn_kernarg_segment_ptr(); asm volatile("" : "+s"(ap_)); KArgs* a = ap_; unsigned char* ws = a->ws; (void)ws; Ctx c; { int t_ = threadIdx.x; asm volatile("" : "+v"(t_)); c.tid = t_; } c.lane = c.tid & 63; c.wid = __builtin_amdgcn_readfirstlane(c.tid >> 6); c.gw = blockIdx.x * 8 + c.wid; c.nw = gridDim.x * 8; c.lds = (LAS unsigned char*)lds_raw
#ifndef PH_ONLY
#define PH_ONLY -1
#endif
#define IN(k) ((PH_ONLY < 0 || PH_ONLY == (k) || (PH_ONLY == 100 && (k) >= PH_MOE0 && (k) < PH_GATE)) && KARG->ph_lo <= (k) && (k) < KARG->ph_hi)
    for (int rep_ = 0; rep_ <= DUP(PH_PREP); ++rep_) { if (rep_) GRID_BAR_NOW(); if (IN(PH_PREP)) { PHASE_ARGS; phase_prep(c, a); __syncthreads(); if ((NT / 256) * (ZC_R / 256) % G == 0 || (G & 15) != 0) phase_prep_late<2>(c, a, bid, G); else phase_prep_late<0>(c, a, bid, G); }
    } GRID_BAR(PH_PREP);
    for (int rep_ = 0; rep_ <= DUP(PH_PROJ); ++rep_) { if (rep_) GRID_BAR_NOW(); if (IN(PH_PROJ)) {
        { PHASE_ARGS; pg8::Gemm g{(const bf16_t*)(ws + WS_XN), (const bf16_t*)(ws + OFF_WT_RKV), DM, DM, DM}; pg8::DenseOrder S; S.init(NT, ZW - ZC_R, G, bid);
          EpiPlain E{(bf16_t*)(ws + OFF_Z) + ZC_R, ZW}; pg8::gemm_phase(c.lds, g, S, E); }
        { PHASE_ARGS; pg8::Gemm g{(const bf16_t*)a->out, (const bf16_t*)(ws + OFF_WT_IN), DM / 2, DM / 2, DM / 2}; pg8::DenseOrder S; S.init(NT, ZC_R, G, bid);
          EpiProj E{(bf16_t*)(ws + OFF_Z), (float*)(ws + OFF_SSQP)}; pg8::gemm_phase(c.lds, g, S, E); } }
        if (IN(PH_PROJ) && rep_ == 0) { const int nrem = (NT / 256) * (ZC_R / 256) % G; if (nrem > 0 && (G & 15) == 0 && bid >= nrem) { PHASE_ARGS; phase_prep_late<1>(c, a, bid - nrem, G - nrem); } }
    } GRID_BAR(PH_PROJ);
    for (int rep_ = 0; rep_ <= DUP(PH_UP); ++rep_) { if (rep_) GRID_BAR_NOW(); if (IN(PH_UP)) { PHASE_ARGS;
        { pg8::Gemm g{(const bf16_t*)(ws + OFF_Z), (const bf16_t*)(ws + OFF_WT_UQ), ZW, 512, 512}; pg8::DenseOrder S; S.init(NT, QW, G, bid);
          EpiQup E{(bf16_t*)(ws + OFF_QB), (const float*)(ws + OFF_SSQP)}; pg8::gemm_phase(c.lds, g, S, E); }
        { pg8::Gemm g{(const bf16_t*)(ws + OFF_Z) + 512, (const bf16_t*)(ws + OFF_WT_UKV), ZW, 256, 256}; pg8::DenseOrder S; S.init(NT, 2048, G, bid);
          EpiKV E{(bf16_t*)(ws + OFF_KB), (bf16_t*)(ws + OFF_VB), (const float*)(ws + OFF_SSQP)}; pg8::gemm_phase(c.lds, g, S, E); }
    }
    } GRID_BAR(PH_UP);
    for (int rep_ = 0; rep_ <= DUP(PH_FINQK); ++rep_) { if (rep_) GRID_BAR_NOW(); if (IN(PH_FINQK)) { PHASE_ARGS; phase_finalize_qk(c, a); phase_lora_prep(c, a); }
    } GRID_BAR(PH_FINQK);
    for (int rep_ = 0; rep_ <= DUP(PH_ATTN); ++rep_) { if (rep_) GRID_BAR_NOW(); if (IN(PH_ATTN)) { PHASE_ARGS; phase_attn_v2(c, a); }
    } GRID_BAR(PH_ATTN);
    for (int rep_ = 0; rep_ <= DUP(PH_LORA); ++rep_) { if (rep_) GRID_BAR_NOW(); if (IN(PH_LORA)) { PHASE_ARGS; pg8::Gemm g{(const bf16_t*)(ws + OFF_ALORA), (const bf16_t*)(ws + OFF_WT_LORA), LORA_K, LORA_K, LORA_K}; pg8::DenseOrder S; S.init(NT, LORA_N, G, bid);
        EpiPlain E{(bf16_t*)(ws + OFF_LB), LORA_N}; pg8::gemm_phase(c.lds, g, S, E); }
    } GRID_BAR(PH_LORA);
    for (int rep_ = 0; rep_ <= DUP(PH_SCANPREP); ++rep_) { if (rep_) GRID_BAR_NOW(); if (IN(PH_SCANPREP)) { PHASE_ARGS; phase_scan_prep(c, a); }
    } GRID_BAR(PH_SCANPREP);
    for (int rep_ = 0; rep_ <= DUP(PH_SCAN1); ++rep_) { if (rep_) GRID_BAR_NOW(); if (IN(PH_SCAN1)) { PHASE_ARGS; phase_scan_p1m(c, a); }
    } GRID_BAR(PH_SCAN1);
    for (int rep_ = 0; rep_ <= DUP(PH_SCAN2); ++rep_) { if (rep_) GRID_BAR_NOW(); if (IN(PH_SCAN2)) { PHASE_ARGS; phase_scan_p2(c, a); }
    } GRID_BAR(PH_SCAN2);
    for (int rep_ = 0; rep_ <= DUP(PH_SCAN3); ++rep_) { if (rep_) GRID_BAR_NOW(); if (IN(PH_SCAN3)) { PHASE_ARGS; phase_scan_p3(c, a); }
    } GRID_BAR(PH_SCAN3);
    for (int rep_ = 0; rep_ <= DUP(PH_WOUT); ++rep_) { if (rep_) GRID_BAR_NOW(); if (IN(PH_WOUT) && rep_ == 0 && (NT / 256) * (ZC_R / 256) % G != 0 && (G & 15) == 0 && ((bid >> 3) & 1)) {
            { PHASE_ARGS; phase_prep_late<3>(c, a, ((bid >> 4) << 3) | (bid & 7), G >> 1); } __syncthreads(); }
        if (IN(PH_WOUT)) { PHASE_ARGS; pg8::Gemm g{(const bf16_t*)(ws + WS_XN), (const bf16_t*)(ws + OFF_WT_OUT), DM / 2, DM / 2, DM / 2}; pg8::DenseOrder S; S.init(NT, DM, G, bid);
        EpiWout E{(const float*)a->in[I_X], a->out}; g.noepi = rep_; pg8::gemm_phase(c.lds, g, S, E); }
    } GRID_BAR(PH_WOUT);
    for (int rep_ = 0; rep_ <= DUP(PH_ROUTER); ++rep_) { if (rep_) GRID_BAR_NOW(); if (IN(PH_ROUTER)) { PHASE_ARGS;
        if ((bid >> 3) & 1) { phase_expert_weights(c, a); __syncthreads(); phase_router(c, a); } else { phase_router(c, a); __syncthreads(); phase_expert_weights(c, a); } if (PROBE_EW) { __syncthreads(); phase_expert_weights(c, a); } }
    } GRID_BAR(PH_ROUTER);
    for (int rep_ = 0; rep_ <= DUP(PH_MOE0); ++rep_) { if (rep_) GRID_BAR_NOW(); if (IN(PH_MOE0)) { PHASE_ARGS; moe_tables(c, a, true);
            pg8::Gemm g{(const bf16_t*)(ws + WS_XN), (const bf16_t*)(ws + OFF_WE1), DM / 2, DM / 2, DM / 2};
            pg8::MoeOrderG1 S{(const LAS int*)(c.lds + LDS_MISC), (const int*)(ws + OFF_LIST), G, bid, 1024};
            EpiMoe1 E{(unsigned char*)(ws + OFF_HMID)}; g.noepi = rep_; pg8::gemm_phase(c.lds, g, S, E);
            { pg8::Gemm g2{(const bf16_t*)(ws + OFF_PB), (const bf16_t*)(ws + OFF_WT_PP), 256, 256, 256}; pg8::DenseOrder S2; S2.init(NT, DM, G, bid);
              EpiPlain E2{(bf16_t*)(ws + OFF_PP), DM}; pg8::gemm_phase(c.lds, g2, S2, E2); } }
    } GRID_BAR(PH_MOE0);
#define MOE_DOWN(ch) do { pg8::Gemm g{(const bf16_t*)(ws + OFF_HMID), (const bf16_t*)(ws + OFF_WE2), 256, 256, 256}; \
            pg8::MoeOrder<false> S{(const LAS int*)(c.lds + LDS_MISC), (const int*)(ws + OFF_LIST), 8, G, bid, ch, ch + 1, 2048, 0}; \
            EpiMoe2 E{(unsigned char*)(ws + OFF_YPART + (size_t)((ch) & 1) * YPART_BYTES), (const i32x2*)(ws + OFF_RINFO), a->out, ch, 0}; pg8::gemm_phase(c.lds, g, S, E); } while (0)
    if (IN(PH_MOE0 + 1)) { PHASE_ARGS; MOE_DOWN(0); }
    GRID_BAR(PH_MOE0 + 1);
#define MOE_MERGED(ch) do { if (IN(PH_MOE0 + 1 + ch)) {        \
            if ((bid >> 3) & 1) { { PHASE_ARGS; phase_combine(c, a, ch - 1); } __syncthreads(); { PHASE_ARGS; MOE_DOWN(ch); } } \
            else { { PHASE_ARGS; MOE_DOWN(ch); } __syncthreads(); { PHASE_ARGS; phase_combine(c, a, ch - 1); } } } \
        GRID_BAR(PH_MOE0 + 1 + ch); } while (0)
    static_assert(NCHUNK == 4, "phase program below is written out for four chunks");
    MOE_MERGED(1); MOE_MERGED(2); MOE_MERGED(3);
#define GATE_ROWS(r0, r1) do { PHASE_ARGS; pg8::Gemm g{(const bf16_t*)(ws + OFF_XN3 + (size_t)(r0) * DM), (const bf16_t*)(ws + OFF_WT_PG), DM / 2, DM / 2, DM / 2}; pg8::DenseOrder S; S.init((r1) - (r0), DM, G, bid); \
        EpiGate E{(const bf16_t*)(ws + OFF_PP) + (size_t)(r0) * DM, (const float*)a->in[I_BPG], (bf16_t*)(ws + OFF_U) + (size_t)(r0) * DM, (float*)(ws + OFF_SSQU) + (size_t)(r0) * 32, 0}; pg8::gemm_phase(c.lds, g, S, E); } while (0)
    constexpr int R3 = (NCHUNK - 1) * CH_TOK;
    if (IN(PH_MOE0 + 1 + NCHUNK)) { if ((bid >> 3) & 1) { { PHASE_ARGS; phase_combine(c, a, NCHUNK - 1); } __syncthreads(); GATE_ROWS(0, R3); } else { GATE_ROWS(0, R3); __syncthreads(); { PHASE_ARGS; phase_combine(c, a, NCHUNK - 1); } } }
    GRID_BAR(PH_MOE0 + 1 + NCHUNK);
#undef MOE_MERGED
#undef MOE_DOWN
    if (IN(PH_GATE)) { if ((bid >> 3) & 1) { { PHASE_ARGS; phase_final(c, a, 0, R3); } __syncthreads(); GATE_ROWS(R3, NT); } else { GATE_ROWS(R3, NT); __syncthreads(); { PHASE_ARGS; phase_final(c, a, 0, R3); } } }
    GRID_BAR(PH_GATE);
    if (IN(PH_FINAL)) { PHASE_ARGS; phase_final(c, a, R3, NT); }
#undef GATE_ROWS
#undef IN
}

extern "C" void kernel_launch(void* const* d_in, const int* in_sizes, int n_in, void* d_out, int out_size, void* d_ws, size_t ws_size, hipStream_t stream) {
    static int grid = 0;
    if (grid == 0) {
        if (n_in != 37 || out_size != NT * DM || ws_size < WS_END) { fprintf(stderr, "kernel_launch: unexpected shapes (n_in %d out %d ws %zu need %zu)\n", n_in, out_size, ws_size, (size_t)WS_END); grid = -1; return; }
        int dev = 0, cus = 0;
        if (hipGetDevice(&dev) != hipSuccess || hipDeviceGetAttribute(&cus, hipDeviceAttributeMultiprocessorCount, dev) != hipSuccess) { grid = -1; return; }
        if (hipFuncSetAttribute((const void*)fwd, hipFuncAttributeMaxDynamicSharedMemorySize, LDS_BYTES) != hipSuccess) { fprintf(stderr, "kernel_launch: hipFuncSetAttribute failed\n"); grid = -1; return; }
        int per_cu = 0; (void)hipOccupancyMaxActiveBlocksPerMultiprocessor(&per_cu, (const void*)fwd, 512, LDS_BYTES); (void)hipGetLastError();
        grid = cus;
    }
    if (grid < 0) return;
    (void)hipMemsetAsync((char*)d_ws + WS_CTL, 0, CTL_ZERO_BYTES, stream);
    Args a{};
    for (int i = 0; i < 37; ++i) a.in[i] = d_in[i];
    a.out = (float*)d_out; a.ws = (unsigned char*)d_ws;
#if N_LAUNCH_MODE == 0
    for (int p = 0; p < PH_COUNT; ++p) { a.ph_lo = p; a.ph_hi = p + 1; hipLaunchKernelGGL(fwd, dim3(grid), dim3(512), LDS_BYTES, stream, a); }
#else
    a.ph_lo = 0; a.ph_hi = PH_COUNT; hipLaunchKernelGGL(fwd, dim3(grid), dim3(512), LDS_BYTES, stream, a);
#endif
}
```

```cpp
#include <hip/hip_runtime.h>
#include <hip/hip_bf16.h>
#include <cstdio>
#include <cstdint>

#ifndef N_LAUNCH_MODE
#define N_LAUNCH_MODE 1
#endif

#define LAS __attribute__((address_space(3)))
typedef unsigned short bf16_t;
typedef short bf16x8 __attribute__((ext_vector_type(8)));
typedef float f32x4 __attribute__((ext_vector_type(4)));
typedef float f32x16 __attribute__((ext_vector_type(16)));
typedef unsigned u32x4 __attribute__((ext_vector_type(4)));
typedef unsigned u32x2 __attribute__((ext_vector_type(2)));
typedef int i32x2 __attribute__((ext_vector_type(2)));
#ifndef PROBE_NOSTORE
#define PROBE_NOSTORE 0
#endif
typedef int i32x8 __attribute__((ext_vector_type(8)));
typedef _Float16 h16;
typedef _Float16 h16x8 __attribute__((ext_vector_type(8)));
typedef _Float16 h16x4 __attribute__((ext_vector_type(4)));

constexpr int NT = 32768, DM = 2048, SEQ = 8192, NB = 4;
constexpr int ZW = 4352;
constexpr int ZC_KPE = 768, ZC_WL = 832, ZC_AL = 896, ZC_GL = 960, ZC_R = 1280, ZC_K = 2304, ZC_V = 3328;
constexpr int QW = 1536;
constexpr int LORA_K = 384, LORA_N = 3072;
constexpr int NEXP = 64, NE1 = 65;
constexpr int NCHUNK = 4, CH_TOK = NT / NCHUNK;
static_assert(CH_TOK % 256 == 0, "shared-expert row tiles must have no padding rows");
constexpr int MAXT = CH_TOK * 8 / 256 + 64 + CH_TOK / 256;
constexpr float RMS_EPS = 1e-6f;
constexpr float QSCALE = 0.07216878364870322f * 1.4426950408889634f;

constexpr size_t MiB = 1ull << 20;
constexpr size_t WS_CTL = 0;
constexpr size_t CTL_BAR = 0;
constexpr size_t CTL_CNT = 64 * 1024;
constexpr size_t CTL_ZERO_BYTES = 128 * 1024;
constexpr size_t WS_SMALL = 1 * MiB;
constexpr size_t OFF_WT_IN = WS_SMALL;
constexpr size_t OFF_WT_UQ = OFF_WT_IN + (size_t)ZW * 2048 * 2;
constexpr size_t OFF_WT_UKV = OFF_WT_UQ + (size_t)1536 * 512 * 2;
constexpr size_t OFF_WT_LORA = OFF_WT_UKV + (size_t)2048 * 256 * 2;
constexpr size_t OFF_WT_OUT = OFF_WT_LORA + (size_t)LORA_N * LORA_K * 2;
constexpr size_t OFF_WT_PG = OFF_WT_OUT + (size_t)2048 * 2048 * 2;
constexpr size_t OFF_WT_PP = OFF_WT_PG + (size_t)2048 * 2048 * 2;
constexpr size_t OFF_WT_RKV = OFF_WT_IN + (size_t)1280 * 2048;
constexpr size_t OFF_WRF = OFF_WT_PP + (size_t)2048 * 256 * 2;
constexpr size_t OFF_SSQP = OFF_WRF + (size_t)2048 * 64 * 4;
constexpr size_t OFF_TOPW = OFF_SSQP + (size_t)NT * 12 * 4;
constexpr size_t OFF_LIST = OFF_TOPW + (size_t)NT * 8 * 4;
constexpr size_t OFF_ROPE = OFF_LIST + (size_t)NCHUNK * NE1 * CH_TOK * 4;
constexpr size_t OFF_SMALL_END = OFF_ROPE + (size_t)NT * 64 * 4;
constexpr size_t WS_XN = 64 * MiB;
static_assert(OFF_SMALL_END <= WS_XN, "small region overflow");
constexpr size_t WS_BIG = WS_XN + 128 * MiB;
constexpr size_t OFF_Z = WS_BIG;
constexpr size_t OFF_R1 = OFF_Z + 272 * MiB;
constexpr size_t OFF_QB = OFF_R1;
constexpr size_t OFF_KB = OFF_QB + (size_t)NT * QW * 2;
constexpr size_t OFF_VB = OFF_KB + (size_t)NT * QW * 2;
constexpr size_t OFF_ALORA = OFF_R1 + 256 * MiB;
constexpr size_t OFF_LB = OFF_R1;
constexpr size_t OFF_DER = OFF_R1 + 256 * MiB;
constexpr size_t DER_STRIDE = (size_t)NT * 1024 * 2;
constexpr size_t OFF_MIX_END = OFF_DER + 6 * DER_STRIDE;
constexpr size_t OFF_WE1 = WS_BIG;
constexpr size_t OFF_WE2 = OFF_WE1 + (size_t)NE1 * 1024 * 2048;
constexpr size_t OFF_XN3 = WS_XN + 64 * MiB;
constexpr size_t OFF_HMID = OFF_WE2 + (size_t)NE1 * 2048 * 512;
constexpr size_t OFF_YPART = OFF_HMID + (size_t)NCHUNK * MAXT * 256 * 512;
constexpr size_t YPART_BYTES = (size_t)(CH_TOK * 8 + 16) * 2048;
constexpr size_t OFF_PB = OFF_YPART + 2 * YPART_BYTES;
constexpr size_t OFF_PP = OFF_PB + (size_t)NT * 256 * 2;
constexpr size_t OFF_U = OFF_PP + (size_t)NT * 2048 * 2;
constexpr size_t OFF_SSQU = OFF_U + (size_t)NT * 2048 * 2;
constexpr size_t OFF_RINFO = OFF_SSQU + (size_t)NT * 32 * 4;
constexpr size_t OFF_MOE_END = OFF_RINFO + (size_t)NCHUNK * MAXT * 256 * 8;
constexpr size_t WS_END = (OFF_MIX_END > OFF_MOE_END ? OFF_MIX_END : OFF_MOE_END);
static_assert(WS_END <= 1140 * MiB, "workspace budget");

__device__ __forceinline__ unsigned cvt_pk_bf16(float lo, float hi) { unsigned r; asm volatile("v_cvt_pk_bf16_f32 %0, %1, %2" : "=v"(r) : "v"(lo), "v"(hi)); return r; }
__device__ __forceinline__ bf16_t f2bf(float f) { return (bf16_t)(cvt_pk_bf16(f, 0.f) & 0xffffu); }
__device__ __forceinline__ float bf2f(bf16_t b) { return __uint_as_float(((unsigned)b) << 16); }
__device__ __forceinline__ float bflo(unsigned w) { return __uint_as_float(w << 16); }
__device__ __forceinline__ float bfhi(unsigned w) { return __uint_as_float(w & 0xffff0000u); }
__device__ __forceinline__ u32x4 pack8(f32x4 a, f32x4 b) { return (u32x4){cvt_pk_bf16(a[0], a[1]), cvt_pk_bf16(a[2], a[3]), cvt_pk_bf16(b[0], b[1]), cvt_pk_bf16(b[2], b[3])}; }
__device__ __forceinline__ unsigned pk_fp8x4(float a, float b, float c2, float d) { unsigned w = 0; a = fminf(fmaxf(a, -448.f), 448.f); b = fminf(fmaxf(b, -448.f), 448.f); c2 = fminf(fmaxf(c2, -448.f), 448.f); d = fminf(fmaxf(d, -448.f), 448.f); w = __builtin_amdgcn_cvt_pk_fp8_f32(a, b, w, false); w = __builtin_amdgcn_cvt_pk_fp8_f32(c2, d, w, true); return w; }
__device__ __forceinline__ void unpack8(const u32x4 w, float (&f)[8]) { f[0] = bflo(w[0]); f[1] = bfhi(w[0]); f[2] = bflo(w[1]); f[3] = bfhi(w[1]); f[4] = bflo(w[2]); f[5] = bfhi(w[2]); f[6] = bflo(w[3]); f[7] = bfhi(w[3]); }
__device__ __forceinline__ u32x4 packf8(const float (&f)[8]) { return (u32x4){cvt_pk_bf16(f[0], f[1]), cvt_pk_bf16(f[2], f[3]), cvt_pk_bf16(f[4], f[5]), cvt_pk_bf16(f[6], f[7])}; }
__device__ __forceinline__ float wave_sum(float v) { for (int o = 32; o >= 1; o >>= 1) v += __shfl_xor(v, o); return v; }
__device__ __forceinline__ float rlane(float x, int j) { return __int_as_float(__builtin_amdgcn_readlane(__float_as_int(x), j)); }
__device__ __forceinline__ float sigmoidf_(float x) { return __builtin_amdgcn_rcpf(1.0f + __builtin_amdgcn_exp2f(-1.44269504f * x)); }

#define DPP_ADD(x, ctrl) ((x) + __int_as_float(__builtin_amdgcn_update_dpp(0, __float_as_int(x), (ctrl), 0xF, 0xF, true)))
__device__ __forceinline__ void reduce8_fq(const float (&s)[8], float& o0, float& o1) {
    float t[4];
#pragma unroll
    for (int i = 0; i < 4; ++i) { auto r = __builtin_amdgcn_permlane32_swap(__float_as_uint(s[i]), __float_as_uint(s[i + 4]), false, false); t[i] = __uint_as_float(r[0]) + __uint_as_float(r[1]); }
    { auto r = __builtin_amdgcn_permlane16_swap(__float_as_uint(t[0]), __float_as_uint(t[2]), false, false); o0 = __uint_as_float(r[0]) + __uint_as_float(r[1]); }
    { auto r = __builtin_amdgcn_permlane16_swap(__float_as_uint(t[1]), __float_as_uint(t[3]), false, false); o1 = __uint_as_float(r[0]) + __uint_as_float(r[1]); }
}
__device__ __forceinline__ float allred8(float x) { x = DPP_ADD(x, 0xB1); x = DPP_ADD(x, 0x4E); x = DPP_ADD(x, 0x141); return x; }

namespace pg8 {
constexpr int BM = 256, BK = 64, HALF = 128, HTB = HALF * BK * 2, STAGE_BYTES = 8 * HTB;
__host__ __device__ __forceinline__ int lds_byte(int r, int c) { const int st = (r >> 4) * 2 + (c >> 5), rr = r & 15, cc = c & 31, ob = rr * 64 + cc * 2; return st * 1024 + (ob ^ (((ob >> 9) & 1) << 5)); }
__host__ __device__ __forceinline__ void stage_rc(int b, int& R, int& C) { const int st = b / 1024, sb = b % 1024, swz = sb ^ (((sb >> 9) & 1) << 5); R = (st >> 1) * 16 + swz / 64; C = (st & 1) * 32 + (swz % 64) / 2; }
__host__ __device__ __forceinline__ int perm32(int rho) { const int n = rho >> 4, i = rho & 15; return 8 * (i >> 2) + 4 * n + (i & 3); }

constexpr int GT_INT = 2624, GM_BYTE = 10760, GT_MAX = 1280;
struct Unit { int pm, pn, e, row0, cnt, chunk, arow, b1, b2, b3; };
struct Gemm { const bf16_t* A; const bf16_t* Bt; int lda, ldb, K; int noepi = 0; };

struct DenseOrder {
    static constexpr bool GATHER = false;
    int nM, nN, nwg, G, c;
    __device__ void init(int M, int N, int G_, int c_) { nM = M / BM; nN = N / BM; nwg = nM * nN; G = G_; c = c_; }
    __device__ bool next(int i, Unit& u) const {
        const long L = (long)i * G + c; if (L >= nwg) return false;
        int wgid = (int)L; { const int q = nwg / 8, r = nwg % 8, xcd = wgid % 8, off = wgid / 8; wgid = (xcd < r ? xcd * (q + 1) : r * (q + 1) + (xcd - r) * q) + off; }
        const int nig = 8 * nN, gid = wgid / nig, fm = gid * 8, gsz = (nM - fm) < 8 ? (nM - fm) : 8;
        u.pm = fm + ((wgid % nig) % gsz); u.pn = (wgid % nig) / gsz; u.e = 0; u.row0 = 0; u.cnt = 0; u.chunk = 0; return true;
    }
    __device__ __forceinline__ unsigned a_base(const Gemm& g, const Unit& u) const { return (unsigned)u.pm * (unsigned)(BM * 2) * (unsigned)g.lda; }
    __device__ __forceinline__ unsigned b_base(const Gemm& g, const Unit& u) const { return (unsigned)u.pn * (unsigned)(BM * 2) * (unsigned)g.ldb; }
    __device__ __forceinline__ unsigned row_off(const Gemm& g, const Unit& u, int lr) const { return (unsigned)lr * (unsigned)g.lda * 2u; }
};

template <bool GATHER_> struct MoeOrder {
    static constexpr bool GATHER = GATHER_;
    const LAS int* tab; const int* list; int ncol, G, c, c0, c1, nb_rows, skip_shared;
    __device__ bool next(int i, Unit& u) const {
        const int t0 = __builtin_amdgcn_readfirstlane(tab[2048 + c0]); int ntile = __builtin_amdgcn_readfirstlane(tab[2048 + c1]) - t0; if (skip_shared) ntile = __builtin_amdgcn_readfirstlane(tab[512 * c0 + NEXP]); int ti, pn;
        if (G == 256) { const int x = c & 7, slot = c >> 3, rt = 32 / ncol; ti = i * 8 * rt + x * rt + slot / ncol; pn = slot % ncol; if (ti >= ntile) return false; }
        else { const int L = i * G + c; if (L >= ntile * ncol) return false; ti = L / ncol; pn = L % ncol; }
        const int tg = t0 + ti; int k = c0; while (k + 1 < c1 && __builtin_amdgcn_readfirstlane(tab[2048 + k + 1]) <= tg) ++k;
        const int tl = tg - __builtin_amdgcn_readfirstlane(tab[2048 + k]); const LAS int* tk = tab + 512 * k;
        const int e = __builtin_amdgcn_readfirstlane(tk[144 + tl]);
        u.pm = tg; u.pn = pn; u.e = e; u.chunk = k; u.row0 = __builtin_amdgcn_readfirstlane((tl - tk[e]) * BM); u.cnt = __builtin_amdgcn_readfirstlane(tk[72 + e]);
        if (!GATHER) { int pc = 0; for (int kk = 0; kk < k; ++kk) pc += __builtin_amdgcn_readfirstlane(tab[512 * kk + 72 + e]);
            u.arow = __builtin_amdgcn_readfirstlane(tab[GT_INT + e]) * BM + pc + u.row0; }
        return true;
    }
    __device__ __forceinline__ unsigned a_base(const Gemm& g, const Unit& u) const { return GATHER ? 0u : (unsigned)u.arow * 2u * (unsigned)g.lda; }
    __device__ __forceinline__ unsigned b_base(const Gemm& g, const Unit& u) const { return ((unsigned)u.e * (unsigned)nb_rows + (unsigned)u.pn * BM) * (unsigned)g.ldb * 2u; }
    __device__ __forceinline__ int row_ent(const Gemm& g, const Unit& u, int lr) const { return 0; }
    __device__ __forceinline__ void prefetch_rows(const Gemm&, const Unit&, int, LAS unsigned char*) const {}
    __device__ __forceinline__ int row_ent_lds(LAS unsigned char*, int) const { return 0; }
    __device__ __forceinline__ unsigned row_fin(const Gemm& g, const Unit& u, int lr, int) const { return row_off(g, u, lr); }
    __device__ __forceinline__ unsigned row_off(const Gemm& g, const Unit& u, int lr) const {
        if (!GATHER) return (unsigned)lr * (unsigned)g.lda * 2u;
        const int pos = u.row0 + lr; int tl = 0;
        if (pos < u.cnt) tl = u.e == NEXP ? pos : (list[((size_t)u.chunk * NE1 + u.e) * CH_TOK + pos] >> 3);
        const unsigned tok = (unsigned)u.chunk * CH_TOK + (unsigned)tl;
        return tok * (unsigned)g.lda * 2u;
    }
};

struct MoeOrderG1 {
    static constexpr bool GATHER = true;
    const LAS int* tab; const int* list; int G, c, nb_rows;
    __device__ bool next(int i, Unit& u) const {
        static_assert(NCHUNK == 4, "chunk boundaries b1..b3");
        const int ntile = __builtin_amdgcn_readfirstlane(tab[GT_INT + NE1]); constexpr int ncol = 4, rt = 32 / ncol; int ti, pn;
        if (G == 256) { const int x = c & 7, slot = c >> 3; ti = i * 8 * rt + x * rt + slot / ncol; pn = slot % ncol; if (ti >= ntile) return false; }
        else { const int L = i * G + c; if (L >= ntile * ncol) return false; ti = L / ncol; pn = L % ncol; }
        const int e = __builtin_amdgcn_readfirstlane((int)((const LAS unsigned char*)tab)[GM_BYTE + ti]);
        const int n0 = __builtin_amdgcn_readfirstlane(tab[72 + e]), n1 = __builtin_amdgcn_readfirstlane(tab[512 + 72 + e]), n2 = __builtin_amdgcn_readfirstlane(tab[1024 + 72 + e]), n3 = __builtin_amdgcn_readfirstlane(tab[1536 + 72 + e]);
        u.pm = ti; u.pn = pn; u.e = e; u.chunk = 0; u.row0 = (ti - __builtin_amdgcn_readfirstlane(tab[GT_INT + e])) * BM; u.b1 = n0; u.b2 = n0 + n1; u.b3 = n0 + n1 + n2; u.cnt = n0 + n1 + n2 + n3; u.arow = 0; return true;
    }
    __device__ __forceinline__ unsigned a_base(const Gemm& g, const Unit& u) const { return 0u; }
    __device__ __forceinline__ unsigned b_base(const Gemm& g, const Unit& u) const { return ((unsigned)u.e * (unsigned)nb_rows + (unsigned)u.pn * BM) * (unsigned)g.ldb * 2u; }
    __device__ __forceinline__ unsigned row_off(const Gemm& g, const Unit& u, int lr) const {
        return row_fin(g, u, lr, row_ent(g, u, lr));
    }
    __device__ __forceinline__ int row_ent(const Gemm& g, const Unit& u, int lr) const {
        const int pos = u.row0 + lr; const bool valid = pos < u.cnt;
        const int k = (pos >= u.b1) + (pos >= u.b2) + (pos >= u.b3); int base = pos >= u.b1 ? u.b1 : 0; base = pos >= u.b2 ? u.b2 : base; base = pos >= u.b3 ? u.b3 : base;
        const int idx = (valid && u.e != NEXP) ? (k * NE1 + u.e) * CH_TOK + (pos - base) : 0;
        return list[idx];
    }
    static constexpr int LDS_GL = STAGE_BYTES + 8448;
    __device__ __forceinline__ void prefetch_rows(const Gemm& g, const Unit& u, int wid, LAS unsigned char* lds) const {
        if (wid < 4) { int l_ = threadIdx.x; asm volatile("" : "+v"(l_)); const int lr = wid * 64 + (l_ & 63);
            const int pos = u.row0 + lr; const bool valid = pos < u.cnt;
            const int k = (pos >= u.b1) + (pos >= u.b2) + (pos >= u.b3); int base = pos >= u.b1 ? u.b1 : 0; base = pos >= u.b2 ? u.b2 : base; base = pos >= u.b3 ? u.b3 : base;
            const int idx = (valid && u.e != NEXP) ? (k * NE1 + u.e) * CH_TOK + (pos - base) : 0;
            const int* gp = list + idx; const unsigned ldsa = (unsigned)(size_t)(lds + LDS_GL + wid * 256);
            asm volatile("s_mov_b32 m0, %0\n\ts_nop 0\n\tglobal_load_lds_dword %1, off" :: "s"(ldsa), "v"(gp) : "memory", "m0"); } }
    __device__ __forceinline__ int row_ent_lds(LAS unsigned char* lds, int lr) const { return *(const LAS int*)(lds + LDS_GL + lr * 4); }
    __device__ __forceinline__ unsigned row_fin(const Gemm& g, const Unit& u, int lr, int ent) const {
        const int pos = u.row0 + lr; const bool valid = pos < u.cnt;
        const int k = (pos >= u.b1) + (pos >= u.b2) + (pos >= u.b3); int base = pos >= u.b1 ? u.b1 : 0; base = pos >= u.b2 ? u.b2 : base; base = pos >= u.b3 ? u.b3 : base;
        const int tl = u.e == NEXP ? pos - base : (ent >> 3);
        const unsigned tok = valid ? (unsigned)k * CH_TOK + (unsigned)tl : 0u;
        return tok * (unsigned)g.lda * 2u;
    }
};

template <class...> using void_t_ = void;
template <class E, class = void> struct EpiScale { static constexpr int A = 0x7f7f7f7f, B = 0x7f7f7f7f; };
template <class E> struct EpiScale<E, void_t_<decltype(E::SCALE_A)>> { static constexpr int A = E::SCALE_A, B = E::SCALE_B; };
template <class Epi, class Sched>
__device__ __forceinline__ void gemm_phase(LAS unsigned char* lds, const Gemm g, const Sched& S, const Epi& E) {
    int tid_ = threadIdx.x; asm volatile("" : "+v"(tid_));
    const int tid = tid_, wid = __builtin_amdgcn_readfirstlane(tid >> 6), lane = tid & 63, wr = wid >> 2, wc = wid & 3, fr = lane & 15, fq = lane >> 4;
    int K_ = g.K; asm volatile("" : "+s"(K_));
    const int K = K_, nt = K / BK;
    int Rr[2]; unsigned cA2[2], voffB[2];
#pragma unroll
    for (int i = 0; i < 2; ++i) { int R, C; stage_rc(tid * 16 + i * 8192, R, C); const int Rb = Epi::PERM == 2 ? (64 * (R >> 5) + 16 * ((R >> 2) & 3) + 4 * ((R >> 4) & 1) + (R & 3)) : Epi::PERM == 1 ? ((R & ~31) + perm32(R & 31)) : R;
        Rr[i] = R; cA2[i] = (unsigned)C * 2u; voffB[i] = (unsigned)(Rb * g.ldb + C) * 2u; }
    const unsigned kstep = (unsigned)(BK * 2);
    const unsigned hstepB = (unsigned)(Epi::PERM == 2 ? 8 : HALF) * (unsigned)g.ldb * 2u;
    const char* const Ab = (const char*)g.A; const char* const Bb = (const char*)g.Bt;
    const unsigned ldsw = (unsigned)wid * 1024u;
    const int aoff = lds_byte(wr * 64 + fr, fq * 8), boff = lds_byte(wc * 32 + fr, fq * 8);
#define PG8_SA(b, h) (((b) * 2 + (h)) * HTB)
#define PG8_SB(b, h) ((4 + (b) * 2 + (h)) * HTB)
#define PG8_STAGE_B(bufoff, gbase, h) do { _Pragma("unroll") for (int _i = 0; _i < 2; ++_i) \
        __builtin_amdgcn_global_load_lds((const unsigned*)(Bb + (size_t)((gbase) + (unsigned)(h) * hstepB + voffB[_i])), (LAS unsigned*)(lds + (bufoff) + ldsw + _i * 8192), 16, 0, 0); } while (0)
#define PG8_STAGE_A(bufoff, gbase, V, h) do { _Pragma("unroll") for (int _i = 0; _i < 2; ++_i) \
        __builtin_amdgcn_global_load_lds((const unsigned*)(Ab + (size_t)((gbase) + (V)[h][_i])), (LAS unsigned*)(lds + (bufoff) + ldsw + _i * 8192), 16, 0, 0); } while (0)
#define PG8_LDA(dst, b, h) do { _Pragma("unroll") for (int m = 0; m < 4; ++m) _Pragma("unroll") for (int k = 0; k < 2; ++k) dst[m][k] = *(const LAS bf16x8*)(lds + PG8_SA(b, h) + aoff + m * 2048 + k * 1024); } while (0)
#define PG8_LDB(dst, b, h) do { _Pragma("unroll") for (int n = 0; n < 2; ++n) _Pragma("unroll") for (int k = 0; k < 2; ++k) dst[n][k] = *(const LAS bf16x8*)(lds + PG8_SB(b, h) + boff + n * 2048 + k * 1024); } while (0)
#define PG8_MMA(ai, bj, At, Bt) do { __builtin_amdgcn_s_setprio(1); _Pragma("unroll") for (int m = 0; m < 4; ++m) _Pragma("unroll") for (int n = 0; n < 2; ++n) { \
        if constexpr (Epi::FP8) { i32x8 bv_, av_; { const u32x4 b0_ = *(const u32x4*)&Bt[n][0], b1_ = *(const u32x4*)&Bt[n][1], a0_ = *(const u32x4*)&At[m][0], a1_ = *(const u32x4*)&At[m][1]; \
                bv_ = (i32x8){(int)b0_[0], (int)b0_[1], (int)b0_[2], (int)b0_[3], (int)b1_[0], (int)b1_[1], (int)b1_[2], (int)b1_[3]}; av_ = (i32x8){(int)a0_[0], (int)a0_[1], (int)a0_[2], (int)a0_[3], (int)a1_[0], (int)a1_[1], (int)a1_[2], (int)a1_[3]}; } \
            acc[ai][bj][m][n] = __builtin_amdgcn_mfma_scale_f32_16x16x128_f8f6f4(bv_, av_, acc[ai][bj][m][n], 0, 0, 0, EpiScale<Epi>::A, 0, EpiScale<Epi>::B); } \
        else { _Pragma("unroll") for (int k = 0; k < 2; ++k) acc[ai][bj][m][n] = __builtin_amdgcn_mfma_f32_16x16x32_bf16(Bt[n][k], At[m][k], acc[ai][bj][m][n], 0, 0, 0); } } \
        __builtin_amdgcn_s_setprio(0); } while (0)
#define PG8_WAIT_V(n) asm volatile("s_waitcnt vmcnt(" #n ")" ::: "memory")
#define PG8_WAIT_L(n) asm volatile("s_waitcnt lgkmcnt(" #n ")" ::: "memory")
#define PG8_BAR __builtin_amdgcn_s_barrier()
#define PG8_SCHED __builtin_amdgcn_sched_barrier(0)
#define PG8_ROWS(V, u, FROM_LDS) do { if constexpr (Sched::GATHER) { int ent_[2][2]; \
            _Pragma("unroll") for (int _h = 0; _h < 2; ++_h) _Pragma("unroll") for (int _i = 0; _i < 2; ++_i) ent_[_h][_i] = (FROM_LDS) ? S.row_ent_lds(lds, _h * HALF + Rr[_i]) : S.row_ent(g, (u), _h * HALF + Rr[_i]); \
            asm volatile("" : "+v"(ent_[0][0]), "+v"(ent_[0][1]), "+v"(ent_[1][0]), "+v"(ent_[1][1]));        \
            _Pragma("unroll") for (int _h = 0; _h < 2; ++_h) _Pragma("unroll") for (int _i = 0; _i < 2; ++_i) (V)[_h][_i] = S.row_fin(g, (u), _h * HALF + Rr[_i], ent_[_h][_i]) + cA2[_i]; } \
        else { _Pragma("unroll") for (int _h = 0; _h < 2; ++_h) _Pragma("unroll") for (int _i = 0; _i < 2; ++_i) (V)[_h][_i] = S.row_off(g, (u), _h * HALF + Rr[_i]) + cA2[_i]; } } while (0)
    Unit cur, nxt; int ui = 0;
    if (!S.next(0, cur)) return;
    f32x4 acc[2][2][4][2];
    bf16x8 At[4][2], B0[2][2], B1[2][2];
    unsigned vA[2][2];
    PG8_ROWS(vA, cur, 0);
    unsigned cA = S.a_base(g, cur), cB = S.b_base(g, cur);
    PG8_STAGE_B(PG8_SB(0, 0), cB, 0); PG8_STAGE_A(PG8_SA(0, 0), cA, vA, 0); PG8_STAGE_B(PG8_SB(0, 1), cB, 1); PG8_STAGE_A(PG8_SA(0, 1), cA, vA, 1);
    if (wr == 1) PG8_BAR;
    PG8_WAIT_V(4); PG8_BAR;
    PG8_STAGE_B(PG8_SB(1, 0), cB + kstep, 0); PG8_STAGE_A(PG8_SA(1, 0), cA + kstep, vA, 0); PG8_STAGE_B(PG8_SB(1, 1), cB + kstep, 1);
    PG8_WAIT_V(6); PG8_BAR;
#pragma unroll
    for (int a = 0; a < 2; ++a)
#pragma unroll
        for (int b = 0; b < 2; ++b)
#pragma unroll
            for (int m = 0; m < 4; ++m)
#pragma unroll
                for (int n = 0; n < 2; ++n) acc[a][b][m][n] = (f32x4){0.f, 0.f, 0.f, 0.f};
    for (;;) {
        const bool has_next = S.next(ui + 1, nxt);
        const unsigned nA = has_next ? S.a_base(g, nxt) : cA, nB = has_next ? S.b_base(g, nxt) : cB;
#pragma nounroll
        for (int t = 0; t < nt; t += 2) {
            const bool last = (t == nt - 2);
            if constexpr (Epi::PREFETCH) { if (last) E.prefetch(cur, wid, lds); }
            if constexpr (Sched::GATHER) { if (t == 0 && has_next) S.prefetch_rows(g, nxt, wid, lds); }
            asm volatile("" : "+v"(vA[0][0]), "+v"(vA[0][1]), "+v"(vA[1][0]), "+v"(vA[1][1]), "+v"(voffB[0]), "+v"(voffB[1]));
            const unsigned a1 = cA + (unsigned)(t + 1) * kstep;
            const unsigned a2 = last ? nA : cA + (unsigned)(t + 2) * kstep, b2 = last ? nB : cB + (unsigned)(t + 2) * kstep;
            const unsigned a3 = a2 + kstep, b3 = b2 + kstep;
            PG8_LDB(B0, 0, 0); PG8_SCHED; PG8_LDA(At, 0, 0); PG8_STAGE_A(PG8_SA(1, 1), a1, vA, 1);
            if (Sched::GATHER) { if (last && has_next) PG8_ROWS(vA, nxt, 1); }
            PG8_WAIT_L(8); PG8_BAR; PG8_WAIT_L(0); PG8_MMA(0, 0, At, B0); PG8_BAR; PG8_SCHED;
            PG8_LDB(B1, 0, 1); PG8_STAGE_B(PG8_SB(0, 0), b2, 0);
            PG8_BAR; PG8_WAIT_L(0); PG8_MMA(0, 1, At, B1); PG8_BAR;
            PG8_LDA(At, 0, 1); PG8_STAGE_A(PG8_SA(0, 0), a2, vA, 0);
            PG8_BAR; PG8_WAIT_L(0); PG8_MMA(1, 0, At, B0); PG8_BAR; PG8_SCHED;
            PG8_STAGE_B(PG8_SB(0, 1), b2, 1);
            PG8_WAIT_V(6); PG8_BAR; PG8_MMA(1, 1, At, B1); PG8_BAR;
            PG8_LDB(B0, 1, 0); PG8_SCHED; PG8_LDA(At, 1, 0); PG8_STAGE_A(PG8_SA(0, 1), a2, vA, 1);
            PG8_WAIT_L(8); PG8_BAR; PG8_WAIT_L(0); PG8_MMA(0, 0, At, B0); PG8_BAR; PG8_SCHED;
            PG8_LDB(B1, 1, 1); PG8_STAGE_B(PG8_SB(1, 0), b3, 0);
            PG8_BAR; PG8_WAIT_L(0); PG8_MMA(0, 1, At, B1); PG8_BAR;
            PG8_LDA(At, 1, 1); PG8_STAGE_A(PG8_SA(1, 0), a3, vA, 0);
            PG8_BAR; PG8_WAIT_L(0); PG8_MMA(1, 0, At, B0); PG8_BAR; PG8_SCHED;
            PG8_STAGE_B(PG8_SB(1, 1), b3, 1);
            PG8_WAIT_V(6); PG8_BAR; PG8_MMA(1, 1, At, B1); PG8_BAR;
        }
        { int z_ = 0; asm volatile("" : "+v"(z_));
          if (PROBE_NOSTORE && g.noepi) { asm volatile("" :: "v"(acc[0][0][0][0]), "v"(acc[1][1][3][1]), "v"(acc[0][1][2][1]), "v"(acc[1][0][1][0])); }
          else if constexpr (Epi::PREFETCH) E.epi(acc, cur, wr, wc, fr + z_, fq + z_, lds); else E(acc, cur, wr, wc, fr + z_, fq + z_); }
        if (!has_next) break;
#pragma unroll
        for (int a = 0; a < 2; ++a)
#pragma unroll
            for (int b = 0; b < 2; ++b)
#pragma unroll
                for (int m = 0; m < 4; ++m)
#pragma unroll
                    for (int n = 0; n < 2; ++n) acc[a][b][m][n] = (f32x4){0.f, 0.f, 0.f, 0.f};
        cur = nxt; cA = nA; cB = nB; ++ui;
    }
    PG8_WAIT_V(0);
    if (wr == 0) PG8_BAR;
    PG8_BAR;
#undef PG8_SA
#undef PG8_SB
#undef PG8_STAGE_A
#undef PG8_STAGE_B
#undef PG8_LDA
#undef PG8_LDB
#undef PG8_MMA
#undef PG8_WAIT_V
#undef PG8_WAIT_L
#undef PG8_BAR
#undef PG8_SCHED
#undef PG8_ROWS
}
}
using pg8::Unit;
constexpr int LDS_STAGE_BYTES = pg8::STAGE_BYTES;
typedef f32x4 AccT[2][2][4][2];

struct EpiProj {
    static constexpr int PERM = 1; static constexpr bool FP8 = true, PREFETCH = false;
    static constexpr int SCALE_A = 0x7b7b7b7b, SCALE_B = 0x79797979;
    bf16_t* Z; float* ssqp;
    __device__ __forceinline__ void operator()(const AccT& acc, const Unit& u, int wr, int wc, int fr, int fq) const {
        const int row0 = u.pm * 256 + wr * 64 + fr, col0 = u.pn * 256 + wc * 32 + 8 * fq;
        const bool st = u.pn <= 2; const int slot = u.pn * 4 + wc;
#pragma unroll
        for (int ai = 0; ai < 2; ++ai)
#pragma unroll
            for (int m = 0; m < 4; ++m) { const int row = row0 + ai * 128 + m * 16; bf16_t* rp = Z + (size_t)row * ZW + col0;
#pragma unroll
                for (int bj = 0; bj < 2; ++bj) *(u32x4*)(rp + bj * 128) = pack8(acc[ai][bj][m][0], acc[ai][bj][m][1]); }
        if (st) { float sv[8];
#pragma unroll
            for (int ai = 0; ai < 2; ++ai)
#pragma unroll
                for (int m = 0; m < 4; ++m) { float s = 0.f;
#pragma unroll
                    for (int bj = 0; bj < 2; ++bj) { const f32x4 v0 = acc[ai][bj][m][0], v1 = acc[ai][bj][m][1];
                        s += v0[0] * v0[0] + v0[1] * v0[1] + v0[2] * v0[2] + v0[3] * v0[3] + v1[0] * v1[0] + v1[1] * v1[1] + v1[2] * v1[2] + v1[3] * v1[3]; }
                    sv[ai * 4 + m] = s; }
            float o0, o1; reduce8_fq(sv, o0, o1);
            const int r0 = 2 * fq, r1 = 2 * fq + 1;
            ssqp[(size_t)(row0 + (r0 >> 2) * 128 + (r0 & 3) * 16) * 12 + slot] = o0; ssqp[(size_t)(row0 + (r1 >> 2) * 128 + (r1 & 3) * 16) * 12 + slot] = o1; }
    }
};
struct EpiQup {
    static constexpr int PERM = 1; static constexpr bool FP8 = false, PREFETCH = false;
    bf16_t* Q; const float* ssqp;
    __device__ __forceinline__ void operator()(const AccT& acc, const Unit& u, int wr, int wc, int fr, int fq) const {
        const int row0 = u.pm * 256 + wr * 64 + fr, col0 = u.pn * 256 + wc * 32 + 8 * fq;
        float scv[2][4];
#pragma unroll
        for (int ai = 0; ai < 2; ++ai)
#pragma unroll
            for (int m = 0; m < 4; ++m) { const int row = row0 + ai * 128 + m * 16; const f32x4 p0 = *(const f32x4*)(ssqp + (size_t)row * 12), p1 = *(const f32x4*)(ssqp + (size_t)row * 12 + 4); scv[ai][m] = rsqrtf((((p0[0] + p0[1]) + (p0[2] + p0[3])) + ((p1[0] + p1[1]) + (p1[2] + p1[3]))) * (1.0f / 512.0f) + RMS_EPS); }
#pragma unroll
        for (int ai = 0; ai < 2; ++ai)
#pragma unroll
            for (int m = 0; m < 4; ++m) { const int row = row0 + ai * 128 + m * 16; const float sc = scv[ai][m]; bf16_t* rp = Q + (size_t)row * QW + col0;
#pragma unroll
                for (int bj = 0; bj < 2; ++bj) *(u32x4*)(rp + bj * 128) = pack8(acc[ai][bj][m][0] * sc, acc[ai][bj][m][1] * sc); }
    }
};
struct EpiKV {
    static constexpr int PERM = 1; static constexpr bool FP8 = false, PREFETCH = false;
    bf16_t* Kb; bf16_t* Vb; const float* ssqp;
    __device__ __forceinline__ void operator()(const AccT& acc, const Unit& u, int wr, int wc, int fr, int fq) const {
        const int row0 = u.pm * 256 + wr * 64 + fr, c0 = wc * 32 + 8 * fq;
        float scv[2][4];
#pragma unroll
        for (int ai = 0; ai < 2; ++ai)
#pragma unroll
            for (int m = 0; m < 4; ++m) { const int row = row0 + ai * 128 + m * 16; const f32x4 p2 = *(const f32x4*)(ssqp + (size_t)row * 12 + 8); scv[ai][m] = rsqrtf(((p2[0] + p2[1]) + (p2[2] + p2[3])) * (1.0f / 256.0f) + RMS_EPS); }
#pragma unroll
        for (int ai = 0; ai < 2; ++ai)
#pragma unroll
            for (int m = 0; m < 4; ++m) { const int row = row0 + ai * 128 + m * 16; const float sc = scv[ai][m];
                *(u32x4*)(Kb + (size_t)row * QW + u.pn * 192 + c0) = pack8(acc[ai][0][m][0] * sc, acc[ai][0][m][1] * sc);
                *(u32x4*)(Vb + (size_t)row * 1024 + u.pn * 128 + c0) = pack8(acc[ai][1][m][0] * sc, acc[ai][1][m][1] * sc); }
    }
};
struct EpiPlain {
    static constexpr int PERM = 1; static constexpr bool FP8 = false, PREFETCH = false;
    bf16_t* O; int ld;
    __device__ __forceinline__ void operator()(const AccT& acc, const Unit& u, int wr, int wc, int fr, int fq) const {
        const int row0 = u.pm * 256 + wr * 64 + fr, col0 = u.pn * 256 + wc * 32 + 8 * fq;
#pragma unroll
        for (int ai = 0; ai < 2; ++ai)
#pragma unroll
            for (int m = 0; m < 4; ++m) { bf16_t* rp = O + (size_t)(row0 + ai * 128 + m * 16) * ld + col0;
#pragma unroll
                for (int bj = 0; bj < 2; ++bj) *(u32x4*)(rp + bj * 128) = pack8(acc[ai][bj][m][0], acc[ai][bj][m][1]); }
    }
};
struct EpiWout {
    static constexpr int PERM = 0; static constexpr bool FP8 = true, PREFETCH = false;
    static constexpr int SCALE_A = 0x7b7b7b7b, SCALE_B = 0x79797979;
    const float* X; float* H;
    __device__ __forceinline__ void operator()(const AccT& acc, const Unit& u, int wr, int wc, int fr, int fq) const {
        const int row0 = u.pm * 256 + wr * 64 + fr, col0 = u.pn * 256 + wc * 32 + 4 * fq;
#pragma unroll
        for (int ai = 0; ai < 2; ++ai) { f32x4 xv[4][2][2];
#pragma unroll
            for (int m = 0; m < 4; ++m)
#pragma unroll
                for (int bj = 0; bj < 2; ++bj)
#pragma unroll
                    for (int n = 0; n < 2; ++n) xv[m][bj][n] = *(const f32x4*)(X + (size_t)(row0 + ai * 128 + m * 16) * DM + col0 + bj * 128 + n * 16);
#pragma unroll
            for (int m = 0; m < 4; ++m)
#pragma unroll
                for (int bj = 0; bj < 2; ++bj)
#pragma unroll
                    for (int n = 0; n < 2; ++n) *(f32x4*)(H + (size_t)(row0 + ai * 128 + m * 16) * DM + col0 + bj * 128 + n * 16) = xv[m][bj][n] + acc[ai][bj][m][n]; }
    }
};
struct EpiMoe1 {
    static constexpr int PERM = 1; static constexpr bool FP8 = true, PREFETCH = false;
    unsigned char* Hmid;
    __device__ __forceinline__ void operator()(const AccT& acc, const Unit& u, int wr, int wc, int fr, int fq) const {
        const int row0 = u.pm * 256 + wr * 64 + fr, c0 = u.pn * 128 + wc * 32 + 8 * fq; constexpr float SC = 1.0f / 1024.0f;
#pragma unroll
        for (int ai = 0; ai < 2; ++ai)
#pragma unroll
            for (int m = 0; m < 4; ++m) { float h0[4], h1[4];
#pragma unroll
                for (int j = 0; j < 4; ++j) { const float a0 = acc[ai][0][m][0][j], a1 = acc[ai][0][m][1][j];
                    h0[j] = a0 * acc[ai][1][m][0][j] * (SC * SC * 4.0f) * __builtin_amdgcn_rcpf(1.0f + __builtin_amdgcn_exp2f(a0 * (-SC * 1.44269504f)));
                    h1[j] = a1 * acc[ai][1][m][1][j] * (SC * SC * 4.0f) * __builtin_amdgcn_rcpf(1.0f + __builtin_amdgcn_exp2f(a1 * (-SC * 1.44269504f))); }
                u32x2 w; w.x = pk_fp8x4(h0[0], h0[1], h0[2], h0[3]); w.y = pk_fp8x4(h1[0], h1[1], h1[2], h1[3]);
                *(u32x2*)(Hmid + (size_t)(row0 + ai * 128 + m * 16) * 512 + c0) = w; }
    }
};
struct EpiMoe2 {
    static constexpr int PERM = 2; static constexpr bool FP8 = true, PREFETCH = true;
    static constexpr int LDS_RI = LDS_STAGE_BYTES + 8448;
    unsigned char* Y; const i32x2* rinfo; float* H; int chunk, nostore;
    __device__ __forceinline__ void prefetch(const Unit& u, int wid, LAS unsigned char* lds) const {
        if (wid < 2) { int l_ = threadIdx.x; asm volatile("" : "+v"(l_));
            const unsigned ldsa = (unsigned)(size_t)(lds + LDS_RI + wid * 1024); const i32x2* gp = rinfo + (size_t)u.pm * 256 + wid * 128 + (l_ & 63) * 2;
            asm volatile("s_mov_b32 m0, %0\n\ts_nop 0\n\tglobal_load_lds_dwordx4 %1, off" :: "s"(ldsa), "v"(gp) : "memory", "m0"); } }
    __device__ __forceinline__ void epi(const AccT& acc, const Unit& u, int wr, int wc, int fr, int fq, LAS unsigned char* lds) const {
        const int lr0 = wr * 64 + fr, col0 = u.pn * 256 + wc * 64 + 16 * fq; const LAS i32x2* rp0 = (const LAS i32x2*)(lds + LDS_RI) + lr0;
        if (u.e != NEXP) {
#pragma unroll
            for (int ai = 0; ai < 2; ++ai)
#pragma unroll
                for (int m = 0; m < 4; ++m) { const i32x2 ri = rp0[ai * 128 + m * 16]; const float w = __int_as_float(ri.y) * 16.0f; unsigned char* rp = Y + (size_t)ri.x * DM + col0;
                    u32x4 w8;
#pragma unroll
                    for (int bj = 0; bj < 2; ++bj) { const f32x4 y0 = acc[ai][bj][m][0] * w, y1 = acc[ai][bj][m][1] * w;
                        w8[2 * bj] = __builtin_amdgcn_cvt_pk_fp8_f32(y0[2], y0[3], __builtin_amdgcn_cvt_pk_fp8_f32(y0[0], y0[1], 0, false), true);
                        w8[2 * bj + 1] = __builtin_amdgcn_cvt_pk_fp8_f32(y1[2], y1[3], __builtin_amdgcn_cvt_pk_fp8_f32(y1[0], y1[1], 0, false), true); }
                    if (nostore && PROBE_NOSTORE) asm volatile("" :: "v"(w8)); else *(u32x4*)rp = w8; }
        } else {
#pragma unroll
            for (int ai = 0; ai < 2; ++ai) { f32x4 hv[4][2][2]; i32x2 ri[4];
#pragma unroll
                for (int m = 0; m < 4; ++m) { ri[m] = rp0[ai * 128 + m * 16]; const float* hp = H + ((size_t)chunk * CH_TOK + (size_t)(-2 - ri[m].x)) * DM + col0;
#pragma unroll
                    for (int bj = 0; bj < 2; ++bj) { hv[m][bj][0] = *(const f32x4*)(hp + bj * 8); hv[m][bj][1] = *(const f32x4*)(hp + bj * 8 + 4); } }
#pragma unroll
                for (int m = 0; m < 4; ++m) { const float w = __int_as_float(ri[m].y); float* hp = H + ((size_t)chunk * CH_TOK + (size_t)(-2 - ri[m].x)) * DM + col0;
#pragma unroll
                    for (int bj = 0; bj < 2; ++bj) { *(f32x4*)(hp + bj * 8) = hv[m][bj][0] + acc[ai][bj][m][0] * w; *(f32x4*)(hp + bj * 8 + 4) = hv[m][bj][1] + acc[ai][bj][m][1] * w; } } }
        }
    }
};
struct EpiGate {
    static constexpr int PERM = 1; static constexpr bool FP8 = true, PREFETCH = false;
    const bf16_t* PP; const float* bias; bf16_t* U; float* ssq_u; int noepi;
    __device__ __forceinline__ void operator()(const AccT& acc, const Unit& u, int wr, int wc, int fr, int fq) const {
        if (noepi && PROBE_NOSTORE) { asm volatile("" :: "v"(acc[0][0][0][0][0]), "v"(acc[1][1][3][1][3])); return; }
        const int row0 = u.pm * 256 + wr * 64 + fr, col0 = u.pn * 256 + wc * 32 + 8 * fq;
        float ssr[2][4];
#pragma unroll
        for (int ai = 0; ai < 2; ++ai)
#pragma unroll
            for (int m = 0; m < 4; ++m) ssr[ai][m] = 0.f;
        u32x4 ppr[2][2][4];
        f32x4 bb[2][2];
#pragma unroll
        for (int bj = 0; bj < 2; ++bj) { bb[bj][0] = *(const f32x4*)(bias + col0 + bj * 128); bb[bj][1] = *(const f32x4*)(bias + col0 + bj * 128 + 4); }
#pragma unroll
        for (int bj = 0; bj < 2; ++bj) { const f32x4 b0 = bb[bj][0], b1 = bb[bj][1];
#pragma unroll
            for (int ai = 0; ai < 2; ++ai)
#pragma unroll
                for (int m = 0; m < 4; ++m) ppr[bj][ai][m] = *(const u32x4*)(PP + (size_t)(row0 + ai * 128 + m * 16) * DM + col0 + bj * 128);
#pragma unroll
            for (int ai = 0; ai < 2; ++ai)
#pragma unroll
                for (int m = 0; m < 4; ++m) { const size_t off = (size_t)(row0 + ai * 128 + m * 16) * DM + col0 + bj * 128; float pp[8]; unpack8(ppr[bj][ai][m], pp);
                    const f32x4 a0 = acc[ai][bj][m][0] * (1.0f / 1024.0f) + b0, a1 = acc[ai][bj][m][1] * (1.0f / 1024.0f) + b1; float uu[8]; float s = 0.f;
#pragma unroll
                    for (int e = 0; e < 4; ++e) { uu[e] = pp[e] * sigmoidf_(a0[e]); uu[4 + e] = pp[4 + e] * sigmoidf_(a1[e]); }
#pragma unroll
                    for (int e = 0; e < 8; ++e) s += uu[e] * uu[e];
                    *(u32x4*)(U + off) = packf8(uu); ssr[ai][m] += s; } }
        { float sv[8];
#pragma unroll
          for (int r = 0; r < 8; ++r) sv[r] = ssr[r >> 2][r & 3];
          float o0, o1; reduce8_fq(sv, o0, o1); const int r0 = 2 * fq, r1 = 2 * fq + 1;
          ssq_u[(size_t)(row0 + (r0 >> 2) * 128 + (r0 & 3) * 16) * 32 + u.pn * 4 + wc] = o0; ssq_u[(size_t)(row0 + (r1 >> 2) * 128 + (r1 & 3) * 16) * 32 + u.pn * 4 + wc] = o1; }
    }
};

#define XB_TMO      128
#define XB_XCNT(j)  (256  + 64 * (j))
#define XB_XSUB(j)  (1280 + 64 * (j))
#define XB_XGEN(j)  (2304 + 64 * (j))
#define XB_TOP      3328
#define XB_TOPGEN   3392
#define XCD_BAR_WORDS 3456
#define XB_SPIN_CAP (1u << 22)
__device__ __forceinline__ unsigned xb_ld(unsigned* p)              { return __hip_atomic_load(p, __ATOMIC_RELAXED, __HIP_MEMORY_SCOPE_AGENT); }
__device__ __forceinline__ unsigned xb_add(unsigned* p, unsigned v) { return __hip_atomic_fetch_add(p, v, __ATOMIC_RELAXED, __HIP_MEMORY_SCOPE_AGENT); }
__device__ __forceinline__ unsigned xb_xcc_id() { return (unsigned)__builtin_amdgcn_s_getreg((3 << 11) | 20) & 0xFu; }
#define XB_SPIN(cond, bar) do { unsigned _sp = 0; while (cond) { __builtin_amdgcn_s_sleep(1); \
    if ((++_sp & 255u) == 0u) { if (xb_ld(&(bar)[XB_TMO])) break; if (_sp > XB_SPIN_CAP) { atomicAdd(&(bar)[XB_TMO], 1u); break; } } } } while (0)
struct XcdBarrier { unsigned* bar; unsigned x; volatile LAS unsigned* st; };
__device__ __forceinline__ XcdBarrier xcd_barrier_post(unsigned* bar, volatile LAS unsigned* st) {
    XcdBarrier b; b.bar = bar; b.x = xb_xcc_id(); b.st = st;
    if (threadIdx.x == 0) (void)xb_add(&bar[XB_XCNT(b.x)], 1u);
    return b;
}
__device__ __forceinline__ void xcd_barrier_complete(unsigned* bar, unsigned x, unsigned& nloc, unsigned& nx) {
    const unsigned G = gridDim.x * gridDim.y * gridDim.z;
    unsigned sum, cnt, mine, sp = 0u;
    for (;;) {
        sum = 0u; cnt = 0u; mine = 0u;
#pragma unroll
        for (unsigned j = 0; j < 16; ++j) { const unsigned c = xb_ld(&bar[XB_XCNT(j)]); sum += c; cnt += (c > 0u) ? 1u : 0u; mine = (j == x) ? c : mine; }
        if (sum == G) break;
        __builtin_amdgcn_s_sleep(1);
        if ((++sp & 255u) == 0u) { if (xb_ld(&bar[XB_TMO])) break; if (sp > XB_SPIN_CAP) { atomicAdd(&bar[XB_TMO], 1u); break; } }
    }
    nloc = mine > 0u ? mine : 1u; nx = cnt > 0u ? cnt : 1u;
}
__device__ __forceinline__ void xcd_barrier(const XcdBarrier& b) {
    asm volatile("s_waitcnt vmcnt(0)" ::: "memory");
    __syncthreads();
    if (threadIdx.x == 0) {
        unsigned* bar = b.bar;
        __builtin_amdgcn_s_waitcnt(0);
        unsigned nloc = b.st[0], nx = b.st[1];
        if (nloc == 0u) { xcd_barrier_complete(bar, b.x, nloc, nx); b.st[0] = nloc; b.st[1] = nx; }
        const unsigned old = xb_add(&bar[XB_XSUB(b.x)], 1u);
        const unsigned gen = old / nloc;
        if (old + 1u == (gen + 1u) * nloc) {
            __builtin_amdgcn_fence(__ATOMIC_RELEASE, "agent");
            asm volatile("s_waitcnt vmcnt(0)" ::: "memory");
            const unsigned og = xb_add(&bar[XB_TOP], 1u);
            const unsigned tg = og / nx;
            if (og + 1u == (tg + 1u) * nx) xb_add(&bar[XB_TOPGEN], 1u);
            else XB_SPIN(xb_ld(&bar[XB_TOPGEN]) == tg, bar);
            __builtin_amdgcn_fence(__ATOMIC_ACQUIRE, "agent");
            xb_add(&bar[XB_XGEN(b.x)], 1u);
            asm volatile("s_waitcnt vmcnt(0)" ::: "memory");
        } else {
            XB_SPIN(xb_ld(&bar[XB_XGEN(b.x)]) == gen, bar);
            __builtin_amdgcn_fence(__ATOMIC_ACQUIRE, "agent");
            asm volatile("s_waitcnt vmcnt(0)" ::: "memory");
        }
    }
    __syncthreads();
}

struct Args { const void* in[37]; float* out; unsigned char* ws; int ph_lo, ph_hi; };
enum { I_X = 0, I_P, I_POS, I_GMIX, I_WIN, I_GQA, I_WUQ, I_GKVA, I_WUKV, I_GQN, I_GKN, I_MU, I_W0, I_WW2, I_A0, I_AW2, I_GW2, I_KK, I_KA, I_RK, I_LNW, I_LNB,
       I_WOUT, I_GFFN, I_WR, I_RBIAS, I_WG, I_WU, I_WD, I_SG, I_SU, I_SD, I_GPIN, I_WPG, I_BPG, I_WPP, I_GPOUT };

typedef const __attribute__((address_space(4))) Args KArgs;
struct Ctx { int tid, lane, wid, gw, nw; LAS unsigned char* lds; };

__device__ __forceinline__ int in_map(int n) {
    if (n < 832) return n; if (n < 896) return 3904 + (n - 832); if (n < 960) return 3968 + (n - 896); if (n < 1120) return 4032 + (n - 960); if (n < 1280) return -1; return 832 + (n - 1280);
}
template <int MODE, bool OUT8 = false>
__device__ __forceinline__ void convert_weight(const Ctx& c, const float* src0, const float* src1, int ld_src, const float* g, bf16_t* dst, int K, int Nd, int blk, int nblk) {
    LAS float* tile = (LAS float*)c.lds;
    const int tk = K / 64, ntile = tk * (Nd / 128);
    const int n4 = c.tid & 31, kr = c.tid >> 5, sc = c.tid & 7, sn = c.tid >> 3;
    f32x4 v[4];
#define CW_LOAD(t_) do { const int n0_ = ((t_) / tk) * 128, k0_ = ((t_) % tk) * 64, n_ = n0_ + 4 * n4; const float* sp_ = nullptr; \
        if (MODE == 0) sp_ = src0 + n_; \
        if (MODE == 1) { const int cc_ = in_map(n_); sp_ = cc_ >= 0 ? src0 + cc_ : nullptr; } \
        if (MODE == 2) { const int half_ = (n_ >> 7) & 1, cc_ = (n_ >> 8) * 128 + (n_ & 127); sp_ = (half_ ? src1 : src0) + cc_; } \
        _Pragma("unroll") for (int i = 0; i < 4; ++i) { const int k_ = k0_ + kr + 16 * i; v[i] = sp_ ? *(const f32x4*)(sp_ + (size_t)k_ * ld_src) : (f32x4){0.f, 0.f, 0.f, 0.f}; if (g) v[i] *= g[k_]; if (OUT8) v[i] *= 64.0f; } } while (0)
    int t = blk; if (t < ntile) CW_LOAD(t);
    for (; t < ntile; t += nblk) {
#pragma unroll
        for (int i = 0; i < 4; ++i)
#pragma unroll
            for (int e = 0; e < 4; ++e) tile[(kr + 16 * i) * 129 + 4 * n4 + e] = v[i][e];
        __syncthreads();
        const int n0 = (t / tk) * 128, k0 = (t % tk) * 64;
        if (t + nblk < ntile) CW_LOAD(t + nblk);
#pragma unroll
        for (int i = 0; i < 2; ++i) { const int nl = sn + 64 * i; float f[8];
#pragma unroll
            for (int j = 0; j < 8; ++j) f[j] = tile[(8 * sc + j) * 129 + nl];
            if (OUT8) { u32x2 w8; w8.x = pk_fp8x4(f[0], f[1], f[2], f[3]); w8.y = pk_fp8x4(f[4], f[5], f[6], f[7]); *(u32x2*)((unsigned char*)dst + (size_t)(n0 + nl) * K + k0 + 8 * sc) = w8; }
            else *(u32x4*)(dst + (size_t)(n0 + nl) * K + k0 + 8 * sc) = (u32x4){cvt_pk_bf16(f[0], f[1]), cvt_pk_bf16(f[2], f[3]), cvt_pk_bf16(f[4], f[5]), cvt_pk_bf16(f[6], f[7])}; }
        __syncthreads();
    }
#undef CW_LOAD
}

__device__ __forceinline__ void rownorm_bf16(const float* src, bf16_t* dst, int lane) {
    f32x4 v[8]; float ss = 0.f;
#pragma unroll
    for (int i = 0; i < 8; ++i) { v[i] = *(const f32x4*)(src + (i * 64 + lane) * 4); ss += v[i][0] * v[i][0] + v[i][1] * v[i][1] + v[i][2] * v[i][2] + v[i][3] * v[i][3]; }
    ss = wave_sum(ss); const float rs = rsqrtf(ss * (1.0f / DM) + RMS_EPS);
#pragma unroll
    for (int i = 0; i < 8; ++i) { u32x2 w; w.x = cvt_pk_bf16(v[i][0] * rs, v[i][1] * rs); w.y = cvt_pk_bf16(v[i][2] * rs, v[i][3] * rs); *(u32x2*)(dst + (i * 64 + lane) * 4) = w; }
}

__device__ __forceinline__ void rownorm_both(const float* src, bf16_t* dst, unsigned char* dst8, int lane) {
    f32x4 v[8]; float ss = 0.f;
#pragma unroll
    for (int i = 0; i < 8; ++i) { v[i] = *(const f32x4*)(src + (i * 64 + lane) * 4); ss += v[i][0] * v[i][0] + v[i][1] * v[i][1] + v[i][2] * v[i][2] + v[i][3] * v[i][3]; }
    ss = wave_sum(ss); const float rs = rsqrtf(ss * (1.0f / DM) + RMS_EPS), rs8 = rs * 16.0f;
#pragma unroll
    for (int i = 0; i < 8; ++i) { u32x2 w; w.x = cvt_pk_bf16(v[i][0] * rs, v[i][1] * rs); w.y = cvt_pk_bf16(v[i][2] * rs, v[i][3] * rs); *(u32x2*)(dst + (i * 64 + lane) * 4) = w;
        *(unsigned*)(dst8 + (i * 64 + lane) * 4) = pk_fp8x4(v[i][0] * rs8, v[i][1] * rs8, v[i][2] * rs8, v[i][3] * rs8); }
}
__device__ __forceinline__ void rownorm_fp8(const float* src, unsigned char* dst, int lane) {
    f32x4 v[8]; float ss = 0.f;
#pragma unroll
    for (int i = 0; i < 8; ++i) { v[i] = *(const f32x4*)(src + (i * 64 + lane) * 4); ss += v[i][0] * v[i][0] + v[i][1] * v[i][1] + v[i][2] * v[i][2] + v[i][3] * v[i][3]; }
    ss = wave_sum(ss); const float rs = rsqrtf(ss * (1.0f / DM) + RMS_EPS) * 16.0f;
#pragma unroll
    for (int i = 0; i < 8; ++i) *(unsigned*)(dst + (i * 64 + lane) * 4) = pk_fp8x4(v[i][0] * rs, v[i][1] * rs, v[i][2] * rs, v[i][3] * rs);
}
__device__ __forceinline__ void phase_prep(const Ctx& c, KArgs* a) {
    unsigned char* ws = a->ws;
    { const float* x = (const float*)a->in[I_X]; bf16_t* xn = (bf16_t*)(ws + WS_XN);
      unsigned char* xn8 = (unsigned char*)a->out;
      for (int r = c.gw; r < NT; r += c.nw) rownorm_both(x + (size_t)r * DM, xn + (size_t)r * DM, xn8 + (size_t)r * DM, c.lane); }
    convert_weight<1, true>(c, (const float*)a->in[I_WIN], nullptr, 4192, (const float*)a->in[I_GMIX], (bf16_t*)(ws + OFF_WT_IN), 2048, ZC_R, blockIdx.x, gridDim.x);
    convert_weight<0>(c, (const float*)a->in[I_WIN] + 832, nullptr, 4192, (const float*)a->in[I_GMIX], (bf16_t*)(ws + OFF_WT_RKV), 2048, ZW - ZC_R, blockIdx.x, gridDim.x);
}
template <int PART  >
__device__ __forceinline__ void phase_prep_late(const Ctx& c, KArgs* a, int blk, int nblk) {
    unsigned char* ws = a->ws;
    if (PART != 1) {
    { const int gt = blk * 512 + c.tid, nthr = nblk * 512;
      int* cnt = (int*)(ws + CTL_CNT); for (int i = gt; i < NCHUNK * NE1; i += nthr) cnt[i] = ((i % NE1) == NEXP) ? CH_TOK : 0; }
    { float* rt = (float*)(ws + OFF_ROPE); const int* pos = (const int*)a->in[I_POS]; const int gt = blk * 512 + c.tid, nthr = nblk * 512;
      for (int i = gt; i < NT * 32; i += nthr) { const int tok = i >> 5, fi = i & 31; const float inv_f = (float)exp2(-(double)fi * (13.287712379549449 / 32.0));
          const float ang = (float)pos[tok] * inv_f; double xr = (double)ang; xr -= 6.283185307179586 * rint(xr * 0.15915494309189535); const float rr = (float)xr;
          rt[2 * i] = __cosf(rr); rt[2 * i + 1] = __sinf(rr); } }
    }
    if (PART != 1) { convert_weight<0>(c, (const float*)a->in[I_WUQ], nullptr, 1536, (const float*)a->in[I_GQA], (bf16_t*)(ws + OFF_WT_UQ), 512, 1536, blk, nblk);
    convert_weight<0>(c, (const float*)a->in[I_WUKV], nullptr, 2048, (const float*)a->in[I_GKVA], (bf16_t*)(ws + OFF_WT_UKV), 256, 2048, blk, nblk); }
    if (PART != 0) {
    convert_weight<0, true>(c, (const float*)a->in[I_WOUT], nullptr, 2048, nullptr, (bf16_t*)(ws + OFF_WT_OUT), 2048, 2048, blk, nblk);
    convert_weight<0, true>(c, (const float*)a->in[I_WPG], nullptr, 2048, (const float*)a->in[I_GPIN], (bf16_t*)(ws + OFF_WT_PG), 2048, 2048, blk, nblk);
    convert_weight<0>(c, (const float*)a->in[I_WPP], nullptr, 2048, nullptr, (bf16_t*)(ws + OFF_WT_PP), 256, 2048, blk, nblk); }
    if (PART != 1) {
    { bf16_t* wl = (bf16_t*)(ws + OFF_WT_LORA); const float* ww2 = (const float*)a->in[I_WW2]; const float* aw2 = (const float*)a->in[I_AW2]; const float* gw2 = (const float*)a->in[I_GW2];
      const int gt = blk * 512 + c.tid, nthr = nblk * 512;
      for (int i = gt; i < LORA_N * LORA_K; i += nthr) { const int n = i / LORA_K, k = i % LORA_K; float v = 0.f;
          if (n < 1024) { if (k < 64) v = ww2[k * 1024 + n]; }
          else if (n < 2048) { if (k >= 64 && k < 128) v = aw2[(k - 64) * 1024 + (n - 1024)]; }
          else { if (k >= 128 && k < 288) v = gw2[(k - 128) * 1024 + (n - 2048)]; }
          wl[i] = f2bf(v); } }
    { u32x4* wf = (u32x4*)(ws + OFF_WRF); const float* wr = (const float*)a->in[I_WR]; const float* gf = (const float*)a->in[I_GFFN];
      const int gt = blk * 512 + c.tid, nthr = nblk * 512;
      for (int i = gt; i < 64 * 4 * 64; i += nthr) { const int l = i & 63, cc = (i >> 6) & 3, s = i >> 8; const int k0 = 32 * s + 8 * (l >> 4), n = 16 * cc + (l & 15);
          float w[8], lo[8];
#pragma unroll
          for (int j = 0; j < 8; ++j) w[j] = wr[(k0 + j) * 64 + n] * gf[k0 + j];
          const u32x4 hi = packf8(w); float h[8]; unpack8(hi, h);
#pragma unroll
          for (int j = 0; j < 8; ++j) lo[j] = w[j] - h[j];
          wf[((s * 4 + cc) * 2 + 0) * 64 + l] = hi; wf[((s * 4 + cc) * 2 + 1) * 64 + l] = packf8(lo); } }
    }
}

__device__ __forceinline__ void phase_finalize_qk(const Ctx& c, KArgs* a) {
    unsigned char* ws = a->ws; bf16_t* Qb = (bf16_t*)(ws + OFF_QB); bf16_t* Kb = (bf16_t*)(ws + OFF_KB); const bf16_t* Z = (const bf16_t*)(ws + OFF_Z); const float* rt = (const float*)(ws + OFF_ROPE);
    const float* gqn = (const float*)a->in[I_GQN]; const float* gkn = (const float*)a->in[I_GKN];
    const int lane = c.lane, h = lane >> 3, sx = lane & 7; const bool lowh = sx < 4;
    float gq[3][8], gk[3][8];
#pragma unroll
    for (int p = 0; p < 3; ++p)
#pragma unroll
        for (int e = 0; e < 8; ++e) { gq[p][e] = gqn[64 * p + 8 * sx + e]; gk[p][e] = gkn[64 * p + 8 * sx + e]; }
    for (int tok = c.gw; tok < NT; tok += c.nw) {
        float cs[8], sn[8];
        { const float* rp = rt + (size_t)tok * 64 + 16 * (sx & 3);
#pragma unroll
          for (int e4 = 0; e4 < 4; ++e4) { const f32x4 t4 = *(const f32x4*)(rp + 4 * e4); cs[2 * e4] = t4[0]; sn[2 * e4] = t4[1]; cs[2 * e4 + 1] = t4[2]; sn[2 * e4 + 1] = t4[3]; } }
        bf16_t* qp = Qb + (size_t)tok * QW + h * 192 + 8 * sx; bf16_t* kp = Kb + (size_t)tok * QW + h * 192 + 8 * sx;
        const u32x4 q0 = *(const u32x4*)qp, q1 = *(const u32x4*)(qp + 64), q2 = *(const u32x4*)(qp + 128);
        const u32x4 k0 = *(const u32x4*)kp, k1 = *(const u32x4*)(kp + 64), k2 = *(const u32x4*)(Z + (size_t)tok * ZW + ZC_KPE + 8 * sx);
        float f[3][8];
        unpack8(q0, f[0]); unpack8(q1, f[1]); unpack8(q2, f[2]);
        { float ss = 0.f;
#pragma unroll
          for (int p = 0; p < 3; ++p)
#pragma unroll
              for (int e = 0; e < 8; ++e) ss += f[p][e] * f[p][e];
          ss = allred8(ss); const float rs = rsqrtf(ss * (1.0f / 192.0f) + RMS_EPS) * QSCALE;
#pragma unroll
          for (int p = 0; p < 3; ++p)
#pragma unroll
              for (int e = 0; e < 8; ++e) f[p][e] *= rs * gq[p][e];
#pragma unroll
          for (int e = 0; e < 8; ++e) { const float oth = __shfl_xor(f[2][e], 4); f[2][e] = lowh ? (f[2][e] * cs[e] - oth * sn[e]) : (f[2][e] * cs[e] + oth * sn[e]); }
          *(u32x4*)qp = packf8(f[0]); *(u32x4*)(qp + 64) = packf8(f[1]); *(u32x4*)(qp + 128) = packf8(f[2]); }
        unpack8(k0, f[0]); unpack8(k1, f[1]); unpack8(k2, f[2]);
        { float ss = 0.f;
#pragma unroll
          for (int p = 0; p < 3; ++p)
#pragma unroll
              for (int e = 0; e < 8; ++e) ss += f[p][e] * f[p][e];
          ss = allred8(ss); const float rs = rsqrtf(ss * (1.0f / 192.0f) + RMS_EPS);
#pragma unroll
          for (int p = 0; p < 3; ++p)
#pragma unroll
              for (int e = 0; e < 8; ++e) f[p][e] *= rs * gk[p][e];
#pragma unroll
          for (int e = 0; e < 8; ++e) { const float oth = __shfl_xor(f[2][e], 4); f[2][e] = lowh ? (f[2][e] * cs[e] - oth * sn[e]) : (f[2][e] * cs[e] + oth * sn[e]); }
          *(u32x4*)kp = packf8(f[0]); *(u32x4*)(kp + 64) = packf8(f[1]); *(u32x4*)(kp + 128) = packf8(f[2]); }
    }
}

__device__ __forceinline__ int crow(int r, int hi) { return (r & 3) + 8 * (r >> 2) + 4 * hi; }
__device__ __forceinline__ void phase_attn_v1(const Ctx& c, KArgs* a) {
    unsigned char* ws = a->ws; const bf16_t* Qb = (const bf16_t*)(ws + OFF_QB); const bf16_t* Kb = (const bf16_t*)(ws + OFF_KB); const bf16_t* Vb = (const bf16_t*)(ws + OFF_VB);
    bf16_t* Ym = (bf16_t*)(ws + WS_XN);
    const int lane = c.lane, r32 = lane & 31, hi = lane >> 5;
    for (int it = c.gw; it < 8192; it += c.nw) {
        const int qb = 255 - (it >> 5), bh = it & 31, b = bh >> 3, h = bh & 7, q0 = qb * 32;
        const size_t tb = (size_t)b * SEQ;
        bf16x8 qr[12];
        { const bf16_t* qp = Qb + (tb + q0 + r32) * QW + h * 192 + hi * 8;
#pragma unroll
          for (int d0 = 0; d0 < 12; ++d0) qr[d0] = *(const bf16x8*)(qp + d0 * 16); }
        float m_reg = -1e30f, l_reg = 0.f; f32x16 o[4];
#pragma unroll
        for (int d = 0; d < 4; ++d)
#pragma unroll
            for (int r = 0; r < 16; ++r) o[d][r] = 0.f;
        const int ntile = (q0 + 31) / 64 + 1;
        for (int kt = 0; kt < ntile; ++kt) {
            const int kb = kt * 64;
            f32x16 p0, p1;
#pragma unroll
            for (int r = 0; r < 16; ++r) { p0[r] = 0.f; p1[r] = 0.f; }
            { const bf16_t* kp = Kb + (tb + kb + r32) * QW + h * 192 + hi * 8;
#pragma unroll
              for (int d0 = 0; d0 < 12; ++d0) { const bf16x8 b0 = *(const bf16x8*)(kp + d0 * 16); const bf16x8 b1 = *(const bf16x8*)(kp + (size_t)32 * QW + d0 * 16);
                  p0 = __builtin_amdgcn_mfma_f32_32x32x16_bf16(b0, qr[d0], p0, 0, 0, 0); p1 = __builtin_amdgcn_mfma_f32_32x32x16_bf16(b1, qr[d0], p1, 0, 0, 0); } }
            if (kb + 63 > q0) {
                const int dq = q0 + r32 - kb - 4 * hi; const float NEG = -__builtin_inff();
#pragma unroll
                for (int r = 0; r < 16; ++r) { const int cc = (r & 3) + 8 * (r >> 2); if (dq - cc < 0) p0[r] = NEG; if (dq - cc - 32 < 0) p1[r] = NEG; }
            }
            float pmax = p0[0];
#pragma unroll
            for (int r = 1; r < 16; ++r) pmax = fmaxf(pmax, p0[r]);
#pragma unroll
            for (int r = 0; r < 16; ++r) pmax = fmaxf(pmax, p1[r]);
            pmax = fmaxf(pmax, __shfl_xor(pmax, 32));
            const float mn = fmaxf(m_reg, pmax); const float alpha = __builtin_amdgcn_exp2f(m_reg - mn); m_reg = mn;
            float ps = 0.f;
#pragma unroll
            for (int r = 0; r < 16; ++r) { p0[r] = __builtin_amdgcn_exp2f(p0[r] - mn); p1[r] = __builtin_amdgcn_exp2f(p1[r] - mn); ps += p0[r] + p1[r]; }
            ps += __shfl_xor(ps, 32);
            l_reg = l_reg * alpha + ps;
#pragma unroll
            for (int r = 0; r < 16; ++r) { const float ar = __shfl(alpha, crow(r, hi));
#pragma unroll
                for (int d = 0; d < 4; ++d) o[d][r] *= ar; }
            bf16x8 pa0, pa1, pa2, pa3;
#define PK4(P, B_, OUT) do { unsigned a0 = cvt_pk_bf16(P[B_ + 0], P[B_ + 1]), a1 = cvt_pk_bf16(P[B_ + 2], P[B_ + 3]); \
        unsigned b0 = cvt_pk_bf16(P[B_ + 4], P[B_ + 5]), b1 = cvt_pk_bf16(P[B_ + 6], P[B_ + 7]); \
        auto r0 = __builtin_amdgcn_permlane32_swap(a0, b0, false, false); auto r1 = __builtin_amdgcn_permlane32_swap(a1, b1, false, false); \
        u32x4 w = {r0[0], r1[0], r0[1], r1[1]}; OUT = *reinterpret_cast<bf16x8*>(&w); } while (0)
            PK4(p0, 0, pa0); PK4(p0, 8, pa1); PK4(p1, 0, pa2); PK4(p1, 8, pa3);
#undef PK4
            const bf16_t* vp = Vb + (tb + kb + 8 * hi) * 1024 + h * 128 + r32;
#pragma unroll
            for (int d0 = 0; d0 < 4; ++d0) {
#pragma unroll
                for (int ks = 0; ks < 4; ++ks) { bf16x8 vf;
#pragma unroll
                    for (int j = 0; j < 8; ++j) vf[j] = (short)vp[(size_t)(16 * ks + j) * 1024 + d0 * 32];
                    const bf16x8 pa = ks == 0 ? pa0 : (ks == 1 ? pa1 : (ks == 2 ? pa2 : pa3));
                    o[d0] = __builtin_amdgcn_mfma_f32_32x32x16_bf16(pa, vf, o[d0], 0, 0, 0); } }
        }
        const float li = 1.0f / l_reg;
#pragma unroll
        for (int r = 0; r < 16; ++r) { const int orow = crow(r, hi); const float lr = __shfl(li, orow);
            bf16_t* op = Ym + (tb + q0 + orow) * DM + h * 128 + r32;
#pragma unroll
            for (int d0 = 0; d0 < 4; ++d0) op[d0 * 32] = f2bf(o[d0][r] * lr); }
    }
}

constexpr int AT_SHM_V = 64 * 128 * 2, AT_SHM_K = 64 * 192 * 2, AT_OFF_K = 2 * AT_SHM_V, AT_OFF_WS = AT_OFF_K + 2 * AT_SHM_K;
#define KSWZ192(row, colB) ((row) * 384 + ((colB) ^ (((row) & 7) << 4)))
__device__ __forceinline__ int v_st(int k, int c) { const int kk = (k & ~0xC) | ((k & 4) << 1) | ((k & 8) >> 1); return ((kk >> 3) * 4 + (c >> 5)) * 512 + ((kk & 7) * 32 + (c & 31)) * 2; }
__device__ __forceinline__ int v_rd_base(int lane) { return ((lane & 3) << 3) | (((lane >> 2) & 3) << 6) | (((lane >> 4) & 1) << 5) | (((lane >> 5) & 1) << 8); }
typedef short s16x4 __attribute__((ext_vector_type(4)));
__device__ __forceinline__ void attn_qblock(LAS unsigned char* lds, const bf16_t* Qb, const bf16_t* Kb, const bf16_t* Vb, bf16_t* Ym, int b, int h, int qblk, int tid_in, int wid) {
    int tid = tid_in; asm volatile("" : "+v"(tid));
    const int lane = tid & 63, r32 = lane & 31, hi = lane >> 5;
    const size_t tb = (size_t)b * SEQ; const int q0 = qblk * 256, qlo = q0 + wid * 32;
    LAS unsigned char* V_lds = lds; LAS unsigned char* K_lds = lds + AT_OFF_K;
    LAS float* wsf = (LAS float*)(lds + AT_OFF_WS) + wid * 64;
    bf16x8 qr[12];
    { const bf16_t* qp = Qb + (tb + qlo + r32) * QW + h * 192 + hi * 8;
#pragma unroll
      for (int d0 = 0; d0 < 12; ++d0) qr[d0] = *(const bf16x8*)(qp + d0 * 16); }
    unsigned kgo[3], vgo[2];
#pragma unroll
    for (int i = 0; i < 3; ++i) { const int L = tid + 512 * i, row = L / 24, cB = ((L % 24) * 16) ^ ((row & 7) << 4); kgo[i] = (unsigned)(row * QW * 2 + cB); }
#pragma unroll
    for (int i = 0; i < 2; ++i) { const int L = tid + 512 * i, kk = (L >> 7) * 8 + ((L & 31) >> 2), k = (kk & ~0xC) | ((kk & 4) << 1) | ((kk & 8) >> 1), cc = ((L >> 5) & 3) * 32 + (L & 3) * 8; vgo[i] = (unsigned)(k * 1024 * 2 + cc * 2); }
    const char* Kg = (const char*)(Kb + tb * QW + h * 192); const char* Vg = (const char*)(Vb + tb * 1024 + h * 128);
    const int vb0 = (int)(uintptr_t)V_lds + v_rd_base(lane);
    int kb4[4];
#pragma unroll
    for (int dd = 0; dd < 4; ++dd) kb4[dd] = r32 * 384 + ((dd * 32 + hi * 16) ^ ((r32 & 7) << 4));
    const int NT_ = (q0 + 255) / 64 + 1;
#define AT_STAGE(t_, buf_) do { const size_t gk_ = (size_t)(t_) * 64 * QW * 2, gv_ = (size_t)(t_) * 64 * 1024 * 2; \
        _Pragma("unroll") for (int i = 0; i < 3; ++i) __builtin_amdgcn_global_load_lds((const unsigned*)(Kg + gk_ + kgo[i]), (LAS unsigned*)(K_lds + (buf_) * AT_SHM_K + (512 * i + wid * 64) * 16), 16, 0, 0); \
        _Pragma("unroll") for (int i = 0; i < 2; ++i) __builtin_amdgcn_global_load_lds((const unsigned*)(Vg + gv_ + vgo[i]), (LAS unsigned*)(V_lds + (buf_) * AT_SHM_V + (512 * i + wid * 64) * 16), 16, 0, 0); } while (0)
    __syncthreads();
    AT_STAGE(0, 0);
    float m_reg = -1e30f, l_reg = 0.f; f32x16 o[4];
#pragma unroll
    for (int d = 0; d < 4; ++d)
#pragma unroll
        for (int r = 0; r < 16; ++r) o[d][r] = 0.f;
    for (int t = 0; t < NT_; ++t) {
        const int buf = t & 1, kb = t * 64;
        asm volatile("s_waitcnt vmcnt(0)" ::: "memory"); __syncthreads();
        if (t + 1 < NT_) AT_STAGE(t + 1, buf ^ 1);
        f32x16 p0, p1;
#pragma unroll
        for (int r = 0; r < 16; ++r) { p0[r] = 0.f; p1[r] = 0.f; }
        { const int kab = (int)(uintptr_t)K_lds + buf * AT_SHM_K; const int ka0 = kab + kb4[0], ka1 = kab + kb4[1], ka2 = kab + kb4[2], ka3 = kab + kb4[3];
          bf16x8 kf[3][2];
#define KRD(dst, areg, off) asm volatile("ds_read_b128 %0, %1 offset:%2" : "=&v"(dst) : "v"(areg), "i"(off) : "memory")
#define KRD2(set, d0) do { if (((d0) & 3) == 0) { KRD(kf[set][0], ka0, ((d0) >> 2) * 128); KRD(kf[set][1], ka0, ((d0) >> 2) * 128 + 32 * 384); } \
                           else if (((d0) & 3) == 1) { KRD(kf[set][0], ka1, ((d0) >> 2) * 128); KRD(kf[set][1], ka1, ((d0) >> 2) * 128 + 32 * 384); } \
                           else if (((d0) & 3) == 2) { KRD(kf[set][0], ka2, ((d0) >> 2) * 128); KRD(kf[set][1], ka2, ((d0) >> 2) * 128 + 32 * 384); } \
                           else { KRD(kf[set][0], ka3, ((d0) >> 2) * 128); KRD(kf[set][1], ka3, ((d0) >> 2) * 128 + 32 * 384); } } while (0)
#define KWAIT(n) do { asm volatile("s_waitcnt lgkmcnt(" #n ")" ::: "memory"); __builtin_amdgcn_sched_barrier(0); } while (0)
#define KSTEP(d0, W) do { if ((d0) + 2 < 12) KRD2(((d0) + 2) % 3, (d0) + 2); W; \
              p0 = __builtin_amdgcn_mfma_f32_32x32x16_bf16(kf[(d0) % 3][0], qr[d0], p0, 0, 0, 0); p1 = __builtin_amdgcn_mfma_f32_32x32x16_bf16(kf[(d0) % 3][1], qr[d0], p1, 0, 0, 0); } while (0)
          KRD2(0, 0); KRD2(1, 1);
          KSTEP(0, KWAIT(4)); KSTEP(1, KWAIT(4)); KSTEP(2, KWAIT(4)); KSTEP(3, KWAIT(4)); KSTEP(4, KWAIT(4)); KSTEP(5, KWAIT(4));
          KSTEP(6, KWAIT(4)); KSTEP(7, KWAIT(4)); KSTEP(8, KWAIT(4)); KSTEP(9, KWAIT(4)); KSTEP(10, KWAIT(2)); KSTEP(11, KWAIT(0));
#undef KSTEP
#undef KWAIT
#undef KRD2
#undef KRD
        }
        if (kb + 63 > qlo) { const int dq = qlo + r32 - kb - 4 * hi; const float NEG = -__builtin_inff();
#pragma unroll
            for (int r = 0; r < 16; ++r) { const int cc = (r & 3) + 8 * (r >> 2); if (dq - cc < 0) p0[r] = NEG; if (dq - cc - 32 < 0) p1[r] = NEG; } }
        float pmax = p0[0];
#pragma unroll
        for (int r = 1; r < 16; ++r) pmax = fmaxf(pmax, p0[r]);
#pragma unroll
        for (int r = 0; r < 16; ++r) pmax = fmaxf(pmax, p1[r]);
        { auto rr = __builtin_amdgcn_permlane32_swap(__float_as_uint(pmax), __float_as_uint(pmax), false, false); pmax = fmaxf(__uint_as_float(rr[0]), __uint_as_float(rr[1])); }
        float alpha = 1.f;
        if (!__all(pmax - m_reg <= 11.5f)) { const float mn = fmaxf(m_reg, pmax); alpha = __builtin_amdgcn_exp2f(m_reg - mn); m_reg = mn; }
        float ps = 0.f;
#pragma unroll
        for (int r = 0; r < 16; ++r) { p0[r] = __builtin_amdgcn_exp2f(p0[r] - m_reg); p1[r] = __builtin_amdgcn_exp2f(p1[r] - m_reg); ps += p0[r] + p1[r]; }
        { auto rr = __builtin_amdgcn_permlane32_swap(__float_as_uint(ps), __float_as_uint(ps), false, false); ps = __uint_as_float(rr[0]) + __uint_as_float(rr[1]); }
        l_reg = l_reg * alpha + ps;
        if (__any(alpha < 1.f)) { if (hi == 0) wsf[r32] = alpha; asm volatile("s_waitcnt lgkmcnt(0)" ::: "memory");
#pragma unroll
            for (int r = 0; r < 16; ++r) { const float ar = wsf[crow(r, hi)];
#pragma unroll
                for (int d = 0; d < 4; ++d) o[d][r] *= ar; } }
        bf16x8 pa0, pa1, pa2, pa3;
#define PK4(P, B_, OUT) do { unsigned a0 = cvt_pk_bf16(P[B_ + 0], P[B_ + 1]), a1 = cvt_pk_bf16(P[B_ + 2], P[B_ + 3]); \
        unsigned b0 = cvt_pk_bf16(P[B_ + 4], P[B_ + 5]), b1 = cvt_pk_bf16(P[B_ + 6], P[B_ + 7]); \
        auto r0 = __builtin_amdgcn_permlane32_swap(a0, b0, false, false); auto r1 = __builtin_amdgcn_permlane32_swap(a1, b1, false, false); \
        u32x4 w = {r0[0], r1[0], r0[1], r1[1]}; OUT = *reinterpret_cast<bf16x8*>(&w); } while (0)
        PK4(p0, 0, pa0); PK4(p0, 8, pa1); PK4(p1, 0, pa2); PK4(p1, 8, pa3);
#undef PK4
#define TRRD(dst, off) asm volatile("ds_read_b64_tr_b16 %0, %1 offset:%2" : "=&v"(dst) : "v"(vbb), "i"(off) : "memory")
#define PV_RD(S_, d0) do { constexpr int b_ = (d0) * 512; TRRD(S_##l0, b_); TRRD(S_##h0, b_ + 2048); TRRD(S_##l1, b_ + 4096); TRRD(S_##h1, b_ + 6144); TRRD(S_##l2, b_ + 8192); TRRD(S_##h2, b_ + 10240); TRRD(S_##l3, b_ + 12288); TRRD(S_##h3, b_ + 14336); } while (0)
#define PV_MM(S_, d0) do { \
        o[d0] = __builtin_amdgcn_mfma_f32_32x32x16_bf16(pa0, (bf16x8){S_##l0[0], S_##l0[1], S_##l0[2], S_##l0[3], S_##h0[0], S_##h0[1], S_##h0[2], S_##h0[3]}, o[d0], 0, 0, 0); \
        o[d0] = __builtin_amdgcn_mfma_f32_32x32x16_bf16(pa1, (bf16x8){S_##l1[0], S_##l1[1], S_##l1[2], S_##l1[3], S_##h1[0], S_##h1[1], S_##h1[2], S_##h1[3]}, o[d0], 0, 0, 0); \
        o[d0] = __builtin_amdgcn_mfma_f32_32x32x16_bf16(pa2, (bf16x8){S_##l2[0], S_##l2[1], S_##l2[2], S_##l2[3], S_##h2[0], S_##h2[1], S_##h2[2], S_##h2[3]}, o[d0], 0, 0, 0); \
        o[d0] = __builtin_amdgcn_mfma_f32_32x32x16_bf16(pa3, (bf16x8){S_##l3[0], S_##l3[1], S_##l3[2], S_##l3[3], S_##h3[0], S_##h3[1], S_##h3[2], S_##h3[3]}, o[d0], 0, 0, 0); } while (0)
#define PV_WAIT(n) do { asm volatile("s_waitcnt lgkmcnt(" #n ")" ::: "memory"); __builtin_amdgcn_sched_barrier(0); } while (0)
        { const int vbb = vb0 + buf * AT_SHM_V; s16x4 Al0, Al1, Al2, Al3, Ah0, Ah1, Ah2, Ah3, Bl0, Bl1, Bl2, Bl3, Bh0, Bh1, Bh2, Bh3;
          PV_RD(A, 0); PV_RD(B, 1); PV_WAIT(8); PV_MM(A, 0);
          PV_RD(A, 2); PV_WAIT(8); PV_MM(B, 1);
          PV_RD(B, 3); PV_WAIT(8); PV_MM(A, 2);
          PV_WAIT(0); PV_MM(B, 3); }
#undef PV_RD
#undef PV_MM
#undef PV_WAIT
#undef TRRD
    }
#undef AT_STAGE
    if (hi == 0) wsf[32 + r32] = 1.0f / l_reg;
    asm volatile("s_waitcnt lgkmcnt(0)" ::: "memory");
    int lane_e = lane; asm volatile("" : "+v"(lane_e));
    const int r32e = lane_e & 31, hie = lane_e >> 5;
    unsigned char* Ow = (unsigned char*)Ym + (size_t)(tb + qlo) * DM + h * 128;
#pragma unroll
    for (int r = 0; r < 16; ++r) { const int orow = crow(r, hie); const float li = wsf[32 + orow] * 16.0f;
#pragma unroll
        for (int d0 = 0; d0 < 4; ++d0) { const float v = o[d0][r] * li; const float v1 = __shfl_xor(v, 1), v2 = __shfl_xor(v, 2), v3 = __shfl_xor(v1, 2);
            if ((r32e & 3) == 0) *(unsigned*)(Ow + (size_t)orow * DM + d0 * 32 + r32e) = pk_fp8x4(v, v1, v2, v3); } }
}
__device__ __forceinline__ void phase_attn_v2(const Ctx& c, KArgs* a) {
    unsigned char* ws = a->ws; const bf16_t* Qb = (const bf16_t*)(ws + OFF_QB); const bf16_t* Kb = (const bf16_t*)(ws + OFF_KB); const bf16_t* Vb = (const bf16_t*)(ws + OFF_VB);
    bf16_t* Ym = (bf16_t*)(ws + WS_XN);
    for (int it = blockIdx.x; it < 512; it += gridDim.x) {
        const int rnd = it >> 8, bb = it & 255, xcd = bb & 7, slot = bb >> 3; const int bh = rnd * 16 + xcd * 2 + (slot >> 4), y = slot & 15;
        attn_qblock(c.lds, Qb, Kb, Vb, Ym, bh >> 3, bh & 7, 31 - y, c.tid, c.wid);
        attn_qblock(c.lds, Qb, Kb, Vb, Ym, bh >> 3, bh & 7, y, c.tid, c.wid);
    }
}

__device__ __forceinline__ void phase_lora_prep(const Ctx& c, KArgs* a) {
    unsigned char* ws = a->ws; const bf16_t* Z = (const bf16_t*)(ws + OFF_Z); bf16_t* AL = (bf16_t*)(ws + OFF_ALORA); const float* mu = (const float*)a->in[I_MU];
    const int gt = blockIdx.x * 512 + c.tid, nthr = gridDim.x * 512;
    for (int i = gt; i < NT * 48; i += nthr) { const int tok = i / 48, ck = i % 48; float f[8];
        if (ck < 36) { const int k0 = 8 * ck; float cu[8], pv[8];
            unpack8(*(const u32x4*)(Z + (size_t)tok * ZW + ZC_WL + k0), cu);
            if (tok % SEQ) unpack8(*(const u32x4*)(Z + (size_t)(tok - 1) * ZW + ZC_WL + k0), pv); else {
#pragma unroll
                for (int e = 0; e < 8; ++e) pv[e] = 0.f; }
            const f32x4 m0 = *(const f32x4*)(mu + 3072 + k0), m1 = *(const f32x4*)(mu + 3072 + k0 + 4);
#pragma unroll
            for (int e = 0; e < 8; ++e) { const float x = cu[e] + (pv[e] - cu[e]) * (e < 4 ? m0[e & 3] : m1[e & 3]); f[e] = ck < 8 ? (1.0f - 2.0f * __builtin_amdgcn_rcpf(1.0f + __builtin_amdgcn_exp2f(2.885390082f * x))) : (ck < 16 ? x : sigmoidf_(x)); }
        } else {
#pragma unroll
            for (int e = 0; e < 8; ++e) f[e] = 0.f; }
        *(u32x4*)(AL + (size_t)tok * LORA_K + 8 * ck) = packf8(f); }
}
__device__ __forceinline__ void phase_scan_prep(const Ctx& c, KArgs* a) {
    unsigned char* ws = a->ws; const bf16_t* Z = (const bf16_t*)(ws + OFF_Z); const bf16_t* Lb = (const bf16_t*)(ws + OFF_LB);
    h16* D0 = (h16*)(ws + OFF_DER); const size_t DS = (size_t)NT * 1024;
    const float* mu = (const float*)a->in[I_MU]; const float* w0 = (const float*)a->in[I_W0]; const float* a0 = (const float*)a->in[I_A0];
    const float* kkp = (const float*)a->in[I_KK]; const float* kap = (const float*)a->in[I_KA];
    const int lane = c.lane, half = c.gw & 1, ch0 = (half * 8 + (lane >> 3)) * 64 + 8 * (lane & 7);
    float mur[8], muk[8], muv[8], cw0[8], ca0[8], ckk[8], cka[8];
#pragma unroll
    for (int e = 0; e < 8; ++e) { mur[e] = mu[ch0 + e]; muk[e] = mu[1024 + ch0 + e]; muv[e] = mu[2048 + ch0 + e]; cw0[e] = w0[ch0 + e]; ca0[e] = a0[ch0 + e]; ckk[e] = kkp[ch0 + e]; cka[e] = kap[ch0 + e]; }
    u32x4 nxa[8], nxb[8];
#define SP_LOAD(nx, it_) do { const int tk_ = (it_) >> 1; const bf16_t* zr_ = Z + (size_t)tk_ * ZW + ch0; const bf16_t* zp_ = (tk_ % SEQ) == 0 ? zr_ : zr_ - ZW; \
        nx[0] = *(const u32x4*)(zr_ + ZC_R); nx[1] = *(const u32x4*)(zr_ + ZC_K); nx[2] = *(const u32x4*)(zr_ + ZC_V); nx[3] = *(const u32x4*)(zp_ + ZC_R); nx[4] = *(const u32x4*)(zp_ + ZC_K); nx[5] = *(const u32x4*)(zp_ + ZC_V); \
        nx[6] = *(const u32x4*)(Lb + (size_t)tk_ * LORA_N + ch0); nx[7] = *(const u32x4*)(Lb + (size_t)tk_ * LORA_N + 1024 + ch0); } while (0)
    if (c.gw < NT * 2) SP_LOAD(nxa, c.gw);
    if (c.gw + c.nw < NT * 2) SP_LOAD(nxb, c.gw + c.nw);
#define SP_ITEM(nx, it) do { const int tok = (it) >> 1; \
        const bool first = (tok % SEQ) == 0; \
        float rc[8], kc[8], vc[8], rp[8], kp[8], vp[8], lw[8], la[8]; \
        unpack8(nx[0], rc); unpack8(nx[1], kc); unpack8(nx[2], vc); unpack8(nx[3], rp); unpack8(nx[4], kp); unpack8(nx[5], vp); unpack8(nx[6], lw); unpack8(nx[7], la); \
        if ((it) + 2 * c.nw < NT * 2) SP_LOAD(nx, (it) + 2 * c.nw); \
        sp_item(tok, first, rc, kc, vc, rp, kp, vp, lw, la); } while (0)
    auto sp_item = [&](int tok, bool first, const float (&rc)[8], const float (&kc)[8], const float (&vc)[8], const float (&rp)[8], const float (&kp)[8], const float (&vp)[8], const float (&lw)[8], const float (&la)[8]) __attribute__((always_inline)) {
        h16x8 o_ld, o_kk, o_b, o_km, o_r, o_v; float kt[8], av[8], ss = 0.f;
#pragma unroll
        for (int e = 0; e < 8; ++e) { const float pr = first ? 0.f : rp[e], pk = first ? 0.f : kp[e], pvv = first ? 0.f : vp[e];
            const float r = rc[e] + (pr - rc[e]) * mur[e], k = kc[e] + (pk - kc[e]) * muk[e], v = vc[e] + (pvv - vc[e]) * muv[e];
            const float xw = -(cw0[e] + lw[e]); const float spl = fmaxf(xw, 0.f) + 0.69314718f * __builtin_amdgcn_logf(1.0f + __builtin_amdgcn_exp2f(-1.44269504f * fabsf(xw)));
            const float ld = -__builtin_amdgcn_exp2f((-spl - 0.5f) * 1.44269504f);
            av[e] = sigmoidf_(ca0[e] + la[e]); kt[e] = k * ckk[e]; ss += kt[e] * kt[e];
            o_ld[e] = (h16)ld; o_km[e] = (h16)(k * (1.0f + (av[e] - 1.0f) * cka[e])); o_r[e] = (h16)r; o_v[e] = (h16)v; }
        ss = allred8(ss); const float rn = ss > 1e-24f ? __builtin_amdgcn_rsqf(ss) : 1e12f;
#pragma unroll
        for (int e = 0; e < 8; ++e) { const float kk = kt[e] * rn; o_kk[e] = (h16)kk; o_b[e] = (h16)(kk * av[e]); }
        const size_t o = (size_t)tok * 1024 + ch0;
        *(h16x8*)(D0 + o) = o_ld; *(h16x8*)(D0 + DS + o) = o_kk; *(h16x8*)(D0 + 2 * DS + o) = o_b; *(h16x8*)(D0 + 3 * DS + o) = o_km; *(h16x8*)(D0 + 4 * DS + o) = o_r; *(h16x8*)(D0 + 5 * DS + o) = o_v; };
    for (int it = c.gw; it < NT * 2; it += 2 * c.nw) { SP_ITEM(nxa, it); if (it + c.nw < NT * 2) SP_ITEM(nxb, it + c.nw); }
#undef SP_ITEM
#undef SP_LOAD
}
constexpr int SC_L = 256, SC_NC = SEQ / SC_L;
constexpr size_t OFF_YRAW = OFF_Z;
constexpr size_t OFF_PM = OFF_Z + 128 * MiB;
constexpr size_t OFF_HM = OFF_PM + 32 * MiB;
constexpr size_t OFF_ST = OFF_HM + 32 * MiB;
static_assert(OFF_ST + 32 * MiB <= OFF_R1, "scan buffers overflow Z region");
constexpr size_t OFF_Q16 = OFF_Z;
constexpr size_t OFF_Y016 = OFF_Z + 64 * MiB;
struct ScanRaw { h16x8 ld, kk, bb, km, r, v; };
__device__ __forceinline__ ScanRaw scan_load(const h16* pj, const h16* pi, size_t DS, int t) {
    ScanRaw q; const size_t o = (size_t)t * 1024;
    q.ld = *(const h16x8*)(pj + o); q.kk = *(const h16x8*)(pj + DS + o); q.bb = *(const h16x8*)(pj + 2 * DS + o);
    q.km = *(const h16x8*)(pj + 3 * DS + o); q.r = *(const h16x8*)(pj + 4 * DS + o); q.v = *(const h16x8*)(pi + o);
    return q;
}
__device__ __forceinline__ void phase_scan_p1(const Ctx& c, KArgs* a) {
    unsigned char* ws = a->ws; const h16* D0 = (const h16*)(ws + OFF_DER); const size_t DS = (size_t)NT * 1024; float* Pm = (float*)(ws + OFF_PM); float* Hm = (float*)(ws + OFF_HM);
    h16* Q16 = (h16*)(ws + OFF_Q16); h16* Y016 = (h16*)(ws + OFF_Y016);
    const int lane = c.lane, la = lane >> 3, lb = lane & 7;
    for (int it = c.gw; it < 64 * SC_NC; it += c.nw) {
        const int bh = it & 63, ch = it >> 6, b = bh >> 4, h = bh & 15;
        const size_t tok0 = (size_t)b * SEQ + (size_t)ch * SC_L;
        float SP[8][8], SH[8][8];
#pragma unroll
        for (int i = 0; i < 8; ++i)
#pragma unroll
            for (int j = 0; j < 8; ++j) { SP[i][j] = (la == lb && i == j) ? 1.f : 0.f; SH[i][j] = 0.f; }
        h16* qo = Q16 + tok0 * 1024 + h * 64 + 8 * la; h16* yo = Y016 + tok0 * 1024 + h * 64 + 8 * la;
        LAS unsigned char* ring = c.lds + c.wid * 4096;
        const h16* gsrc = D0 + (size_t)((lane >> 3) < 5 ? (lane >> 3) : 5) * DS + tok0 * 1024 + h * 64 + 8 * (lane & 7);
#define SC_DMA(t_) __builtin_amdgcn_global_load_lds((const unsigned*)(gsrc + (size_t)((t_) < SC_L ? (t_) : SC_L - 1) * 1024), (LAS unsigned*)(ring + ((t_) & 3) * 1024), 16, 0, 0)
        SC_DMA(0); SC_DMA(1); SC_DMA(2);
#pragma unroll 1
        for (int t = 0; t < SC_L; ++t) {
            if (t < 3) asm volatile("s_waitcnt vmcnt(0)" ::: "memory"); else asm volatile("s_waitcnt vmcnt(8)" ::: "memory");
            SC_DMA(t + 3);
            ScanRaw cr; { const LAS unsigned char* sl = ring + (t & 3) * 1024;
                cr.ld = *(const LAS h16x8*)(sl + 16 * lb); cr.kk = *(const LAS h16x8*)(sl + 128 + 16 * lb); cr.bb = *(const LAS h16x8*)(sl + 256 + 16 * lb);
                cr.km = *(const LAS h16x8*)(sl + 384 + 16 * lb); cr.r = *(const LAS h16x8*)(sl + 512 + 16 * lb); cr.v = *(const LAS h16x8*)(sl + 640 + 16 * la); }
            float w[8], kk[8], bb[8];
#pragma unroll
            for (int j = 0; j < 8; ++j) { w[j] = __expf((float)cr.ld[j]); kk[j] = (float)cr.kk[j]; bb[j] = (float)cr.bb[j]; }
            float dp[8], dh[8];
#pragma unroll
            for (int i = 0; i < 8; ++i) { float s0 = 0.f, s1 = 0.f;
#pragma unroll
                for (int j = 0; j < 8; ++j) { s0 += SP[i][j] * kk[j]; s1 += SH[i][j] * kk[j]; }
                dp[i] = s0; dh[i] = s1; }
#pragma unroll
            for (int i = 0; i < 8; ++i) { dp[i] = -allred8(dp[i]); dh[i] = -allred8(dh[i]); }
            float qv[8], yv[8];
#pragma unroll
            for (int i = 0; i < 8; ++i) { const float vi = (float)cr.v[i]; float s0 = 0.f, s1 = 0.f;
#pragma unroll
                for (int j = 0; j < 8; ++j) { const float rj = (float)cr.r[j];
                    SP[i][j] = SP[i][j] * w[j] + dp[i] * bb[j]; SH[i][j] = SH[i][j] * w[j] + (dh[i] * bb[j] + vi * (float)cr.km[j]);
                    s0 += SP[i][j] * rj; s1 += SH[i][j] * rj; }
                qv[i] = s0; yv[i] = s1; }
#pragma unroll
            for (int i = 0; i < 8; ++i) { qv[i] = allred8(qv[i]); yv[i] = allred8(yv[i]); }
            if (lb == 0) { h16x8 hq, hy;
#pragma unroll
                for (int i = 0; i < 8; ++i) { hq[i] = (h16)qv[i]; hy[i] = (h16)yv[i]; }
                *(h16x8*)(qo + (size_t)t * 1024) = hq; *(h16x8*)(yo + (size_t)t * 1024) = hy; }
        }
#undef SC_DMA
        asm volatile("s_waitcnt vmcnt(0)" ::: "memory");
        { float* dst = Hm + ((size_t)bh * SC_NC + ch) * 4096 + ((((la >> 1) * 4 + (lb >> 1)) * 64 + 2 * (lb & 1) * 16 + 8 * (la & 1)) * 4);
#pragma unroll
          for (int i = 0; i < 8; ++i)
#pragma unroll
              for (int j = 0; j < 8; ++j) dst[((j >> 2) * 16 + i) * 4 + (j & 3)] = SH[i][j]; }
        { float* dst = Pm + ((size_t)bh * SC_NC + ch) * 4096 + ((((lb >> 1) * 4 + (la >> 1)) * 64 + 2 * (la & 1) * 16 + 8 * (lb & 1)) * 4);
#pragma unroll
          for (int i = 0; i < 8; ++i)
#pragma unroll
              for (int j = 0; j < 8; ++j) dst[((i >> 2) * 16 + j) * 4 + (i & 3)] = SP[i][j]; }
    }
}
typedef short s16x4_t __attribute__((ext_vector_type(4)));
#define P1M_MFMA16(a, b, c) __builtin_amdgcn_mfma_f32_16x16x16f16((a), (b), (c), 0, 0, 0)
#define P1M_MFMA32(a, b, c) __builtin_amdgcn_mfma_f32_16x16x32_f16((a), (b), (c), 0, 0, 0)
__device__ __forceinline__ h16x4 cvt_h4(const f32x4 v) { return (h16x4){(h16)v[0], (h16)v[1], (h16)v[2], (h16)v[3]}; }
__device__ __forceinline__ float row_pfx(float x) {
    x += __int_as_float(__builtin_amdgcn_update_dpp(0, __float_as_int(x), 0x111, 0xF, 0xF, false));
    x += __int_as_float(__builtin_amdgcn_update_dpp(0, __float_as_int(x), 0x112, 0xF, 0xF, false));
    x += __int_as_float(__builtin_amdgcn_update_dpp(0, __float_as_int(x), 0x114, 0xF, 0xF, false));
    x += __int_as_float(__builtin_amdgcn_update_dpp(0, __float_as_int(x), 0x118, 0xF, 0xF, false));
    return x; }
__device__ __forceinline__ float row_sum16(float x) {
    x = DPP_ADD(x, 0xB1); x = DPP_ADD(x, 0x4E); x = DPP_ADD(x, 0x141); x = DPP_ADD(x, 0x140); return x; }
#define P1M_TR(dst, addr) asm volatile("ds_read_b64_tr_b16 %0, %1" : "=v"(dst) : "v"(addr) : "memory")
#define P1M_WAITL() do { asm volatile("s_waitcnt lgkmcnt(0)" ::: "memory"); __builtin_amdgcn_sched_barrier(0); } while (0)
__device__ __forceinline__ void phase_scan_p1m(const Ctx& c, KArgs* a) {
    unsigned char* ws = a->ws; const h16* D0 = (const h16*)(ws + OFF_DER); const size_t DS = (size_t)NT * 1024; float* Pm = (float*)(ws + OFF_PM); float* Hm = (float*)(ws + OFF_HM);
    h16* Q16 = (h16*)(ws + OFF_Q16); h16* Y016 = (h16*)(ws + OFF_Y016);
    const int lane = c.lane;
    LAS unsigned char* wl = c.lds + c.wid * 16640;
    const int wb = (int)(uintptr_t)wl;
    constexpr int IMG_KT = 0, IMG_BH = 2048, IMG_KH = 4096, IMG_RT = 6144, IMG_BB = 8192, IMG_KB = 10240, IMG_V = 12288, SM_M = 14336, SM_TT = 15360, SM_NT = 15872;
    constexpr int SM_ARB = IMG_BH, SM_ARK = IMG_BH + 512, SM_GAM = 16384, IMG_RP = IMG_KH, STG_Q = IMG_KT, STG_Y = IMG_RT;
    for (int itk = c.gw; itk < 64 * SC_NC; itk += c.nw) {
        const int bh = itk & 63, ch = itk >> 6, b = bh >> 4, h = bh & 15;
        const size_t tok0 = (size_t)b * SEQ + (size_t)ch * SC_L;
        f32x4 PT[4][4], SHT[4][4];
        { int lz = lane; asm volatile("" : "+v"(lz));
#pragma unroll
          for (int kt = 0; kt < 4; ++kt)
#pragma unroll
              for (int ct = 0; ct < 4; ++ct) { SHT[kt][ct] = (f32x4){0.f, 0.f, 0.f, 0.f};
#pragma unroll
                  for (int rg = 0; rg < 4; ++rg) PT[kt][ct][rg] = (kt == ct && 4 * (lz >> 4) + rg == (lz & 15)) ? 1.f : 0.f; } }
#pragma unroll 1
        for (int sc = 0; sc < SC_L / 16; ++sc) {
            int lq = lane; asm volatile("" : "+v"(lq)); const int r16 = lq & 15, gq = lq >> 4;
            const size_t go = (tok0 + 16 * sc + r16) * 1024 + h * 64 + 16 * gq;
            { const h16x8 v0 = *(const h16x8*)(D0 + 5 * DS + go), v1 = *(const h16x8*)(D0 + 5 * DS + go + 8);
              *(LAS h16x8*)(wl + IMG_V + gq * 512 + r16 * 32) = v0; *(LAS h16x8*)(wl + IMG_V + gq * 512 + r16 * 32 + 16) = v1; }
#pragma unroll
            for (int p = 0; p < 2; ++p) { float ep[8], em[8], ex[8], eb[8];
                { const h16x8 a0 = *(const h16x8*)(D0 + go + 8 * p);
#pragma unroll
                  for (int e = 0; e < 8; ++e) { const float ld = (float)a0[e]; const float lw = row_pfx(ld), tot = row_sum16(ld); if (r16 == 15) *(LAS float*)(wl + SM_GAM + (16 * gq + 8 * p + e) * 4) = __expf(tot);
                      ep[e] = __expf(lw); em[e] = __expf(-lw); ex[e] = __expf(lw - ld); eb[e] = __expf(tot - lw); } }
                const int io = gq * 512 + r16 * 32 + 16 * p;
                { const h16x8 x = *(const h16x8*)(D0 + DS + go + 8 * p); h16x8 o;
#pragma unroll
                  for (int e = 0; e < 8; ++e) o[e] = (h16)((float)x[e] * ex[e]);
                  *(LAS h16x8*)(wl + IMG_KT + io) = o; }
                { const h16x8 x = *(const h16x8*)(D0 + 2 * DS + go + 8 * p); h16x8 o, o2;
#pragma unroll
                  for (int e = 0; e < 8; ++e) { o[e] = (h16)((float)x[e] * em[e]); o2[e] = (h16)((float)x[e] * eb[e]); }
                  *(LAS h16x8*)(wl + IMG_BH + io) = o; *(LAS h16x8*)(wl + IMG_BB + io) = o2; }
                { const h16x8 x = *(const h16x8*)(D0 + 3 * DS + go + 8 * p); h16x8 o, o2;
#pragma unroll
                  for (int e = 0; e < 8; ++e) { o[e] = (h16)((float)x[e] * em[e]); o2[e] = (h16)((float)x[e] * eb[e]); }
                  *(LAS h16x8*)(wl + IMG_KH + io) = o; *(LAS h16x8*)(wl + IMG_KB + io) = o2; }
                { const h16x8 x = *(const h16x8*)(D0 + 4 * DS + go + 8 * p); h16x8 o;
#pragma unroll
                  for (int e = 0; e < 8; ++e) o[e] = (h16)((float)x[e] * ep[e]);
                  *(LAS h16x8*)(wl + IMG_RT + io) = o; } }
            asm volatile("s_waitcnt lgkmcnt(0)" ::: "memory");
            { f32x4 m_ = {0.f, 0.f, 0.f, 0.f}, n_ = m_, rb = m_, rk = m_;
#pragma unroll
              for (int kk2 = 0; kk2 < 2; ++kk2) { const int ro = (2 * kk2 + (gq >> 1)) * 512 + r16 * 32 + (gq & 1) * 16;
                  const h16x8 aK = *(const LAS h16x8*)(wl + IMG_KT + ro), aR = *(const LAS h16x8*)(wl + IMG_RT + ro), bB = *(const LAS h16x8*)(wl + IMG_BH + ro), bK = *(const LAS h16x8*)(wl + IMG_KH + ro);
                  m_ = P1M_MFMA32(aK, bB, m_); n_ = P1M_MFMA32(aK, bK, n_); rb = P1M_MFMA32(aR, bB, rb); rk = P1M_MFMA32(aR, bK, rk); }
              h16x4 nT, rbT, rkT;
#pragma unroll
              for (int rg = 0; rg < 4; ++rg) { const int t = 4 * gq + rg; const bool lo = t > r16, le = t >= r16;
                  *(LAS float*)(wl + SM_M + (t * 16 + r16) * 4) = lo ? m_[rg] : 0.f; nT[rg] = (h16)(lo ? n_[rg] : 0.f); rbT[rg] = (h16)(le ? rb[rg] : 0.f); rkT[rg] = (h16)(le ? rk[rg] : 0.f); }
              *(LAS h16x4*)(wl + SM_NT + r16 * 32 + gq * 8) = nT; *(LAS h16x4*)(wl + SM_ARB + r16 * 32 + gq * 8) = rbT; *(LAS h16x4*)(wl + SM_ARK + r16 * 32 + gq * 8) = rkT;
            }
            asm volatile("s_waitcnt lgkmcnt(0)" ::: "memory");
            { float x[16];
#pragma unroll
              for (int t = 0; t < 16; ++t) { float acc = (t == r16) ? 1.f : 0.f;
#pragma unroll
                  for (int s4 = 0; s4 < (t + 3) / 4; ++s4) { const f32x4 mr = *(const LAS f32x4*)(wl + SM_M + (t * 16 + 4 * s4) * 4);
#pragma unroll
                      for (int e = 0; e < 4; ++e) if (4 * s4 + e < t) acc -= mr[e] * x[4 * s4 + e]; }
                  x[t] = acc; }
              h16x8 t0, t1;
#pragma unroll
              for (int e = 0; e < 8; ++e) { t0[e] = (h16)x[e]; t1[e] = (h16)x[8 + e]; }
              if (gq == 0) { *(LAS h16x8*)(wl + SM_TT + r16 * 32) = t0; *(LAS h16x8*)(wl + SM_TT + r16 * 32 + 16) = t1; } }
            asm volatile("s_waitcnt lgkmcnt(0)" ::: "memory");
            const int la8 = wb + 8 * lq;
            s16x4_t rT, rN, rArb, rArk, rK[4], rV[4];
            P1M_TR(rT, la8 + SM_TT); P1M_TR(rN, la8 + SM_NT); P1M_TR(rArb, la8 + SM_ARB); P1M_TR(rArk, la8 + SM_ARK);
#pragma unroll
            for (int j4 = 0; j4 < 4; ++j4) { P1M_TR(rK[j4], la8 + IMG_KT + j4 * 512); P1M_TR(rV[j4], la8 + IMG_V + j4 * 512); }
            P1M_WAITL();
            const h16x4 aT = *(h16x4*)&rT, aN = *(h16x4*)&rN, aArb = *(h16x4*)&rArb, aArk = *(h16x4*)&rArk;
            h16x4 kcH[4], zH[4], bV[4];
            const f32x4 zero4 = {0.f, 0.f, 0.f, 0.f};
#pragma unroll
            for (int j4 = 0; j4 < 4; ++j4) { bV[j4] = *(h16x4*)&rV[j4];
                kcH[j4] = cvt_h4(P1M_MFMA16(aT, *(h16x4*)&rK[j4], zero4));
                const h16x4 nvH = cvt_h4(P1M_MFMA16(aN, bV[j4], zero4)); zH[j4] = cvt_h4(P1M_MFMA16(aT, nvH, zero4)); }
            { s16x4_t rR[4];
#pragma unroll
              for (int j4 = 0; j4 < 4; ++j4) P1M_TR(rR[j4], la8 + IMG_RT + j4 * 512);
              P1M_WAITL();
#pragma unroll
              for (int j4 = 0; j4 < 4; ++j4) { const h16x4 rt = *(h16x4*)&rR[j4]; const f32x4 ak = P1M_MFMA16(aArb, kcH[j4], zero4);
                  const f32x4 rp = (f32x4){(float)rt[0], (float)rt[1], (float)rt[2], (float)rt[3]} - ak;
                  *(LAS h16x4*)(wl + IMG_RP + j4 * 512 + r16 * 32 + gq * 8) = cvt_h4(rp); } }
            { s16x4_t rRp[4];
              asm volatile("s_waitcnt lgkmcnt(0)" ::: "memory");
#pragma unroll
              for (int j4 = 0; j4 < 4; ++j4) P1M_TR(rRp[j4], la8 + IMG_RP + j4 * 512);
              P1M_WAITL();
#pragma unroll
              for (int ct = 0; ct < 4; ++ct) { f32x4 qv = zero4, yv = P1M_MFMA16(aArk, bV[ct], zero4) - P1M_MFMA16(aArb, zH[ct], zero4);
#pragma unroll
                  for (int kt = 0; kt < 4; ++kt) { const h16x4 aR = *(h16x4*)&rRp[kt]; qv = P1M_MFMA16(aR, cvt_h4(PT[kt][ct]), qv); yv = P1M_MFMA16(aR, cvt_h4(SHT[kt][ct]), yv); }
#pragma unroll
                  for (int rg = 0; rg < 4; ++rg) { *(LAS h16*)(wl + STG_Q + (4 * gq + rg) * 128 + (16 * ct + r16) * 2) = (h16)qv[rg]; *(LAS h16*)(wl + STG_Y + (4 * gq + rg) * 128 + (16 * ct + r16) * 2) = (h16)yv[rg]; } } }
            { h16x4 GT[4][4];
              s16x4_t rBB[4], rKB[4];
#pragma unroll
              for (int j4 = 0; j4 < 4; ++j4) { P1M_TR(rBB[j4], la8 + IMG_BB + j4 * 512); P1M_TR(rKB[j4], la8 + IMG_KB + j4 * 512); }
              float gdiag[4];
#pragma unroll
              for (int j4 = 0; j4 < 4; ++j4) gdiag[j4] = *(const LAS float*)(wl + SM_GAM + (16 * j4 + r16) * 4);
              P1M_WAITL();
#pragma unroll
              for (int ta = 0; ta < 4; ++ta)
#pragma unroll
                  for (int tb = 0; tb < 4; ++tb) { f32x4 g4 = P1M_MFMA16(kcH[ta], *(h16x4*)&rBB[tb], zero4);
#pragma unroll
                      for (int rg = 0; rg < 4; ++rg) g4[rg] = ((ta == tb && 4 * gq + rg == r16) ? gdiag[tb] : 0.f) - g4[rg];
                      GT[ta][tb] = cvt_h4(g4); }
#pragma unroll
              for (int ct = 0; ct < 4; ++ct) { h16x4 pH[4], sH[4];
#pragma unroll
                  for (int kt = 0; kt < 4; ++kt) { pH[kt] = cvt_h4(PT[kt][ct]); sH[kt] = cvt_h4(SHT[kt][ct]); }
#pragma unroll
                  for (int tb = 0; tb < 4; ++tb) { f32x4 hs = P1M_MFMA16(*(h16x4*)&rKB[tb], bV[ct], zero4) - P1M_MFMA16(*(h16x4*)&rBB[tb], zH[ct], zero4); f32x4 pp = zero4;
#pragma unroll
                      for (int ta = 0; ta < 4; ++ta) { pp = P1M_MFMA16(GT[ta][tb], pH[ta], pp); hs = P1M_MFMA16(GT[ta][tb], sH[ta], hs); }
                      PT[tb][ct] = pp; SHT[tb][ct] = hs; } } }
            asm volatile("s_waitcnt lgkmcnt(0)" ::: "memory");
#pragma unroll
            for (int p = 0; p < 2; ++p) { const int id = lq + 64 * p, row = id >> 3, part = id & 7; const size_t o = (tok0 + 16 * sc + row) * 1024 + h * 64 + part * 8;
                *(h16x8*)(Q16 + o) = *(const LAS h16x8*)(wl + STG_Q + id * 16); *(h16x8*)(Y016 + o) = *(const LAS h16x8*)(wl + STG_Y + id * 16); }
            asm volatile("s_waitcnt lgkmcnt(0)" ::: "memory");
        }
        { int lz = lane; asm volatile("" : "+v"(lz)); const int r16z = lz & 15, gqz = lz >> 4;
          float* hd = Hm + ((size_t)bh * SC_NC + ch) * 4096 + lz * 4; float* pb = Pm + ((size_t)bh * SC_NC + ch) * 4096 + ((r16z >> 2) * 16 + 4 * gqz) * 4 + (r16z & 3);
#pragma unroll
          for (int kt = 0; kt < 4; ++kt)
#pragma unroll
              for (int ct = 0; ct < 4; ++ct) { *(f32x4*)(hd + (ct * 4 + kt) * 256) = SHT[kt][ct];
#pragma unroll
                  for (int rg = 0; rg < 4; ++rg) pb[(kt * 4 + ct) * 256 + rg * 4] = PT[kt][ct][rg]; } }
    }
}

__device__ __forceinline__ void phase_scan_p2(const Ctx& c, KArgs* a) {
    if (c.wid != 0) return;
    unsigned char* ws = a->ws; const float* Pm = (const float*)(ws + OFF_PM); const float* Hm = (const float*)(ws + OFF_HM); float* ST = (float*)(ws + OFF_ST);
    const int lane = c.lane, q = lane >> 4, cc = lane & 15;
    for (int w = blockIdx.x; w < 256; w += gridDim.x) { const int bh = w >> 2, itl = w & 3;
        f32x4 st[4];
#pragma unroll
        for (int jt = 0; jt < 4; ++jt) st[jt] = (f32x4){0.f, 0.f, 0.f, 0.f};
        for (int ch = 0; ch < SC_NC; ++ch) {
            float* sp = ST + ((size_t)bh * SC_NC + ch) * 4096;
#pragma unroll
            for (int jt = 0; jt < 4; ++jt)
#pragma unroll
                for (int rg = 0; rg < 4; ++rg) sp[(16 * jt + 4 * q + rg) * 64 + 16 * itl + cc] = st[jt][rg];
            if (ch == SC_NC - 1) break;
            const float* pp = Pm + ((size_t)bh * SC_NC + ch) * 4096; const float* hp = Hm + ((size_t)bh * SC_NC + ch) * 4096;
            f32x4 nw[4];
#pragma unroll
            for (int jtp = 0; jtp < 4; ++jtp) nw[jtp] = *(const f32x4*)(hp + ((itl * 4 + jtp) * 64 + lane) * 4);
#pragma unroll
            for (int jtp = 0; jtp < 4; ++jtp)
#pragma unroll
                for (int jt = 0; jt < 4; ++jt) { const f32x4 av = *(const f32x4*)(pp + ((jtp * 4 + jt) * 64 + lane) * 4);
                    nw[jtp] = __builtin_amdgcn_mfma_f32_16x16x16f16(cvt_h4(av), cvt_h4(st[jt]), nw[jtp], 0, 0, 0); }
#pragma unroll
            for (int jt = 0; jt < 4; ++jt) st[jt] = nw[jt];
        }
    }
}
__device__ __forceinline__ float red_kq(float x) { x += __shfl_xor(x, 16); x += __shfl_xor(x, 32); return x; }
__device__ __forceinline__ void phase_scan_p3(const Ctx& c, KArgs* a) {
    unsigned char* ws = a->ws; const h16* D0 = (const h16*)(ws + OFF_DER); const size_t DS = (size_t)NT * 1024; const float* ST = (const float*)(ws + OFF_ST);
    const h16* Q16 = (const h16*)(ws + OFF_Q16); const h16* Y016 = (const h16*)(ws + OFF_Y016); const bf16_t* Lb = (const bf16_t*)(ws + OFF_LB); bf16_t* Ym = (bf16_t*)(ws + WS_XN);
    const float* rk = (const float*)a->in[I_RK]; const float* lnw = (const float*)a->in[I_LNW]; const float* lnb = (const float*)a->in[I_LNB];
    const int lane = c.lane, kq = lane >> 4, cc = lane & 15;
    for (int itk = c.gw; itk < 64 * SC_NC; itk += c.nw) {
        const int bh = itk & 63, ch = itk >> 6, b = bh >> 4, h = bh & 15;
        const size_t tok0 = (size_t)b * SEQ + (size_t)ch * SC_L;
        const float* sp = ST + ((size_t)bh * SC_NC + ch) * 4096;
        h16x4 sa[4][4];
#pragma unroll
        for (int itl = 0; itl < 4; ++itl)
#pragma unroll
            for (int s4 = 0; s4 < 4; ++s4)
#pragma unroll
                for (int e = 0; e < 4; ++e) sa[itl][s4][e] = (h16)sp[(16 * s4 + 4 * kq + e) * 64 + 16 * itl + cc];
        float crk[4][4], clw[4][4], clb[4][4];
#pragma unroll
        for (int itl = 0; itl < 4; ++itl)
#pragma unroll
            for (int e = 0; e < 4; ++e) { const int chn = h * 64 + 16 * itl + 4 * kq + e; crk[itl][e] = rk[chn]; clw[itl][e] = lnw[chn]; clb[itl][e] = lnb[chn]; }
#pragma unroll 1
        for (int tt = 0; tt < SC_L / 16; ++tt) { const size_t tok = tok0 + 16 * tt + cc; const size_t ob = tok * 1024 + h * 64 + 4 * kq;
            f32x4 acc[4]; h16x4 qa[4];
#pragma unroll
            for (int s4 = 0; s4 < 4; ++s4) qa[s4] = *(const h16x4*)(Q16 + ob + 16 * s4);
#pragma unroll
            for (int itl = 0; itl < 4; ++itl) { const h16x4 t4 = *(const h16x4*)(Y016 + ob + 16 * itl); acc[itl] = (f32x4){(float)t4[0], (float)t4[1], (float)t4[2], (float)t4[3]}; }
#pragma unroll
            for (int s4 = 0; s4 < 4; ++s4)
#pragma unroll
                for (int itl = 0; itl < 4; ++itl) acc[itl] = __builtin_amdgcn_mfma_f32_16x16x16f16(sa[itl][s4], qa[s4], acc[itl], 0, 0, 0);
            float sm = 0.f, bd = 0.f; h16x4 hv[4]; float g[4][4];
#pragma unroll
            for (int itl = 0; itl < 4; ++itl) { const h16x4 hr = *(const h16x4*)(D0 + 4 * DS + ob + 16 * itl), hk = *(const h16x4*)(D0 + 3 * DS + ob + 16 * itl); hv[itl] = *(const h16x4*)(D0 + 5 * DS + ob + 16 * itl);
                const u32x2 gw = *(const u32x2*)(Lb + tok * LORA_N + 2048 + h * 64 + 4 * kq + 16 * itl); g[itl][0] = bflo(gw.x); g[itl][1] = bfhi(gw.x); g[itl][2] = bflo(gw.y); g[itl][3] = bfhi(gw.y);
#pragma unroll
                for (int e = 0; e < 4; ++e) { sm += acc[itl][e]; bd += (float)hr[e] * (float)hk[e] * crk[itl][e]; } }
            sm = red_kq(sm); bd = red_kq(bd); const float mean = sm * (1.0f / 64.0f); float vs = 0.f;
#pragma unroll
            for (int itl = 0; itl < 4; ++itl)
#pragma unroll
                for (int e = 0; e < 4; ++e) { acc[itl][e] -= mean; vs += acc[itl][e] * acc[itl][e]; }
            vs = red_kq(vs); const float rstd = rsqrtf(vs * (1.0f / 64.0f) + 64e-5f);
#pragma unroll
            for (int itl = 0; itl < 4; ++itl) { float f[4];
#pragma unroll
                for (int e = 0; e < 4; ++e) f[e] = (acc[itl][e] * rstd * clw[itl][e] + clb[itl][e] + bd * (float)hv[itl][e]) * g[itl][e];
                *(unsigned*)((unsigned char*)Ym + (size_t)tok * DM + 1024 + h * 64 + 4 * kq + 16 * itl) = pk_fp8x4(f[0] * 16.0f, f[1] * 16.0f, f[2] * 16.0f, f[3] * 16.0f); }
        }
    }
}

__device__ __forceinline__ void phase_router(const Ctx& c, KArgs* a) {
    unsigned char* ws = a->ws; const float* H = a->out; bf16_t* xn2 = (bf16_t*)(ws + WS_XN); const u32x4* wf = (const u32x4*)(ws + OFF_WRF);
    const float* rbias = (const float*)a->in[I_RBIAS]; float* topw = (float*)(ws + OFF_TOPW); int* list = (int*)(ws + OFF_LIST); int* cnt = (int*)(ws + CTL_CNT);
    const int lane = c.lane, r16 = lane & 15, q = lane >> 4;
    LAS float* lg = (LAS float*)(c.lds + 65536) + c.wid * 1088;
    LAS u32x4* wl = (LAS u32x4*)c.lds;
    const float bias_e = rbias[lane];
    for (int itb = blockIdx.x; itb < NT / 128; itb += gridDim.x) { const int tok0 = itb * 128 + c.wid * 16;
        f32x4 acc[4];
#pragma unroll
        for (int cc = 0; cc < 4; ++cc) acc[cc] = (f32x4){0.f, 0.f, 0.f, 0.f};
        float ss = 0.f; const float* hp = H + (size_t)(tok0 + r16) * DM + 8 * q;
        u32x4 wreg[4];
#pragma unroll
        for (int j = 0; j < 4; ++j) wreg[j] = wf[c.tid + 512 * j];
#pragma nounroll
        for (int ch = 0; ch < 16; ++ch) { LAS u32x4* wb = wl + (ch & 1) * 2048;
#pragma unroll
            for (int j = 0; j < 4; ++j) wb[c.tid + 512 * j] = wreg[j];
            if (ch + 1 < 16) {
#pragma unroll
                for (int j = 0; j < 4; ++j) wreg[j] = wf[(size_t)(ch + 1) * 2048 + c.tid + 512 * j]; }
            __syncthreads();
#pragma unroll
          for (int s4 = 0; s4 < 4; ++s4) { const int s = ch * 4 + s4; const f32x4 x0 = *(const f32x4*)(hp + 32 * s), x1 = *(const f32x4*)(hp + 32 * s + 4);
            ss += x0[0] * x0[0] + x0[1] * x0[1] + x0[2] * x0[2] + x0[3] * x0[3] + x1[0] * x1[0] + x1[1] * x1[1] + x1[2] * x1[2] + x1[3] * x1[3];
            const u32x4 ahi = pack8(x0, x1); float h[8]; unpack8(ahi, h);
            const u32x4 alo = pack8((f32x4){x0[0] - h[0], x0[1] - h[1], x0[2] - h[2], x0[3] - h[3]}, (f32x4){x1[0] - h[4], x1[1] - h[5], x1[2] - h[6], x1[3] - h[7]});
            const bf16x8 ah = __builtin_bit_cast(bf16x8, ahi), al = __builtin_bit_cast(bf16x8, alo);
            const LAS u32x4* wp = wb + s4 * 512 + lane;
#pragma unroll
            for (int cc = 0; cc < 4; ++cc) { const bf16x8 bh = __builtin_bit_cast(bf16x8, wp[(cc * 2 + 0) * 64]), bl = __builtin_bit_cast(bf16x8, wp[(cc * 2 + 1) * 64]);
                acc[cc] = __builtin_amdgcn_mfma_f32_16x16x32_bf16(ah, bh, acc[cc], 0, 0, 0); acc[cc] = __builtin_amdgcn_mfma_f32_16x16x32_bf16(ah, bl, acc[cc], 0, 0, 0); acc[cc] = __builtin_amdgcn_mfma_f32_16x16x32_bf16(al, bh, acc[cc], 0, 0, 0); } } }
        __syncthreads();
        ss += __shfl_xor(ss, 16); ss += __shfl_xor(ss, 32);
        if (q == 0) lg[1024 + r16] = ss;
#pragma unroll
        for (int cc = 0; cc < 4; ++cc)
#pragma unroll
            for (int rg = 0; rg < 4; ++rg) lg[(4 * q + rg) * 64 + 16 * cc + r16] = acc[cc][rg];
        asm volatile("s_waitcnt lgkmcnt(0)" ::: "memory");
#pragma unroll 4
        for (int tt = 0; tt < 16; ++tt) { const int tok = tok0 + tt; const int chunk = tok / CH_TOK, tl = tok % CH_TOK;
            const float rs = rsqrtf(lg[1024 + tt] * (1.0f / DM) + RMS_EPS);
            const float sc = sigmoidf_(lg[tt * 64 + lane] * rs); const float bs = sc + bias_e;
            float m1 = bs; m1 = fmaxf(m1, __shfl_xor(m1, 1)); m1 = fmaxf(m1, __shfl_xor(m1, 2)); m1 = fmaxf(m1, __shfl_xor(m1, 4));
            const unsigned long long eq = __ballot(bs == m1); const unsigned grp = (unsigned)(eq >> (lane & ~7)) & 0xffu; const int first = (lane & ~7) + (__ffs(grp) - 1);
            float m2 = (lane == first) ? -__builtin_inff() : bs; m2 = fmaxf(m2, __shfl_xor(m2, 1)); m2 = fmaxf(m2, __shfl_xor(m2, 2)); m2 = fmaxf(m2, __shfl_xor(m2, 4));
            const float gs = m1 + m2; const int g = lane >> 3; int grank = 0;
#pragma unroll
            for (int gp = 0; gp < 8; ++gp) { const float o = rlane(gs, gp * 8); grank += (o > gs || (o == gs && gp < g)) ? 1 : 0; }
            const float mv = grank < 4 ? bs : -__builtin_inff(); int rank = 0;
#pragma unroll
            for (int e = 0; e < 64; ++e) { const float o = rlane(mv, e); rank += (o > mv || (o == mv && e < lane)) ? 1 : 0; }
            const bool sel = (grank < 4) && (rank < 8);
            const float wsum = wave_sum(sel ? sc : 0.f);
            if (sel) { topw[(size_t)tok * 8 + rank] = sc / wsum * 2.5f;
                const int p = atomicAdd(cnt + chunk * NE1 + lane, 1); list[((size_t)chunk * NE1 + lane) * CH_TOK + p] = tl * 8 + rank; }
        }
        asm volatile("s_waitcnt lgkmcnt(0)" ::: "memory");
        for (int tt = 0; tt < 16; ++tt) rownorm_fp8(H + (size_t)(tok0 + tt) * DM, (unsigned char*)xn2 + (size_t)(tok0 + tt) * DM, lane);
    }
}
__device__ __forceinline__ void phase_expert_weights(const Ctx& c, KArgs* a) {
    unsigned char* ws = a->ws; const float* gf = (const float*)a->in[I_GFFN];
    bf16_t* we1 = (bf16_t*)(ws + OFF_WE1); bf16_t* we2 = (bf16_t*)(ws + OFF_WE2);
    { LAS float* tile = (LAS float*)c.lds; const int n4 = c.tid & 31, kr = c.tid >> 5, sc = c.tid & 7, sn = c.tid >> 3; const int ntile = NE1 * 384;
      const float* wgp = (const float*)a->in[I_WG]; const float* wup = (const float*)a->in[I_WU]; const float* wdp = (const float*)a->in[I_WD];
      const float* sgp = (const float*)a->in[I_SG]; const float* sup = (const float*)a->in[I_SU]; const float* sdp = (const float*)a->in[I_SD];
      f32x4 va[4], vb[4];
#define EW_LOAD(v, T_) do { const int e_ = (T_) / 384, r_ = (T_) % 384; \
        if (r_ < 256) { const int n_ = (r_ >> 5) * 128 + 4 * n4, k0_ = (r_ & 31) * 64, half_ = (n_ >> 7) & 1, cc_ = (n_ >> 8) * 128 + (n_ & 127); \
            const float* sp_ = (e_ < NEXP ? (half_ ? wup : wgp) + (size_t)e_ * 2048 * 512 : (half_ ? sup : sgp)) + cc_; \
            _Pragma("unroll") for (int i = 0; i < 4; ++i) { const int k_ = k0_ + kr + 16 * i; v[i] = *(const f32x4*)(sp_ + (size_t)k_ * 512) * (gf[k_] * 64.0f); } } \
        else { const int t2_ = r_ - 256, n_ = (t2_ >> 3) * 128 + 4 * n4, k0_ = (t2_ & 7) * 64; const float* sp_ = (e_ < NEXP ? wdp + (size_t)e_ * 512 * 2048 : sdp) + n_; \
            _Pragma("unroll") for (int i = 0; i < 4; ++i) v[i] = *(const f32x4*)(sp_ + (size_t)(k0_ + kr + 16 * i) * 2048) * 64.0f; } } while (0)
#define EW_STEP(v, T_) do { \
          _Pragma("unroll") for (int i = 0; i < 4; ++i) _Pragma("unroll") for (int e = 0; e < 4; ++e) tile[(kr + 16 * i) * 129 + 4 * n4 + e] = v[i][e]; \
          __syncthreads(); \
          const int e_ = (T_) / 384, r_ = (T_) % 384; const bool up = r_ < 256; const int t2 = r_ - 256; \
          const int n0 = up ? (r_ >> 5) * 128 : (t2 >> 3) * 128, k0 = up ? (r_ & 31) * 64 : (t2 & 7) * 64, Kd = up ? 2048 : 512; \
          unsigned char* dst = up ? (unsigned char*)we1 + (size_t)e_ * 1024 * 2048 : (unsigned char*)we2 + (size_t)e_ * 2048 * 512; \
          if ((T_) + 2 * (int)gridDim.x < ntile) EW_LOAD(v, (T_) + 2 * (int)gridDim.x); \
          _Pragma("unroll") for (int i = 0; i < 2; ++i) { const int nl = sn + 64 * i; float f[8]; \
              _Pragma("unroll") for (int j = 0; j < 8; ++j) f[j] = tile[(8 * sc + j) * 129 + nl]; \
              u32x2 w8; w8.x = pk_fp8x4(f[0], f[1], f[2], f[3]); w8.y = pk_fp8x4(f[4], f[5], f[6], f[7]); *(u32x2*)(dst + (size_t)(n0 + nl) * Kd + k0 + 8 * sc) = w8; } \
          __syncthreads(); } while (0)
      int T = blockIdx.x; if (T < ntile) EW_LOAD(va, T); if (T + (int)gridDim.x < ntile) EW_LOAD(vb, T + (int)gridDim.x);
      for (; T < ntile; T += 2 * gridDim.x) { EW_STEP(va, T); if (T + (int)gridDim.x < ntile) EW_STEP(vb, T + (int)gridDim.x); }
#undef EW_STEP
#undef EW_LOAD
    }
    { const float* p = (const float*)a->in[I_P]; bf16_t* pb = (bf16_t*)(ws + OFF_PB); const int gt = blockIdx.x * 512 + c.tid, nthr = gridDim.x * 512;
      for (size_t i = gt; i < (size_t)NT * 256 / 4; i += nthr) { const f32x4 v = *(const f32x4*)(p + i * 4); u32x2 w; w.x = cvt_pk_bf16(v[0], v[1]); w.y = cvt_pk_bf16(v[2], v[3]); *(u32x2*)(pb + i * 4) = w; } }
}
__device__ __forceinline__ void phase_combine(const Ctx& c, KArgs* a, int chunk) {
    unsigned char* ws = a->ws; float* H = a->out; const bf16_t* Y = (const bf16_t*)(ws + OFF_YPART + (size_t)(chunk & 1) * YPART_BYTES); bf16_t* xn3 = (bf16_t*)(ws + OFF_XN3);
    const int lane = c.lane;
    for (int tl = c.gw; tl < CH_TOK; tl += c.nw) { const int tok = chunk * CH_TOK + tl; float* hp = H + (size_t)tok * DM;
        float v[4][8];
#pragma unroll
        for (int i = 0; i < 4; ++i) { const f32x4 h0 = *(const f32x4*)(hp + (i * 64 + lane) * 8), h1 = *(const f32x4*)(hp + (i * 64 + lane) * 8 + 4);
            v[i][0] = h0[0]; v[i][1] = h0[1]; v[i][2] = h0[2]; v[i][3] = h0[3]; v[i][4] = h1[0]; v[i][5] = h1[1]; v[i][6] = h1[2]; v[i][7] = h1[3]; }
#pragma unroll 4
        for (int k = 0; k < 8; ++k) { const unsigned char* yp = (const unsigned char*)Y + ((size_t)tl * 8 + k) * DM;
#pragma unroll
            for (int i = 0; i < 4; ++i) { const u32x2 w8 = *(const u32x2*)(yp + (i * 64 + lane) * 8);
                const auto f0 = __builtin_amdgcn_cvt_pk_f32_fp8((int)w8.x, false), f1 = __builtin_amdgcn_cvt_pk_f32_fp8((int)w8.x, true), f2 = __builtin_amdgcn_cvt_pk_f32_fp8((int)w8.y, false), f3 = __builtin_amdgcn_cvt_pk_f32_fp8((int)w8.y, true);
                v[i][0] += f0[0] * (1.0f / 16.0f); v[i][1] += f0[1] * (1.0f / 16.0f); v[i][2] += f1[0] * (1.0f / 16.0f); v[i][3] += f1[1] * (1.0f / 16.0f);
                v[i][4] += f2[0] * (1.0f / 16.0f); v[i][5] += f2[1] * (1.0f / 16.0f); v[i][6] += f3[0] * (1.0f / 16.0f); v[i][7] += f3[1] * (1.0f / 16.0f); } }
        float ss = 0.f;
#pragma unroll
        for (int i = 0; i < 4; ++i) { *(f32x4*)(hp + (i * 64 + lane) * 8) = (f32x4){v[i][0], v[i][1], v[i][2], v[i][3]}; *(f32x4*)(hp + (i * 64 + lane) * 8 + 4) = (f32x4){v[i][4], v[i][5], v[i][6], v[i][7]};
#pragma unroll
            for (int e = 0; e < 8; ++e) ss += v[i][e] * v[i][e]; }
        ss = wave_sum(ss); const float rs = rsqrtf(ss * (1.0f / DM) + RMS_EPS) * 16.0f; unsigned char* xp = (unsigned char*)xn3 + (size_t)tok * DM;
#pragma unroll
        for (int i = 0; i < 4; ++i) { u32x2 w8; w8.x = pk_fp8x4(v[i][0] * rs, v[i][1] * rs, v[i][2] * rs, v[i][3] * rs); w8.y = pk_fp8x4(v[i][4] * rs, v[i][5] * rs, v[i][6] * rs, v[i][7] * rs);
            *(u32x2*)(xp + (i * 64 + lane) * 8) = w8; } }
}
__device__ __forceinline__ void phase_final(const Ctx& c, KArgs* a, int tok0, int tok1) {
    unsigned char* ws = a->ws; float* H = a->out; const bf16_t* U = (const bf16_t*)(ws + OFF_U); const float* ssq = (const float*)(ws + OFF_SSQU); const float* gp = (const float*)a->in[I_GPOUT];
    const int lane = c.lane;
    for (int tok = tok0 + c.gw; tok < tok1; tok += c.nw) { const float rs = rsqrtf(wave_sum(lane < 32 ? ssq[(size_t)tok * 32 + lane] : 0.f) * (1.0f / DM) + RMS_EPS); float* hp = H + (size_t)tok * DM; const bf16_t* up = U + (size_t)tok * DM;
#pragma unroll
        for (int i = 0; i < 4; ++i) { const int cc = (i * 64 + lane) * 8; f32x4 h0 = *(const f32x4*)(hp + cc), h1 = *(const f32x4*)(hp + cc + 4); const f32x4 g0 = *(const f32x4*)(gp + cc), g1 = *(const f32x4*)(gp + cc + 4);
            float f[8]; unpack8(*(const u32x4*)(up + cc), f);
            h0[0] += f[0] * rs * g0[0]; h0[1] += f[1] * rs * g0[1]; h0[2] += f[2] * rs * g0[2]; h0[3] += f[3] * rs * g0[3];
            h1[0] += f[4] * rs * g1[0]; h1[1] += f[5] * rs * g1[1]; h1[2] += f[6] * rs * g1[2]; h1[3] += f[7] * rs * g1[3];
            *(f32x4*)(hp + cc) = h0; *(f32x4*)(hp + cc + 4) = h1; } }
}

constexpr int LDS_STAGE = pg8::STAGE_BYTES;
constexpr int LDS_MISC = LDS_STAGE;
constexpr int LDS_BYTES = LDS_STAGE + 12288;
enum { PH_PREP = 0, PH_PROJ, PH_UP, PH_FINQK, PH_ATTN, PH_LORA, PH_SCANPREP, PH_SCAN1, PH_SCAN2, PH_SCAN3, PH_WOUT, PH_ROUTER, PH_MOE0  , PH_GATE = PH_MOE0 + 2 + NCHUNK  , PH_FINAL, PH_COUNT };

__device__ __forceinline__ int tile_expert(const LAS int* starts, int t) { int lo = 0, hi = NE1; while (hi - lo > 1) { const int mid = (lo + hi) >> 1; if (starts[mid] <= t) lo = mid; else hi = mid; } return lo; }
__device__ __forceinline__ void moe_tables(const Ctx& c, KArgs* a, bool build_rinfo) {
    LAS int* tb = (LAS int*)(c.lds + LDS_MISC); const int* cnt = (const int*)(a->ws + CTL_CNT);
    __syncthreads();
    for (int i = c.tid; i < NCHUNK * NE1; i += 512) { int v = cnt[i]; v = v < 0 ? 0 : (v > CH_TOK ? CH_TOK : v); tb[512 * (i / NE1) + 72 + (i % NE1)] = v; }
    __syncthreads();
    if (c.wid <= NCHUNK) {
        int n = 0, n64 = 0;
        if (c.wid < NCHUNK) { n = tb[512 * c.wid + 72 + c.lane]; n64 = tb[512 * c.wid + 72 + NEXP]; }
        else { for (int k = 0; k < NCHUNK; ++k) { n += tb[512 * k + 72 + c.lane]; n64 += tb[512 * k + 72 + NEXP]; } }
        const int t = (n + 255) >> 8; int incl = t;
#pragma unroll
        for (int o = 1; o < 64; o <<= 1) { const int v = __shfl_up(incl, o); if (c.lane >= o) incl += v; }
        const int tot = __shfl(incl, 63); LAS int* st = c.wid < NCHUNK ? tb + 512 * c.wid : tb + pg8::GT_INT;
        st[c.lane] = incl - t; if (c.lane == 0) { st[NEXP] = tot; st[NE1] = tot + ((n64 + 255) >> 8); } }
    __syncthreads();
    if (c.tid == 0) { int s = 0; for (int k = 0; k < NCHUNK; ++k) { tb[2048 + k] = s; s += tb[512 * k + NE1]; } tb[2048 + NCHUNK] = s; }
    if (build_rinfo) for (int t = c.tid; t < pg8::GT_MAX; t += 512) if (t < tb[pg8::GT_INT + NE1]) ((LAS unsigned char*)tb)[pg8::GM_BYTE + t] = (unsigned char)tile_expert(tb + pg8::GT_INT, t);
    for (int i = c.tid; i < NCHUNK * MAXT; i += 512) { const int k = i / MAXT, t = i % MAXT; const LAS int* tk = tb + 512 * k; if (t < tk[NE1]) tb[512 * k + 144 + t] = tile_expert(tk, t); }
    __syncthreads();
    if (build_rinfo) {
        int2* ri = (int2*)(a->ws + OFF_RINFO); const int* list = (const int*)(a->ws + OFF_LIST); const float* topw = (const float*)(a->ws + OFF_TOPW);
        const int ntall = tb[2048 + NCHUNK];
        for (int idx = blockIdx.x * 512 + c.tid; idx < ntall * 256; idx += gridDim.x * 512) { const int tg = idx >> 8; int k = 0; while (k + 1 < NCHUNK && tb[2048 + k + 1] <= tg) ++k;
            const LAS int* tk = tb + 512 * k; const int ti = tg - tb[2048 + k], e = tk[144 + ti], pos = (ti - tk[e]) * 256 + (idx & 255); int2 v; v.x = CH_TOK * 8; v.y = 0;
            if (pos < tk[72 + e]) { if (e == NEXP) { v.x = -2 - pos; v.y = __float_as_int(1.0f / 256.0f); }
                else { const int ent = list[((size_t)k * NE1 + e) * CH_TOK + pos]; v.x = ent; v.y = __float_as_int(topw[(size_t)k * CH_TOK * 8 + ent] * (1.0f / 256.0f)); } }
            ri[idx] = v; }
    }
}

__global__ void __launch_bounds__(512, 2) fwd(Args a_in) {
    extern __shared__ __attribute__((aligned(16))) unsigned char lds_raw[];
    const int G = gridDim.x, bid = blockIdx.x;
#define KARG ({ KArgs* kp_ = (KArgs*)__builtin_amdgcn_kernarg_segment_ptr(); asm volatile("" : "+s"(kp_)); kp_; })
#define XBW ((volatile LAS unsigned*)((LAS unsigned char*)lds_raw + LDS_MISC + 12272))
    { KArgs* k0 = KARG; if (k0->ph_hi - k0->ph_lo > 1) { if (threadIdx.x == 0) { XBW[0] = 0u; XBW[1] = 0u; XBW[2] = 0u; XBW[3] = 0u; } __syncthreads(); (void)xcd_barrier_post((unsigned*)(k0->ws + CTL_BAR), XBW); } }
#define GRID_BAR_NOW() do { KArgs* kb_ = KARG; XcdBarrier bar_; bar_.bar = (unsigned*)(kb_->ws + CTL_BAR); bar_.x = xb_xcc_id(); bar_.st = XBW; xcd_barrier(bar_); } while (0)
#ifndef PROBE_MASK
#define PROBE_MASK 0ull
#endif
#ifndef PROBE_EW
#define PROBE_EW 0
#endif
#define DUP(k) ((int)((PROBE_MASK >> (k)) & 1ull))
#define GRID_BAR(k) do { KArgs* kq_ = KARG; if ((k) + 1 < kq_->ph_hi && kq_->ph_lo <= (k)) GRID_BAR_NOW(); } while (0)
#define PHASE_ARGS KArgs* ap_ = (KArgs*)__builtin_amdgcn_kernarg_segment_ptr(); asm volatile("" : "+s"(ap_)); KArgs* a = ap_; unsigned char* ws = a->ws; (void)ws; Ctx c; { int t_ = threadIdx.x; asm volatile("" : "+v"(t_)); c.tid = t_; } c.lane = c.tid & 63; c.wid = __builtin_amdgcn_readfirstlane(c.tid >> 6); c.gw = blockIdx.x * 8 + c.wid; c.nw = gridDim.x * 8; c.lds = (LAS unsigned char*)lds_raw
#ifndef PH_ONLY
#define PH_ONLY -1
#endif
#define IN(k) ((PH_ONLY < 0 || PH_ONLY == (k) || (PH_ONLY == 100 && (k) >= PH_MOE0 && (k) < PH_GATE)) && KARG->ph_lo <= (k) && (k) < KARG->ph_hi)
    for (int rep_ = 0; rep_ <= DUP(PH_PREP); ++rep_) { if (rep_) GRID_BAR_NOW(); if (IN(PH_PREP)) { PHASE_ARGS; phase_prep(c, a); __syncthreads(); if ((NT / 256) * (ZW / 256) % G == 0) phase_prep_late<2>(c, a, bid, G); else phase_prep_late<0>(c, a, bid, G); }
    } GRID_BAR(PH_PREP);
    for (int rep_ = 0; rep_ <= DUP(PH_PROJ); ++rep_) { if (rep_) GRID_BAR_NOW(); if (IN(PH_PROJ)) {
        { PHASE_ARGS; pg8::Gemm g{(const bf16_t*)(ws + WS_XN), (const bf16_t*)(ws + OFF_WT_RKV), DM, DM, DM}; pg8::DenseOrder S; S.init(NT, ZW - ZC_R, G, bid);
          EpiPlain E{(bf16_t*)(ws + OFF_Z) + ZC_R, ZW}; pg8::gemm_phase(c.lds, g, S, E); }
        { PHASE_ARGS; pg8::Gemm g{(const bf16_t*)a->out, (const bf16_t*)(ws + OFF_WT_IN), DM / 2, DM / 2, DM / 2}; pg8::DenseOrder S; S.init(NT, ZC_R, G, bid);
          EpiProj E{(bf16_t*)(ws + OFF_Z), (float*)(ws + OFF_SSQP)}; pg8::gemm_phase(c.lds, g, S, E); } }
        if (IN(PH_PROJ) && rep_ == 0) { const int nrem = (NT / 256) * (ZC_R / 256) % G; if (nrem > 0 && bid >= nrem) { PHASE_ARGS; phase_prep_late<1>(c, a, bid - nrem, G - nrem); } }
    } GRID_BAR(PH_PROJ);
    for (int rep_ = 0; rep_ <= DUP(PH_UP); ++rep_) { if (rep_) GRID_BAR_NOW(); if (IN(PH_UP)) { PHASE_ARGS;
        { pg8::Gemm g{(const bf16_t*)(ws + OFF_Z), (const bf16_t*)(ws + OFF_WT_UQ), ZW, 512, 512}; pg8::DenseOrder S; S.init(NT, QW, G, bid);
          EpiQup E{(bf16_t*)(ws + OFF_QB), (const float*)(ws + OFF_SSQP)}; pg8::gemm_phase(c.lds, g, S, E); }
        { pg8::Gemm g{(const bf16_t*)(ws + OFF_Z) + 512, (const bf16_t*)(ws + OFF_WT_UKV), ZW, 256, 256}; pg8::DenseOrder S; S.init(NT, 2048, G, bid);
          EpiKV E{(bf16_t*)(ws + OFF_KB), (bf16_t*)(ws + OFF_VB), (const float*)(ws + OFF_SSQP)}; pg8::gemm_phase(c.lds, g, S, E); }
    }
    } GRID_BAR(PH_UP);
    for (int rep_ = 0; rep_ <= DUP(PH_FINQK); ++rep_) { if (rep_) GRID_BAR_NOW(); if (IN(PH_FINQK)) { PHASE_ARGS; phase_finalize_qk(c, a); phase_lora_prep(c, a); }
    } GRID_BAR(PH_FINQK);
    for (int rep_ = 0; rep_ <= DUP(PH_ATTN); ++rep_) { if (rep_) GRID_BAR_NOW(); if (IN(PH_ATTN)) { PHASE_ARGS; phase_attn_v2(c, a); }
    } GRID_BAR(PH_ATTN);
    for (int rep_ = 0; rep_ <= DUP(PH_LORA); ++rep_) { if (rep_) GRID_BAR_NOW(); if (IN(PH_LORA)) { PHASE_ARGS; pg8::Gemm g{(const bf16_t*)(ws + OFF_ALORA), (const bf16_t*)(ws + OFF_WT_LORA), LORA_K, LORA_K, LORA_K}; pg8::DenseOrder S; S.init(NT, LORA_N, G, bid);
        EpiPlain E{(bf16_t*)(ws + OFF_LB), LORA_N}; pg8::gemm_phase(c.lds, g, S, E); }
    } GRID_BAR(PH_LORA);
    for (int rep_ = 0; rep_ <= DUP(PH_SCANPREP); ++rep_) { if (rep_) GRID_BAR_NOW(); if (IN(PH_SCANPREP)) { PHASE_ARGS; phase_scan_prep(c, a); }
    } GRID_BAR(PH_SCANPREP);
    for (int rep_ = 0; rep_ <= DUP(PH_SCAN1); ++rep_) { if (rep_) GRID_BAR_NOW(); if (IN(PH_SCAN1)) { PHASE_ARGS; phase_scan_p1m(c, a); }
    } GRID_BAR(PH_SCAN1);
    for (int rep_ = 0; rep_ <= DUP(PH_SCAN2); ++rep_) { if (rep_) GRID_BAR_NOW(); if (IN(PH_SCAN2)) { PHASE_ARGS; phase_scan_p2(c, a); }
    } GRID_BAR(PH_SCAN2);
    for (int rep_ = 0; rep_ <= DUP(PH_SCAN3); ++rep_) { if (rep_) GRID_BAR_NOW(); if (IN(PH_SCAN3)) { PHASE_ARGS; phase_scan_p3(c, a); }
    } GRID_BAR(PH_SCAN3);
    for (int rep_ = 0; rep_ <= DUP(PH_WOUT); ++rep_) { if (rep_) GRID_BAR_NOW(); if (IN(PH_WOUT)) { PHASE_ARGS; pg8::Gemm g{(const bf16_t*)(ws + WS_XN), (const bf16_t*)(ws + OFF_WT_OUT), DM / 2, DM / 2, DM / 2}; pg8::DenseOrder S; S.init(NT, DM, G, bid);
        EpiWout E{(const float*)a->in[I_X], a->out}; g.noepi = rep_; pg8::gemm_phase(c.lds, g, S, E); }
    } GRID_BAR(PH_WOUT);
    for (int rep_ = 0; rep_ <= DUP(PH_ROUTER); ++rep_) { if (rep_) GRID_BAR_NOW(); if (IN(PH_ROUTER)) { PHASE_ARGS;
        if ((bid >> 3) & 1) { phase_expert_weights(c, a); __syncthreads(); phase_router(c, a); } else { phase_router(c, a); __syncthreads(); phase_expert_weights(c, a); } if (PROBE_EW) { __syncthreads(); phase_expert_weights(c, a); } }
    } GRID_BAR(PH_ROUTER);
    for (int rep_ = 0; rep_ <= DUP(PH_MOE0); ++rep_) { if (rep_) GRID_BAR_NOW(); if (IN(PH_MOE0)) { PHASE_ARGS; moe_tables(c, a, true);
            pg8::Gemm g{(const bf16_t*)(ws + WS_XN), (const bf16_t*)(ws + OFF_WE1), DM / 2, DM / 2, DM / 2};
            pg8::MoeOrderG1 S{(const LAS int*)(c.lds + LDS_MISC), (const int*)(ws + OFF_LIST), G, bid, 1024};
            EpiMoe1 E{(unsigned char*)(ws + OFF_HMID)}; g.noepi = rep_; pg8::gemm_phase(c.lds, g, S, E);
            { pg8::Gemm g2{(const bf16_t*)(ws + OFF_PB), (const bf16_t*)(ws + OFF_WT_PP), 256, 256, 256}; pg8::DenseOrder S2; S2.init(NT, DM, G, bid);
              EpiPlain E2{(bf16_t*)(ws + OFF_PP), DM}; pg8::gemm_phase(c.lds, g2, S2, E2); } }
    } GRID_BAR(PH_MOE0);
#define MOE_DOWN(ch) do { pg8::Gemm g{(const bf16_t*)(ws + OFF_HMID), (const bf16_t*)(ws + OFF_WE2), 256, 256, 256}; \
            pg8::MoeOrder<false> S{(const LAS int*)(c.lds + LDS_MISC), (const int*)(ws + OFF_LIST), 8, G, bid, ch, ch + 1, 2048, 0}; \
            EpiMoe2 E{(unsigned char*)(ws + OFF_YPART + (size_t)((ch) & 1) * YPART_BYTES), (const i32x2*)(ws + OFF_RINFO), a->out, ch, 0}; pg8::gemm_phase(c.lds, g, S, E); } while (0)
    if (IN(PH_MOE0 + 1)) { PHASE_ARGS; MOE_DOWN(0); }
    GRID_BAR(PH_MOE0 + 1);
#define MOE_MERGED(ch) do { if (IN(PH_MOE0 + 1 + ch)) {        \
            if ((bid >> 3) & 1) { { PHASE_ARGS; phase_combine(c, a, ch - 1); } __syncthreads(); { PHASE_ARGS; MOE_DOWN(ch); } } \
            else { { PHASE_ARGS; MOE_DOWN(ch); } __syncthreads(); { PHASE_ARGS; phase_combine(c, a, ch - 1); } } } \
        GRID_BAR(PH_MOE0 + 1 + ch); } while (0)
    static_assert(NCHUNK == 4, "phase program below is written out for four chunks");
    MOE_MERGED(1); MOE_MERGED(2); MOE_MERGED(3);
#define GATE_ROWS(r0, r1) do { PHASE_ARGS; pg8::Gemm g{(const bf16_t*)(ws + OFF_XN3 + (size_t)(r0) * DM), (const bf16_t*)(ws + OFF_WT_PG), DM / 2, DM / 2, DM / 2}; pg8::DenseOrder S; S.init((r1) - (r0), DM, G, bid); \
        EpiGate E{(const bf16_t*)(ws + OFF_PP) + (size_t)(r0) * DM, (const float*)a->in[I_BPG], (bf16_t*)(ws + OFF_U) + (size_t)(r0) * DM, (float*)(ws + OFF_SSQU) + (size_t)(r0) * 32, 0}; pg8::gemm_phase(c.lds, g, S, E); } while (0)
    constexpr int R3 = (NCHUNK - 1) * CH_TOK;
    if (IN(PH_MOE0 + 1 + NCHUNK)) { if ((bid >> 3) & 1) { { PHASE_ARGS; phase_combine(c, a, NCHUNK - 1); } __syncthreads(); GATE_ROWS(0, R3); } else { GATE_ROWS(0, R3); __syncthreads(); { PHASE_ARGS; phase_combine(c, a, NCHUNK - 1); } } }
    GRID_BAR(PH_MOE0 + 1 + NCHUNK);
#undef MOE_MERGED
#undef MOE_DOWN
    if (IN(PH_GATE)) { if ((bid >> 3) & 1) { { PHASE_ARGS; phase_final(c, a, 0, R3); } __syncthreads(); GATE_ROWS(R3, NT); } else { GATE_ROWS(R3, NT); __syncthreads(); { PHASE_ARGS; phase_final(c, a, 0, R3); } } }
    GRID_BAR(PH_GATE);
    if (IN(PH_FINAL)) { PHASE_ARGS; phase_final(c, a, R3, NT); }
#undef GATE_ROWS
#undef IN
}

extern "C" void kernel_launch(void* const* d_in, const int* in_sizes, int n_in, void* d_out, int out_size, void* d_ws, size_t ws_size, hipStream_t stream) {
    static int grid = 0;
    if (grid == 0) {
        if (n_in != 37 || out_size != NT * DM || ws_size < WS_END) { fprintf(stderr, "kernel_launch: unexpected shapes (n_in %d out %d ws %zu need %zu)\n", n_in, out_size, ws_size, (size_t)WS_END); grid = -1; return; }
        int dev = 0, cus = 0;
        if (hipGetDevice(&dev) != hipSuccess || hipDeviceGetAttribute(&cus, hipDeviceAttributeMultiprocessorCount, dev) != hipSuccess) { grid = -1; return; }
        if (hipFuncSetAttribute((const void*)fwd, hipFuncAttributeMaxDynamicSharedMemorySize, LDS_BYTES) != hipSuccess) { fprintf(stderr, "kernel_launch: hipFuncSetAttribute failed\n"); grid = -1; return; }
        int per_cu = 0; (void)hipOccupancyMaxActiveBlocksPerMultiprocessor(&per_cu, (const void*)fwd, 512, LDS_BYTES); (void)hipGetLastError();
        grid = cus;
    }
    if (grid < 0) return;
    (void)hipMemsetAsync((char*)d_ws + WS_CTL, 0, CTL_ZERO_BYTES, stream);
    Args a{};
    for (int i = 0; i < 37; ++i) a.in[i] = d_in[i];
    a.out = (float*)d_out; a.ws = (unsigned char*)d_ws;
#if N_LAUNCH_MODE == 0
    for (int p = 0; p < PH_COUNT; ++p) { a.ph_lo = p; a.ph_hi = p + 1; hipLaunchKernelGGL(fwd, dim3(grid), dim3(512), LDS_BYTES, stream, a); }
#else
    a.ph_lo = 0; a.ph_hi = PH_COUNT; hipLaunchKernelGGL(fwd, dim3(grid), dim3(512), LDS_BYTES, stream, a);
#endif
}
```

```cpp
#include <hip/hip_runtime.h>
#include <hip/hip_bf16.h>
#include <cstdio>
#include <cstdint>

#ifndef N_LAUNCH_MODE
#define N_LAUNCH_MODE 1
#endif

#define LAS __attribute__((address_space(3)))
typedef unsigned short bf16_t;
typedef short bf16x8 __attribute__((ext_vector_type(8)));
typedef float f32x4 __attribute__((ext_vector_type(4)));
typedef float f32x16 __attribute__((ext_vector_type(16)));
typedef unsigned u32x4 __attribute__((ext_vector_type(4)));
typedef unsigned u32x2 __attribute__((ext_vector_type(2)));
typedef int i32x2 __attribute__((ext_vector_type(2)));
#ifndef PROBE_NOSTORE
#define PROBE_NOSTORE 0
#endif
typedef int i32x8 __attribute__((ext_vector_type(8)));
typedef _Float16 h16;
typedef _Float16 h16x8 __attribute__((ext_vector_type(8)));
typedef _Float16 h16x4 __attribute__((ext_vector_type(4)));

constexpr int NT = 32768, DM = 2048, SEQ = 8192, NB = 4;
constexpr int ZW = 4352;
constexpr int ZC_KPE = 768, ZC_WL = 832, ZC_AL = 896, ZC_GL = 960, ZC_R = 1280, ZC_K = 2304, ZC_V = 3328;
constexpr int QW = 1536;
constexpr int LORA_K = 384, LORA_N = 3072;
constexpr int NEXP = 64, NE1 = 65;
constexpr int NCHUNK = 4, CH_TOK = NT / NCHUNK;
static_assert(CH_TOK % 256 == 0, "shared-expert row tiles must have no padding rows");
constexpr int MAXT = CH_TOK * 8 / 256 + 64 + CH_TOK / 256;
constexpr float RMS_EPS = 1e-6f;
constexpr float QSCALE = 0.07216878364870322f * 1.4426950408889634f;

constexpr size_t MiB = 1ull << 20;
constexpr size_t WS_CTL = 0;
constexpr size_t CTL_BAR = 0;
constexpr size_t CTL_CNT = 64 * 1024;
constexpr size_t CTL_ZERO_BYTES = 128 * 1024;
constexpr size_t WS_SMALL = 1 * MiB;
constexpr size_t OFF_WT_IN = WS_SMALL;
constexpr size_t OFF_WT_UQ = OFF_WT_IN + (size_t)ZW * 2048 * 2;
constexpr size_t OFF_WT_UKV = OFF_WT_UQ + (size_t)1536 * 512 * 2;
constexpr size_t OFF_WT_LORA = OFF_WT_UKV + (size_t)2048 * 256 * 2;
constexpr size_t OFF_WT_OUT = OFF_WT_LORA + (size_t)LORA_N * LORA_K * 2;
constexpr size_t OFF_WT_PG = OFF_WT_OUT + (size_t)2048 * 2048 * 2;
constexpr size_t OFF_WT_PP = OFF_WT_PG + (size_t)2048 * 2048 * 2;
constexpr size_t OFF_WT_RKV = OFF_WT_IN + (size_t)1280 * 2048;
constexpr size_t OFF_WRF = OFF_WT_PP + (size_t)2048 * 256 * 2;
constexpr size_t OFF_SSQP = OFF_WRF + (size_t)2048 * 64 * 4;
constexpr size_t OFF_TOPW = OFF_SSQP + (size_t)NT * 12 * 4;
constexpr size_t OFF_LIST = OFF_TOPW + (size_t)NT * 8 * 4;
constexpr size_t OFF_ROPE = OFF_LIST + (size_t)NCHUNK * NE1 * CH_TOK * 4;
constexpr size_t OFF_SMALL_END = OFF_ROPE + (size_t)NT * 64 * 4;
constexpr size_t WS_XN = 64 * MiB;
static_assert(OFF_SMALL_END <= WS_XN, "small region overflow");
constexpr size_t WS_BIG = WS_XN + 128 * MiB;
constexpr size_t OFF_Z = WS_BIG;
constexpr size_t OFF_R1 = OFF_Z + 272 * MiB;
constexpr size_t OFF_QB = OFF_R1;
constexpr size_t OFF_KB = OFF_QB + (size_t)NT * QW * 2;
constexpr size_t OFF_VB = OFF_KB + (size_t)NT * QW * 2;
constexpr size_t OFF_ALORA = OFF_R1 + 256 * MiB;
constexpr size_t OFF_LB = OFF_R1;
constexpr size_t OFF_DER = OFF_R1 + 256 * MiB;
constexpr size_t DER_STRIDE = (size_t)NT * 1024 * 2;
constexpr size_t OFF_MIX_END = OFF_DER + 6 * DER_STRIDE;
constexpr size_t OFF_WE1 = WS_BIG;
constexpr size_t OFF_WE2 = OFF_WE1 + (size_t)NE1 * 1024 * 2048;
constexpr size_t OFF_XN3 = WS_XN + 64 * MiB;
constexpr size_t OFF_HMID = OFF_WE2 + (size_t)NE1 * 2048 * 512;
constexpr size_t OFF_YPART = OFF_HMID + (size_t)NCHUNK * MAXT * 256 * 512;
constexpr int YP_SHARED = CH_TOK * 8 + 16;
constexpr size_t YPART_BYTES = (size_t)(CH_TOK * 9 + 16) * 2048;
constexpr size_t OFF_PB = OFF_YPART + 2 * YPART_BYTES;
constexpr size_t OFF_PP = OFF_PB + (size_t)NT * 256 * 2;
constexpr size_t OFF_U = OFF_PP + (size_t)NT * 2048 * 2;
constexpr size_t OFF_SSQU = OFF_U + (size_t)NT * 2048 * 2;
constexpr size_t OFF_RINFO = OFF_SSQU + (size_t)NT * 32 * 4;
constexpr size_t OFF_MOE_END = OFF_RINFO + (size_t)NCHUNK * MAXT * 256 * 8;
constexpr size_t WS_END = (OFF_MIX_END > OFF_MOE_END ? OFF_MIX_END : OFF_MOE_END);
static_assert(WS_END <= 1140 * MiB, "workspace budget");

__device__ __forceinline__ unsigned cvt_pk_bf16(float lo, float hi) { unsigned r; asm volatile("v_cvt_pk_bf16_f32 %0, %1, %2" : "=v"(r) : "v"(lo), "v"(hi)); return r; }
__device__ __forceinline__ bf16_t f2bf(float f) { return (bf16_t)(cvt_pk_bf16(f, 0.f) & 0xffffu); }
__device__ __forceinline__ float bf2f(bf16_t b) { return __uint_as_float(((unsigned)b) << 16); }
__device__ __forceinline__ float bflo(unsigned w) { return __uint_as_float(w << 16); }
__device__ __forceinline__ float bfhi(unsigned w) { return __uint_as_float(w & 0xffff0000u); }
__device__ __forceinline__ u32x4 pack8(f32x4 a, f32x4 b) { return (u32x4){cvt_pk_bf16(a[0], a[1]), cvt_pk_bf16(a[2], a[3]), cvt_pk_bf16(b[0], b[1]), cvt_pk_bf16(b[2], b[3])}; }
__device__ __forceinline__ unsigned pk_fp8x4(float a, float b, float c2, float d) { unsigned w = 0; a = fminf(fmaxf(a, -448.f), 448.f); b = fminf(fmaxf(b, -448.f), 448.f); c2 = fminf(fmaxf(c2, -448.f), 448.f); d = fminf(fmaxf(d, -448.f), 448.f); w = __builtin_amdgcn_cvt_pk_fp8_f32(a, b, w, false); w = __builtin_amdgcn_cvt_pk_fp8_f32(c2, d, w, true); return w; }
__device__ __forceinline__ void unpack8(const u32x4 w, float (&f)[8]) { f[0] = bflo(w[0]); f[1] = bfhi(w[0]); f[2] = bflo(w[1]); f[3] = bfhi(w[1]); f[4] = bflo(w[2]); f[5] = bfhi(w[2]); f[6] = bflo(w[3]); f[7] = bfhi(w[3]); }
__device__ __forceinline__ u32x4 packf8(const float (&f)[8]) { return (u32x4){cvt_pk_bf16(f[0], f[1]), cvt_pk_bf16(f[2], f[3]), cvt_pk_bf16(f[4], f[5]), cvt_pk_bf16(f[6], f[7])}; }
__device__ __forceinline__ float wave_sum(float v) { for (int o = 32; o >= 1; o >>= 1) v += __shfl_xor(v, o); return v; }
__device__ __forceinline__ float rlane(float x, int j) { return __int_as_float(__builtin_amdgcn_readlane(__float_as_int(x), j)); }
__device__ __forceinline__ float sigmoidf_(float x) { return __builtin_amdgcn_rcpf(1.0f + __builtin_amdgcn_exp2f(-1.44269504f * x)); }

#define DPP_ADD(x, ctrl) ((x) + __int_as_float(__builtin_amdgcn_update_dpp(0, __float_as_int(x), (ctrl), 0xF, 0xF, true)))
__device__ __forceinline__ void reduce8_fq(const float (&s)[8], float& o0, float& o1) {
    float t[4];
#pragma unroll
    for (int i = 0; i < 4; ++i) { auto r = __builtin_amdgcn_permlane32_swap(__float_as_uint(s[i]), __float_as_uint(s[i + 4]), false, false); t[i] = __uint_as_float(r[0]) + __uint_as_float(r[1]); }
    { auto r = __builtin_amdgcn_permlane16_swap(__float_as_uint(t[0]), __float_as_uint(t[2]), false, false); o0 = __uint_as_float(r[0]) + __uint_as_float(r[1]); }
    { auto r = __builtin_amdgcn_permlane16_swap(__float_as_uint(t[1]), __float_as_uint(t[3]), false, false); o1 = __uint_as_float(r[0]) + __uint_as_float(r[1]); }
}
__device__ __forceinline__ float allred8(float x) { x = DPP_ADD(x, 0xB1); x = DPP_ADD(x, 0x4E); x = DPP_ADD(x, 0x141); return x; }

namespace pg8 {
constexpr int BM = 256, BK = 64, HALF = 128, HTB = HALF * BK * 2, STAGE_BYTES = 8 * HTB;
__host__ __device__ __forceinline__ int lds_byte(int r, int c) { const int st = (r >> 4) * 2 + (c >> 5), rr = r & 15, cc = c & 31, ob = rr * 64 + cc * 2; return st * 1024 + (ob ^ (((ob >> 9) & 1) << 5)); }
__host__ __device__ __forceinline__ void stage_rc(int b, int& R, int& C) { const int st = b / 1024, sb = b % 1024, swz = sb ^ (((sb >> 9) & 1) << 5); R = (st >> 1) * 16 + swz / 64; C = (st & 1) * 32 + (swz % 64) / 2; }
__host__ __device__ __forceinline__ int perm32(int rho) { const int n = rho >> 4, i = rho & 15; return 8 * (i >> 2) + 4 * n + (i & 3); }

constexpr int GT_INT = 2624, GM_BYTE = 10760, GT_MAX = 1280;
struct Unit { int pm, pn, e, row0, cnt, chunk, arow, b1, b2, b3; };
struct Gemm { const bf16_t* A; const bf16_t* Bt; int lda, ldb, K; int noepi = 0; };

struct DenseOrder {
    static constexpr bool GATHER = false;
    int nM, nN, nwg, G, c;
    __device__ void init(int M, int N, int G_, int c_) { nM = M / BM; nN = N / BM; nwg = nM * nN; G = G_; c = c_; }
    __device__ bool next(int i, Unit& u) const {
        const long L = (long)i * G + c; if (L >= nwg) return false;
        int wgid = (int)L; { const int q = nwg / 8, r = nwg % 8, xcd = wgid % 8, off = wgid / 8; wgid = (xcd < r ? xcd * (q + 1) : r * (q + 1) + (xcd - r) * q) + off; }
        const int nig = 8 * nN, gid = wgid / nig, fm = gid * 8, gsz = (nM - fm) < 8 ? (nM - fm) : 8;
        u.pm = fm + ((wgid % nig) % gsz); u.pn = (wgid % nig) / gsz; u.e = 0; u.row0 = 0; u.cnt = 0; u.chunk = 0; return true;
    }
    __device__ __forceinline__ unsigned a_base(const Gemm& g, const Unit& u) const { return (unsigned)u.pm * (unsigned)(BM * 2) * (unsigned)g.lda; }
    __device__ __forceinline__ unsigned b_base(const Gemm& g, const Unit& u) const { return (unsigned)u.pn * (unsigned)(BM * 2) * (unsigned)g.ldb; }
    __device__ __forceinline__ unsigned row_off(const Gemm& g, const Unit& u, int lr) const { return (unsigned)lr * (unsigned)g.lda * 2u; }
};

template <bool GATHER_> struct MoeOrder {
    static constexpr bool GATHER = GATHER_;
    const LAS int* tab; const int* list; int ncol, G, c, c0, c1, nb_rows, skip_shared;
    __device__ bool next(int i, Unit& u) const {
        const int t0 = __builtin_amdgcn_readfirstlane(tab[2048 + c0]); int ntile = __builtin_amdgcn_readfirstlane(tab[2048 + c1]) - t0; if (skip_shared) ntile = __builtin_amdgcn_readfirstlane(tab[512 * c0 + NEXP]); int ti, pn;
        if (G == 256) { const int x = c & 7, slot = c >> 3, rt = 32 / ncol; ti = i * 8 * rt + x * rt + slot / ncol; pn = slot % ncol; if (ti >= ntile) return false; }
        else { const int L = i * G + c; if (L >= ntile * ncol) return false; ti = L / ncol; pn = L % ncol; }
        const int tg = t0 + ti; int k = c0; while (k + 1 < c1 && __builtin_amdgcn_readfirstlane(tab[2048 + k + 1]) <= tg) ++k;
        const int tl = tg - __builtin_amdgcn_readfirstlane(tab[2048 + k]); const LAS int* tk = tab + 512 * k;
        const int e = __builtin_amdgcn_readfirstlane(tk[144 + tl]);
        u.pm = tg; u.pn = pn; u.e = e; u.chunk = k; u.row0 = __builtin_amdgcn_readfirstlane((tl - tk[e]) * BM); u.cnt = __builtin_amdgcn_readfirstlane(tk[72 + e]);
        if (!GATHER) { int pc = 0; for (int kk = 0; kk < k; ++kk) pc += __builtin_amdgcn_readfirstlane(tab[512 * kk + 72 + e]);
            u.arow = __builtin_amdgcn_readfirstlane(tab[GT_INT + e]) * BM + pc + u.row0; }
        return true;
    }
    __device__ __forceinline__ unsigned a_base(const Gemm& g, const Unit& u) const { return GATHER ? 0u : (unsigned)u.arow * 2u * (unsigned)g.lda; }
    __device__ __forceinline__ unsigned b_base(const Gemm& g, const Unit& u) const { return ((unsigned)u.e * (unsigned)nb_rows + (unsigned)u.pn * BM) * (unsigned)g.ldb * 2u; }
    __device__ __forceinline__ int row_ent(const Gemm& g, const Unit& u, int lr) const { return 0; }
    __device__ __forceinline__ void prefetch_rows(const Gemm&, const Unit&, int, LAS unsigned char*) const {}
    __device__ __forceinline__ int row_ent_lds(LAS unsigned char*, int) const { return 0; }
    __device__ __forceinline__ unsigned row_fin(const Gemm& g, const Unit& u, int lr, int) const { return row_off(g, u, lr); }
    __device__ __forceinline__ unsigned row_off(const Gemm& g, const Unit& u, int lr) const {
        if (!GATHER) return (unsigned)lr * (unsigned)g.lda * 2u;
        const int pos = u.row0 + lr; int tl = 0;
        if (pos < u.cnt) tl = u.e == NEXP ? pos : (list[((size_t)u.chunk * NE1 + u.e) * CH_TOK + pos] >> 3);
        const unsigned tok = (unsigned)u.chunk * CH_TOK + (unsigned)tl;
        return tok * (unsigned)g.lda * 2u;
    }
};

struct MoeOrderG1 {
    static constexpr bool GATHER = true;
    const LAS int* tab; const int* list; int G, c, nb_rows;
    __device__ bool next(int i, Unit& u) const {
        static_assert(NCHUNK == 4, "chunk boundaries b1..b3");
        const int ntile = __builtin_amdgcn_readfirstlane(tab[GT_INT + NE1]); constexpr int ncol = 4, rt = 32 / ncol; int ti, pn;
        if (G == 256) { const int x = c & 7, slot = c >> 3; ti = i * 8 * rt + x * rt + slot / ncol; pn = slot % ncol; if (ti >= ntile) return false; }
        else { const int L = i * G + c; if (L >= ntile * ncol) return false; ti = L / ncol; pn = L % ncol; }
        const int e = __builtin_amdgcn_readfirstlane((int)((const LAS unsigned char*)tab)[GM_BYTE + ti]);
        const int n0 = __builtin_amdgcn_readfirstlane(tab[72 + e]), n1 = __builtin_amdgcn_readfirstlane(tab[512 + 72 + e]), n2 = __builtin_amdgcn_readfirstlane(tab[1024 + 72 + e]), n3 = __builtin_amdgcn_readfirstlane(tab[1536 + 72 + e]);
        u.pm = ti; u.pn = pn; u.e = e; u.chunk = 0; u.row0 = (ti - __builtin_amdgcn_readfirstlane(tab[GT_INT + e])) * BM; u.b1 = n0; u.b2 = n0 + n1; u.b3 = n0 + n1 + n2; u.cnt = n0 + n1 + n2 + n3; u.arow = 0; return true;
    }
    __device__ __forceinline__ unsigned a_base(const Gemm& g, const Unit& u) const { return 0u; }
    __device__ __forceinline__ unsigned b_base(const Gemm& g, const Unit& u) const { return ((unsigned)u.e * (unsigned)nb_rows + (unsigned)u.pn * BM) * (unsigned)g.ldb * 2u; }
    __device__ __forceinline__ unsigned row_off(const Gemm& g, const Unit& u, int lr) const {
        return row_fin(g, u, lr, row_ent(g, u, lr));
    }
    __device__ __forceinline__ int row_ent(const Gemm& g, const Unit& u, int lr) const {
        const int pos = u.row0 + lr; const bool valid = pos < u.cnt;
        const int k = (pos >= u.b1) + (pos >= u.b2) + (pos >= u.b3); int base = pos >= u.b1 ? u.b1 : 0; base = pos >= u.b2 ? u.b2 : base; base = pos >= u.b3 ? u.b3 : base;
        const int idx = (valid && u.e != NEXP) ? (k * NE1 + u.e) * CH_TOK + (pos - base) : 0;
        return list[idx];
    }
    static constexpr int LDS_GL = STAGE_BYTES + 8448;
    __device__ __forceinline__ void prefetch_rows(const Gemm& g, const Unit& u, int wid, LAS unsigned char* lds) const {
        if (wid < 4) { int l_ = threadIdx.x; asm volatile("" : "+v"(l_)); const int lr = wid * 64 + (l_ & 63);
            const int pos = u.row0 + lr; const bool valid = pos < u.cnt;
            const int k = (pos >= u.b1) + (pos >= u.b2) + (pos >= u.b3); int base = pos >= u.b1 ? u.b1 : 0; base = pos >= u.b2 ? u.b2 : base; base = pos >= u.b3 ? u.b3 : base;
            const int idx = (valid && u.e != NEXP) ? (k * NE1 + u.e) * CH_TOK + (pos - base) : 0;
            const int* gp = list + idx; const unsigned ldsa = (unsigned)(size_t)(lds + LDS_GL + wid * 256);
            asm volatile("s_mov_b32 m0, %0\n\ts_nop 0\n\tglobal_load_lds_dword %1, off" :: "s"(ldsa), "v"(gp) : "memory", "m0"); } }
    __device__ __forceinline__ int row_ent_lds(LAS unsigned char* lds, int lr) const { return *(const LAS int*)(lds + LDS_GL + lr * 4); }
    __device__ __forceinline__ unsigned row_fin(const Gemm& g, const Unit& u, int lr, int ent) const {
        const int pos = u.row0 + lr; const bool valid = pos < u.cnt;
        const int k = (pos >= u.b1) + (pos >= u.b2) + (pos >= u.b3); int base = pos >= u.b1 ? u.b1 : 0; base = pos >= u.b2 ? u.b2 : base; base = pos >= u.b3 ? u.b3 : base;
        const int tl = u.e == NEXP ? pos - base : (ent >> 3);
        const unsigned tok = valid ? (unsigned)k * CH_TOK + (unsigned)tl : 0u;
        return tok * (unsigned)g.lda * 2u;
    }
};

template <class...> using void_t_ = void;
template <class E, class = void> struct EpiScale { static constexpr int A = 0x7f7f7f7f, B = 0x7f7f7f7f; };
template <class E> struct EpiScale<E, void_t_<decltype(E::SCALE_A)>> { static constexpr int A = E::SCALE_A, B = E::SCALE_B; };
template <class Epi, class Sched>
__device__ __forceinline__ void gemm_phase(LAS unsigned char* lds, const Gemm g, const Sched& S, const Epi& E) {
    int tid_ = threadIdx.x; asm volatile("" : "+v"(tid_));
    const int tid = tid_, wid = __builtin_amdgcn_readfirstlane(tid >> 6), lane = tid & 63, wr = wid >> 2, wc = wid & 3, fr = lane & 15, fq = lane >> 4;
    int K_ = g.K; asm volatile("" : "+s"(K_));
    const int K = K_, nt = K / BK;
    int Rr[2]; unsigned cA2[2], voffB[2];
#pragma unroll
    for (int i = 0; i < 2; ++i) { int R, C; stage_rc(tid * 16 + i * 8192, R, C); const int Rb = Epi::PERM == 2 ? (64 * (R >> 5) + 16 * ((R >> 2) & 3) + 4 * ((R >> 4) & 1) + (R & 3)) : Epi::PERM == 1 ? ((R & ~31) + perm32(R & 31)) : R;
        Rr[i] = R; cA2[i] = (unsigned)C * 2u; voffB[i] = (unsigned)(Rb * g.ldb + C) * 2u; }
    const unsigned kstep = (unsigned)(BK * 2);
    const unsigned hstepB = (unsigned)(Epi::PERM == 2 ? 8 : HALF) * (unsigned)g.ldb * 2u;
    const char* const Ab = (const char*)g.A; const char* const Bb = (const char*)g.Bt;
    const unsigned ldsw = (unsigned)wid * 1024u;
    const int aoff = lds_byte(wr * 64 + fr, fq * 8), boff = lds_byte(wc * 32 + fr, fq * 8);
#define PG8_SA(b, h) (((b) * 2 + (h)) * HTB)
#define PG8_SB(b, h) ((4 + (b) * 2 + (h)) * HTB)
#define PG8_STAGE_B(bufoff, gbase, h) do { _Pragma("unroll") for (int _i = 0; _i < 2; ++_i) \
        __builtin_amdgcn_global_load_lds((const unsigned*)(Bb + (size_t)((gbase) + (unsigned)(h) * hstepB + voffB[_i])), (LAS unsigned*)(lds + (bufoff) + ldsw + _i * 8192), 16, 0, 0); } while (0)
#define PG8_STAGE_A(bufoff, gbase, V, h) do { _Pragma("unroll") for (int _i = 0; _i < 2; ++_i) \
        __builtin_amdgcn_global_load_lds((const unsigned*)(Ab + (size_t)((gbase) + (V)[h][_i])), (LAS unsigned*)(lds + (bufoff) + ldsw + _i * 8192), 16, 0, 0); } while (0)
#define PG8_LDA(dst, b, h) do { _Pragma("unroll") for (int m = 0; m < 4; ++m) _Pragma("unroll") for (int k = 0; k < 2; ++k) dst[m][k] = *(const LAS bf16x8*)(lds + PG8_SA(b, h) + aoff + m * 2048 + k * 1024); } while (0)
#define PG8_LDB(dst, b, h) do { _Pragma("unroll") for (int n = 0; n < 2; ++n) _Pragma("unroll") for (int k = 0; k < 2; ++k) dst[n][k] = *(const LAS bf16x8*)(lds + PG8_SB(b, h) + boff + n * 2048 + k * 1024); } while (0)
#define PG8_MMA(ai, bj, At, Bt) do { __builtin_amdgcn_s_setprio(1); _Pragma("unroll") for (int m = 0; m < 4; ++m) _Pragma("unroll") for (int n = 0; n < 2; ++n) { \
        if constexpr (Epi::FP8) { i32x8 bv_, av_; { const u32x4 b0_ = *(const u32x4*)&Bt[n][0], b1_ = *(const u32x4*)&Bt[n][1], a0_ = *(const u32x4*)&At[m][0], a1_ = *(const u32x4*)&At[m][1]; \
                bv_ = (i32x8){(int)b0_[0], (int)b0_[1], (int)b0_[2], (int)b0_[3], (int)b1_[0], (int)b1_[1], (int)b1_[2], (int)b1_[3]}; av_ = (i32x8){(int)a0_[0], (int)a0_[1], (int)a0_[2], (int)a0_[3], (int)a1_[0], (int)a1_[1], (int)a1_[2], (int)a1_[3]}; } \
            acc[ai][bj][m][n] = __builtin_amdgcn_mfma_scale_f32_16x16x128_f8f6f4(bv_, av_, acc[ai][bj][m][n], 0, 0, 0, EpiScale<Epi>::A, 0, EpiScale<Epi>::B); } \
        else { _Pragma("unroll") for (int k = 0; k < 2; ++k) acc[ai][bj][m][n] = __builtin_amdgcn_mfma_f32_16x16x32_bf16(Bt[n][k], At[m][k], acc[ai][bj][m][n], 0, 0, 0); } } \
        __builtin_amdgcn_s_setprio(0); } while (0)
#define PG8_WAIT_V(n) asm volatile("s_waitcnt vmcnt(" #n ")" ::: "memory")
#define PG8_WAIT_L(n) asm volatile("s_waitcnt lgkmcnt(" #n ")" ::: "memory")
#define PG8_BAR __builtin_amdgcn_s_barrier()
#define PG8_SCHED __builtin_amdgcn_sched_barrier(0)
#define PG8_ROWS(V, u, FROM_LDS) do { if constexpr (Sched::GATHER) { int ent_[2][2]; \
            _Pragma("unroll") for (int _h = 0; _h < 2; ++_h) _Pragma("unroll") for (int _i = 0; _i < 2; ++_i) ent_[_h][_i] = (FROM_LDS) ? S.row_ent_lds(lds, _h * HALF + Rr[_i]) : S.row_ent(g, (u), _h * HALF + Rr[_i]); \
            asm volatile("" : "+v"(ent_[0][0]), "+v"(ent_[0][1]), "+v"(ent_[1][0]), "+v"(ent_[1][1]));        \
            _Pragma("unroll") for (int _h = 0; _h < 2; ++_h) _Pragma("unroll") for (int _i = 0; _i < 2; ++_i) (V)[_h][_i] = S.row_fin(g, (u), _h * HALF + Rr[_i], ent_[_h][_i]) + cA2[_i]; } \
        else { _Pragma("unroll") for (int _h = 0; _h < 2; ++_h) _Pragma("unroll") for (int _i = 0; _i < 2; ++_i) (V)[_h][_i] = S.row_off(g, (u), _h * HALF + Rr[_i]) + cA2[_i]; } } while (0)
    Unit cur, nxt; int ui = 0;
    if (!S.next(0, cur)) return;
    f32x4 acc[2][2][4][2];
    bf16x8 At[4][2], B0[2][2], B1[2][2];
    unsigned vA[2][2];
    PG8_ROWS(vA, cur, 0);
    unsigned cA = S.a_base(g, cur), cB = S.b_base(g, cur);
    PG8_STAGE_B(PG8_SB(0, 0), cB, 0); PG8_STAGE_A(PG8_SA(0, 0), cA, vA, 0); PG8_STAGE_B(PG8_SB(0, 1), cB, 1); PG8_STAGE_A(PG8_SA(0, 1), cA, vA, 1);
    if (wr == 1) PG8_BAR;
    PG8_WAIT_V(4); PG8_BAR;
    PG8_STAGE_B(PG8_SB(1, 0), cB + kstep, 0); PG8_STAGE_A(PG8_SA(1, 0), cA + kstep, vA, 0); PG8_STAGE_B(PG8_SB(1, 1), cB + kstep, 1);
    PG8_WAIT_V(6); PG8_BAR;
#pragma unroll
    for (int a = 0; a < 2; ++a)
#pragma unroll
        for (int b = 0; b < 2; ++b)
#pragma unroll
            for (int m = 0; m < 4; ++m)
#pragma unroll
                for (int n = 0; n < 2; ++n) acc[a][b][m][n] = (f32x4){0.f, 0.f, 0.f, 0.f};
    for (;;) {
        const bool has_next = S.next(ui + 1, nxt);
        const unsigned nA = has_next ? S.a_base(g, nxt) : cA, nB = has_next ? S.b_base(g, nxt) : cB;
#pragma nounroll
        for (int t = 0; t < nt; t += 2) {
            const bool last = (t == nt - 2);
            if constexpr (Epi::PREFETCH) { if (last) E.prefetch(cur, wid, lds); }
            if constexpr (Sched::GATHER) { if (t == 0 && has_next) S.prefetch_rows(g, nxt, wid, lds); }
            asm volatile("" : "+v"(vA[0][0]), "+v"(vA[0][1]), "+v"(vA[1][0]), "+v"(vA[1][1]), "+v"(voffB[0]), "+v"(voffB[1]));
            const unsigned a1 = cA + (unsigned)(t + 1) * kstep;
            const unsigned a2 = last ? nA : cA + (unsigned)(t + 2) * kstep, b2 = last ? nB : cB + (unsigned)(t + 2) * kstep;
            const unsigned a3 = a2 + kstep, b3 = b2 + kstep;
            PG8_LDB(B0, 0, 0); PG8_SCHED; PG8_LDA(At, 0, 0); PG8_STAGE_A(PG8_SA(1, 1), a1, vA, 1);
            if (Sched::GATHER) { if (last && has_next) PG8_ROWS(vA, nxt, 1); }
            PG8_WAIT_L(8); PG8_BAR; PG8_WAIT_L(0); PG8_MMA(0, 0, At, B0); PG8_BAR; PG8_SCHED;
            PG8_LDB(B1, 0, 1); PG8_STAGE_B(PG8_SB(0, 0), b2, 0);
            PG8_BAR; PG8_WAIT_L(0); PG8_MMA(0, 1, At, B1); PG8_BAR;
            PG8_LDA(At, 0, 1); PG8_STAGE_A(PG8_SA(0, 0), a2, vA, 0);
            PG8_BAR; PG8_WAIT_L(0); PG8_MMA(1, 0, At, B0); PG8_BAR; PG8_SCHED;
            PG8_STAGE_B(PG8_SB(0, 1), b2, 1);
            PG8_WAIT_V(6); PG8_BAR; PG8_MMA(1, 1, At, B1); PG8_BAR;
            PG8_LDB(B0, 1, 0); PG8_SCHED; PG8_LDA(At, 1, 0); PG8_STAGE_A(PG8_SA(0, 1), a2, vA, 1);
            PG8_WAIT_L(8); PG8_BAR; PG8_WAIT_L(0); PG8_MMA(0, 0, At, B0); PG8_BAR; PG8_SCHED;
            PG8_LDB(B1, 1, 1); PG8_STAGE_B(PG8_SB(1, 0), b3, 0);
            PG8_BAR; PG8_WAIT_L(0); PG8_MMA(0, 1, At, B1); PG8_BAR;
            PG8_LDA(At, 1, 1); PG8_STAGE_A(PG8_SA(1, 0), a3, vA, 0);
            PG8_BAR; PG8_WAIT_L(0); PG8_MMA(1, 0, At, B0); PG8_BAR; PG8_SCHED;
            PG8_STAGE_B(PG8_SB(1, 1), b3, 1);
            PG8_WAIT_V(6); PG8_BAR; PG8_MMA(1, 1, At, B1); PG8_BAR;
        }
        { int z_ = 0; asm volatile("" : "+v"(z_));
          if (PROBE_NOSTORE && g.noepi) { asm volatile("" :: "v"(acc[0][0][0][0]), "v"(acc[1][1][3][1]), "v"(acc[0][1][2][1]), "v"(acc[1][0][1][0])); }
          else if constexpr (Epi::PREFETCH) E.epi(acc, cur, wr, wc, fr + z_, fq + z_, lds); else E(acc, cur, wr, wc, fr + z_, fq + z_); }
        if (!has_next) break;
#pragma unroll
        for (int a = 0; a < 2; ++a)
#pragma unroll
            for (int b = 0; b < 2; ++b)
#pragma unroll
                for (int m = 0; m < 4; ++m)
#pragma unroll
                    for (int n = 0; n < 2; ++n) acc[a][b][m][n] = (f32x4){0.f, 0.f, 0.f, 0.f};
        cur = nxt; cA = nA; cB = nB; ++ui;
    }
    PG8_WAIT_V(0);
    if (wr == 0) PG8_BAR;
    PG8_BAR;
#undef PG8_SA
#undef PG8_SB
#undef PG8_STAGE_A
#undef PG8_STAGE_B
#undef PG8_LDA
#undef PG8_LDB
#undef PG8_MMA
#undef PG8_WAIT_V
#undef PG8_WAIT_L
#undef PG8_BAR
#undef PG8_SCHED
#undef PG8_ROWS
}
}
using pg8::Unit;
constexpr int LDS_STAGE_BYTES = pg8::STAGE_BYTES;
typedef f32x4 AccT[2][2][4][2];

struct EpiProj {
    static constexpr int PERM = 1; static constexpr bool FP8 = true, PREFETCH = false;
    static constexpr int SCALE_A = 0x7b7b7b7b, SCALE_B = 0x79797979;
    bf16_t* Z; float* ssqp;
    __device__ __forceinline__ void operator()(const AccT& acc, const Unit& u, int wr, int wc, int fr, int fq) const {
        const int row0 = u.pm * 256 + wr * 64 + fr, col0 = u.pn * 256 + wc * 32 + 8 * fq;
        const bool st = u.pn <= 2; const int slot = u.pn * 4 + wc;
#pragma unroll
        for (int ai = 0; ai < 2; ++ai)
#pragma unroll
            for (int m = 0; m < 4; ++m) { const int row = row0 + ai * 128 + m * 16; bf16_t* rp = Z + (size_t)row * ZW + col0;
#pragma unroll
                for (int bj = 0; bj < 2; ++bj) *(u32x4*)(rp + bj * 128) = pack8(acc[ai][bj][m][0], acc[ai][bj][m][1]); }
        if (st) { float sv[8];
#pragma unroll
            for (int ai = 0; ai < 2; ++ai)
#pragma unroll
                for (int m = 0; m < 4; ++m) { float s = 0.f;
#pragma unroll
                    for (int bj = 0; bj < 2; ++bj) { const f32x4 v0 = acc[ai][bj][m][0], v1 = acc[ai][bj][m][1];
                        s += v0[0] * v0[0] + v0[1] * v0[1] + v0[2] * v0[2] + v0[3] * v0[3] + v1[0] * v1[0] + v1[1] * v1[1] + v1[2] * v1[2] + v1[3] * v1[3]; }
                    sv[ai * 4 + m] = s; }
            float o0, o1; reduce8_fq(sv, o0, o1);
            const int r0 = 2 * fq, r1 = 2 * fq + 1;
            ssqp[(size_t)(row0 + (r0 >> 2) * 128 + (r0 & 3) * 16) * 12 + slot] = o0; ssqp[(size_t)(row0 + (r1 >> 2) * 128 + (r1 & 3) * 16) * 12 + slot] = o1; }
    }
};
struct EpiQup {
    static constexpr int PERM = 1; static constexpr bool FP8 = false, PREFETCH = false;
    bf16_t* Q; const float* ssqp;
    __device__ __forceinline__ void operator()(const AccT& acc, const Unit& u, int wr, int wc, int fr, int fq) const {
        const int row0 = u.pm * 256 + wr * 64 + fr, col0 = u.pn * 256 + wc * 32 + 8 * fq;
        float scv[2][4];
#pragma unroll
        for (int ai = 0; ai < 2; ++ai)
#pragma unroll
            for (int m = 0; m < 4; ++m) { const int row = row0 + ai * 128 + m * 16; const f32x4 p0 = *(const f32x4*)(ssqp + (size_t)row * 12), p1 = *(const f32x4*)(ssqp + (size_t)row * 12 + 4); scv[ai][m] = rsqrtf((((p0[0] + p0[1]) + (p0[2] + p0[3])) + ((p1[0] + p1[1]) + (p1[2] + p1[3]))) * (1.0f / 512.0f) + RMS_EPS); }
#pragma unroll
        for (int ai = 0; ai < 2; ++ai)
#pragma unroll
            for (int m = 0; m < 4; ++m) { const int row = row0 + ai * 128 + m * 16; const float sc = scv[ai][m]; bf16_t* rp = Q + (size_t)row * QW + col0;
#pragma unroll
                for (int bj = 0; bj < 2; ++bj) *(u32x4*)(rp + bj * 128) = pack8(acc[ai][bj][m][0] * sc, acc[ai][bj][m][1] * sc); }
    }
};
struct EpiKV {
    static constexpr int PERM = 1; static constexpr bool FP8 = false, PREFETCH = false;
    bf16_t* Kb; bf16_t* Vb; const float* ssqp;
    __device__ __forceinline__ void operator()(const AccT& acc, const Unit& u, int wr, int wc, int fr, int fq) const {
        const int row0 = u.pm * 256 + wr * 64 + fr, c0 = wc * 32 + 8 * fq;
        float scv[2][4];
#pragma unroll
        for (int ai = 0; ai < 2; ++ai)
#pragma unroll
            for (int m = 0; m < 4; ++m) { const int row = row0 + ai * 128 + m * 16; const f32x4 p2 = *(const f32x4*)(ssqp + (size_t)row * 12 + 8); scv[ai][m] = rsqrtf(((p2[0] + p2[1]) + (p2[2] + p2[3])) * (1.0f / 256.0f) + RMS_EPS); }
#pragma unroll
        for (int ai = 0; ai < 2; ++ai)
#pragma unroll
            for (int m = 0; m < 4; ++m) { const int row = row0 + ai * 128 + m * 16; const float sc = scv[ai][m];
                *(u32x4*)(Kb + (size_t)row * QW + u.pn * 192 + c0) = pack8(acc[ai][0][m][0] * sc, acc[ai][0][m][1] * sc);
                *(u32x4*)(Vb + (size_t)row * 1024 + u.pn * 128 + c0) = pack8(acc[ai][1][m][0] * sc, acc[ai][1][m][1] * sc); }
    }
};
struct EpiPlain {
    static constexpr int PERM = 1; static constexpr bool FP8 = false, PREFETCH = false;
    bf16_t* O; int ld;
    __device__ __forceinline__ void operator()(const AccT& acc, const Unit& u, int wr, int wc, int fr, int fq) const {
        const int row0 = u.pm * 256 + wr * 64 + fr, col0 = u.pn * 256 + wc * 32 + 8 * fq;
#pragma unroll
        for (int ai = 0; ai < 2; ++ai)
#pragma unroll
            for (int m = 0; m < 4; ++m) { bf16_t* rp = O + (size_t)(row0 + ai * 128 + m * 16) * ld + col0;
#pragma unroll
                for (int bj = 0; bj < 2; ++bj) *(u32x4*)(rp + bj * 128) = pack8(acc[ai][bj][m][0], acc[ai][bj][m][1]); }
    }
};
struct EpiWout {
    static constexpr int PERM = 0; static constexpr bool FP8 = true, PREFETCH = false;
    static constexpr int SCALE_A = 0x7b7b7b7b, SCALE_B = 0x79797979;
    const float* X; float* H;
    __device__ __forceinline__ void operator()(const AccT& acc, const Unit& u, int wr, int wc, int fr, int fq) const {
        const int row0 = u.pm * 256 + wr * 64 + fr, col0 = u.pn * 256 + wc * 32 + 4 * fq;
#pragma unroll
        for (int ai = 0; ai < 2; ++ai) { f32x4 xv[4][2][2];
#pragma unroll
            for (int m = 0; m < 4; ++m)
#pragma unroll
                for (int bj = 0; bj < 2; ++bj)
#pragma unroll
                    for (int n = 0; n < 2; ++n) xv[m][bj][n] = *(const f32x4*)(X + (size_t)(row0 + ai * 128 + m * 16) * DM + col0 + bj * 128 + n * 16);
#pragma unroll
            for (int m = 0; m < 4; ++m)
#pragma unroll
                for (int bj = 0; bj < 2; ++bj)
#pragma unroll
                    for (int n = 0; n < 2; ++n) *(f32x4*)(H + (size_t)(row0 + ai * 128 + m * 16) * DM + col0 + bj * 128 + n * 16) = xv[m][bj][n] + acc[ai][bj][m][n]; }
    }
};
struct EpiMoe1 {
    static constexpr int PERM = 1; static constexpr bool FP8 = true, PREFETCH = false;
    unsigned char* Hmid;
    __device__ __forceinline__ void operator()(const AccT& acc, const Unit& u, int wr, int wc, int fr, int fq) const {
        const int row0 = u.pm * 256 + wr * 64 + fr, c0 = u.pn * 128 + wc * 32 + 8 * fq; constexpr float SC = 1.0f / 1024.0f;
#pragma unroll
        for (int ai = 0; ai < 2; ++ai)
#pragma unroll
            for (int m = 0; m < 4; ++m) { float h0[4], h1[4];
#pragma unroll
                for (int j = 0; j < 4; ++j) { const float a0 = acc[ai][0][m][0][j], a1 = acc[ai][0][m][1][j];
                    h0[j] = a0 * acc[ai][1][m][0][j] * (SC * SC * 4.0f) * __builtin_amdgcn_rcpf(1.0f + __builtin_amdgcn_exp2f(a0 * (-SC * 1.44269504f)));
                    h1[j] = a1 * acc[ai][1][m][1][j] * (SC * SC * 4.0f) * __builtin_amdgcn_rcpf(1.0f + __builtin_amdgcn_exp2f(a1 * (-SC * 1.44269504f))); }
                u32x2 w; w.x = pk_fp8x4(h0[0], h0[1], h0[2], h0[3]); w.y = pk_fp8x4(h1[0], h1[1], h1[2], h1[3]);
                *(u32x2*)(Hmid + (size_t)(row0 + ai * 128 + m * 16) * 512 + c0) = w; }
    }
};
struct EpiMoe2 {
    static constexpr int PERM = 2; static constexpr bool FP8 = true, PREFETCH = true;
    static constexpr int LDS_RI = LDS_STAGE_BYTES + 8448;
    unsigned char* Y; const i32x2* rinfo; float* H; int chunk, nostore;
    __device__ __forceinline__ void prefetch(const Unit& u, int wid, LAS unsigned char* lds) const {
        if (wid < 2) { int l_ = threadIdx.x; asm volatile("" : "+v"(l_));
            const unsigned ldsa = (unsigned)(size_t)(lds + LDS_RI + wid * 1024); const i32x2* gb = rinfo + (size_t)u.pm * 256 + wid * 128; const unsigned vo = (unsigned)(l_ & 63) * 16u;
            asm volatile("s_mov_b32 m0, %0\n\ts_nop 0\n\tglobal_load_lds_dwordx4 %1, %2" :: "s"(ldsa), "v"(vo), "s"(gb) : "memory", "m0"); } }
    __device__ __forceinline__ void epi(const AccT& acc, const Unit& u, int wr, int wc, int fr, int fq, LAS unsigned char* lds) const {
        const int lr0 = wr * 64 + fr, col0 = u.pn * 256 + wc * 64 + 16 * fq; const LAS i32x2* rp0 = (const LAS i32x2*)(lds + LDS_RI) + lr0;
        unsigned char* Yl = Y; asm volatile("" : "+s"(Yl));
        {
#pragma unroll
            for (int ai = 0; ai < 2; ++ai)
#pragma unroll
                for (int m = 0; m < 4; ++m) { const i32x2 ri = rp0[ai * 128 + m * 16]; const float w = __int_as_float(ri.y) * 16.0f; unsigned char* rp = Yl + (size_t)ri.x * DM + col0;
                    u32x4 w8;
#pragma unroll
                    for (int bj = 0; bj < 2; ++bj) { const f32x4 y0 = acc[ai][bj][m][0] * w, y1 = acc[ai][bj][m][1] * w;
                        w8[2 * bj] = __builtin_amdgcn_cvt_pk_fp8_f32(y0[2], y0[3], __builtin_amdgcn_cvt_pk_fp8_f32(y0[0], y0[1], 0, false), true);
                        w8[2 * bj + 1] = __builtin_amdgcn_cvt_pk_fp8_f32(y1[2], y1[3], __builtin_amdgcn_cvt_pk_fp8_f32(y1[0], y1[1], 0, false), true); }
                    if (nostore && PROBE_NOSTORE) asm volatile("" :: "v"(w8)); else *(u32x4*)rp = w8; }
        }
    }
};
struct EpiGate {
    static constexpr int PERM = 1; static constexpr bool FP8 = true, PREFETCH = false;
    const bf16_t* PP; const float* bias; bf16_t* U; float* ssq_u; int noepi;
    __device__ __forceinline__ void operator()(const AccT& acc, const Unit& u, int wr, int wc, int fr, int fq) const {
        if (noepi && PROBE_NOSTORE) { asm volatile("" :: "v"(acc[0][0][0][0][0]), "v"(acc[1][1][3][1][3])); return; }
        const int row0 = u.pm * 256 + wr * 64 + fr, col0 = u.pn * 256 + wc * 32 + 8 * fq;
        float ssr[2][4];
#pragma unroll
        for (int ai = 0; ai < 2; ++ai)
#pragma unroll
            for (int m = 0; m < 4; ++m) ssr[ai][m] = 0.f;
        u32x4 ppr[2][2][4];
        f32x4 bb[2][2];
#pragma unroll
        for (int bj = 0; bj < 2; ++bj) { bb[bj][0] = *(const f32x4*)(bias + col0 + bj * 128); bb[bj][1] = *(const f32x4*)(bias + col0 + bj * 128 + 4); }
#pragma unroll
        for (int bj = 0; bj < 2; ++bj) { const f32x4 b0 = bb[bj][0], b1 = bb[bj][1];
#pragma unroll
            for (int ai = 0; ai < 2; ++ai)
#pragma unroll
                for (int m = 0; m < 4; ++m) ppr[bj][ai][m] = *(const u32x4*)(PP + (size_t)(row0 + ai * 128 + m * 16) * DM + col0 + bj * 128);
#pragma unroll
            for (int ai = 0; ai < 2; ++ai)
#pragma unroll
                for (int m = 0; m < 4; ++m) { const size_t off = (size_t)(row0 + ai * 128 + m * 16) * DM + col0 + bj * 128; float pp[8]; unpack8(ppr[bj][ai][m], pp);
                    const f32x4 a0 = acc[ai][bj][m][0] * (1.0f / 1024.0f) + b0, a1 = acc[ai][bj][m][1] * (1.0f / 1024.0f) + b1; float uu[8]; float s = 0.f;
#pragma unroll
                    for (int e = 0; e < 4; ++e) { uu[e] = pp[e] * sigmoidf_(a0[e]); uu[4 + e] = pp[4 + e] * sigmoidf_(a1[e]); }
#pragma unroll
                    for (int e = 0; e < 8; ++e) s += uu[e] * uu[e];
                    *(u32x4*)(U + off) = packf8(uu); ssr[ai][m] += s; } }
        { float sv[8];
#pragma unroll
          for (int r = 0; r < 8; ++r) sv[r] = ssr[r >> 2][r & 3];
          float o0, o1; reduce8_fq(sv, o0, o1); const int r0 = 2 * fq, r1 = 2 * fq + 1;
          ssq_u[(size_t)(row0 + (r0 >> 2) * 128 + (r0 & 3) * 16) * 32 + u.pn * 4 + wc] = o0; ssq_u[(size_t)(row0 + (r1 >> 2) * 128 + (r1 & 3) * 16) * 32 + u.pn * 4 + wc] = o1; }
    }
};

#define XB_TMO      128
#define XB_XCNT(j)  (256  + 64 * (j))
#define XB_XSUB(j)  (1280 + 64 * (j))
#define XB_XGEN(j)  (2304 + 64 * (j))
#define XB_TOP      3328
#define XB_TOPGEN   3392
#define XCD_BAR_WORDS 3456
#define XB_SPIN_CAP (1u << 22)
__device__ __forceinline__ unsigned xb_ld(unsigned* p)              { return __hip_atomic_load(p, __ATOMIC_RELAXED, __HIP_MEMORY_SCOPE_AGENT); }
__device__ __forceinline__ unsigned xb_add(unsigned* p, unsigned v) { return __hip_atomic_fetch_add(p, v, __ATOMIC_RELAXED, __HIP_MEMORY_SCOPE_AGENT); }
__device__ __forceinline__ unsigned xb_xcc_id() { return (unsigned)__builtin_amdgcn_s_getreg((3 << 11) | 20) & 0xFu; }
#define XB_SPIN(cond, bar) do { unsigned _sp = 0; while (cond) { __builtin_amdgcn_s_sleep(1); \
    if ((++_sp & 255u) == 0u) { if (xb_ld(&(bar)[XB_TMO])) break; if (_sp > XB_SPIN_CAP) { atomicAdd(&(bar)[XB_TMO], 1u); break; } } } } while (0)
struct XcdBarrier { unsigned* bar; unsigned x; volatile LAS unsigned* st; };
__device__ __forceinline__ XcdBarrier xcd_barrier_post(unsigned* bar, volatile LAS unsigned* st) {
    XcdBarrier b; b.bar = bar; b.x = xb_xcc_id(); b.st = st;
    if (threadIdx.x == 0) (void)xb_add(&bar[XB_XCNT(b.x)], 1u);
    return b;
}
__device__ __forceinline__ void xcd_barrier_complete(unsigned* bar, unsigned x, unsigned& nloc, unsigned& nx) {
    const unsigned G = gridDim.x * gridDim.y * gridDim.z;
    unsigned sum, cnt, mine, sp = 0u;
    for (;;) {
        sum = 0u; cnt = 0u; mine = 0u;
#pragma unroll
        for (unsigned j = 0; j < 16; ++j) { const unsigned c = xb_ld(&bar[XB_XCNT(j)]); sum += c; cnt += (c > 0u) ? 1u : 0u; mine = (j == x) ? c : mine; }
        if (sum == G) break;
        __builtin_amdgcn_s_sleep(1);
        if ((++sp & 255u) == 0u) { if (xb_ld(&bar[XB_TMO])) break; if (sp > XB_SPIN_CAP) { atomicAdd(&bar[XB_TMO], 1u); break; } }
    }
    nloc = mine > 0u ? mine : 1u; nx = cnt > 0u ? cnt : 1u;
}
__device__ __forceinline__ void xcd_barrier(const XcdBarrier& b) {
    asm volatile("s_waitcnt vmcnt(0)" ::: "memory");
    __syncthreads();
    if (threadIdx.x == 0) {
        unsigned* bar = b.bar;
        __builtin_amdgcn_s_waitcnt(0);
        unsigned nloc = b.st[0], nx = b.st[1];
        if (nloc == 0u) { xcd_barrier_complete(bar, b.x, nloc, nx); b.st[0] = nloc; b.st[1] = nx; }
        const unsigned old = xb_add(&bar[XB_XSUB(b.x)], 1u);
        const unsigned gen = old / nloc;
        if (old + 1u == (gen + 1u) * nloc) {
            __builtin_amdgcn_fence(__ATOMIC_RELEASE, "agent");
            asm volatile("s_waitcnt vmcnt(0)" ::: "memory");
            const unsigned og = xb_add(&bar[XB_TOP], 1u);
            const unsigned tg = og / nx;
            if (og + 1u == (tg + 1u) * nx) xb_add(&bar[XB_TOPGEN], 1u);
            else XB_SPIN(xb_ld(&bar[XB_TOPGEN]) == tg, bar);
            __builtin_amdgcn_fence(__ATOMIC_ACQUIRE, "agent");
            xb_add(&bar[XB_XGEN(b.x)], 1u);
            asm volatile("s_waitcnt vmcnt(0)" ::: "memory");
        } else {
            XB_SPIN(xb_ld(&bar[XB_XGEN(b.x)]) == gen, bar);
            __builtin_amdgcn_fence(__ATOMIC_ACQUIRE, "agent");
            asm volatile("s_waitcnt vmcnt(0)" ::: "memory");
        }
    }
    __syncthreads();
}

struct Args { const void* in[37]; float* out; unsigned char* ws; int ph_lo, ph_hi; };
enum { I_X = 0, I_P, I_POS, I_GMIX, I_WIN, I_GQA, I_WUQ, I_GKVA, I_WUKV, I_GQN, I_GKN, I_MU, I_W0, I_WW2, I_A0, I_AW2, I_GW2, I_KK, I_KA, I_RK, I_LNW, I_LNB,
       I_WOUT, I_GFFN, I_WR, I_RBIAS, I_WG, I_WU, I_WD, I_SG, I_SU, I_SD, I_GPIN, I_WPG, I_BPG, I_WPP, I_GPOUT };

typedef const __attribute__((address_space(4))) Args KArgs;
struct Ctx { int tid, lane, wid, gw, nw; LAS unsigned char* lds; };

__device__ __forceinline__ int in_map(int n) {
    if (n < 832) return n; if (n < 896) return 3904 + (n - 832); if (n < 960) return 3968 + (n - 896); if (n < 1120) return 4032 + (n - 960); if (n < 1280) return -1; return 832 + (n - 1280);
}
template <int MODE, bool OUT8 = false>
__device__ __forceinline__ void convert_weight(const Ctx& c, const float* src0, const float* src1, int ld_src, const float* g, bf16_t* dst, int K, int Nd, int blk, int nblk) {
    LAS float* tile = (LAS float*)c.lds;
    const int tk = K / 64, ntile = tk * (Nd / 128);
    const int n4 = c.tid & 31, kr = c.tid >> 5, sc = c.tid & 7, sn = c.tid >> 3;
    f32x4 v[4];
#define CW_LOAD(t_) do { const int n0_ = ((t_) / tk) * 128, k0_ = ((t_) % tk) * 64, n_ = n0_ + 4 * n4; const float* sp_ = nullptr; \
        if (MODE == 0) sp_ = src0 + n_; \
        if (MODE == 1) { const int cc_ = in_map(n_); sp_ = cc_ >= 0 ? src0 + cc_ : nullptr; } \
        if (MODE == 2) { const int half_ = (n_ >> 7) & 1, cc_ = (n_ >> 8) * 128 + (n_ & 127); sp_ = (half_ ? src1 : src0) + cc_; } \
        _Pragma("unroll") for (int i = 0; i < 4; ++i) { const int k_ = k0_ + kr + 16 * i; v[i] = sp_ ? *(const f32x4*)(sp_ + (size_t)k_ * ld_src) : (f32x4){0.f, 0.f, 0.f, 0.f}; if (g) v[i] *= g[k_]; if (OUT8) v[i] *= 64.0f; } } while (0)
    int t = blk; if (t < ntile) CW_LOAD(t);
    for (; t < ntile; t += nblk) {
#pragma unroll
        for (int i = 0; i < 4; ++i)
#pragma unroll
            for (int e = 0; e < 4; ++e) tile[(kr + 16 * i) * 129 + 4 * n4 + e] = v[i][e];
        __syncthreads();
        const int n0 = (t / tk) * 128, k0 = (t % tk) * 64;
        if (t + nblk < ntile) CW_LOAD(t + nblk);
#pragma unroll
        for (int i = 0; i < 2; ++i) { const int nl = sn + 64 * i; float f[8];
#pragma unroll
            for (int j = 0; j < 8; ++j) f[j] = tile[(8 * sc + j) * 129 + nl];
            if (OUT8) { u32x2 w8; w8.x = pk_fp8x4(f[0], f[1], f[2], f[3]); w8.y = pk_fp8x4(f[4], f[5], f[6], f[7]); *(u32x2*)((unsigned char*)dst + (size_t)(n0 + nl) * K + k0 + 8 * sc) = w8; }
            else *(u32x4*)(dst + (size_t)(n0 + nl) * K + k0 + 8 * sc) = (u32x4){cvt_pk_bf16(f[0], f[1]), cvt_pk_bf16(f[2], f[3]), cvt_pk_bf16(f[4], f[5]), cvt_pk_bf16(f[6], f[7])}; }
        __syncthreads();
    }
#undef CW_LOAD
}

__device__ __forceinline__ void rownorm_bf16(const float* src, bf16_t* dst, int lane) {
    f32x4 v[8]; float ss = 0.f;
#pragma unroll
    for (int i = 0; i < 8; ++i) { v[i] = *(const f32x4*)(src + (i * 64 + lane) * 4); ss += v[i][0] * v[i][0] + v[i][1] * v[i][1] + v[i][2] * v[i][2] + v[i][3] * v[i][3]; }
    ss = wave_sum(ss); const float rs = rsqrtf(ss * (1.0f / DM) + RMS_EPS);
#pragma unroll
    for (int i = 0; i < 8; ++i) { u32x2 w; w.x = cvt_pk_bf16(v[i][0] * rs, v[i][1] * rs); w.y = cvt_pk_bf16(v[i][2] * rs, v[i][3] * rs); *(u32x2*)(dst + (i * 64 + lane) * 4) = w; }
}

__device__ __forceinline__ void rownorm_both(const float* src, bf16_t* dst, unsigned char* dst8, int lane) {
    f32x4 v[8]; float ss = 0.f;
#pragma unroll
    for (int i = 0; i < 8; ++i) { v[i] = *(const f32x4*)(src + (i * 64 + lane) * 4); ss += v[i][0] * v[i][0] + v[i][1] * v[i][1] + v[i][2] * v[i][2] + v[i][3] * v[i][3]; }
    ss = wave_sum(ss); const float rs = rsqrtf(ss * (1.0f / DM) + RMS_EPS), rs8 = rs * 16.0f;
#pragma unroll
    for (int i = 0; i < 8; ++i) { u32x2 w; w.x = cvt_pk_bf16(v[i][0] * rs, v[i][1] * rs); w.y = cvt_pk_bf16(v[i][2] * rs, v[i][3] * rs); *(u32x2*)(dst + (i * 64 + lane) * 4) = w;
        *(unsigned*)(dst8 + (i * 64 + lane) * 4) = pk_fp8x4(v[i][0] * rs8, v[i][1] * rs8, v[i][2] * rs8, v[i][3] * rs8); }
}
__device__ __forceinline__ void rownorm_fp8(const float* src, unsigned char* dst, int lane) {
    f32x4 v[8]; float ss = 0.f;
#pragma unroll
    for (int i = 0; i < 8; ++i) { v[i] = *(const f32x4*)(src + (i * 64 + lane) * 4); ss += v[i][0] * v[i][0] + v[i][1] * v[i][1] + v[i][2] * v[i][2] + v[i][3] * v[i][3]; }
    ss = wave_sum(ss); const float rs = rsqrtf(ss * (1.0f / DM) + RMS_EPS) * 16.0f;
#pragma unroll
    for (int i = 0; i < 8; ++i) *(unsigned*)(dst + (i * 64 + lane) * 4) = pk_fp8x4(v[i][0] * rs, v[i][1] * rs, v[i][2] * rs, v[i][3] * rs);
}
__device__ __forceinline__ void phase_prep(const Ctx& c, KArgs* a) {
    unsigned char* ws = a->ws;
    { const float* x = (const float*)a->in[I_X]; bf16_t* xn = (bf16_t*)(ws + WS_XN);
      unsigned char* xn8 = (unsigned char*)a->out;
      for (int r = c.gw; r < NT; r += c.nw) rownorm_both(x + (size_t)r * DM, xn + (size_t)r * DM, xn8 + (size_t)r * DM, c.lane); }
    convert_weight<1, true>(c, (const float*)a->in[I_WIN], nullptr, 4192, (const float*)a->in[I_GMIX], (bf16_t*)(ws + OFF_WT_IN), 2048, ZC_R, blockIdx.x, gridDim.x);
    convert_weight<0>(c, (const float*)a->in[I_WIN] + 832, nullptr, 4192, (const float*)a->in[I_GMIX], (bf16_t*)(ws + OFF_WT_RKV), 2048, ZW - ZC_R, blockIdx.x, gridDim.x);
}
template <int PART  >
__device__ __forceinline__ void phase_prep_late(const Ctx& c, KArgs* a, int blk, int nblk) {
    unsigned char* ws = a->ws;
    if (PART != 1) {
    { const int gt = blk * 512 + c.tid, nthr = nblk * 512;
      int* cnt = (int*)(ws + CTL_CNT); for (int i = gt; i < NCHUNK * NE1; i += nthr) cnt[i] = ((i % NE1) == NEXP) ? CH_TOK : 0; }
    { float* rt = (float*)(ws + OFF_ROPE); const int* pos = (const int*)a->in[I_POS]; const int gt = blk * 512 + c.tid, nthr = nblk * 512;
      for (int i = gt; i < NT * 32; i += nthr) { const int tok = i >> 5, fi = i & 31; const float inv_f = (float)exp2(-(double)fi * (13.287712379549449 / 32.0));
          const float ang = (float)pos[tok] * inv_f; double xr = (double)ang; xr -= 6.283185307179586 * rint(xr * 0.15915494309189535); const float rr = (float)xr;
          rt[2 * i] = __cosf(rr); rt[2 * i + 1] = __sinf(rr); } }
    }
    if (PART != 1) { convert_weight<0>(c, (const float*)a->in[I_WUQ], nullptr, 1536, (const float*)a->in[I_GQA], (bf16_t*)(ws + OFF_WT_UQ), 512, 1536, blk, nblk);
    convert_weight<0>(c, (const float*)a->in[I_WUKV], nullptr, 2048, (const float*)a->in[I_GKVA], (bf16_t*)(ws + OFF_WT_UKV), 256, 2048, blk, nblk); }
    if (PART != 0) {
    convert_weight<0, true>(c, (const float*)a->in[I_WOUT], nullptr, 2048, nullptr, (bf16_t*)(ws + OFF_WT_OUT), 2048, 2048, blk, nblk);
    convert_weight<0, true>(c, (const float*)a->in[I_WPG], nullptr, 2048, (const float*)a->in[I_GPIN], (bf16_t*)(ws + OFF_WT_PG), 2048, 2048, blk, nblk);
    convert_weight<0>(c, (const float*)a->in[I_WPP], nullptr, 2048, nullptr, (bf16_t*)(ws + OFF_WT_PP), 256, 2048, blk, nblk); }
    if (PART != 1) {
    { bf16_t* wl = (bf16_t*)(ws + OFF_WT_LORA); const float* ww2 = (const float*)a->in[I_WW2]; const float* aw2 = (const float*)a->in[I_AW2]; const float* gw2 = (const float*)a->in[I_GW2];
      const int gt = blk * 512 + c.tid, nthr = nblk * 512;
      for (int i = gt; i < LORA_N * LORA_K; i += nthr) { const int n = i / LORA_K, k = i % LORA_K; float v = 0.f;
          if (n < 1024) { if (k < 64) v = ww2[k * 1024 + n]; }
          else if (n < 2048) { if (k >= 64 && k < 128) v = aw2[(k - 64) * 1024 + (n - 1024)]; }
          else { if (k >= 128 && k < 288) v = gw2[(k - 128) * 1024 + (n - 2048)]; }
          wl[i] = f2bf(v); } }
    { u32x4* wf = (u32x4*)(ws + OFF_WRF); const float* wr = (const float*)a->in[I_WR]; const float* gf = (const float*)a->in[I_GFFN];
      const int gt = blk * 512 + c.tid, nthr = nblk * 512;
      for (int i = gt; i < 64 * 4 * 64; i += nthr) { const int l = i & 63, cc = (i >> 6) & 3, s = i >> 8; const int k0 = 32 * s + 8 * (l >> 4), n = 16 * cc + (l & 15);
          float w[8], lo[8];
#pragma unroll
          for (int j = 0; j < 8; ++j) w[j] = wr[(k0 + j) * 64 + n] * gf[k0 + j];
          const u32x4 hi = packf8(w); float h[8]; unpack8(hi, h);
#pragma unroll
          for (int j = 0; j < 8; ++j) lo[j] = w[j] - h[j];
          wf[((s * 4 + cc) * 2 + 0) * 64 + l] = hi; wf[((s * 4 + cc) * 2 + 1) * 64 + l] = packf8(lo); } }
    }
}

__device__ __forceinline__ void phase_finalize_qk(const Ctx& c, KArgs* a) {
    unsigned char* ws = a->ws; bf16_t* Qb = (bf16_t*)(ws + OFF_QB); bf16_t* Kb = (bf16_t*)(ws + OFF_KB); const bf16_t* Z = (const bf16_t*)(ws + OFF_Z); const float* rt = (const float*)(ws + OFF_ROPE);
    const float* gqn = (const float*)a->in[I_GQN]; const float* gkn = (const float*)a->in[I_GKN];
    const int lane = c.lane, h = lane >> 3, sx = lane & 7; const bool lowh = sx < 4;
    float gq[3][8], gk[3][8];
#pragma unroll
    for (int p = 0; p < 3; ++p)
#pragma unroll
        for (int e = 0; e < 8; ++e) { gq[p][e] = gqn[64 * p + 8 * sx + e]; gk[p][e] = gkn[64 * p + 8 * sx + e]; }
    for (int tok = c.gw; tok < NT; tok += c.nw) {
        float cs[8], sn[8];
        { const float* rp = rt + (size_t)tok * 64 + 16 * (sx & 3);
#pragma unroll
          for (int e4 = 0; e4 < 4; ++e4) { const f32x4 t4 = *(const f32x4*)(rp + 4 * e4); cs[2 * e4] = t4[0]; sn[2 * e4] = t4[1]; cs[2 * e4 + 1] = t4[2]; sn[2 * e4 + 1] = t4[3]; } }
        bf16_t* qp = Qb + (size_t)tok * QW + h * 192 + 8 * sx; bf16_t* kp = Kb + (size_t)tok * QW + h * 192 + 8 * sx;
        const u32x4 q0 = *(const u32x4*)qp, q1 = *(const u32x4*)(qp + 64), q2 = *(const u32x4*)(qp + 128);
        const u32x4 k0 = *(const u32x4*)kp, k1 = *(const u32x4*)(kp + 64), k2 = *(const u32x4*)(Z + (size_t)tok * ZW + ZC_KPE + 8 * sx);
        float f[3][8];
        unpack8(q0, f[0]); unpack8(q1, f[1]); unpack8(q2, f[2]);
        { float ss = 0.f;
#pragma unroll
          for (int p = 0; p < 3; ++p)
#pragma unroll
              for (int e = 0; e < 8; ++e) ss += f[p][e] * f[p][e];
          ss = allred8(ss); const float rs = rsqrtf(ss * (1.0f / 192.0f) + RMS_EPS) * QSCALE;
#pragma unroll
          for (int p = 0; p < 3; ++p)
#pragma unroll
              for (int e = 0; e < 8; ++e) f[p][e] *= rs * gq[p][e];
#pragma unroll
          for (int e = 0; e < 8; ++e) { const float oth = __shfl_xor(f[2][e], 4); f[2][e] = lowh ? (f[2][e] * cs[e] - oth * sn[e]) : (f[2][e] * cs[e] + oth * sn[e]); }
          *(u32x4*)qp = packf8(f[0]); *(u32x4*)(qp + 64) = packf8(f[1]); *(u32x4*)(qp + 128) = packf8(f[2]); }
        unpack8(k0, f[0]); unpack8(k1, f[1]); unpack8(k2, f[2]);
        { float ss = 0.f;
#pragma unroll
          for (int p = 0; p < 3; ++p)
#pragma unroll
              for (int e = 0; e < 8; ++e) ss += f[p][e] * f[p][e];
          ss = allred8(ss); const float rs = rsqrtf(ss * (1.0f / 192.0f) + RMS_EPS);
#pragma unroll
          for (int p = 0; p < 3; ++p)
#pragma unroll
              for (int e = 0; e < 8; ++e) f[p][e] *= rs * gk[p][e];
#pragma unroll
          for (int e = 0; e < 8; ++e) { const float oth = __shfl_xor(f[2][e], 4); f[2][e] = lowh ? (f[2][e] * cs[e] - oth * sn[e]) : (f[2][e] * cs[e] + oth * sn[e]); }
          *(u32x4*)kp = packf8(f[0]); *(u32x4*)(kp + 64) = packf8(f[1]); *(u32x4*)(kp + 128) = packf8(f[2]); }
    }
}

__device__ __forceinline__ int crow(int r, int hi) { return (r & 3) + 8 * (r >> 2) + 4 * hi; }
__device__ __forceinline__ void phase_attn_v1(const Ctx& c, KArgs* a) {
    unsigned char* ws = a->ws; const bf16_t* Qb = (const bf16_t*)(ws + OFF_QB); const bf16_t* Kb = (const bf16_t*)(ws + OFF_KB); const bf16_t* Vb = (const bf16_t*)(ws + OFF_VB);
    bf16_t* Ym = (bf16_t*)(ws + WS_XN);
    const int lane = c.lane, r32 = lane & 31, hi = lane >> 5;
    for (int it = c.gw; it < 8192; it += c.nw) {
        const int qb = 255 - (it >> 5), bh = it & 31, b = bh >> 3, h = bh & 7, q0 = qb * 32;
        const size_t tb = (size_t)b * SEQ;
        bf16x8 qr[12];
        { const bf16_t* qp = Qb + (tb + q0 + r32) * QW + h * 192 + hi * 8;
#pragma unroll
          for (int d0 = 0; d0 < 12; ++d0) qr[d0] = *(const bf16x8*)(qp + d0 * 16); }
        float m_reg = -1e30f, l_reg = 0.f; f32x16 o[4];
#pragma unroll
        for (int d = 0; d < 4; ++d)
#pragma unroll
            for (int r = 0; r < 16; ++r) o[d][r] = 0.f;
        const int ntile = (q0 + 31) / 64 + 1;
        for (int kt = 0; kt < ntile; ++kt) {
            const int kb = kt * 64;
            f32x16 p0, p1;
#pragma unroll
            for (int r = 0; r < 16; ++r) { p0[r] = 0.f; p1[r] = 0.f; }
            { const bf16_t* kp = Kb + (tb + kb + r32) * QW + h * 192 + hi * 8;
#pragma unroll
              for (int d0 = 0; d0 < 12; ++d0) { const bf16x8 b0 = *(const bf16x8*)(kp + d0 * 16); const bf16x8 b1 = *(const bf16x8*)(kp + (size_t)32 * QW + d0 * 16);
                  p0 = __builtin_amdgcn_mfma_f32_32x32x16_bf16(b0, qr[d0], p0, 0, 0, 0); p1 = __builtin_amdgcn_mfma_f32_32x32x16_bf16(b1, qr[d0], p1, 0, 0, 0); } }
            if (kb + 63 > q0) {
                const int dq = q0 + r32 - kb - 4 * hi; const float NEG = -__builtin_inff();
#pragma unroll
                for (int r = 0; r < 16; ++r) { const int cc = (r & 3) + 8 * (r >> 2); if (dq - cc < 0) p0[r] = NEG; if (dq - cc - 32 < 0) p1[r] = NEG; }
            }
            float pmax = p0[0];
#pragma unroll
            for (int r = 1; r < 16; ++r) pmax = fmaxf(pmax, p0[r]);
#pragma unroll
            for (int r = 0; r < 16; ++r) pmax = fmaxf(pmax, p1[r]);
            pmax = fmaxf(pmax, __shfl_xor(pmax, 32));
            const float mn = fmaxf(m_reg, pmax); const float alpha = __builtin_amdgcn_exp2f(m_reg - mn); m_reg = mn;
            float ps = 0.f;
#pragma unroll
            for (int r = 0; r < 16; ++r) { p0[r] = __builtin_amdgcn_exp2f(p0[r] - mn); p1[r] = __builtin_amdgcn_exp2f(p1[r] - mn); ps += p0[r] + p1[r]; }
            ps += __shfl_xor(ps, 32);
            l_reg = l_reg * alpha + ps;
#pragma unroll
            for (int r = 0; r < 16; ++r) { const float ar = __shfl(alpha, crow(r, hi));
#pragma unroll
                for (int d = 0; d < 4; ++d) o[d][r] *= ar; }
            bf16x8 pa0, pa1, pa2, pa3;
#define PK4(P, B_, OUT) do { unsigned a0 = cvt_pk_bf16(P[B_ + 0], P[B_ + 1]), a1 = cvt_pk_bf16(P[B_ + 2], P[B_ + 3]); \
        unsigned b0 = cvt_pk_bf16(P[B_ + 4], P[B_ + 5]), b1 = cvt_pk_bf16(P[B_ + 6], P[B_ + 7]); \
        auto r0 = __builtin_amdgcn_permlane32_swap(a0, b0, false, false); auto r1 = __builtin_amdgcn_permlane32_swap(a1, b1, false, false); \
        u32x4 w = {r0[0], r1[0], r0[1], r1[1]}; OUT = *reinterpret_cast<bf16x8*>(&w); } while (0)
            PK4(p0, 0, pa0); PK4(p0, 8, pa1); PK4(p1, 0, pa2); PK4(p1, 8, pa3);
#undef PK4
            const bf16_t* vp = Vb + (tb + kb + 8 * hi) * 1024 + h * 128 + r32;
#pragma unroll
            for (int d0 = 0; d0 < 4; ++d0) {
#pragma unroll
                for (int ks = 0; ks < 4; ++ks) { bf16x8 vf;
#pragma unroll
                    for (int j = 0; j < 8; ++j) vf[j] = (short)vp[(size_t)(16 * ks + j) * 1024 + d0 * 32];
                    const bf16x8 pa = ks == 0 ? pa0 : (ks == 1 ? pa1 : (ks == 2 ? pa2 : pa3));
                    o[d0] = __builtin_amdgcn_mfma_f32_32x32x16_bf16(pa, vf, o[d0], 0, 0, 0); } }
        }
        const float li = 1.0f / l_reg;
#pragma unroll
        for (int r = 0; r < 16; ++r) { const int orow = crow(r, hi); const float lr = __shfl(li, orow);
            bf16_t* op = Ym + (tb + q0 + orow) * DM + h * 128 + r32;
#pragma unroll
            for (int d0 = 0; d0 < 4; ++d0) op[d0 * 32] = f2bf(o[d0][r] * lr); }
    }
}

constexpr int AT_SHM_V = 64 * 128 * 2, AT_SHM_K = 64 * 192 * 2, AT_OFF_K = 2 * AT_SHM_V, AT_OFF_WS = AT_OFF_K + 2 * AT_SHM_K;
#define KSWZ192(row, colB) ((row) * 384 + ((colB) ^ (((row) & 7) << 4)))
__device__ __forceinline__ int v_st(int k, int c) { const int kk = (k & ~0xC) | ((k & 4) << 1) | ((k & 8) >> 1); return ((kk >> 3) * 4 + (c >> 5)) * 512 + ((kk & 7) * 32 + (c & 31)) * 2; }
__device__ __forceinline__ int v_rd_base(int lane) { return ((lane & 3) << 3) | (((lane >> 2) & 3) << 6) | (((lane >> 4) & 1) << 5) | (((lane >> 5) & 1) << 8); }
typedef short s16x4 __attribute__((ext_vector_type(4)));
__device__ __forceinline__ void attn_qblock(LAS unsigned char* lds, const bf16_t* Qb, const bf16_t* Kb, const bf16_t* Vb, bf16_t* Ym, int b, int h, int qblk, int tid_in, int wid) {
    int tid = tid_in; asm volatile("" : "+v"(tid));
    const int lane = tid & 63, r32 = lane & 31, hi = lane >> 5;
    const size_t tb = (size_t)b * SEQ; const int q0 = qblk * 256, qlo = q0 + wid * 32;
    LAS unsigned char* V_lds = lds; LAS unsigned char* K_lds = lds + AT_OFF_K;
    LAS float* wsf = (LAS float*)(lds + AT_OFF_WS) + wid * 64;
    bf16x8 qr[12];
    { const bf16_t* qp = Qb + (tb + qlo + r32) * QW + h * 192 + hi * 8;
#pragma unroll
      for (int d0 = 0; d0 < 12; ++d0) qr[d0] = *(const bf16x8*)(qp + d0 * 16); }
    unsigned kgo[3], vgo[2];
#pragma unroll
    for (int i = 0; i < 3; ++i) { const int L = tid + 512 * i, row = L / 24, cB = ((L % 24) * 16) ^ ((row & 7) << 4); kgo[i] = (unsigned)(row * QW * 2 + cB); }
#pragma unroll
    for (int i = 0; i < 2; ++i) { const int L = tid + 512 * i, kk = (L >> 7) * 8 + ((L & 31) >> 2), k = (kk & ~0xC) | ((kk & 4) << 1) | ((kk & 8) >> 1), cc = ((L >> 5) & 3) * 32 + (L & 3) * 8; vgo[i] = (unsigned)(k * 1024 * 2 + cc * 2); }
    const char* Kg = (const char*)(Kb + tb * QW + h * 192); const char* Vg = (const char*)(Vb + tb * 1024 + h * 128);
    const int vb0 = (int)(uintptr_t)V_lds + v_rd_base(lane);
    int kb4[4];
#pragma unroll
    for (int dd = 0; dd < 4; ++dd) kb4[dd] = r32 * 384 + ((dd * 32 + hi * 16) ^ ((r32 & 7) << 4));
    const int NT_ = (q0 + 255) / 64 + 1;
#define AT_STAGE(t_, buf_) do { const size_t gk_ = (size_t)(t_) * 64 * QW * 2, gv_ = (size_t)(t_) * 64 * 1024 * 2; \
        _Pragma("unroll") for (int i = 0; i < 3; ++i) __builtin_amdgcn_global_load_lds((const unsigned*)(Kg + gk_ + kgo[i]), (LAS unsigned*)(K_lds + (buf_) * AT_SHM_K + (512 * i + wid * 64) * 16), 16, 0, 0); \
        _Pragma("unroll") for (int i = 0; i < 2; ++i) __builtin_amdgcn_global_load_lds((const unsigned*)(Vg + gv_ + vgo[i]), (LAS unsigned*)(V_lds + (buf_) * AT_SHM_V + (512 * i + wid * 64) * 16), 16, 0, 0); } while (0)
    __syncthreads();
    AT_STAGE(0, 0);
    float m_reg = -1e30f, l_reg = 0.f; f32x16 o[4];
#pragma unroll
    for (int d = 0; d < 4; ++d)
#pragma unroll
        for (int r = 0; r < 16; ++r) o[d][r] = 0.f;
    for (int t = 0; t < NT_; ++t) {
        const int buf = t & 1, kb = t * 64;
        asm volatile("s_waitcnt vmcnt(0)" ::: "memory"); __syncthreads();
        if (t + 1 < NT_) AT_STAGE(t + 1, buf ^ 1);
        f32x16 p0, p1;
#pragma unroll
        for (int r = 0; r < 16; ++r) { p0[r] = 0.f; p1[r] = 0.f; }
        { const int kab = (int)(uintptr_t)K_lds + buf * AT_SHM_K; const int ka0 = kab + kb4[0], ka1 = kab + kb4[1], ka2 = kab + kb4[2], ka3 = kab + kb4[3];
          bf16x8 kf[3][2];
#define KRD(dst, areg, off) asm volatile("ds_read_b128 %0, %1 offset:%2" : "=&v"(dst) : "v"(areg), "i"(off) : "memory")
#define KRD2(set, d0) do { if (((d0) & 3) == 0) { KRD(kf[set][0], ka0, ((d0) >> 2) * 128); KRD(kf[set][1], ka0, ((d0) >> 2) * 128 + 32 * 384); } \
                           else if (((d0) & 3) == 1) { KRD(kf[set][0], ka1, ((d0) >> 2) * 128); KRD(kf[set][1], ka1, ((d0) >> 2) * 128 + 32 * 384); } \
                           else if (((d0) & 3) == 2) { KRD(kf[set][0], ka2, ((d0) >> 2) * 128); KRD(kf[set][1], ka2, ((d0) >> 2) * 128 + 32 * 384); } \
                           else { KRD(kf[set][0], ka3, ((d0) >> 2) * 128); KRD(kf[set][1], ka3, ((d0) >> 2) * 128 + 32 * 384); } } while (0)
#define KWAIT(n) do { asm volatile("s_waitcnt lgkmcnt(" #n ")" ::: "memory"); __builtin_amdgcn_sched_barrier(0); } while (0)
#define KSTEP(d0, W) do { if ((d0) + 2 < 12) KRD2(((d0) + 2) % 3, (d0) + 2); W; \
              p0 = __builtin_amdgcn_mfma_f32_32x32x16_bf16(kf[(d0) % 3][0], qr[d0], p0, 0, 0, 0); p1 = __builtin_amdgcn_mfma_f32_32x32x16_bf16(kf[(d0) % 3][1], qr[d0], p1, 0, 0, 0); } while (0)
          KRD2(0, 0); KRD2(1, 1);
          KSTEP(0, KWAIT(4)); KSTEP(1, KWAIT(4)); KSTEP(2, KWAIT(4)); KSTEP(3, KWAIT(4)); KSTEP(4, KWAIT(4)); KSTEP(5, KWAIT(4));
          KSTEP(6, KWAIT(4)); KSTEP(7, KWAIT(4)); KSTEP(8, KWAIT(4)); KSTEP(9, KWAIT(4)); KSTEP(10, KWAIT(2)); KSTEP(11, KWAIT(0));
#undef KSTEP
#undef KWAIT
#undef KRD2
#undef KRD
        }
        if (kb + 63 > qlo) { const int dq = qlo + r32 - kb - 4 * hi; const float NEG = -__builtin_inff();
#pragma unroll
            for (int r = 0; r < 16; ++r) { const int cc = (r & 3) + 8 * (r >> 2); if (dq - cc < 0) p0[r] = NEG; if (dq - cc - 32 < 0) p1[r] = NEG; } }
        float pmax = p0[0];
#pragma unroll
        for (int r = 1; r < 16; ++r) pmax = fmaxf(pmax, p0[r]);
#pragma unroll
        for (int r = 0; r < 16; ++r) pmax = fmaxf(pmax, p1[r]);
        { auto rr = __builtin_amdgcn_permlane32_swap(__float_as_uint(pmax), __float_as_uint(pmax), false, false); pmax = fmaxf(__uint_as_float(rr[0]), __uint_as_float(rr[1])); }
        float alpha = 1.f;
        if (!__all(pmax - m_reg <= 11.5f)) { const float mn = fmaxf(m_reg, pmax); alpha = __builtin_amdgcn_exp2f(m_reg - mn); m_reg = mn; }
        float ps = 0.f;
#pragma unroll
        for (int r = 0; r < 16; ++r) { p0[r] = __builtin_amdgcn_exp2f(p0[r] - m_reg); p1[r] = __builtin_amdgcn_exp2f(p1[r] - m_reg); ps += p0[r] + p1[r]; }
        { auto rr = __builtin_amdgcn_permlane32_swap(__float_as_uint(ps), __float_as_uint(ps), false, false); ps = __uint_as_float(rr[0]) + __uint_as_float(rr[1]); }
        l_reg = l_reg * alpha + ps;
        if (__any(alpha < 1.f)) { if (hi == 0) wsf[r32] = alpha; asm volatile("s_waitcnt lgkmcnt(0)" ::: "memory");
#pragma unroll
            for (int r = 0; r < 16; ++r) { const float ar = wsf[crow(r, hi)];
#pragma unroll
                for (int d = 0; d < 4; ++d) o[d][r] *= ar; } }
        bf16x8 pa0, pa1, pa2, pa3;
#define PK4(P, B_, OUT) do { unsigned a0 = cvt_pk_bf16(P[B_ + 0], P[B_ + 1]), a1 = cvt_pk_bf16(P[B_ + 2], P[B_ + 3]); \
        unsigned b0 = cvt_pk_bf16(P[B_ + 4], P[B_ + 5]), b1 = cvt_pk_bf16(P[B_ + 6], P[B_ + 7]); \
        auto r0 = __builtin_amdgcn_permlane32_swap(a0, b0, false, false); auto r1 = __builtin_amdgcn_permlane32_swap(a1, b1, false, false); \
        u32x4 w = {r0[0], r1[0], r0[1], r1[1]}; OUT = *reinterpret_cast<bf16x8*>(&w); } while (0)
        PK4(p0, 0, pa0); PK4(p0, 8, pa1); PK4(p1, 0, pa2); PK4(p1, 8, pa3);
#undef PK4
#define TRRD(dst, off) asm volatile("ds_read_b64_tr_b16 %0, %1 offset:%2" : "=&v"(dst) : "v"(vbb), "i"(off) : "memory")
#define PV_RD(S_, d0) do { constexpr int b_ = (d0) * 512; TRRD(S_##l0, b_); TRRD(S_##h0, b_ + 2048); TRRD(S_##l1, b_ + 4096); TRRD(S_##h1, b_ + 6144); TRRD(S_##l2, b_ + 8192); TRRD(S_##h2, b_ + 10240); TRRD(S_##l3, b_ + 12288); TRRD(S_##h3, b_ + 14336); } while (0)
#define PV_MM(S_, d0) do { \
        o[d0] = __builtin_amdgcn_mfma_f32_32x32x16_bf16(pa0, (bf16x8){S_##l0[0], S_##l0[1], S_##l0[2], S_##l0[3], S_##h0[0], S_##h0[1], S_##h0[2], S_##h0[3]}, o[d0], 0, 0, 0); \
        o[d0] = __builtin_amdgcn_mfma_f32_32x32x16_bf16(pa1, (bf16x8){S_##l1[0], S_##l1[1], S_##l1[2], S_##l1[3], S_##h1[0], S_##h1[1], S_##h1[2], S_##h1[3]}, o[d0], 0, 0, 0); \
        o[d0] = __builtin_amdgcn_mfma_f32_32x32x16_bf16(pa2, (bf16x8){S_##l2[0], S_##l2[1], S_##l2[2], S_##l2[3], S_##h2[0], S_##h2[1], S_##h2[2], S_##h2[3]}, o[d0], 0, 0, 0); \
        o[d0] = __builtin_amdgcn_mfma_f32_32x32x16_bf16(pa3, (bf16x8){S_##l3[0], S_##l3[1], S_##l3[2], S_##l3[3], S_##h3[0], S_##h3[1], S_##h3[2], S_##h3[3]}, o[d0], 0, 0, 0); } while (0)
#define PV_WAIT(n) do { asm volatile("s_waitcnt lgkmcnt(" #n ")" ::: "memory"); __builtin_amdgcn_sched_barrier(0); } while (0)
        { const int vbb = vb0 + buf * AT_SHM_V; s16x4 Al0, Al1, Al2, Al3, Ah0, Ah1, Ah2, Ah3, Bl0, Bl1, Bl2, Bl3, Bh0, Bh1, Bh2, Bh3;
          PV_RD(A, 0); PV_RD(B, 1); PV_WAIT(8); PV_MM(A, 0);
          PV_RD(A, 2); PV_WAIT(8); PV_MM(B, 1);
          PV_RD(B, 3); PV_WAIT(8); PV_MM(A, 2);
          PV_WAIT(0); PV_MM(B, 3); }
#undef PV_RD
#undef PV_MM
#undef PV_WAIT
#undef TRRD
    }
#undef AT_STAGE
    if (hi == 0) wsf[32 + r32] = 1.0f / l_reg;
    asm volatile("s_waitcnt lgkmcnt(0)" ::: "memory");
    int lane_e = lane; asm volatile("" : "+v"(lane_e));
    const int r32e = lane_e & 31, hie = lane_e >> 5;
    unsigned char* Ow = (unsigned char*)Ym + (size_t)(tb + qlo) * DM + h * 128;
#pragma unroll
    for (int r = 0; r < 16; ++r) { const int orow = crow(r, hie); const float li = wsf[32 + orow] * 16.0f;
#pragma unroll
        for (int d0 = 0; d0 < 4; ++d0) { const float v = o[d0][r] * li; const float v1 = __shfl_xor(v, 1), v2 = __shfl_xor(v, 2), v3 = __shfl_xor(v1, 2);
            if ((r32e & 3) == 0) *(unsigned*)(Ow + (size_t)orow * DM + d0 * 32 + r32e) = pk_fp8x4(v, v1, v2, v3); } }
}
__device__ __forceinline__ void phase_attn_v2(const Ctx& c, KArgs* a) {
    unsigned char* ws = a->ws; const bf16_t* Qb = (const bf16_t*)(ws + OFF_QB); const bf16_t* Kb = (const bf16_t*)(ws + OFF_KB); const bf16_t* Vb = (const bf16_t*)(ws + OFF_VB);
    bf16_t* Ym = (bf16_t*)(ws + WS_XN);
    for (int it = blockIdx.x; it < 512; it += gridDim.x) {
        const int rnd = it >> 8, bb = it & 255, xcd = bb & 7, slot = bb >> 3; const int bh = rnd * 16 + xcd * 2 + (slot >> 4), y = slot & 15;
        attn_qblock(c.lds, Qb, Kb, Vb, Ym, bh >> 3, bh & 7, 31 - y, c.tid, c.wid);
        attn_qblock(c.lds, Qb, Kb, Vb, Ym, bh >> 3, bh & 7, y, c.tid, c.wid);
    }
}

__device__ __forceinline__ void phase_lora_prep(const Ctx& c, KArgs* a) {
    unsigned char* ws = a->ws; const bf16_t* Z = (const bf16_t*)(ws + OFF_Z); bf16_t* AL = (bf16_t*)(ws + OFF_ALORA); const float* mu = (const float*)a->in[I_MU];
    const int gt = blockIdx.x * 512 + c.tid, nthr = gridDim.x * 512;
    for (int i = gt; i < NT * 48; i += nthr) { const int tok = i / 48, ck = i % 48; float f[8];
        if (ck < 36) { const int k0 = 8 * ck; float cu[8], pv[8];
            unpack8(*(const u32x4*)(Z + (size_t)tok * ZW + ZC_WL + k0), cu);
            if (tok % SEQ) unpack8(*(const u32x4*)(Z + (size_t)(tok - 1) * ZW + ZC_WL + k0), pv); else {
#pragma unroll
                for (int e = 0; e < 8; ++e) pv[e] = 0.f; }
            const f32x4 m0 = *(const f32x4*)(mu + 3072 + k0), m1 = *(const f32x4*)(mu + 3072 + k0 + 4);
#pragma unroll
            for (int e = 0; e < 8; ++e) { const float x = cu[e] + (pv[e] - cu[e]) * (e < 4 ? m0[e & 3] : m1[e & 3]); f[e] = ck < 8 ? (1.0f - 2.0f * __builtin_amdgcn_rcpf(1.0f + __builtin_amdgcn_exp2f(2.885390082f * x))) : (ck < 16 ? x : sigmoidf_(x)); }
        } else {
#pragma unroll
            for (int e = 0; e < 8; ++e) f[e] = 0.f; }
        *(u32x4*)(AL + (size_t)tok * LORA_K + 8 * ck) = packf8(f); }
}
__device__ __forceinline__ void phase_scan_prep(const Ctx& c, KArgs* a) {
    unsigned char* ws = a->ws; const bf16_t* Z = (const bf16_t*)(ws + OFF_Z); const bf16_t* Lb = (const bf16_t*)(ws + OFF_LB);
    h16* D0 = (h16*)(ws + OFF_DER); const size_t DS = (size_t)NT * 1024;
    const float* mu = (const float*)a->in[I_MU]; const float* w0 = (const float*)a->in[I_W0]; const float* a0 = (const float*)a->in[I_A0];
    const float* kkp = (const float*)a->in[I_KK]; const float* kap = (const float*)a->in[I_KA];
    const int lane = c.lane, half = c.gw & 1, ch0 = (half * 8 + (lane >> 3)) * 64 + 8 * (lane & 7);
    float mur[8], muk[8], muv[8], cw0[8], ca0[8], ckk[8], cka[8];
#pragma unroll
    for (int e = 0; e < 8; ++e) { mur[e] = mu[ch0 + e]; muk[e] = mu[1024 + ch0 + e]; muv[e] = mu[2048 + ch0 + e]; cw0[e] = w0[ch0 + e]; ca0[e] = a0[ch0 + e]; ckk[e] = kkp[ch0 + e]; cka[e] = kap[ch0 + e]; }
    u32x4 nxa[8], nxb[8];
#define SP_LOAD(nx, it_) do { const int tk_ = (it_) >> 1; const bf16_t* zr_ = Z + (size_t)tk_ * ZW + ch0; const bf16_t* zp_ = (tk_ % SEQ) == 0 ? zr_ : zr_ - ZW; \
        nx[0] = *(const u32x4*)(zr_ + ZC_R); nx[1] = *(const u32x4*)(zr_ + ZC_K); nx[2] = *(const u32x4*)(zr_ + ZC_V); nx[3] = *(const u32x4*)(zp_ + ZC_R); nx[4] = *(const u32x4*)(zp_ + ZC_K); nx[5] = *(const u32x4*)(zp_ + ZC_V); \
        nx[6] = *(const u32x4*)(Lb + (size_t)tk_ * LORA_N + ch0); nx[7] = *(const u32x4*)(Lb + (size_t)tk_ * LORA_N + 1024 + ch0); } while (0)
    if (c.gw < NT * 2) SP_LOAD(nxa, c.gw);
    if (c.gw + c.nw < NT * 2) SP_LOAD(nxb, c.gw + c.nw);
#define SP_ITEM(nx, it) do { const int tok = (it) >> 1; \
        const bool first = (tok % SEQ) == 0; \
        float rc[8], kc[8], vc[8], rp[8], kp[8], vp[8], lw[8], la[8]; \
        unpack8(nx[0], rc); unpack8(nx[1], kc); unpack8(nx[2], vc); unpack8(nx[3], rp); unpack8(nx[4], kp); unpack8(nx[5], vp); unpack8(nx[6], lw); unpack8(nx[7], la); \
        if ((it) + 2 * c.nw < NT * 2) SP_LOAD(nx, (it) + 2 * c.nw); \
        sp_item(tok, first, rc, kc, vc, rp, kp, vp, lw, la); } while (0)
    auto sp_item = [&](int tok, bool first, const float (&rc)[8], const float (&kc)[8], const float (&vc)[8], const float (&rp)[8], const float (&kp)[8], const float (&vp)[8], const float (&lw)[8], const float (&la)[8]) __attribute__((always_inline)) {
        h16x8 o_ld, o_kk, o_b, o_km, o_r, o_v; float kt[8], av[8], ss = 0.f;
#pragma unroll
        for (int e = 0; e < 8; ++e) { const float pr = first ? 0.f : rp[e], pk = first ? 0.f : kp[e], pvv = first ? 0.f : vp[e];
            const float r = rc[e] + (pr - rc[e]) * mur[e], k = kc[e] + (pk - kc[e]) * muk[e], v = vc[e] + (pvv - vc[e]) * muv[e];
            const float xw = -(cw0[e] + lw[e]); const float spl = fmaxf(xw, 0.f) + 0.69314718f * __builtin_amdgcn_logf(1.0f + __builtin_amdgcn_exp2f(-1.44269504f * fabsf(xw)));
            const float ld = -__builtin_amdgcn_exp2f((-spl - 0.5f) * 1.44269504f);
            av[e] = sigmoidf_(ca0[e] + la[e]); kt[e] = k * ckk[e]; ss += kt[e] * kt[e];
            o_ld[e] = (h16)ld; o_km[e] = (h16)(k * (1.0f + (av[e] - 1.0f) * cka[e])); o_r[e] = (h16)r; o_v[e] = (h16)v; }
        ss = allred8(ss); const float rn = ss > 1e-24f ? __builtin_amdgcn_rsqf(ss) : 1e12f;
#pragma unroll
        for (int e = 0; e < 8; ++e) { const float kk = kt[e] * rn; o_kk[e] = (h16)kk; o_b[e] = (h16)(kk * av[e]); }
        const size_t o = (size_t)tok * 1024 + ch0;
        *(h16x8*)(D0 + o) = o_ld; *(h16x8*)(D0 + DS + o) = o_kk; *(h16x8*)(D0 + 2 * DS + o) = o_b; *(h16x8*)(D0 + 3 * DS + o) = o_km; *(h16x8*)(D0 + 4 * DS + o) = o_r; *(h16x8*)(D0 + 5 * DS + o) = o_v; };
    for (int it = c.gw; it < NT * 2; it += 2 * c.nw) { SP_ITEM(nxa, it); if (it + c.nw < NT * 2) SP_ITEM(nxb, it + c.nw); }
#undef SP_ITEM
#undef SP_LOAD
}
constexpr int SC_L = 256, SC_NC = SEQ / SC_L;
constexpr size_t OFF_YRAW = OFF_Z;
constexpr size_t OFF_PM = OFF_Z + 128 * MiB;
constexpr size_t OFF_HM = OFF_PM + 32 * MiB;
constexpr size_t OFF_ST = OFF_HM + 32 * MiB;
static_assert(OFF_ST + 32 * MiB <= OFF_R1, "scan buffers overflow Z region");
constexpr size_t OFF_Q16 = OFF_Z;
constexpr size_t OFF_Y016 = OFF_Z + 64 * MiB;
struct ScanRaw { h16x8 ld, kk, bb, km, r, v; };
__device__ __forceinline__ ScanRaw scan_load(const h16* pj, const h16* pi, size_t DS, int t) {
    ScanRaw q; const size_t o = (size_t)t * 1024;
    q.ld = *(const h16x8*)(pj + o); q.kk = *(const h16x8*)(pj + DS + o); q.bb = *(const h16x8*)(pj + 2 * DS + o);
    q.km = *(const h16x8*)(pj + 3 * DS + o); q.r = *(const h16x8*)(pj + 4 * DS + o); q.v = *(const h16x8*)(pi + o);
    return q;
}
__device__ __forceinline__ void phase_scan_p1(const Ctx& c, KArgs* a) {
    unsigned char* ws = a->ws; const h16* D0 = (const h16*)(ws + OFF_DER); const size_t DS = (size_t)NT * 1024; float* Pm = (float*)(ws + OFF_PM); float* Hm = (float*)(ws + OFF_HM);
    h16* Q16 = (h16*)(ws + OFF_Q16); h16* Y016 = (h16*)(ws + OFF_Y016);
    const int lane = c.lane, la = lane >> 3, lb = lane & 7;
    for (int it = c.gw; it < 64 * SC_NC; it += c.nw) {
        const int bh = it & 63, ch = it >> 6, b = bh >> 4, h = bh & 15;
        const size_t tok0 = (size_t)b * SEQ + (size_t)ch * SC_L;
        float SP[8][8], SH[8][8];
#pragma unroll
        for (int i = 0; i < 8; ++i)
#pragma unroll
            for (int j = 0; j < 8; ++j) { SP[i][j] = (la == lb && i == j) ? 1.f : 0.f; SH[i][j] = 0.f; }
        h16* qo = Q16 + tok0 * 1024 + h * 64 + 8 * la; h16* yo = Y016 + tok0 * 1024 + h * 64 + 8 * la;
        LAS unsigned char* ring = c.lds + c.wid * 4096;
        const h16* gsrc = D0 + (size_t)((lane >> 3) < 5 ? (lane >> 3) : 5) * DS + tok0 * 1024 + h * 64 + 8 * (lane & 7);
#define SC_DMA(t_) __builtin_amdgcn_global_load_lds((const unsigned*)(gsrc + (size_t)((t_) < SC_L ? (t_) : SC_L - 1) * 1024), (LAS unsigned*)(ring + ((t_) & 3) * 1024), 16, 0, 0)
        SC_DMA(0); SC_DMA(1); SC_DMA(2);
#pragma unroll 1
        for (int t = 0; t < SC_L; ++t) {
            if (t < 3) asm volatile("s_waitcnt vmcnt(0)" ::: "memory"); else asm volatile("s_waitcnt vmcnt(8)" ::: "memory");
            SC_DMA(t + 3);
            ScanRaw cr; { const LAS unsigned char* sl = ring + (t & 3) * 1024;
                cr.ld = *(const LAS h16x8*)(sl + 16 * lb); cr.kk = *(const LAS h16x8*)(sl + 128 + 16 * lb); cr.bb = *(const LAS h16x8*)(sl + 256 + 16 * lb);
                cr.km = *(const LAS h16x8*)(sl + 384 + 16 * lb); cr.r = *(const LAS h16x8*)(sl + 512 + 16 * lb); cr.v = *(const LAS h16x8*)(sl + 640 + 16 * la); }
            float w[8], kk[8], bb[8];
#pragma unroll
            for (int j = 0; j < 8; ++j) { w[j] = __expf((float)cr.ld[j]); kk[j] = (float)cr.kk[j]; bb[j] = (float)cr.bb[j]; }
            float dp[8], dh[8];
#pragma unroll
            for (int i = 0; i < 8; ++i) { float s0 = 0.f, s1 = 0.f;
#pragma unroll
                for (int j = 0; j < 8; ++j) { s0 += SP[i][j] * kk[j]; s1 += SH[i][j] * kk[j]; }
                dp[i] = s0; dh[i] = s1; }
#pragma unroll
            for (int i = 0; i < 8; ++i) { dp[i] = -allred8(dp[i]); dh[i] = -allred8(dh[i]); }
            float qv[8], yv[8];
#pragma unroll
            for (int i = 0; i < 8; ++i) { const float vi = (float)cr.v[i]; float s0 = 0.f, s1 = 0.f;
#pragma unroll
                for (int j = 0; j < 8; ++j) { const float rj = (float)cr.r[j];
                    SP[i][j] = SP[i][j] * w[j] + dp[i] * bb[j]; SH[i][j] = SH[i][j] * w[j] + (dh[i] * bb[j] + vi * (float)cr.km[j]);
                    s0 += SP[i][j] * rj; s1 += SH[i][j] * rj; }
                qv[i] = s0; yv[i] = s1; }
#pragma unroll
            for (int i = 0; i < 8; ++i) { qv[i] = allred8(qv[i]); yv[i] = allred8(yv[i]); }
            if (lb == 0) { h16x8 hq, hy;
#pragma unroll
                for (int i = 0; i < 8; ++i) { hq[i] = (h16)qv[i]; hy[i] = (h16)yv[i]; }
                *(h16x8*)(qo + (size_t)t * 1024) = hq; *(h16x8*)(yo + (size_t)t * 1024) = hy; }
        }
#undef SC_DMA
        asm volatile("s_waitcnt vmcnt(0)" ::: "memory");
        { float* dst = Hm + ((size_t)bh * SC_NC + ch) * 4096 + ((((la >> 1) * 4 + (lb >> 1)) * 64 + 2 * (lb & 1) * 16 + 8 * (la & 1)) * 4);
#pragma unroll
          for (int i = 0; i < 8; ++i)
#pragma unroll
              for (int j = 0; j < 8; ++j) dst[((j >> 2) * 16 + i) * 4 + (j & 3)] = SH[i][j]; }
        { float* dst = Pm + ((size_t)bh * SC_NC + ch) * 4096 + ((((lb >> 1) * 4 + (la >> 1)) * 64 + 2 * (la & 1) * 16 + 8 * (lb & 1)) * 4);
#pragma unroll
          for (int i = 0; i < 8; ++i)
#pragma unroll
              for (int j = 0; j < 8; ++j) dst[((i >> 2) * 16 + j) * 4 + (i & 3)] = SP[i][j]; }
    }
}
typedef short s16x4_t __attribute__((ext_vector_type(4)));
#define P1M_MFMA16(a, b, c) __builtin_amdgcn_mfma_f32_16x16x16f16((a), (b), (c), 0, 0, 0)
#define P1M_MFMA32(a, b, c) __builtin_amdgcn_mfma_f32_16x16x32_f16((a), (b), (c), 0, 0, 0)
__device__ __forceinline__ h16x4 cvt_h4(const f32x4 v) { return (h16x4){(h16)v[0], (h16)v[1], (h16)v[2], (h16)v[3]}; }
__device__ __forceinline__ float row_pfx(float x) {
    x += __int_as_float(__builtin_amdgcn_update_dpp(0, __float_as_int(x), 0x111, 0xF, 0xF, false));
    x += __int_as_float(__builtin_amdgcn_update_dpp(0, __float_as_int(x), 0x112, 0xF, 0xF, false));
    x += __int_as_float(__builtin_amdgcn_update_dpp(0, __float_as_int(x), 0x114, 0xF, 0xF, false));
    x += __int_as_float(__builtin_amdgcn_update_dpp(0, __float_as_int(x), 0x118, 0xF, 0xF, false));
    return x; }
__device__ __forceinline__ float row_sum16(float x) {
    x = DPP_ADD(x, 0xB1); x = DPP_ADD(x, 0x4E); x = DPP_ADD(x, 0x141); x = DPP_ADD(x, 0x140); return x; }
#define P1M_TR(dst, addr) asm volatile("ds_read_b64_tr_b16 %0, %1" : "=v"(dst) : "v"(addr) : "memory")
#define P1M_WAITL() do { asm volatile("s_waitcnt lgkmcnt(0)" ::: "memory"); __builtin_amdgcn_sched_barrier(0); } while (0)
__device__ __forceinline__ void phase_scan_p1m(const Ctx& c, KArgs* a) {
    unsigned char* ws = a->ws; const h16* D0 = (const h16*)(ws + OFF_DER); const size_t DS = (size_t)NT * 1024; float* Pm = (float*)(ws + OFF_PM); float* Hm = (float*)(ws + OFF_HM);
    h16* Q16 = (h16*)(ws + OFF_Q16); h16* Y016 = (h16*)(ws + OFF_Y016);
    const int lane = c.lane;
    LAS unsigned char* wl = c.lds + c.wid * 16640;
    const int wb = (int)(uintptr_t)wl;
    constexpr int IMG_KT = 0, IMG_BH = 2048, IMG_KH = 4096, IMG_RT = 6144, IMG_BB = 8192, IMG_KB = 10240, IMG_V = 12288, SM_M = 14336, SM_TT = 15360, SM_NT = 15872;
    constexpr int SM_ARB = IMG_BH, SM_ARK = IMG_BH + 512, SM_GAM = 16384, IMG_RP = IMG_KH, STG_Q = IMG_KT, STG_Y = IMG_RT;
    for (int itk = c.gw; itk < 64 * SC_NC; itk += c.nw) {
        const int bh = itk & 63, ch = itk >> 6, b = bh >> 4, h = bh & 15;
        const size_t tok0 = (size_t)b * SEQ + (size_t)ch * SC_L;
        f32x4 PT[4][4], SHT[4][4];
        { int lz = lane; asm volatile("" : "+v"(lz));
#pragma unroll
          for (int kt = 0; kt < 4; ++kt)
#pragma unroll
              for (int ct = 0; ct < 4; ++ct) { SHT[kt][ct] = (f32x4){0.f, 0.f, 0.f, 0.f};
#pragma unroll
                  for (int rg = 0; rg < 4; ++rg) PT[kt][ct][rg] = (kt == ct && 4 * (lz >> 4) + rg == (lz & 15)) ? 1.f : 0.f; } }
#pragma unroll 1
        for (int sc = 0; sc < SC_L / 16; ++sc) {
            int lq = lane; asm volatile("" : "+v"(lq)); const int r16 = lq & 15, gq = lq >> 4;
            const size_t go = (tok0 + 16 * sc + r16) * 1024 + h * 64 + 16 * gq;
            { const h16x8 v0 = *(const h16x8*)(D0 + 5 * DS + go), v1 = *(const h16x8*)(D0 + 5 * DS + go + 8);
              *(LAS h16x8*)(wl + IMG_V + gq * 512 + r16 * 32) = v0; *(LAS h16x8*)(wl + IMG_V + gq * 512 + r16 * 32 + 16) = v1; }
#pragma unroll
            for (int p = 0; p < 2; ++p) { float ep[8], em[8], ex[8], eb[8];
                { const h16x8 a0 = *(const h16x8*)(D0 + go + 8 * p);
#pragma unroll
                  for (int e = 0; e < 8; ++e) { const float ld = (float)a0[e]; const float lw = row_pfx(ld), tot = row_sum16(ld); if (r16 == 15) *(LAS float*)(wl + SM_GAM + (16 * gq + 8 * p + e) * 4) = __expf(tot);
                      ep[e] = __expf(lw); em[e] = __expf(-lw); ex[e] = __expf(lw - ld); eb[e] = __expf(tot - lw); } }
                const int io = gq * 512 + r16 * 32 + 16 * p;
                { const h16x8 x = *(const h16x8*)(D0 + DS + go + 8 * p); h16x8 o;
#pragma unroll
                  for (int e = 0; e < 8; ++e) o[e] = (h16)((float)x[e] * ex[e]);
                  *(LAS h16x8*)(wl + IMG_KT + io) = o; }
                { const h16x8 x = *(const h16x8*)(D0 + 2 * DS + go + 8 * p); h16x8 o, o2;
#pragma unroll
                  for (int e = 0; e < 8; ++e) { o[e] = (h16)((float)x[e] * em[e]); o2[e] = (h16)((float)x[e] * eb[e]); }
                  *(LAS h16x8*)(wl + IMG_BH + io) = o; *(LAS h16x8*)(wl + IMG_BB + io) = o2; }
                { const h16x8 x = *(const h16x8*)(D0 + 3 * DS + go + 8 * p); h16x8 o, o2;
#pragma unroll
                  for (int e = 0; e < 8; ++e) { o[e] = (h16)((float)x[e] * em[e]); o2[e] = (h16)((float)x[e] * eb[e]); }
                  *(LAS h16x8*)(wl + IMG_KH + io) = o; *(LAS h16x8*)(wl + IMG_KB + io) = o2; }
                { const h16x8 x = *(const h16x8*)(D0 + 4 * DS + go + 8 * p); h16x8 o;
#pragma unroll
                  for (int e = 0; e < 8; ++e) o[e] = (h16)((float)x[e] * ep[e]);
                  *(LAS h16x8*)(wl + IMG_RT + io) = o; } }
            asm volatile("s_waitcnt lgkmcnt(0)" ::: "memory");
            { f32x4 m_ = {0.f, 0.f, 0.f, 0.f}, n_ = m_, rb = m_, rk = m_;
#pragma unroll
              for (int kk2 = 0; kk2 < 2; ++kk2) { const int ro = (2 * kk2 + (gq >> 1)) * 512 + r16 * 32 + (gq & 1) * 16;
                  const h16x8 aK = *(const LAS h16x8*)(wl + IMG_KT + ro), aR = *(const LAS h16x8*)(wl + IMG_RT + ro), bB = *(const LAS h16x8*)(wl + IMG_BH + ro), bK = *(const LAS h16x8*)(wl + IMG_KH + ro);
                  m_ = P1M_MFMA32(aK, bB, m_); n_ = P1M_MFMA32(aK, bK, n_); rb = P1M_MFMA32(aR, bB, rb); rk = P1M_MFMA32(aR, bK, rk); }
              h16x4 nT, rbT, rkT;
#pragma unroll
              for (int rg = 0; rg < 4; ++rg) { const int t = 4 * gq + rg; const bool lo = t > r16, le = t >= r16;
                  *(LAS float*)(wl + SM_M + (t * 16 + r16) * 4) = lo ? m_[rg] : 0.f; nT[rg] = (h16)(lo ? n_[rg] : 0.f); rbT[rg] = (h16)(le ? rb[rg] : 0.f); rkT[rg] = (h16)(le ? rk[rg] : 0.f); }
              *(LAS h16x4*)(wl + SM_NT + r16 * 32 + gq * 8) = nT; *(LAS h16x4*)(wl + SM_ARB + r16 * 32 + gq * 8) = rbT; *(LAS h16x4*)(wl + SM_ARK + r16 * 32 + gq * 8) = rkT;
            }
            asm volatile("s_waitcnt lgkmcnt(0)" ::: "memory");
            { float x[16];
#pragma unroll
              for (int t = 0; t < 16; ++t) { float acc = (t == r16) ? 1.f : 0.f;
#pragma unroll
                  for (int s4 = 0; s4 < (t + 3) / 4; ++s4) { const f32x4 mr = *(const LAS f32x4*)(wl + SM_M + (t * 16 + 4 * s4) * 4);
#pragma unroll
                      for (int e = 0; e < 4; ++e) if (4 * s4 + e < t) acc -= mr[e] * x[4 * s4 + e]; }
                  x[t] = acc; }
              h16x8 t0, t1;
#pragma unroll
              for (int e = 0; e < 8; ++e) { t0[e] = (h16)x[e]; t1[e] = (h16)x[8 + e]; }
              if (gq == 0) { *(LAS h16x8*)(wl + SM_TT + r16 * 32) = t0; *(LAS h16x8*)(wl + SM_TT + r16 * 32 + 16) = t1; } }
            asm volatile("s_waitcnt lgkmcnt(0)" ::: "memory");
            const int la8 = wb + 8 * lq;
            s16x4_t rT, rN, rArb, rArk, rK[4], rV[4];
            P1M_TR(rT, la8 + SM_TT); P1M_TR(rN, la8 + SM_NT); P1M_TR(rArb, la8 + SM_ARB); P1M_TR(rArk, la8 + SM_ARK);
#pragma unroll
            for (int j4 = 0; j4 < 4; ++j4) { P1M_TR(rK[j4], la8 + IMG_KT + j4 * 512); P1M_TR(rV[j4], la8 + IMG_V + j4 * 512); }
            P1M_WAITL();
            const h16x4 aT = *(h16x4*)&rT, aN = *(h16x4*)&rN, aArb = *(h16x4*)&rArb, aArk = *(h16x4*)&rArk;
            h16x4 kcH[4], zH[4], bV[4];
            const f32x4 zero4 = {0.f, 0.f, 0.f, 0.f};
#pragma unroll
            for (int j4 = 0; j4 < 4; ++j4) { bV[j4] = *(h16x4*)&rV[j4];
                kcH[j4] = cvt_h4(P1M_MFMA16(aT, *(h16x4*)&rK[j4], zero4));
                const h16x4 nvH = cvt_h4(P1M_MFMA16(aN, bV[j4], zero4)); zH[j4] = cvt_h4(P1M_MFMA16(aT, nvH, zero4)); }
            { s16x4_t rR[4];
#pragma unroll
              for (int j4 = 0; j4 < 4; ++j4) P1M_TR(rR[j4], la8 + IMG_RT + j4 * 512);
              P1M_WAITL();
#pragma unroll
              for (int j4 = 0; j4 < 4; ++j4) { const h16x4 rt = *(h16x4*)&rR[j4]; const f32x4 ak = P1M_MFMA16(aArb, kcH[j4], zero4);
                  const f32x4 rp = (f32x4){(float)rt[0], (float)rt[1], (float)rt[2], (float)rt[3]} - ak;
                  *(LAS h16x4*)(wl + IMG_RP + j4 * 512 + r16 * 32 + gq * 8) = cvt_h4(rp); } }
            { s16x4_t rRp[4];
              asm volatile("s_waitcnt lgkmcnt(0)" ::: "memory");
#pragma unroll
              for (int j4 = 0; j4 < 4; ++j4) P1M_TR(rRp[j4], la8 + IMG_RP + j4 * 512);
              P1M_WAITL();
#pragma unroll
              for (int ct = 0; ct < 4; ++ct) { f32x4 qv = zero4, yv = P1M_MFMA16(aArk, bV[ct], zero4) - P1M_MFMA16(aArb, zH[ct], zero4);
#pragma unroll
                  for (int kt = 0; kt < 4; ++kt) { const h16x4 aR = *(h16x4*)&rRp[kt]; qv = P1M_MFMA16(aR, cvt_h4(PT[kt][ct]), qv); yv = P1M_MFMA16(aR, cvt_h4(SHT[kt][ct]), yv); }
#pragma unroll
                  for (int rg = 0; rg < 4; ++rg) { *(LAS h16*)(wl + STG_Q + (4 * gq + rg) * 128 + (16 * ct + r16) * 2) = (h16)qv[rg]; *(LAS h16*)(wl + STG_Y + (4 * gq + rg) * 128 + (16 * ct + r16) * 2) = (h16)yv[rg]; } } }
            { h16x4 GT[4][4];
              s16x4_t rBB[4], rKB[4];
#pragma unroll
              for (int j4 = 0; j4 < 4; ++j4) { P1M_TR(rBB[j4], la8 + IMG_BB + j4 * 512); P1M_TR(rKB[j4], la8 + IMG_KB + j4 * 512); }
              float gdiag[4];
#pragma unroll
              for (int j4 = 0; j4 < 4; ++j4) gdiag[j4] = *(const LAS float*)(wl + SM_GAM + (16 * j4 + r16) * 4);
              P1M_WAITL();
#pragma unroll
              for (int ta = 0; ta < 4; ++ta)
#pragma unroll
                  for (int tb = 0; tb < 4; ++tb) { f32x4 g4 = P1M_MFMA16(kcH[ta], *(h16x4*)&rBB[tb], zero4);
#pragma unroll
                      for (int rg = 0; rg < 4; ++rg) g4[rg] = ((ta == tb && 4 * gq + rg == r16) ? gdiag[tb] : 0.f) - g4[rg];
                      GT[ta][tb] = cvt_h4(g4); }
#pragma unroll
              for (int ct = 0; ct < 4; ++ct) { h16x4 pH[4], sH[4];
#pragma unroll
                  for (int kt = 0; kt < 4; ++kt) { pH[kt] = cvt_h4(PT[kt][ct]); sH[kt] = cvt_h4(SHT[kt][ct]); }
#pragma unroll
                  for (int tb = 0; tb < 4; ++tb) { f32x4 hs = P1M_MFMA16(*(h16x4*)&rKB[tb], bV[ct], zero4) - P1M_MFMA16(*(h16x4*)&rBB[tb], zH[ct], zero4); f32x4 pp = zero4;
#pragma unroll
                      for (int ta = 0; ta < 4; ++ta) { pp = P1M_MFMA16(GT[ta][tb], pH[ta], pp); hs = P1M_MFMA16(GT[ta][tb], sH[ta], hs); }
                      PT[tb][ct] = pp; SHT[tb][ct] = hs; } } }
            asm volatile("s_waitcnt lgkmcnt(0)" ::: "memory");
#pragma unroll
            for (int p = 0; p < 2; ++p) { const int id = lq + 64 * p, row = id >> 3, part = id & 7; const size_t o = (tok0 + 16 * sc + row) * 1024 + h * 64 + part * 8;
                *(h16x8*)(Q16 + o) = *(const LAS h16x8*)(wl + STG_Q + id * 16); *(h16x8*)(Y016 + o) = *(const LAS h16x8*)(wl + STG_Y + id * 16); }
            asm volatile("s_waitcnt lgkmcnt(0)" ::: "memory");
        }
        { int lz = lane; asm volatile("" : "+v"(lz)); const int r16z = lz & 15, gqz = lz >> 4;
          float* hd = Hm + ((size_t)bh * SC_NC + ch) * 4096 + lz * 4; float* pb = Pm + ((size_t)bh * SC_NC + ch) * 4096 + ((r16z >> 2) * 16 + 4 * gqz) * 4 + (r16z & 3);
#pragma unroll
          for (int kt = 0; kt < 4; ++kt)
#pragma unroll
              for (int ct = 0; ct < 4; ++ct) { *(f32x4*)(hd + (ct * 4 + kt) * 256) = SHT[kt][ct];
#pragma unroll
                  for (int rg = 0; rg < 4; ++rg) pb[(kt * 4 + ct) * 256 + rg * 4] = PT[kt][ct][rg]; } }
    }
}

__device__ __forceinline__ void phase_scan_p2(const Ctx& c, KArgs* a) {
    if (c.wid != 0) return;
    unsigned char* ws = a->ws; const float* Pm = (const float*)(ws + OFF_PM); const float* Hm = (const float*)(ws + OFF_HM); float* ST = (float*)(ws + OFF_ST);
    const int lane = c.lane, q = lane >> 4, cc = lane & 15;
    for (int w = blockIdx.x; w < 256; w += gridDim.x) { const int bh = w >> 2, itl = w & 3;
        f32x4 st[4];
#pragma unroll
        for (int jt = 0; jt < 4; ++jt) st[jt] = (f32x4){0.f, 0.f, 0.f, 0.f};
        for (int ch = 0; ch < SC_NC; ++ch) {
            float* sp = ST + ((size_t)bh * SC_NC + ch) * 4096;
#pragma unroll
            for (int jt = 0; jt < 4; ++jt)
#pragma unroll
                for (int rg = 0; rg < 4; ++rg) sp[(16 * jt + 4 * q + rg) * 64 + 16 * itl + cc] = st[jt][rg];
            if (ch == SC_NC - 1) break;
            const float* pp = Pm + ((size_t)bh * SC_NC + ch) * 4096; const float* hp = Hm + ((size_t)bh * SC_NC + ch) * 4096;
            f32x4 nw[4];
#pragma unroll
            for (int jtp = 0; jtp < 4; ++jtp) nw[jtp] = *(const f32x4*)(hp + ((itl * 4 + jtp) * 64 + lane) * 4);
#pragma unroll
            for (int jtp = 0; jtp < 4; ++jtp)
#pragma unroll
                for (int jt = 0; jt < 4; ++jt) { const f32x4 av = *(const f32x4*)(pp + ((jtp * 4 + jt) * 64 + lane) * 4);
                    nw[jtp] = __builtin_amdgcn_mfma_f32_16x16x16f16(cvt_h4(av), cvt_h4(st[jt]), nw[jtp], 0, 0, 0); }
#pragma unroll
            for (int jt = 0; jt < 4; ++jt) st[jt] = nw[jt];
        }
    }
}
__device__ __forceinline__ float red_kq(float x) { x += __shfl_xor(x, 16); x += __shfl_xor(x, 32); return x; }
__device__ __forceinline__ void phase_scan_p3(const Ctx& c, KArgs* a) {
    unsigned char* ws = a->ws; const h16* D0 = (const h16*)(ws + OFF_DER); const size_t DS = (size_t)NT * 1024; const float* ST = (const float*)(ws + OFF_ST);
    const h16* Q16 = (const h16*)(ws + OFF_Q16); const h16* Y016 = (const h16*)(ws + OFF_Y016); const bf16_t* Lb = (const bf16_t*)(ws + OFF_LB); bf16_t* Ym = (bf16_t*)(ws + WS_XN);
    const float* rk = (const float*)a->in[I_RK]; const float* lnw = (const float*)a->in[I_LNW]; const float* lnb = (const float*)a->in[I_LNB];
    const int lane = c.lane, kq = lane >> 4, cc = lane & 15;
    for (int itk = c.gw; itk < 64 * SC_NC; itk += c.nw) {
        const int bh = itk & 63, ch = itk >> 6, b = bh >> 4, h = bh & 15;
        const size_t tok0 = (size_t)b * SEQ + (size_t)ch * SC_L;
        const float* sp = ST + ((size_t)bh * SC_NC + ch) * 4096;
        h16x4 sa[4][4];
#pragma unroll
        for (int itl = 0; itl < 4; ++itl)
#pragma unroll
            for (int s4 = 0; s4 < 4; ++s4)
#pragma unroll
                for (int e = 0; e < 4; ++e) sa[itl][s4][e] = (h16)sp[(16 * s4 + 4 * kq + e) * 64 + 16 * itl + cc];
        float crk[4][4], clw[4][4], clb[4][4];
#pragma unroll
        for (int itl = 0; itl < 4; ++itl)
#pragma unroll
            for (int e = 0; e < 4; ++e) { const int chn = h * 64 + 16 * itl + 4 * kq + e; crk[itl][e] = rk[chn]; clw[itl][e] = lnw[chn]; clb[itl][e] = lnb[chn]; }
#pragma unroll 1
        for (int tt = 0; tt < SC_L / 16; ++tt) { const size_t tok = tok0 + 16 * tt + cc; const size_t ob = tok * 1024 + h * 64 + 4 * kq;
            f32x4 acc[4]; h16x4 qa[4];
#pragma unroll
            for (int s4 = 0; s4 < 4; ++s4) qa[s4] = *(const h16x4*)(Q16 + ob + 16 * s4);
#pragma unroll
            for (int itl = 0; itl < 4; ++itl) { const h16x4 t4 = *(const h16x4*)(Y016 + ob + 16 * itl); acc[itl] = (f32x4){(float)t4[0], (float)t4[1], (float)t4[2], (float)t4[3]}; }
#pragma unroll
            for (int s4 = 0; s4 < 4; ++s4)
#pragma unroll
                for (int itl = 0; itl < 4; ++itl) acc[itl] = __builtin_amdgcn_mfma_f32_16x16x16f16(sa[itl][s4], qa[s4], acc[itl], 0, 0, 0);
            float sm = 0.f, bd = 0.f; h16x4 hv[4]; float g[4][4];
#pragma unroll
            for (int itl = 0; itl < 4; ++itl) { const h16x4 hr = *(const h16x4*)(D0 + 4 * DS + ob + 16 * itl), hk = *(const h16x4*)(D0 + 3 * DS + ob + 16 * itl); hv[itl] = *(const h16x4*)(D0 + 5 * DS + ob + 16 * itl);
                const u32x2 gw = *(const u32x2*)(Lb + tok * LORA_N + 2048 + h * 64 + 4 * kq + 16 * itl); g[itl][0] = bflo(gw.x); g[itl][1] = bfhi(gw.x); g[itl][2] = bflo(gw.y); g[itl][3] = bfhi(gw.y);
#pragma unroll
                for (int e = 0; e < 4; ++e) { sm += acc[itl][e]; bd += (float)hr[e] * (float)hk[e] * crk[itl][e]; } }
            sm = red_kq(sm); bd = red_kq(bd); const float mean = sm * (1.0f / 64.0f); float vs = 0.f;
#pragma unroll
            for (int itl = 0; itl < 4; ++itl)
#pragma unroll
                for (int e = 0; e < 4; ++e) { acc[itl][e] -= mean; vs += acc[itl][e] * acc[itl][e]; }
            vs = red_kq(vs); const float rstd = rsqrtf(vs * (1.0f / 64.0f) + 64e-5f);
#pragma unroll
            for (int itl = 0; itl < 4; ++itl) { float f[4];
#pragma unroll
                for (int e = 0; e < 4; ++e) f[e] = (acc[itl][e] * rstd * clw[itl][e] + clb[itl][e] + bd * (float)hv[itl][e]) * g[itl][e];
                *(unsigned*)((unsigned char*)Ym + (size_t)tok * DM + 1024 + h * 64 + 4 * kq + 16 * itl) = pk_fp8x4(f[0] * 16.0f, f[1] * 16.0f, f[2] * 16.0f, f[3] * 16.0f); }
        }
    }
}

__device__ __forceinline__ void phase_router(const Ctx& c, KArgs* a) {
    unsigned char* ws = a->ws; const float* H = a->out; bf16_t* xn2 = (bf16_t*)(ws + WS_XN); const u32x4* wf = (const u32x4*)(ws + OFF_WRF);
    const float* rbias = (const float*)a->in[I_RBIAS]; float* topw = (float*)(ws + OFF_TOPW); int* list = (int*)(ws + OFF_LIST); int* cnt = (int*)(ws + CTL_CNT);
    const int lane = c.lane, r16 = lane & 15, q = lane >> 4;
    LAS float* lg = (LAS float*)(c.lds) + c.wid * 1088;
    const float bias_e = rbias[lane];
    for (int it = c.gw; it < NT / 16; it += c.nw) { const int tok0 = it * 16;
        f32x4 acc[4];
#pragma unroll
        for (int cc = 0; cc < 4; ++cc) acc[cc] = (f32x4){0.f, 0.f, 0.f, 0.f};
        float ss = 0.f; const float* hp = H + (size_t)(tok0 + r16) * DM + 8 * q;
#pragma unroll 2
        for (int s = 0; s < 64; ++s) { const f32x4 x0 = *(const f32x4*)(hp + 32 * s), x1 = *(const f32x4*)(hp + 32 * s + 4);
            ss += x0[0] * x0[0] + x0[1] * x0[1] + x0[2] * x0[2] + x0[3] * x0[3] + x1[0] * x1[0] + x1[1] * x1[1] + x1[2] * x1[2] + x1[3] * x1[3];
            const u32x4 ahi = pack8(x0, x1); float h[8]; unpack8(ahi, h);
            const u32x4 alo = pack8((f32x4){x0[0] - h[0], x0[1] - h[1], x0[2] - h[2], x0[3] - h[3]}, (f32x4){x1[0] - h[4], x1[1] - h[5], x1[2] - h[6], x1[3] - h[7]});
            const bf16x8 ah = __builtin_bit_cast(bf16x8, ahi), al = __builtin_bit_cast(bf16x8, alo);
            const u32x4* wp = wf + (size_t)s * 512 + lane;
#pragma unroll
            for (int cc = 0; cc < 4; ++cc) { const bf16x8 bh = __builtin_bit_cast(bf16x8, wp[(cc * 2 + 0) * 64]), bl = __builtin_bit_cast(bf16x8, wp[(cc * 2 + 1) * 64]);
                acc[cc] = __builtin_amdgcn_mfma_f32_16x16x32_bf16(ah, bh, acc[cc], 0, 0, 0); acc[cc] = __builtin_amdgcn_mfma_f32_16x16x32_bf16(ah, bl, acc[cc], 0, 0, 0); acc[cc] = __builtin_amdgcn_mfma_f32_16x16x32_bf16(al, bh, acc[cc], 0, 0, 0); } }
        ss += __shfl_xor(ss, 16); ss += __shfl_xor(ss, 32);
        if (q == 0) lg[1024 + r16] = ss;
#pragma unroll
        for (int cc = 0; cc < 4; ++cc)
#pragma unroll
            for (int rg = 0; rg < 4; ++rg) lg[(4 * q + rg) * 64 + 16 * cc + r16] = acc[cc][rg];
        asm volatile("s_waitcnt lgkmcnt(0)" ::: "memory");
#pragma unroll 4
        for (int tt = 0; tt < 16; ++tt) { const int tok = tok0 + tt; const int chunk = tok / CH_TOK, tl = tok % CH_TOK;
            const float rs = rsqrtf(lg[1024 + tt] * (1.0f / DM) + RMS_EPS);
            const float sc = sigmoidf_(lg[tt * 64 + lane] * rs); const float bs = sc + bias_e;
            float m1 = bs; m1 = fmaxf(m1, __shfl_xor(m1, 1)); m1 = fmaxf(m1, __shfl_xor(m1, 2)); m1 = fmaxf(m1, __shfl_xor(m1, 4));
            const unsigned long long eq = __ballot(bs == m1); const unsigned grp = (unsigned)(eq >> (lane & ~7)) & 0xffu; const int first = (lane & ~7) + (__ffs(grp) - 1);
            float m2 = (lane == first) ? -__builtin_inff() : bs; m2 = fmaxf(m2, __shfl_xor(m2, 1)); m2 = fmaxf(m2, __shfl_xor(m2, 2)); m2 = fmaxf(m2, __shfl_xor(m2, 4));
            const float gs = m1 + m2; const int g = lane >> 3; int grank = 0;
#pragma unroll
            for (int gp = 0; gp < 8; ++gp) { const float o = rlane(gs, gp * 8); grank += (o > gs || (o == gs && gp < g)) ? 1 : 0; }
            const float mv = grank < 4 ? bs : -__builtin_inff(); int rank = 0;
#pragma unroll
            for (int e = 0; e < 64; ++e) { const float o = rlane(mv, e); rank += (o > mv || (o == mv && e < lane)) ? 1 : 0; }
            const bool sel = (grank < 4) && (rank < 8);
            const float wsum = wave_sum(sel ? sc : 0.f);
            if (sel) { topw[(size_t)tok * 8 + rank] = sc / wsum * 2.5f;
                const int p = atomicAdd(cnt + chunk * NE1 + lane, 1); list[((size_t)chunk * NE1 + lane) * CH_TOK + p] = tl * 8 + rank; }
        }
        asm volatile("s_waitcnt lgkmcnt(0)" ::: "memory");
        for (int tt = 0; tt < 16; ++tt) rownorm_fp8(H + (size_t)(tok0 + tt) * DM, (unsigned char*)xn2 + (size_t)(tok0 + tt) * DM, lane);
    }
}
__device__ __forceinline__ void phase_expert_weights(const Ctx& c, KArgs* a) {
    unsigned char* ws = a->ws; const float* gf = (const float*)a->in[I_GFFN];
    bf16_t* we1 = (bf16_t*)(ws + OFF_WE1); bf16_t* we2 = (bf16_t*)(ws + OFF_WE2);
    { LAS float* tile = (LAS float*)c.lds; const int n4 = c.tid & 31, kr = c.tid >> 5, sc = c.tid & 7, sn = c.tid >> 3; const int ntile = NE1 * 384;
      const float* wgp = (const float*)a->in[I_WG]; const float* wup = (const float*)a->in[I_WU]; const float* wdp = (const float*)a->in[I_WD];
      const float* sgp = (const float*)a->in[I_SG]; const float* sup = (const float*)a->in[I_SU]; const float* sdp = (const float*)a->in[I_SD];
      f32x4 va[4], vb[4];
#define EW_LOAD(v, T_) do { const int e_ = (T_) / 384, r_ = (T_) % 384; \
        if (r_ < 256) { const int n_ = (r_ >> 5) * 128 + 4 * n4, k0_ = (r_ & 31) * 64, half_ = (n_ >> 7) & 1, cc_ = (n_ >> 8) * 128 + (n_ & 127); \
            const float* sp_ = (e_ < NEXP ? (half_ ? wup : wgp) + (size_t)e_ * 2048 * 512 : (half_ ? sup : sgp)) + cc_; \
            _Pragma("unroll") for (int i = 0; i < 4; ++i) { const int k_ = k0_ + kr + 16 * i; v[i] = *(const f32x4*)(sp_ + (size_t)k_ * 512) * (gf[k_] * 64.0f); } } \
        else { const int t2_ = r_ - 256, n_ = (t2_ >> 3) * 128 + 4 * n4, k0_ = (t2_ & 7) * 64; const float* sp_ = (e_ < NEXP ? wdp + (size_t)e_ * 512 * 2048 : sdp) + n_; \
            _Pragma("unroll") for (int i = 0; i < 4; ++i) v[i] = *(const f32x4*)(sp_ + (size_t)(k0_ + kr + 16 * i) * 2048) * 64.0f; } } while (0)
#define EW_STEP(v, T_) do { \
          _Pragma("unroll") for (int i = 0; i < 4; ++i) _Pragma("unroll") for (int e = 0; e < 4; ++e) tile[(kr + 16 * i) * 129 + 4 * n4 + e] = v[i][e]; \
          __syncthreads(); \
          const int e_ = (T_) / 384, r_ = (T_) % 384; const bool up = r_ < 256; const int t2 = r_ - 256; \
          const int n0 = up ? (r_ >> 5) * 128 : (t2 >> 3) * 128, k0 = up ? (r_ & 31) * 64 : (t2 & 7) * 64, Kd = up ? 2048 : 512; \
          unsigned char* dst = up ? (unsigned char*)we1 + (size_t)e_ * 1024 * 2048 : (unsigned char*)we2 + (size_t)e_ * 2048 * 512; \
          if ((T_) + 2 * (int)gridDim.x < ntile) EW_LOAD(v, (T_) + 2 * (int)gridDim.x); \
          _Pragma("unroll") for (int i = 0; i < 2; ++i) { const int nl = sn + 64 * i; float f[8]; \
              _Pragma("unroll") for (int j = 0; j < 8; ++j) f[j] = tile[(8 * sc + j) * 129 + nl]; \
              u32x2 w8; w8.x = pk_fp8x4(f[0], f[1], f[2], f[3]); w8.y = pk_fp8x4(f[4], f[5], f[6], f[7]); *(u32x2*)(dst + (size_t)(n0 + nl) * Kd + k0 + 8 * sc) = w8; } \
          __syncthreads(); } while (0)
      int T = blockIdx.x; if (T < ntile) EW_LOAD(va, T); if (T + (int)gridDim.x < ntile) EW_LOAD(vb, T + (int)gridDim.x);
      for (; T < ntile; T += 2 * gridDim.x) { EW_STEP(va, T); if (T + (int)gridDim.x < ntile) EW_STEP(vb, T + (int)gridDim.x); }
#undef EW_STEP
#undef EW_LOAD
    }
    { const float* p = (const float*)a->in[I_P]; bf16_t* pb = (bf16_t*)(ws + OFF_PB); const int gt = blockIdx.x * 512 + c.tid, nthr = gridDim.x * 512;
      for (size_t i = gt; i < (size_t)NT * 256 / 4; i += nthr) { const f32x4 v = *(const f32x4*)(p + i * 4); u32x2 w; w.x = cvt_pk_bf16(v[0], v[1]); w.y = cvt_pk_bf16(v[2], v[3]); *(u32x2*)(pb + i * 4) = w; } }
}
__device__ __forceinline__ void phase_combine(const Ctx& c, KArgs* a, int chunk) {
    unsigned char* ws = a->ws; float* H = a->out; const bf16_t* Y = (const bf16_t*)(ws + OFF_YPART + (size_t)(chunk & 1) * YPART_BYTES); bf16_t* xn3 = (bf16_t*)(ws + OFF_XN3);
    const int lane = c.lane;
    for (int tl = c.gw; tl < CH_TOK; tl += c.nw) { const int tok = chunk * CH_TOK + tl; float* hp = H + (size_t)tok * DM;
        float v[4][8];
#pragma unroll
        for (int i = 0; i < 4; ++i) { const f32x4 h0 = *(const f32x4*)(hp + (i * 64 + lane) * 8), h1 = *(const f32x4*)(hp + (i * 64 + lane) * 8 + 4);
            v[i][0] = h0[0]; v[i][1] = h0[1]; v[i][2] = h0[2]; v[i][3] = h0[3]; v[i][4] = h1[0]; v[i][5] = h1[1]; v[i][6] = h1[2]; v[i][7] = h1[3]; }
#pragma unroll 3
        for (int k = 0; k < 9; ++k) { const unsigned char* yp = (const unsigned char*)Y + (k < 8 ? (size_t)tl * 8 + k : (size_t)YP_SHARED + tl) * DM;
#pragma unroll
            for (int i = 0; i < 4; ++i) { const u32x2 w8 = *(const u32x2*)(yp + (i * 64 + lane) * 8);
                const auto f0 = __builtin_amdgcn_cvt_pk_f32_fp8((int)w8.x, false), f1 = __builtin_amdgcn_cvt_pk_f32_fp8((int)w8.x, true), f2 = __builtin_amdgcn_cvt_pk_f32_fp8((int)w8.y, false), f3 = __builtin_amdgcn_cvt_pk_f32_fp8((int)w8.y, true);
                v[i][0] += f0[0] * (1.0f / 16.0f); v[i][1] += f0[1] * (1.0f / 16.0f); v[i][2] += f1[0] * (1.0f / 16.0f); v[i][3] += f1[1] * (1.0f / 16.0f);
                v[i][4] += f2[0] * (1.0f / 16.0f); v[i][5] += f2[1] * (1.0f / 16.0f); v[i][6] += f3[0] * (1.0f / 16.0f); v[i][7] += f3[1] * (1.0f / 16.0f); } }
        float ss = 0.f;
#pragma unroll
        for (int i = 0; i < 4; ++i) { *(f32x4*)(hp + (i * 64 + lane) * 8) = (f32x4){v[i][0], v[i][1], v[i][2], v[i][3]}; *(f32x4*)(hp + (i * 64 + lane) * 8 + 4) = (f32x4){v[i][4], v[i][5], v[i][6], v[i][7]};
#pragma unroll
            for (int e = 0; e < 8; ++e) ss += v[i][e] * v[i][e]; }
        ss = wave_sum(ss); const float rs = rsqrtf(ss * (1.0f / DM) + RMS_EPS) * 16.0f; unsigned char* xp = (unsigned char*)xn3 + (size_t)tok * DM;
#pragma unroll
        for (int i = 0; i < 4; ++i) { u32x2 w8; w8.x = pk_fp8x4(v[i][0] * rs, v[i][1] * rs, v[i][2] * rs, v[i][3] * rs); w8.y = pk_fp8x4(v[i][4] * rs, v[i][5] * rs, v[i][6] * rs, v[i][7] * rs);
            *(u32x2*)(xp + (i * 64 + lane) * 8) = w8; } }
}
__device__ __forceinline__ void phase_final(const Ctx& c, KArgs* a, int tok0, int tok1) {
    unsigned char* ws = a->ws; float* H = a->out; const bf16_t* U = (const bf16_t*)(ws + OFF_U); const float* ssq = (const float*)(ws + OFF_SSQU); const float* gp = (const float*)a->in[I_GPOUT];
    const int lane = c.lane;
    for (int tok = tok0 + c.gw; tok < tok1; tok += c.nw) { const float rs = rsqrtf(wave_sum(lane < 32 ? ssq[(size_t)tok * 32 + lane] : 0.f) * (1.0f / DM) + RMS_EPS); float* hp = H + (size_t)tok * DM; const bf16_t* up = U + (size_t)tok * DM;
#pragma unroll
        for (int i = 0; i < 4; ++i) { const int cc = (i * 64 + lane) * 8; f32x4 h0 = *(const f32x4*)(hp + cc), h1 = *(const f32x4*)(hp + cc + 4); const f32x4 g0 = *(const f32x4*)(gp + cc), g1 = *(const f32x4*)(gp + cc + 4);
            float f[8]; unpack8(*(const u32x4*)(up + cc), f);
            h0[0] += f[0] * rs * g0[0]; h0[1] += f[1] * rs * g0[1]; h0[2] += f[2] * rs * g0[2]; h0[3] += f[3] * rs * g0[3];
            h1[0] += f[4] * rs * g1[0]; h1[1] += f[5] * rs * g1[1]; h1[2] += f[6] * rs * g1[2]; h1[3] += f[7] * rs * g1[3];
            *(f32x4*)(hp + cc) = h0; *(f32x4*)(hp + cc + 4) = h1; } }
}

constexpr int LDS_STAGE = pg8::STAGE_BYTES;
constexpr int LDS_MISC = LDS_STAGE;
constexpr int LDS_BYTES = LDS_STAGE + 12288;
enum { PH_PREP = 0, PH_PROJ, PH_UP, PH_FINQK, PH_ATTN, PH_LORA, PH_SCANPREP, PH_SCAN1, PH_SCAN2, PH_SCAN3, PH_WOUT, PH_ROUTER, PH_MOE0  , PH_GATE = PH_MOE0 + 2 + NCHUNK  , PH_FINAL, PH_COUNT };

__device__ __forceinline__ int tile_expert(const LAS int* starts, int t) { int lo = 0, hi = NE1; while (hi - lo > 1) { const int mid = (lo + hi) >> 1; if (starts[mid] <= t) lo = mid; else hi = mid; } return lo; }
__device__ __forceinline__ void moe_tables(const Ctx& c, KArgs* a, bool build_rinfo) {
    LAS int* tb = (LAS int*)(c.lds + LDS_MISC); const int* cnt = (const int*)(a->ws + CTL_CNT);
    __syncthreads();
    for (int i = c.tid; i < NCHUNK * NE1; i += 512) { int v = cnt[i]; v = v < 0 ? 0 : (v > CH_TOK ? CH_TOK : v); tb[512 * (i / NE1) + 72 + (i % NE1)] = v; }
    __syncthreads();
    if (c.wid <= NCHUNK) {
        int n = 0, n64 = 0;
        if (c.wid < NCHUNK) { n = tb[512 * c.wid + 72 + c.lane]; n64 = tb[512 * c.wid + 72 + NEXP]; }
        else { for (int k = 0; k < NCHUNK; ++k) { n += tb[512 * k + 72 + c.lane]; n64 += tb[512 * k + 72 + NEXP]; } }
        const int t = (n + 255) >> 8; int incl = t;
#pragma unroll
        for (int o = 1; o < 64; o <<= 1) { const int v = __shfl_up(incl, o); if (c.lane >= o) incl += v; }
        const int tot = __shfl(incl, 63); LAS int* st = c.wid < NCHUNK ? tb + 512 * c.wid : tb + pg8::GT_INT;
        st[c.lane] = incl - t; if (c.lane == 0) { st[NEXP] = tot; st[NE1] = tot + ((n64 + 255) >> 8); } }
    __syncthreads();
    if (c.tid == 0) { int s = 0; for (int k = 0; k < NCHUNK; ++k) { tb[2048 + k] = s; s += tb[512 * k + NE1]; } tb[2048 + NCHUNK] = s; }
    if (build_rinfo) for (int t = c.tid; t < pg8::GT_MAX; t += 512) if (t < tb[pg8::GT_INT + NE1]) ((LAS unsigned char*)tb)[pg8::GM_BYTE + t] = (unsigned char)tile_expert(tb + pg8::GT_INT, t);
    for (int i = c.tid; i < NCHUNK * MAXT; i += 512) { const int k = i / MAXT, t = i % MAXT; const LAS int* tk = tb + 512 * k; if (t < tk[NE1]) tb[512 * k + 144 + t] = tile_expert(tk, t); }
    __syncthreads();
    if (build_rinfo) {
        int2* ri = (int2*)(a->ws + OFF_RINFO); const int* list = (const int*)(a->ws + OFF_LIST); const float* topw = (const float*)(a->ws + OFF_TOPW);
        const int ntall = tb[2048 + NCHUNK];
        for (int idx = blockIdx.x * 512 + c.tid; idx < ntall * 256; idx += gridDim.x * 512) { const int tg = idx >> 8; int k = 0; while (k + 1 < NCHUNK && tb[2048 + k + 1] <= tg) ++k;
            const LAS int* tk = tb + 512 * k; const int ti = tg - tb[2048 + k], e = tk[144 + ti], pos = (ti - tk[e]) * 256 + (idx & 255); int2 v; v.x = CH_TOK * 8; v.y = 0;
            if (pos < tk[72 + e]) { if (e == NEXP) { v.x = YP_SHARED + pos; v.y = __float_as_int(1.0f / 256.0f); }
                else { const int ent = list[((size_t)k * NE1 + e) * CH_TOK + pos]; v.x = ent; v.y = __float_as_int(topw[(size_t)k * CH_TOK * 8 + ent] * (1.0f / 256.0f)); } }
            ri[idx] = v; }
    }
}

__global__ void __launch_bounds__(512, 2) fwd(Args a_in) {
    extern __shared__ __attribute__((aligned(16))) unsigned char lds_raw[];
    const int G = gridDim.x, bid = blockIdx.x;
#define KARG ({ KArgs* kp_ = (KArgs*)__builtin_amdgcn_kernarg_segment_ptr(); asm volatile("" : "+s"(kp_)); kp_; })
#define XBW ((volatile LAS unsigned*)((LAS unsigned char*)lds_raw + LDS_MISC + 12272))
    { KArgs* k0 = KARG; if (k0->ph_hi - k0->ph_lo > 1) { if (threadIdx.x == 0) { XBW[0] = 0u; XBW[1] = 0u; XBW[2] = 0u; XBW[3] = 0u; } __syncthreads(); (void)xcd_barrier_post((unsigned*)(k0->ws + CTL_BAR), XBW); } }
#define GRID_BAR_NOW() do { KArgs* kb_ = KARG; XcdBarrier bar_; bar_.bar = (unsigned*)(kb_->ws + CTL_BAR); bar_.x = xb_xcc_id(); bar_.st = XBW; xcd_barrier(bar_); } while (0)
#ifndef PROBE_MASK
#define PROBE_MASK 0ull
#endif
#ifndef PROBE_EW
#define PROBE_EW 0
#endif
#define DUP(k) ((int)((PROBE_MASK >> (k)) & 1ull))
#define GRID_BAR(k) do { KArgs* kq_ = KARG; if ((k) + 1 < kq_->ph_hi && kq_->ph_lo <= (k)) GRID_BAR_NOW(); } while (0)
#define PHASE_ARGS KArgs* ap_ = (KArgs*)__builtin_amdgcn_kernarg_segment_ptr(); asm volatile("" : "+s"(ap_)); KArgs* a = ap_; unsigned char* ws = a->ws; (void)ws; Ctx c; { int t_ = threadIdx.x; asm volatile("" : "+v"(t_)); c.tid = t_; } c.lane = c.tid & 63; c.wid = __builtin_amdgcn_readfirstlane(c.tid >> 6); c.gw = blockIdx.x * 8 + c.wid; c.nw = gridDim.x * 8; c.lds = (LAS unsigned char*)lds_raw
#ifndef PH_ONLY
#define PH_ONLY -1
#endif
#define IN(k) ((PH_ONLY < 0 || PH_ONLY == (k) || (PH_ONLY == 100 && (k) >= PH_MOE0 && (k) < PH_GATE)) && KARG->ph_lo <= (k) && (k) < KARG->ph_hi)
    for (int rep_ = 0; rep_ <= DUP(PH_PREP); ++rep_) { if (rep_) GRID_BAR_NOW(); if (IN(PH_PREP)) { PHASE_ARGS; phase_prep(c, a); __syncthreads(); if ((NT / 256) * (ZW / 256) % G == 0) phase_prep_late<2>(c, a, bid, G); else phase_prep_late<0>(c, a, bid, G); }
    } GRID_BAR(PH_PREP);
    for (int rep_ = 0; rep_ <= DUP(PH_PROJ); ++rep_) { if (rep_) GRID_BAR_NOW(); if (IN(PH_PROJ)) {
        { PHASE_ARGS; pg8::Gemm g{(const bf16_t*)(ws + WS_XN), (const bf16_t*)(ws + OFF_WT_RKV), DM, DM, DM}; pg8::DenseOrder S; S.init(NT, ZW - ZC_R, G, bid);
          EpiPlain E{(bf16_t*)(ws + OFF_Z) + ZC_R, ZW}; pg8::gemm_phase(c.lds, g, S, E); }
        { PHASE_ARGS; pg8::Gemm g{(const bf16_t*)a->out, (const bf16_t*)(ws + OFF_WT_IN), DM / 2, DM / 2, DM / 2}; pg8::DenseOrder S; S.init(NT, ZC_R, G, bid);
          EpiProj E{(bf16_t*)(ws + OFF_Z), (float*)(ws + OFF_SSQP)}; pg8::gemm_phase(c.lds, g, S, E); } }
        if (IN(PH_PROJ) && rep_ == 0) { const int nrem = (NT / 256) * (ZC_R / 256) % G; if (nrem > 0 && bid >= nrem) { PHASE_ARGS; phase_prep_late<1>(c, a, bid - nrem, G - nrem); } }
    } GRID_BAR(PH_PROJ);
    for (int rep_ = 0; rep_ <= DUP(PH_UP); ++rep_) { if (rep_) GRID_BAR_NOW(); if (IN(PH_UP)) { PHASE_ARGS;
        { pg8::Gemm g{(const bf16_t*)(ws + OFF_Z), (const bf16_t*)(ws + OFF_WT_UQ), ZW, 512, 512}; pg8::DenseOrder S; S.init(NT, QW, G, bid);
          EpiQup E{(bf16_t*)(ws + OFF_QB), (const float*)(ws + OFF_SSQP)}; pg8::gemm_phase(c.lds, g, S, E); }
        { pg8::Gemm g{(const bf16_t*)(ws + OFF_Z) + 512, (const bf16_t*)(ws + OFF_WT_UKV), ZW, 256, 256}; pg8::DenseOrder S; S.init(NT, 2048, G, bid);
          EpiKV E{(bf16_t*)(ws + OFF_KB), (bf16_t*)(ws + OFF_VB), (const float*)(ws + OFF_SSQP)}; pg8::gemm_phase(c.lds, g, S, E); }
    }
    } GRID_BAR(PH_UP);
    for (int rep_ = 0; rep_ <= DUP(PH_FINQK); ++rep_) { if (rep_) GRID_BAR_NOW(); if (IN(PH_FINQK)) { PHASE_ARGS; phase_finalize_qk(c, a); phase_lora_prep(c, a); }
    } GRID_BAR(PH_FINQK);
    for (int rep_ = 0; rep_ <= DUP(PH_ATTN); ++rep_) { if (rep_) GRID_BAR_NOW(); if (IN(PH_ATTN)) { PHASE_ARGS; phase_attn_v2(c, a); }
    } GRID_BAR(PH_ATTN);
    for (int rep_ = 0; rep_ <= DUP(PH_LORA); ++rep_) { if (rep_) GRID_BAR_NOW(); if (IN(PH_LORA)) { PHASE_ARGS; pg8::Gemm g{(const bf16_t*)(ws + OFF_ALORA), (const bf16_t*)(ws + OFF_WT_LORA), LORA_K, LORA_K, LORA_K}; pg8::DenseOrder S; S.init(NT, LORA_N, G, bid);
        EpiPlain E{(bf16_t*)(ws + OFF_LB), LORA_N}; pg8::gemm_phase(c.lds, g, S, E); }
    } GRID_BAR(PH_LORA);
    for (int rep_ = 0; rep_ <= DUP(PH_SCANPREP); ++rep_) { if (rep_) GRID_BAR_NOW(); if (IN(PH_SCANPREP)) { PHASE_ARGS; phase_scan_prep(c, a); }
    } GRID_BAR(PH_SCANPREP);
    for (int rep_ = 0; rep_ <= DUP(PH_SCAN1); ++rep_) { if (rep_) GRID_BAR_NOW(); if (IN(PH_SCAN1)) { PHASE_ARGS; phase_scan_p1m(c, a); }
    } GRID_BAR(PH_SCAN1);
    for (int rep_ = 0; rep_ <= DUP(PH_SCAN2); ++rep_) { if (rep_) GRID_BAR_NOW(); if (IN(PH_SCAN2)) { PHASE_ARGS; phase_scan_p2(c, a); }
    } GRID_BAR(PH_SCAN2);
    for (int rep_ = 0; rep_ <= DUP(PH_SCAN3); ++rep_) { if (rep_) GRID_BAR_NOW(); if (IN(PH_SCAN3)) { PHASE_ARGS; phase_scan_p3(c, a); }
    } GRID_BAR(PH_SCAN3);
    for (int rep_ = 0; rep_ <= DUP(PH_WOUT); ++rep_) { if (rep_) GRID_BAR_NOW(); if (IN(PH_WOUT)) { PHASE_ARGS; pg8::Gemm g{(const bf16_t*)(ws + WS_XN), (const bf16_t*)(ws + OFF_WT_OUT), DM / 2, DM / 2, DM / 2}; pg8::DenseOrder S; S.init(NT, DM, G, bid);
        EpiWout E{(const float*)a->in[I_X], a->out}; g.noepi = rep_; pg8::gemm_phase(c.lds, g, S, E); }
    } GRID_BAR(PH_WOUT);
    for (int rep_ = 0; rep_ <= DUP(PH_ROUTER); ++rep_) { if (rep_) GRID_BAR_NOW(); if (IN(PH_ROUTER)) { PHASE_ARGS;
        if ((bid >> 3) & 1) { phase_expert_weights(c, a); __syncthreads(); phase_router(c, a); } else { phase_router(c, a); __syncthreads(); phase_expert_weights(c, a); } if (PROBE_EW) { __syncthreads(); phase_expert_weights(c, a); } }
    } GRID_BAR(PH_ROUTER);
    for (int rep_ = 0; rep_ <= DUP(PH_MOE0); ++rep_) { if (rep_) GRID_BAR_NOW(); if (IN(PH_MOE0)) { PHASE_ARGS; moe_tables(c, a, true);
            pg8::Gemm g{(const bf16_t*)(ws + WS_XN), (const bf16_t*)(ws + OFF_WE1), DM / 2, DM / 2, DM / 2};
            pg8::MoeOrderG1 S{(const LAS int*)(c.lds + LDS_MISC), (const int*)(ws + OFF_LIST), G, bid, 1024};
            EpiMoe1 E{(unsigned char*)(ws + OFF_HMID)}; g.noepi = rep_; pg8::gemm_phase(c.lds, g, S, E);
            { pg8::Gemm g2{(const bf16_t*)(ws + OFF_PB), (const bf16_t*)(ws + OFF_WT_PP), 256, 256, 256}; pg8::DenseOrder S2; S2.init(NT, DM, G, bid);
              EpiPlain E2{(bf16_t*)(ws + OFF_PP), DM}; pg8::gemm_phase(c.lds, g2, S2, E2); } }
    } GRID_BAR(PH_MOE0);
#define MOE_DOWN(ch) do { pg8::Gemm g{(const bf16_t*)(ws + OFF_HMID), (const bf16_t*)(ws + OFF_WE2), 256, 256, 256}; \
            pg8::MoeOrder<false> S{(const LAS int*)(c.lds + LDS_MISC), (const int*)(ws + OFF_LIST), 8, G, bid, ch, ch + 1, 2048, 0}; \
            EpiMoe2 E{(unsigned char*)(ws + OFF_YPART + (size_t)((ch) & 1) * YPART_BYTES), (const i32x2*)(ws + OFF_RINFO), a->out, ch, 0}; pg8::gemm_phase(c.lds, g, S, E); } while (0)
    if (IN(PH_MOE0 + 1)) { PHASE_ARGS; MOE_DOWN(0); }
    GRID_BAR(PH_MOE0 + 1);
#define MOE_MERGED(ch) do { if (IN(PH_MOE0 + 1 + ch)) {        \
            if ((bid >> 3) & 1) { { PHASE_ARGS; phase_combine(c, a, ch - 1); } __syncthreads(); { PHASE_ARGS; MOE_DOWN(ch); } } \
            else { { PHASE_ARGS; MOE_DOWN(ch); } __syncthreads(); { PHASE_ARGS; phase_combine(c, a, ch - 1); } } } \
        GRID_BAR(PH_MOE0 + 1 + ch); } while (0)
    static_assert(NCHUNK == 4, "phase program below is written out for four chunks");
    MOE_MERGED(1); MOE_MERGED(2); MOE_MERGED(3);
#define GATE_ROWS(r0, r1) do { PHASE_ARGS; pg8::Gemm g{(const bf16_t*)(ws + OFF_XN3 + (size_t)(r0) * DM), (const bf16_t*)(ws + OFF_WT_PG), DM / 2, DM / 2, DM / 2}; pg8::DenseOrder S; S.init((r1) - (r0), DM, G, bid); \
        EpiGate E{(const bf16_t*)(ws + OFF_PP) + (size_t)(r0) * DM, (const float*)a->in[I_BPG], (bf16_t*)(ws + OFF_U) + (size_t)(r0) * DM, (float*)(ws + OFF_SSQU) + (size_t)(r0) * 32, 0}; pg8::gemm_phase(c.lds, g, S, E); } while (0)
    constexpr int R3 = (NCHUNK - 1) * CH_TOK;
    if (IN(PH_MOE0 + 1 + NCHUNK)) { if ((bid >> 3) & 1) { { PHASE_ARGS; phase_combine(c, a, NCHUNK - 1); } __syncthreads(); GATE_ROWS(0, R3); } else { GATE_ROWS(0, R3); __syncthreads(); { PHASE_ARGS; phase_combine(c, a, NCHUNK - 1); } } }
    GRID_BAR(PH_MOE0 + 1 + NCHUNK);
#undef MOE_MERGED
#undef MOE_DOWN
    if (IN(PH_GATE)) { if ((bid >> 3) & 1) { { PHASE_ARGS; phase_final(c, a, 0, R3); } __syncthreads(); GATE_ROWS(R3, NT); } else { GATE_ROWS(R3, NT); __syncthreads(); { PHASE_ARGS; phase_final(c, a, 0, R3); } } }
    GRID_BAR(PH_GATE);
    if (IN(PH_FINAL)) { PHASE_ARGS; phase_final(c, a, R3, NT); }
#undef GATE_ROWS
#undef IN
}

extern "C" void kernel_launch(void* const* d_in, const int* in_sizes, int n_in, void* d_out, int out_size, void* d_ws, size_t ws_size, hipStream_t stream) {
    static int grid = 0;
    if (grid == 0) {
        if (n_in != 37 || out_size != NT * DM || ws_size < WS_END) { fprintf(stderr, "kernel_launch: unexpected shapes (n_in %d out %d ws %zu need %zu)\n", n_in, out_size, ws_size, (size_t)WS_END); grid = -1; return; }
        int dev = 0, cus = 0;
        if (hipGetDevice(&dev) != hipSuccess || hipDeviceGetAttribute(&cus, hipDeviceAttributeMultiprocessorCount, dev) != hipSuccess) { grid = -1; return; }
        if (hipFuncSetAttribute((const void*)fwd, hipFuncAttributeMaxDynamicSharedMemorySize, LDS_BYTES) != hipSuccess) { fprintf(stderr, "kernel_launch: hipFuncSetAttribute failed\n"); grid = -1; return; }
        int per_cu = 0; (void)hipOccupancyMaxActiveBlocksPerMultiprocessor(&per_cu, (const void*)fwd, 512, LDS_BYTES); (void)hipGetLastError();
        grid = cus;
    }
    if (grid < 0) return;
    (void)hipMemsetAsync((char*)d_ws + WS_CTL, 0, CTL_ZERO_BYTES, stream);
    Args a{};
    for (int i = 0; i < 37; ++i) a.in[i] = d_in[i];
    a.out = (float*)d_out; a.ws = (unsigned char*)d_ws;
#if N_LAUNCH_MODE == 0
    for (int p = 0; p < PH_COUNT; ++p) { a.ph_lo = p; a.ph_hi = p + 1; hipLaunchKernelGGL(fwd, dim3(grid), dim3(512), LDS_BYTES, stream, a); }
#else
    a.ph_lo = 0; a.ph_hi = PH_COUNT; hipLaunchKernelGGL(fwd, dim3(grid), dim3(512), LDS_BYTES, stream, a);
#endif
}
```

```cpp
#include <hip/hip_runtime.h>
#include <hip/hip_bf16.h>
#include <cstdio>
#include <cstdint>

#ifndef N_LAUNCH_MODE
#define N_LAUNCH_MODE 1
#endif

#define LAS __attribute__((address_space(3)))
typedef unsigned short bf16_t;
typedef short bf16x8 __attribute__((ext_vector_type(8)));
typedef float f32x4 __attribute__((ext_vector_type(4)));
typedef float f32x16 __attribute__((ext_vector_type(16)));
typedef unsigned u32x4 __attribute__((ext_vector_type(4)));
typedef unsigned u32x2 __attribute__((ext_vector_type(2)));
typedef int i32x2 __attribute__((ext_vector_type(2)));
#ifndef PROBE_NOSTORE
#define PROBE_NOSTORE 0
#endif
typedef int i32x8 __attribute__((ext_vector_type(8)));
typedef _Float16 h16;
typedef _Float16 h16x8 __attribute__((ext_vector_type(8)));
typedef _Float16 h16x4 __attribute__((ext_vector_type(4)));

constexpr int NT = 32768, DM = 2048, SEQ = 8192, NB = 4;
constexpr int ZW = 4352;
constexpr int ZC_KPE = 768, ZC_WL = 832, ZC_AL = 896, ZC_GL = 960, ZC_R = 1280, ZC_K = 2304, ZC_V = 3328;
constexpr int QW = 1536;
constexpr int LORA_K = 384, LORA_N = 3072;
constexpr int NEXP = 64, NE1 = 65;
constexpr int NCHUNK = 4, CH_TOK = NT / NCHUNK;
static_assert(CH_TOK % 256 == 0, "shared-expert row tiles must have no padding rows");
constexpr int MAXT = CH_TOK * 8 / 256 + 64 + CH_TOK / 256;
constexpr float RMS_EPS = 1e-6f;
constexpr float QSCALE = 0.07216878364870322f * 1.4426950408889634f;

constexpr size_t MiB = 1ull << 20;
constexpr size_t WS_CTL = 0;
constexpr size_t CTL_BAR = 0;
constexpr size_t CTL_CNT = 64 * 1024;
constexpr size_t CTL_ZERO_BYTES = 128 * 1024;
constexpr size_t WS_SMALL = 1 * MiB;
constexpr size_t OFF_WT_IN = WS_SMALL;
constexpr size_t OFF_WT_UQ = OFF_WT_IN + (size_t)ZW * 2048 * 2;
constexpr size_t OFF_WT_UKV = OFF_WT_UQ + (size_t)1536 * 512 * 2;
constexpr size_t OFF_WT_LORA = OFF_WT_UKV + (size_t)2048 * 256 * 2;
constexpr size_t OFF_WT_OUT = OFF_WT_LORA + (size_t)LORA_N * LORA_K * 2;
constexpr size_t OFF_WT_PG = OFF_WT_OUT + (size_t)2048 * 2048 * 2;
constexpr size_t OFF_WT_PP = OFF_WT_PG + (size_t)2048 * 2048 * 2;
constexpr size_t OFF_WT_RKV = OFF_WT_IN + (size_t)1280 * 2048;
constexpr size_t OFF_WRF = OFF_WT_PP + (size_t)2048 * 256 * 2;
constexpr size_t OFF_SSQP = OFF_WRF + (size_t)2048 * 64 * 4;
constexpr size_t OFF_TOPW = OFF_SSQP + (size_t)NT * 12 * 4;
constexpr size_t OFF_LIST = OFF_TOPW + (size_t)NT * 8 * 4;
constexpr size_t OFF_ROPE = OFF_LIST + (size_t)NCHUNK * NE1 * CH_TOK * 4;
constexpr size_t OFF_SMALL_END = OFF_ROPE + (size_t)NT * 64 * 4;
constexpr size_t WS_XN = 64 * MiB;
static_assert(OFF_SMALL_END <= WS_XN, "small region overflow");
constexpr size_t WS_BIG = WS_XN + 128 * MiB;
constexpr size_t OFF_Z = WS_BIG;
constexpr size_t OFF_R1 = OFF_Z + 272 * MiB;
constexpr size_t OFF_QB = OFF_R1;
constexpr size_t OFF_KB = OFF_QB + (size_t)NT * QW * 2;
constexpr size_t OFF_VB = OFF_KB + (size_t)NT * QW * 2;
constexpr size_t OFF_ALORA = OFF_R1 + 256 * MiB;
constexpr size_t OFF_LB = OFF_R1;
constexpr size_t OFF_DER = OFF_R1 + 256 * MiB;
constexpr size_t DER_STRIDE = (size_t)NT * 1024 * 2;
constexpr size_t OFF_MIX_END = OFF_DER + 6 * DER_STRIDE;
constexpr size_t OFF_WE1 = WS_BIG;
constexpr size_t OFF_WE2 = OFF_WE1 + (size_t)NE1 * 1024 * 2048;
constexpr size_t OFF_XN3 = WS_XN + 64 * MiB;
constexpr size_t OFF_HMID = OFF_WE2 + (size_t)NE1 * 2048 * 512;
constexpr size_t OFF_YPART = OFF_HMID + (size_t)NCHUNK * MAXT * 256 * 512;
constexpr int YP_SHARED = CH_TOK * 8 + 16;
constexpr size_t YPART_BYTES = (size_t)(CH_TOK * 9 + 16) * 2048;
constexpr size_t OFF_PB = OFF_YPART + 2 * YPART_BYTES;
constexpr size_t OFF_PP = OFF_PB + (size_t)NT * 256 * 2;
constexpr size_t OFF_U = OFF_PP + (size_t)NT * 2048 * 2;
constexpr size_t OFF_SSQU = OFF_U + (size_t)NT * 2048 * 2;
constexpr size_t OFF_RINFO = OFF_SSQU + (size_t)NT * 32 * 4;
constexpr size_t OFF_MOE_END = OFF_RINFO + (size_t)NCHUNK * MAXT * 256 * 8;
constexpr size_t WS_END = (OFF_MIX_END > OFF_MOE_END ? OFF_MIX_END : OFF_MOE_END);
static_assert(WS_END <= 1140 * MiB, "workspace budget");

__device__ __forceinline__ unsigned cvt_pk_bf16(float lo, float hi) { unsigned r; asm volatile("v_cvt_pk_bf16_f32 %0, %1, %2" : "=v"(r) : "v"(lo), "v"(hi)); return r; }
__device__ __forceinline__ bf16_t f2bf(float f) { return (bf16_t)(cvt_pk_bf16(f, 0.f) & 0xffffu); }
__device__ __forceinline__ float bf2f(bf16_t b) { return __uint_as_float(((unsigned)b) << 16); }
__device__ __forceinline__ float bflo(unsigned w) { return __uint_as_float(w << 16); }
__device__ __forceinline__ float bfhi(unsigned w) { return __uint_as_float(w & 0xffff0000u); }
__device__ __forceinline__ u32x4 pack8(f32x4 a, f32x4 b) { return (u32x4){cvt_pk_bf16(a[0], a[1]), cvt_pk_bf16(a[2], a[3]), cvt_pk_bf16(b[0], b[1]), cvt_pk_bf16(b[2], b[3])}; }
__device__ __forceinline__ unsigned pk_fp8x4(float a, float b, float c2, float d) { unsigned w = 0; a = fminf(fmaxf(a, -448.f), 448.f); b = fminf(fmaxf(b, -448.f), 448.f); c2 = fminf(fmaxf(c2, -448.f), 448.f); d = fminf(fmaxf(d, -448.f), 448.f); w = __builtin_amdgcn_cvt_pk_fp8_f32(a, b, w, false); w = __builtin_amdgcn_cvt_pk_fp8_f32(c2, d, w, true); return w; }
__device__ __forceinline__ void unpack8(const u32x4 w, float (&f)[8]) { f[0] = bflo(w[0]); f[1] = bfhi(w[0]); f[2] = bflo(w[1]); f[3] = bfhi(w[1]); f[4] = bflo(w[2]); f[5] = bfhi(w[2]); f[6] = bflo(w[3]); f[7] = bfhi(w[3]); }
__device__ __forceinline__ u32x4 packf8(const float (&f)[8]) { return (u32x4){cvt_pk_bf16(f[0], f[1]), cvt_pk_bf16(f[2], f[3]), cvt_pk_bf16(f[4], f[5]), cvt_pk_bf16(f[6], f[7])}; }
__device__ __forceinline__ float wave_sum(float v) { for (int o = 32; o >= 1; o >>= 1) v += __shfl_xor(v, o); return v; }
__device__ __forceinline__ float rlane(float x, int j) { return __int_as_float(__builtin_amdgcn_readlane(__float_as_int(x), j)); }
__device__ __forceinline__ float sigmoidf_(float x) { return __builtin_amdgcn_rcpf(1.0f + __builtin_amdgcn_exp2f(-1.44269504f * x)); }

#define DPP_ADD(x, ctrl) ((x) + __int_as_float(__builtin_amdgcn_update_dpp(0, __float_as_int(x), (ctrl), 0xF, 0xF, true)))
__device__ __forceinline__ void reduce8_fq(const float (&s)[8], float& o0, float& o1) {
    float t[4];
#pragma unroll
    for (int i = 0; i < 4; ++i) { auto r = __builtin_amdgcn_permlane32_swap(__float_as_uint(s[i]), __float_as_uint(s[i + 4]), false, false); t[i] = __uint_as_float(r[0]) + __uint_as_float(r[1]); }
    { auto r = __builtin_amdgcn_permlane16_swap(__float_as_uint(t[0]), __float_as_uint(t[2]), false, false); o0 = __uint_as_float(r[0]) + __uint_as_float(r[1]); }
    { auto r = __builtin_amdgcn_permlane16_swap(__float_as_uint(t[1]), __float_as_uint(t[3]), false, false); o1 = __uint_as_float(r[0]) + __uint_as_float(r[1]); }
}
__device__ __forceinline__ float allred8(float x) { x = DPP_ADD(x, 0xB1); x = DPP_ADD(x, 0x4E); x = DPP_ADD(x, 0x141); return x; }

namespace pg8 {
constexpr int BM = 256, BK = 64, HALF = 128, HTB = HALF * BK * 2, STAGE_BYTES = 8 * HTB;
__host__ __device__ __forceinline__ int lds_byte(int r, int c) { const int st = (r >> 4) * 2 + (c >> 5), rr = r & 15, cc = c & 31, ob = rr * 64 + cc * 2; return st * 1024 + (ob ^ (((ob >> 9) & 1) << 5)); }
__host__ __device__ __forceinline__ void stage_rc(int b, int& R, int& C) { const int st = b / 1024, sb = b % 1024, swz = sb ^ (((sb >> 9) & 1) << 5); R = (st >> 1) * 16 + swz / 64; C = (st & 1) * 32 + (swz % 64) / 2; }
__host__ __device__ __forceinline__ int perm32(int rho) { const int n = rho >> 4, i = rho & 15; return 8 * (i >> 2) + 4 * n + (i & 3); }

constexpr int GT_INT = 2624, GM_BYTE = 10760, GT_MAX = 1280;
struct Unit { int pm, pn, e, row0, cnt, chunk, arow, b1, b2, b3; };
struct Gemm { const bf16_t* A; const bf16_t* Bt; int lda, ldb, K; int noepi = 0; };

struct DenseOrder {
    static constexpr bool GATHER = false;
    int nM, nN, nwg, G, c;
    __device__ void init(int M, int N, int G_, int c_) { nM = M / BM; nN = N / BM; nwg = nM * nN; G = G_; c = c_; }
    __device__ bool next(int i, Unit& u) const {
        const long L = (long)i * G + c; if (L >= nwg) return false;
        int wgid = (int)L; { const int q = nwg / 8, r = nwg % 8, xcd = wgid % 8, off = wgid / 8; wgid = (xcd < r ? xcd * (q + 1) : r * (q + 1) + (xcd - r) * q) + off; }
        const int nig = 8 * nN, gid = wgid / nig, fm = gid * 8, gsz = (nM - fm) < 8 ? (nM - fm) : 8;
        u.pm = fm + ((wgid % nig) % gsz); u.pn = (wgid % nig) / gsz; u.e = 0; u.row0 = 0; u.cnt = 0; u.chunk = 0; return true;
    }
    __device__ __forceinline__ unsigned a_base(const Gemm& g, const Unit& u) const { return (unsigned)u.pm * (unsigned)(BM * 2) * (unsigned)g.lda; }
    __device__ __forceinline__ unsigned b_base(const Gemm& g, const Unit& u) const { return (unsigned)u.pn * (unsigned)(BM * 2) * (unsigned)g.ldb; }
    __device__ __forceinline__ unsigned row_off(const Gemm& g, const Unit& u, int lr) const { return (unsigned)lr * (unsigned)g.lda * 2u; }
};

template <bool GATHER_> struct MoeOrder {
    static constexpr bool GATHER = GATHER_;
    const LAS int* tab; const int* list; int ncol, G, c, c0, c1, nb_rows, skip_shared;
    __device__ bool next(int i, Unit& u) const {
        const int t0 = __builtin_amdgcn_readfirstlane(tab[2048 + c0]); int ntile = __builtin_amdgcn_readfirstlane(tab[2048 + c1]) - t0; if (skip_shared) ntile = __builtin_amdgcn_readfirstlane(tab[512 * c0 + NEXP]); int ti, pn;
        if (G == 256) { const int x = c & 7, slot = c >> 3, rt = 32 / ncol; ti = i * 8 * rt + x * rt + slot / ncol; pn = slot % ncol; if (ti >= ntile) return false; }
        else { const int L = i * G + c; if (L >= ntile * ncol) return false; ti = L / ncol; pn = L % ncol; }
        const int tg = t0 + ti; int k = c0; while (k + 1 < c1 && __builtin_amdgcn_readfirstlane(tab[2048 + k + 1]) <= tg) ++k;
        const int tl = tg - __builtin_amdgcn_readfirstlane(tab[2048 + k]); const LAS int* tk = tab + 512 * k;
        const int e = __builtin_amdgcn_readfirstlane(tk[144 + tl]);
        u.pm = tg; u.pn = pn; u.e = e; u.chunk = k; u.row0 = __builtin_amdgcn_readfirstlane((tl - tk[e]) * BM); u.cnt = __builtin_amdgcn_readfirstlane(tk[72 + e]);
        if (!GATHER) { int pc = 0; for (int kk = 0; kk < k; ++kk) pc += __builtin_amdgcn_readfirstlane(tab[512 * kk + 72 + e]);
            u.arow = __builtin_amdgcn_readfirstlane(tab[GT_INT + e]) * BM + pc + u.row0; }
        return true;
    }
    __device__ __forceinline__ unsigned a_base(const Gemm& g, const Unit& u) const { return GATHER ? 0u : (unsigned)u.arow * 2u * (unsigned)g.lda; }
    __device__ __forceinline__ unsigned b_base(const Gemm& g, const Unit& u) const { return ((unsigned)u.e * (unsigned)nb_rows + (unsigned)u.pn * BM) * (unsigned)g.ldb * 2u; }
    __device__ __forceinline__ int row_ent(const Gemm& g, const Unit& u, int lr) const { return 0; }
    __device__ __forceinline__ void prefetch_rows(const Gemm&, const Unit&, int, LAS unsigned char*) const {}
    __device__ __forceinline__ int row_ent_lds(LAS unsigned char*, int) const { return 0; }
    __device__ __forceinline__ unsigned row_fin(const Gemm& g, const Unit& u, int lr, int) const { return row_off(g, u, lr); }
    __device__ __forceinline__ unsigned row_off(const Gemm& g, const Unit& u, int lr) const {
        if (!GATHER) return (unsigned)lr * (unsigned)g.lda * 2u;
        const int pos = u.row0 + lr; int tl = 0;
        if (pos < u.cnt) tl = u.e == NEXP ? pos : (list[((size_t)u.chunk * NE1 + u.e) * CH_TOK + pos] >> 3);
        const unsigned tok = (unsigned)u.chunk * CH_TOK + (unsigned)tl;
        return tok * (unsigned)g.lda * 2u;
    }
};

struct MoeOrderG1 {
    static constexpr bool GATHER = true;
    const LAS int* tab; const int* list; int G, c, nb_rows;
    __device__ bool next(int i, Unit& u) const {
        static_assert(NCHUNK == 4, "chunk boundaries b1..b3");
        const int ntile = __builtin_amdgcn_readfirstlane(tab[GT_INT + NE1]); constexpr int ncol = 4, rt = 32 / ncol; int ti, pn;
        if (G == 256) { const int x = c & 7, slot = c >> 3; ti = i * 8 * rt + x * rt + slot / ncol; pn = slot % ncol; if (ti >= ntile) return false; }
        else { const int L = i * G + c; if (L >= ntile * ncol) return false; ti = L / ncol; pn = L % ncol; }
        const int e = __builtin_amdgcn_readfirstlane((int)((const LAS unsigned char*)tab)[GM_BYTE + ti]);
        const int n0 = __builtin_amdgcn_readfirstlane(tab[72 + e]), n1 = __builtin_amdgcn_readfirstlane(tab[512 + 72 + e]), n2 = __builtin_amdgcn_readfirstlane(tab[1024 + 72 + e]), n3 = __builtin_amdgcn_readfirstlane(tab[1536 + 72 + e]);
        u.pm = ti; u.pn = pn; u.e = e; u.chunk = 0; u.row0 = (ti - __builtin_amdgcn_readfirstlane(tab[GT_INT + e])) * BM; u.b1 = n0; u.b2 = n0 + n1; u.b3 = n0 + n1 + n2; u.cnt = n0 + n1 + n2 + n3; u.arow = 0; return true;
    }
    __device__ __forceinline__ unsigned a_base(const Gemm& g, const Unit& u) const { return 0u; }
    __device__ __forceinline__ unsigned b_base(const Gemm& g, const Unit& u) const { return ((unsigned)u.e * (unsigned)nb_rows + (unsigned)u.pn * BM) * (unsigned)g.ldb * 2u; }
    __device__ __forceinline__ unsigned row_off(const Gemm& g, const Unit& u, int lr) const {
        return row_fin(g, u, lr, row_ent(g, u, lr));
    }
    __device__ __forceinline__ int row_ent(const Gemm& g, const Unit& u, int lr) const {
        const int pos = u.row0 + lr; const bool valid = pos < u.cnt;
        const int k = (pos >= u.b1) + (pos >= u.b2) + (pos >= u.b3); int base = pos >= u.b1 ? u.b1 : 0; base = pos >= u.b2 ? u.b2 : base; base = pos >= u.b3 ? u.b3 : base;
        const int idx = (valid && u.e != NEXP) ? (k * NE1 + u.e) * CH_TOK + (pos - base) : 0;
        return list[idx];
    }
    static constexpr int LDS_GL = STAGE_BYTES + 8448;
    __device__ __forceinline__ void prefetch_rows(const Gemm& g, const Unit& u, int wid, LAS unsigned char* lds) const {
        if (wid < 4) { int l_ = threadIdx.x; asm volatile("" : "+v"(l_)); const int lr = wid * 64 + (l_ & 63);
            const int pos = u.row0 + lr; const bool valid = pos < u.cnt;
            const int k = (pos >= u.b1) + (pos >= u.b2) + (pos >= u.b3); int base = pos >= u.b1 ? u.b1 : 0; base = pos >= u.b2 ? u.b2 : base; base = pos >= u.b3 ? u.b3 : base;
            const int idx = (valid && u.e != NEXP) ? (k * NE1 + u.e) * CH_TOK + (pos - base) : 0;
            const int* gp = list + idx; const unsigned ldsa = (unsigned)(size_t)(lds + LDS_GL + wid * 256);
            asm volatile("s_mov_b32 m0, %0\n\ts_nop 0\n\tglobal_load_lds_dword %1, off" :: "s"(ldsa), "v"(gp) : "memory", "m0"); } }
    __device__ __forceinline__ int row_ent_lds(LAS unsigned char* lds, int lr) const { return *(const LAS int*)(lds + LDS_GL + lr * 4); }
    __device__ __forceinline__ unsigned row_fin(const Gemm& g, const Unit& u, int lr, int ent) const {
        const int pos = u.row0 + lr; const bool valid = pos < u.cnt;
        const int k = (pos >= u.b1) + (pos >= u.b2) + (pos >= u.b3); int base = pos >= u.b1 ? u.b1 : 0; base = pos >= u.b2 ? u.b2 : base; base = pos >= u.b3 ? u.b3 : base;
        const int tl = u.e == NEXP ? pos - base : (ent >> 3);
        const unsigned tok = valid ? (unsigned)k * CH_TOK + (unsigned)tl : 0u;
        return tok * (unsigned)g.lda * 2u;
    }
};

template <class...> using void_t_ = void;
template <class E, class = void> struct EpiScale { static constexpr int A = 0x7f7f7f7f, B = 0x7f7f7f7f; };
template <class E> struct EpiScale<E, void_t_<decltype(E::SCALE_A)>> { static constexpr int A = E::SCALE_A, B = E::SCALE_B; };
template <class Epi, class Sched>
__device__ __forceinline__ void gemm_phase(LAS unsigned char* lds, const Gemm g, const Sched& S, const Epi& E) {
    int tid_ = threadIdx.x; asm volatile("" : "+v"(tid_));
    const int tid = tid_, wid = __builtin_amdgcn_readfirstlane(tid >> 6), lane = tid & 63, wr = wid >> 2, wc = wid & 3, fr = lane & 15, fq = lane >> 4;
    int K_ = g.K; asm volatile("" : "+s"(K_));
    const int K = K_, nt = K / BK;
    int Rr[2]; unsigned cA2[2], voffB[2];
#pragma unroll
    for (int i = 0; i < 2; ++i) { int R, C; stage_rc(tid * 16 + i * 8192, R, C); const int Rb = Epi::PERM == 2 ? (64 * (R >> 5) + 16 * ((R >> 2) & 3) + 4 * ((R >> 4) & 1) + (R & 3)) : Epi::PERM == 1 ? ((R & ~31) + perm32(R & 31)) : R;
        Rr[i] = R; cA2[i] = (unsigned)C * 2u; voffB[i] = (unsigned)(Rb * g.ldb + C) * 2u; }
    const unsigned kstep = (unsigned)(BK * 2);
    const unsigned hstepB = (unsigned)(Epi::PERM == 2 ? 8 : HALF) * (unsigned)g.ldb * 2u;
    const char* const Ab = (const char*)g.A; const char* const Bb = (const char*)g.Bt;
    const unsigned ldsw = (unsigned)wid * 1024u;
    const int aoff = lds_byte(wr * 64 + fr, fq * 8), boff = lds_byte(wc * 32 + fr, fq * 8);
#define PG8_SA(b, h) (((b) * 2 + (h)) * HTB)
#define PG8_SB(b, h) ((4 + (b) * 2 + (h)) * HTB)
#define PG8_STAGE_B(bufoff, gbase, h) do { _Pragma("unroll") for (int _i = 0; _i < 2; ++_i) \
        __builtin_amdgcn_global_load_lds((const unsigned*)(Bb + (size_t)((gbase) + (unsigned)(h) * hstepB + voffB[_i])), (LAS unsigned*)(lds + (bufoff) + ldsw + _i * 8192), 16, 0, 0); } while (0)
#define PG8_STAGE_A(bufoff, gbase, V, h) do { _Pragma("unroll") for (int _i = 0; _i < 2; ++_i) \
        __builtin_amdgcn_global_load_lds((const unsigned*)(Ab + (size_t)((gbase) + (V)[h][_i])), (LAS unsigned*)(lds + (bufoff) + ldsw + _i * 8192), 16, 0, 0); } while (0)
#define PG8_LDA(dst, b, h) do { _Pragma("unroll") for (int m = 0; m < 4; ++m) _Pragma("unroll") for (int k = 0; k < 2; ++k) dst[m][k] = *(const LAS bf16x8*)(lds + PG8_SA(b, h) + aoff + m * 2048 + k * 1024); } while (0)
#define PG8_LDB(dst, b, h) do { _Pragma("unroll") for (int n = 0; n < 2; ++n) _Pragma("unroll") for (int k = 0; k < 2; ++k) dst[n][k] = *(const LAS bf16x8*)(lds + PG8_SB(b, h) + boff + n * 2048 + k * 1024); } while (0)
#define PG8_MMA(ai, bj, At, Bt) do { __builtin_amdgcn_s_setprio(1); _Pragma("unroll") for (int m = 0; m < 4; ++m) _Pragma("unroll") for (int n = 0; n < 2; ++n) { \
        if constexpr (Epi::FP8) { i32x8 bv_, av_; { const u32x4 b0_ = *(const u32x4*)&Bt[n][0], b1_ = *(const u32x4*)&Bt[n][1], a0_ = *(const u32x4*)&At[m][0], a1_ = *(const u32x4*)&At[m][1]; \
                bv_ = (i32x8){(int)b0_[0], (int)b0_[1], (int)b0_[2], (int)b0_[3], (int)b1_[0], (int)b1_[1], (int)b1_[2], (int)b1_[3]}; av_ = (i32x8){(int)a0_[0], (int)a0_[1], (int)a0_[2], (int)a0_[3], (int)a1_[0], (int)a1_[1], (int)a1_[2], (int)a1_[3]}; } \
            acc[ai][bj][m][n] = __builtin_amdgcn_mfma_scale_f32_16x16x128_f8f6f4(bv_, av_, acc[ai][bj][m][n], 0, 0, 0, EpiScale<Epi>::A, 0, EpiScale<Epi>::B); } \
        else { _Pragma("unroll") for (int k = 0; k < 2; ++k) acc[ai][bj][m][n] = __builtin_amdgcn_mfma_f32_16x16x32_bf16(Bt[n][k], At[m][k], acc[ai][bj][m][n], 0, 0, 0); } } \
        __builtin_amdgcn_s_setprio(0); } while (0)
#define PG8_WAIT_V(n) asm volatile("s_waitcnt vmcnt(" #n ")" ::: "memory")
#define PG8_WAIT_L(n) asm volatile("s_waitcnt lgkmcnt(" #n ")" ::: "memory")
#define PG8_BAR __builtin_amdgcn_s_barrier()
#define PG8_SCHED __builtin_amdgcn_sched_barrier(0)
#define PG8_ROWS(V, u, FROM_LDS) do { if constexpr (Sched::GATHER) { int ent_[2][2]; \
            _Pragma("unroll") for (int _h = 0; _h < 2; ++_h) _Pragma("unroll") for (int _i = 0; _i < 2; ++_i) ent_[_h][_i] = (FROM_LDS) ? S.row_ent_lds(lds, _h * HALF + Rr[_i]) : S.row_ent(g, (u), _h * HALF + Rr[_i]); \
            asm volatile("" : "+v"(ent_[0][0]), "+v"(ent_[0][1]), "+v"(ent_[1][0]), "+v"(ent_[1][1]));        \
            _Pragma("unroll") for (int _h = 0; _h < 2; ++_h) _Pragma("unroll") for (int _i = 0; _i < 2; ++_i) (V)[_h][_i] = S.row_fin(g, (u), _h * HALF + Rr[_i], ent_[_h][_i]) + cA2[_i]; } \
        else { _Pragma("unroll") for (int _h = 0; _h < 2; ++_h) _Pragma("unroll") for (int _i = 0; _i < 2; ++_i) (V)[_h][_i] = S.row_off(g, (u), _h * HALF + Rr[_i]) + cA2[_i]; } } while (0)
    Unit cur, nxt; int ui = 0;
    if (!S.next(0, cur)) return;
    f32x4 acc[2][2][4][2];
    bf16x8 At[4][2], B0[2][2], B1[2][2];
    unsigned vA[2][2];
    PG8_ROWS(vA, cur, 0);
    unsigned cA = S.a_base(g, cur), cB = S.b_base(g, cur);
    PG8_STAGE_B(PG8_SB(0, 0), cB, 0); PG8_STAGE_A(PG8_SA(0, 0), cA, vA, 0); PG8_STAGE_B(PG8_SB(0, 1), cB, 1); PG8_STAGE_A(PG8_SA(0, 1), cA, vA, 1);
    if (wr == 1) PG8_BAR;
    PG8_WAIT_V(4); PG8_BAR;
    PG8_STAGE_B(PG8_SB(1, 0), cB + kstep, 0); PG8_STAGE_A(PG8_SA(1, 0), cA + kstep, vA, 0); PG8_STAGE_B(PG8_SB(1, 1), cB + kstep, 1);
    PG8_WAIT_V(6); PG8_BAR;
#pragma unroll
    for (int a = 0; a < 2; ++a)
#pragma unroll
        for (int b = 0; b < 2; ++b)
#pragma unroll
            for (int m = 0; m < 4; ++m)
#pragma unroll
                for (int n = 0; n < 2; ++n) acc[a][b][m][n] = (f32x4){0.f, 0.f, 0.f, 0.f};
    for (;;) {
        const bool has_next = S.next(ui + 1, nxt);
        const unsigned nA = has_next ? S.a_base(g, nxt) : cA, nB = has_next ? S.b_base(g, nxt) : cB;
#pragma nounroll
        for (int t = 0; t < nt; t += 2) {
            const bool last = (t == nt - 2);
            if constexpr (Epi::PREFETCH) { if (last) E.prefetch(cur, wid, lds); }
            if constexpr (Sched::GATHER) { if (t == 0 && has_next) S.prefetch_rows(g, nxt, wid, lds); }
            asm volatile("" : "+v"(vA[0][0]), "+v"(vA[0][1]), "+v"(vA[1][0]), "+v"(vA[1][1]), "+v"(voffB[0]), "+v"(voffB[1]));
            const unsigned a1 = cA + (unsigned)(t + 1) * kstep;
            const unsigned a2 = last ? nA : cA + (unsigned)(t + 2) * kstep, b2 = last ? nB : cB + (unsigned)(t + 2) * kstep;
            const unsigned a3 = a2 + kstep, b3 = b2 + kstep;
            PG8_LDB(B0, 0, 0); PG8_SCHED; PG8_LDA(At, 0, 0); PG8_STAGE_A(PG8_SA(1, 1), a1, vA, 1);
            if (Sched::GATHER) { if (last && has_next) PG8_ROWS(vA, nxt, 1); }
            PG8_WAIT_L(8); PG8_BAR; PG8_WAIT_L(0); PG8_MMA(0, 0, At, B0); PG8_BAR; PG8_SCHED;
            PG8_LDB(B1, 0, 1); PG8_STAGE_B(PG8_SB(0, 0), b2, 0);
            PG8_BAR; PG8_WAIT_L(0); PG8_MMA(0, 1, At, B1); PG8_BAR;
            PG8_LDA(At, 0, 1); PG8_STAGE_A(PG8_SA(0, 0), a2, vA, 0);
            PG8_BAR; PG8_WAIT_L(0); PG8_MMA(1, 0, At, B0); PG8_BAR; PG8_SCHED;
            PG8_STAGE_B(PG8_SB(0, 1), b2, 1);
            PG8_WAIT_V(6); PG8_BAR; PG8_MMA(1, 1, At, B1); PG8_BAR;
            PG8_LDB(B0, 1, 0); PG8_SCHED; PG8_LDA(At, 1, 0); PG8_STAGE_A(PG8_SA(0, 1), a2, vA, 1);
            PG8_WAIT_L(8); PG8_BAR; PG8_WAIT_L(0); PG8_MMA(0, 0, At, B0); PG8_BAR; PG8_SCHED;
            PG8_LDB(B1, 1, 1); PG8_STAGE_B(PG8_SB(1, 0), b3, 0);
            PG8_BAR; PG8_WAIT_L(0); PG8_MMA(0, 1, At, B1); PG8_BAR;
            PG8_LDA(At, 1, 1); PG8_STAGE_A(PG8_SA(1, 0), a3, vA, 0);
            PG8_BAR; PG8_WAIT_L(0); PG8_MMA(1, 0, At, B0); PG8_BAR; PG8_SCHED;
            PG8_STAGE_B(PG8_SB(1, 1), b3, 1);
            PG8_WAIT_V(6); PG8_BAR; PG8_MMA(1, 1, At, B1); PG8_BAR;
        }
        { int z_ = 0; asm volatile("" : "+v"(z_));
          if (PROBE_NOSTORE && g.noepi) { asm volatile("" :: "v"(acc[0][0][0][0]), "v"(acc[1][1][3][1]), "v"(acc[0][1][2][1]), "v"(acc[1][0][1][0])); }
          else if constexpr (Epi::PREFETCH) E.epi(acc, cur, wr, wc, fr + z_, fq + z_, lds); else E(acc, cur, wr, wc, fr + z_, fq + z_); }
        if (!has_next) break;
#pragma unroll
        for (int a = 0; a < 2; ++a)
#pragma unroll
            for (int b = 0; b < 2; ++b)
#pragma unroll
                for (int m = 0; m < 4; ++m)
#pragma unroll
                    for (int n = 0; n < 2; ++n) acc[a][b][m][n] = (f32x4){0.f, 0.f, 0.f, 0.f};
        cur = nxt; cA = nA; cB = nB; ++ui;
    }
    PG8_WAIT_V(0);
    if (wr == 0) PG8_BAR;
    PG8_BAR;
#undef PG8_SA
#undef PG8_SB
#undef PG8_STAGE_A
#undef PG8_STAGE_B
#undef PG8_LDA
#undef PG8_LDB
#undef PG8_MMA
#undef PG8_WAIT_V
#undef PG8_WAIT_L
#undef PG8_BAR
#undef PG8_SCHED
#undef PG8_ROWS
}
}
using pg8::Unit;
constexpr int LDS_STAGE_BYTES = pg8::STAGE_BYTES;
typedef f32x4 AccT[2][2][4][2];

struct EpiProj {
    static constexpr int PERM = 1; static constexpr bool FP8 = true, PREFETCH = false;
    static constexpr int SCALE_A = 0x7b7b7b7b, SCALE_B = 0x79797979;
    bf16_t* Z; float* ssqp;
    __device__ __forceinline__ void operator()(const AccT& acc, const Unit& u, int wr, int wc, int fr, int fq) const {
        const int row0 = u.pm * 256 + wr * 64 + fr, col0 = u.pn * 256 + wc * 32 + 8 * fq;
        const bool st = u.pn <= 2; const int slot = u.pn * 4 + wc;
#pragma unroll
        for (int ai = 0; ai < 2; ++ai)
#pragma unroll
            for (int m = 0; m < 4; ++m) { const int row = row0 + ai * 128 + m * 16; bf16_t* rp = Z + (size_t)row * ZW + col0;
#pragma unroll
                for (int bj = 0; bj < 2; ++bj) *(u32x4*)(rp + bj * 128) = pack8(acc[ai][bj][m][0], acc[ai][bj][m][1]); }
        if (st) { float sv[8];
#pragma unroll
            for (int ai = 0; ai < 2; ++ai)
#pragma unroll
                for (int m = 0; m < 4; ++m) { float s = 0.f;
#pragma unroll
                    for (int bj = 0; bj < 2; ++bj) { const f32x4 v0 = acc[ai][bj][m][0], v1 = acc[ai][bj][m][1];
                        s += v0[0] * v0[0] + v0[1] * v0[1] + v0[2] * v0[2] + v0[3] * v0[3] + v1[0] * v1[0] + v1[1] * v1[1] + v1[2] * v1[2] + v1[3] * v1[3]; }
                    sv[ai * 4 + m] = s; }
            float o0, o1; reduce8_fq(sv, o0, o1);
            const int r0 = 2 * fq, r1 = 2 * fq + 1;
            ssqp[(size_t)(row0 + (r0 >> 2) * 128 + (r0 & 3) * 16) * 12 + slot] = o0; ssqp[(size_t)(row0 + (r1 >> 2) * 128 + (r1 & 3) * 16) * 12 + slot] = o1; }
    }
};
struct EpiQup {
    static constexpr int PERM = 1; static constexpr bool FP8 = false, PREFETCH = false;
    bf16_t* Q; const float* ssqp;
    __device__ __forceinline__ void operator()(const AccT& acc, const Unit& u, int wr, int wc, int fr, int fq) const {
        const int row0 = u.pm * 256 + wr * 64 + fr, col0 = u.pn * 256 + wc * 32 + 8 * fq;
        float scv[2][4];
#pragma unroll
        for (int ai = 0; ai < 2; ++ai)
#pragma unroll
            for (int m = 0; m < 4; ++m) { const int row = row0 + ai * 128 + m * 16; const f32x4 p0 = *(const f32x4*)(ssqp + (size_t)row * 12), p1 = *(const f32x4*)(ssqp + (size_t)row * 12 + 4); scv[ai][m] = rsqrtf((((p0[0] + p0[1]) + (p0[2] + p0[3])) + ((p1[0] + p1[1]) + (p1[2] + p1[3]))) * (1.0f / 512.0f) + RMS_EPS); }
#pragma unroll
        for (int ai = 0; ai < 2; ++ai)
#pragma unroll
            for (int m = 0; m < 4; ++m) { const int row = row0 + ai * 128 + m * 16; const float sc = scv[ai][m]; bf16_t* rp = Q + (size_t)row * QW + col0;
#pragma unroll
                for (int bj = 0; bj < 2; ++bj) *(u32x4*)(rp + bj * 128) = pack8(acc[ai][bj][m][0] * sc, acc[ai][bj][m][1] * sc); }
    }
};
struct EpiKV {
    static constexpr int PERM = 1; static constexpr bool FP8 = false, PREFETCH = false;
    bf16_t* Kb; bf16_t* Vb; const float* ssqp;
    __device__ __forceinline__ void operator()(const AccT& acc, const Unit& u, int wr, int wc, int fr, int fq) const {
        const int row0 = u.pm * 256 + wr * 64 + fr, c0 = wc * 32 + 8 * fq;
        float scv[2][4];
#pragma unroll
        for (int ai = 0; ai < 2; ++ai)
#pragma unroll
            for (int m = 0; m < 4; ++m) { const int row = row0 + ai * 128 + m * 16; const f32x4 p2 = *(const f32x4*)(ssqp + (size_t)row * 12 + 8); scv[ai][m] = rsqrtf(((p2[0] + p2[1]) + (p2[2] + p2[3])) * (1.0f / 256.0f) + RMS_EPS); }
#pragma unroll
        for (int ai = 0; ai < 2; ++ai)
#pragma unroll
            for (int m = 0; m < 4; ++m) { const int row = row0 + ai * 128 + m * 16; const float sc = scv[ai][m];
                *(u32x4*)(Kb + (size_t)row * QW + u.pn * 192 + c0) = pack8(acc[ai][0][m][0] * sc, acc[ai][0][m][1] * sc);
                *(u32x4*)(Vb + (size_t)row * 1024 + u.pn * 128 + c0) = pack8(acc[ai][1][m][0] * sc, acc[ai][1][m][1] * sc); }
    }
};
struct EpiPlain {
    static constexpr int PERM = 1; static constexpr bool FP8 = false, PREFETCH = false;
    bf16_t* O; int ld;
    __device__ __forceinline__ void operator()(const AccT& acc, const Unit& u, int wr, int wc, int fr, int fq) const {
        const int row0 = u.pm * 256 + wr * 64 + fr, col0 = u.pn * 256 + wc * 32 + 8 * fq;
#pragma unroll
        for (int ai = 0; ai < 2; ++ai)
#pragma unroll
            for (int m = 0; m < 4; ++m) { bf16_t* rp = O + (size_t)(row0 + ai * 128 + m * 16) * ld + col0;
#pragma unroll
                for (int bj = 0; bj < 2; ++bj) *(u32x4*)(rp + bj * 128) = pack8(acc[ai][bj][m][0], acc[ai][bj][m][1]); }
    }
};
__device__ __forceinline__ bf16_t* hrow(float* out, size_t tok) { return (bf16_t*)((unsigned char*)out + tok * (size_t)(DM * 4) + (size_t)(DM * 2)); }
struct EpiWout {
    static constexpr int PERM = 1; static constexpr bool FP8 = true, PREFETCH = false;
    static constexpr int SCALE_A = 0x7b7b7b7b, SCALE_B = 0x79797979;
    const float* X; float* H;
    __device__ __forceinline__ void operator()(const AccT& acc, const Unit& u, int wr, int wc, int fr, int fq) const {
        const int row0 = u.pm * 256 + wr * 64 + fr, col0 = u.pn * 256 + wc * 32 + 8 * fq;
#pragma unroll
        for (int ai = 0; ai < 2; ++ai) { f32x4 xv[4][2][2];
#pragma unroll
            for (int m = 0; m < 4; ++m)
#pragma unroll
                for (int bj = 0; bj < 2; ++bj)
#pragma unroll
                    for (int n = 0; n < 2; ++n) xv[m][bj][n] = *(const f32x4*)(X + (size_t)(row0 + ai * 128 + m * 16) * DM + col0 + bj * 128 + n * 4);
#pragma unroll
            for (int m = 0; m < 4; ++m)
#pragma unroll
                for (int bj = 0; bj < 2; ++bj) *(u32x4*)(hrow(H, (size_t)(row0 + ai * 128 + m * 16)) + col0 + bj * 128) = pack8(xv[m][bj][0] + acc[ai][bj][m][0], xv[m][bj][1] + acc[ai][bj][m][1]); }
    }
};
struct EpiMoe1 {
    static constexpr int PERM = 1; static constexpr bool FP8 = true, PREFETCH = false;
    unsigned char* Hmid;
    __device__ __forceinline__ void operator()(const AccT& acc, const Unit& u, int wr, int wc, int fr, int fq) const {
        const int row0 = u.pm * 256 + wr * 64 + fr, c0 = u.pn * 128 + wc * 32 + 8 * fq; constexpr float SC = 1.0f / 1024.0f;
#pragma unroll
        for (int ai = 0; ai < 2; ++ai)
#pragma unroll
            for (int m = 0; m < 4; ++m) { float h0[4], h1[4];
#pragma unroll
                for (int j = 0; j < 4; ++j) { const float a0 = acc[ai][0][m][0][j], a1 = acc[ai][0][m][1][j];
                    h0[j] = a0 * acc[ai][1][m][0][j] * (SC * SC * 4.0f) * __builtin_amdgcn_rcpf(1.0f + __builtin_amdgcn_exp2f(a0 * (-SC * 1.44269504f)));
                    h1[j] = a1 * acc[ai][1][m][1][j] * (SC * SC * 4.0f) * __builtin_amdgcn_rcpf(1.0f + __builtin_amdgcn_exp2f(a1 * (-SC * 1.44269504f))); }
                u32x2 w; w.x = pk_fp8x4(h0[0], h0[1], h0[2], h0[3]); w.y = pk_fp8x4(h1[0], h1[1], h1[2], h1[3]);
                *(u32x2*)(Hmid + (size_t)(row0 + ai * 128 + m * 16) * 512 + c0) = w; }
    }
};
struct EpiMoe2 {
    static constexpr int PERM = 2; static constexpr bool FP8 = true, PREFETCH = true;
    static constexpr int LDS_RI = LDS_STAGE_BYTES + 8448;
    unsigned char* Y; const i32x2* rinfo; float* H; int chunk, nostore;
    __device__ __forceinline__ void prefetch(const Unit& u, int wid, LAS unsigned char* lds) const {
        if (wid < 2) { int l_ = threadIdx.x; asm volatile("" : "+v"(l_));
            const unsigned ldsa = (unsigned)(size_t)(lds + LDS_RI + wid * 1024); const i32x2* gb = rinfo + (size_t)u.pm * 256 + wid * 128; const unsigned vo = (unsigned)(l_ & 63) * 16u;
            asm volatile("s_mov_b32 m0, %0\n\ts_nop 0\n\tglobal_load_lds_dwordx4 %1, %2" :: "s"(ldsa), "v"(vo), "s"(gb) : "memory", "m0"); } }
    __device__ __forceinline__ void epi(const AccT& acc, const Unit& u, int wr, int wc, int fr, int fq, LAS unsigned char* lds) const {
        const int lr0 = wr * 64 + fr, col0 = u.pn * 256 + wc * 64 + 16 * fq; const LAS i32x2* rp0 = (const LAS i32x2*)(lds + LDS_RI) + lr0;
        unsigned char* Yl = Y; asm volatile("" : "+s"(Yl));
        {
#pragma unroll
            for (int ai = 0; ai < 2; ++ai)
#pragma unroll
                for (int m = 0; m < 4; ++m) { const i32x2 ri = rp0[ai * 128 + m * 16]; const float w = __int_as_float(ri.y) * 16.0f; unsigned char* rp = Yl + (size_t)ri.x * DM + col0;
                    u32x4 w8;
#pragma unroll
                    for (int bj = 0; bj < 2; ++bj) { const f32x4 y0 = acc[ai][bj][m][0] * w, y1 = acc[ai][bj][m][1] * w;
                        w8[2 * bj] = __builtin_amdgcn_cvt_pk_fp8_f32(y0[2], y0[3], __builtin_amdgcn_cvt_pk_fp8_f32(y0[0], y0[1], 0, false), true);
                        w8[2 * bj + 1] = __builtin_amdgcn_cvt_pk_fp8_f32(y1[2], y1[3], __builtin_amdgcn_cvt_pk_fp8_f32(y1[0], y1[1], 0, false), true); }
                    if (nostore && PROBE_NOSTORE) asm volatile("" :: "v"(w8)); else *(u32x4*)rp = w8; }
        }
    }
};
struct EpiGate {
    static constexpr int PERM = 1; static constexpr bool FP8 = true, PREFETCH = false;
    const bf16_t* PP; const float* bias; bf16_t* U; float* ssq_u; int noepi;
    __device__ __forceinline__ void operator()(const AccT& acc, const Unit& u, int wr, int wc, int fr, int fq) const {
        if (noepi && PROBE_NOSTORE) { asm volatile("" :: "v"(acc[0][0][0][0][0]), "v"(acc[1][1][3][1][3])); return; }
        const int row0 = u.pm * 256 + wr * 64 + fr, col0 = u.pn * 256 + wc * 32 + 8 * fq;
        float ssr[2][4];
#pragma unroll
        for (int ai = 0; ai < 2; ++ai)
#pragma unroll
            for (int m = 0; m < 4; ++m) ssr[ai][m] = 0.f;
        u32x4 ppr[2][2][4];
        f32x4 bb[2][2];
#pragma unroll
        for (int bj = 0; bj < 2; ++bj) { bb[bj][0] = *(const f32x4*)(bias + col0 + bj * 128); bb[bj][1] = *(const f32x4*)(bias + col0 + bj * 128 + 4); }
#pragma unroll
        for (int bj = 0; bj < 2; ++bj) { const f32x4 b0 = bb[bj][0], b1 = bb[bj][1];
#pragma unroll
            for (int ai = 0; ai < 2; ++ai)
#pragma unroll
                for (int m = 0; m < 4; ++m) ppr[bj][ai][m] = *(const u32x4*)(PP + (size_t)(row0 + ai * 128 + m * 16) * DM + col0 + bj * 128);
#pragma unroll
            for (int ai = 0; ai < 2; ++ai)
#pragma unroll
                for (int m = 0; m < 4; ++m) { const size_t off = (size_t)(row0 + ai * 128 + m * 16) * DM + col0 + bj * 128; float pp[8]; unpack8(ppr[bj][ai][m], pp);
                    const f32x4 a0 = acc[ai][bj][m][0] * (1.0f / 1024.0f) + b0, a1 = acc[ai][bj][m][1] * (1.0f / 1024.0f) + b1; float uu[8]; float s = 0.f;
#pragma unroll
                    for (int e = 0; e < 4; ++e) { uu[e] = pp[e] * sigmoidf_(a0[e]); uu[4 + e] = pp[4 + e] * sigmoidf_(a1[e]); }
#pragma unroll
                    for (int e = 0; e < 8; ++e) s += uu[e] * uu[e];
                    *(u32x4*)(U + off) = packf8(uu); ssr[ai][m] += s; } }
        { float sv[8];
#pragma unroll
          for (int r = 0; r < 8; ++r) sv[r] = ssr[r >> 2][r & 3];
          float o0, o1; reduce8_fq(sv, o0, o1); const int r0 = 2 * fq, r1 = 2 * fq + 1;
          ssq_u[(size_t)(row0 + (r0 >> 2) * 128 + (r0 & 3) * 16) * 32 + u.pn * 4 + wc] = o0; ssq_u[(size_t)(row0 + (r1 >> 2) * 128 + (r1 & 3) * 16) * 32 + u.pn * 4 + wc] = o1; }
    }
};

#define XB_TMO      128
#define XB_XCNT(j)  (256  + 64 * (j))
#define XB_XSUB(j)  (1280 + 64 * (j))
#define XB_XGEN(j)  (2304 + 64 * (j))
#define XB_TOP      3328
#define XB_TOPGEN   3392
#define XCD_BAR_WORDS 3456
#define XB_SPIN_CAP (1u << 22)
__device__ __forceinline__ unsigned xb_ld(unsigned* p)              { return __hip_atomic_load(p, __ATOMIC_RELAXED, __HIP_MEMORY_SCOPE_AGENT); }
__device__ __forceinline__ unsigned xb_add(unsigned* p, unsigned v) { return __hip_atomic_fetch_add(p, v, __ATOMIC_RELAXED, __HIP_MEMORY_SCOPE_AGENT); }
__device__ __forceinline__ unsigned xb_xcc_id() { return (unsigned)__builtin_amdgcn_s_getreg((3 << 11) | 20) & 0xFu; }
#define XB_SPIN(cond, bar) do { unsigned _sp = 0; while (cond) { __builtin_amdgcn_s_sleep(1); \
    if ((++_sp & 255u) == 0u) { if (xb_ld(&(bar)[XB_TMO])) break; if (_sp > XB_SPIN_CAP) { atomicAdd(&(bar)[XB_TMO], 1u); break; } } } } while (0)
struct XcdBarrier { unsigned* bar; unsigned x; volatile LAS unsigned* st; };
__device__ __forceinline__ XcdBarrier xcd_barrier_post(unsigned* bar, volatile LAS unsigned* st) {
    XcdBarrier b; b.bar = bar; b.x = xb_xcc_id(); b.st = st;
    if (threadIdx.x == 0) (void)xb_add(&bar[XB_XCNT(b.x)], 1u);
    return b;
}
__device__ __forceinline__ void xcd_barrier_complete(unsigned* bar, unsigned x, unsigned& nloc, unsigned& nx) {
    const unsigned G = gridDim.x * gridDim.y * gridDim.z;
    unsigned sum, cnt, mine, sp = 0u;
    for (;;) {
        sum = 0u; cnt = 0u; mine = 0u;
#pragma unroll
        for (unsigned j = 0; j < 16; ++j) { const unsigned c = xb_ld(&bar[XB_XCNT(j)]); sum += c; cnt += (c > 0u) ? 1u : 0u; mine = (j == x) ? c : mine; }
        if (sum == G) break;
        __builtin_amdgcn_s_sleep(1);
        if ((++sp & 255u) == 0u) { if (xb_ld(&bar[XB_TMO])) break; if (sp > XB_SPIN_CAP) { atomicAdd(&bar[XB_TMO], 1u); break; } }
    }
    nloc = mine > 0u ? mine : 1u; nx = cnt > 0u ? cnt : 1u;
}
__device__ __forceinline__ void xcd_barrier(const XcdBarrier& b) {
    asm volatile("s_waitcnt vmcnt(0)" ::: "memory");
    __syncthreads();
    if (threadIdx.x == 0) {
        unsigned* bar = b.bar;
        __builtin_amdgcn_s_waitcnt(0);
        unsigned nloc = b.st[0], nx = b.st[1];
        if (nloc == 0u) { xcd_barrier_complete(bar, b.x, nloc, nx); b.st[0] = nloc; b.st[1] = nx; }
        const unsigned old = xb_add(&bar[XB_XSUB(b.x)], 1u);
        const unsigned gen = old / nloc;
        if (old + 1u == (gen + 1u) * nloc) {
            __builtin_amdgcn_fence(__ATOMIC_RELEASE, "agent");
            asm volatile("s_waitcnt vmcnt(0)" ::: "memory");
            const unsigned og = xb_add(&bar[XB_TOP], 1u);
            const unsigned tg = og / nx;
            if (og + 1u == (tg + 1u) * nx) xb_add(&bar[XB_TOPGEN], 1u);
            else XB_SPIN(xb_ld(&bar[XB_TOPGEN]) == tg, bar);
            __builtin_amdgcn_fence(__ATOMIC_ACQUIRE, "agent");
            xb_add(&bar[XB_XGEN(b.x)], 1u);
            asm volatile("s_waitcnt vmcnt(0)" ::: "memory");
        } else {
            XB_SPIN(xb_ld(&bar[XB_XGEN(b.x)]) == gen, bar);
            __builtin_amdgcn_fence(__ATOMIC_ACQUIRE, "agent");
            asm volatile("s_waitcnt vmcnt(0)" ::: "memory");
        }
    }
    __syncthreads();
}

struct Args { const void* in[37]; float* out; unsigned char* ws; int ph_lo, ph_hi; };
enum { I_X = 0, I_P, I_POS, I_GMIX, I_WIN, I_GQA, I_WUQ, I_GKVA, I_WUKV, I_GQN, I_GKN, I_MU, I_W0, I_WW2, I_A0, I_AW2, I_GW2, I_KK, I_KA, I_RK, I_LNW, I_LNB,
       I_WOUT, I_GFFN, I_WR, I_RBIAS, I_WG, I_WU, I_WD, I_SG, I_SU, I_SD, I_GPIN, I_WPG, I_BPG, I_WPP, I_GPOUT };

typedef const __attribute__((address_space(4))) Args KArgs;
struct Ctx { int tid, lane, wid, gw, nw; LAS unsigned char* lds; };

__device__ __forceinline__ int in_map(int n) {
    if (n < 832) return n; if (n < 896) return 3904 + (n - 832); if (n < 960) return 3968 + (n - 896); if (n < 1120) return 4032 + (n - 960); if (n < 1280) return -1; return 832 + (n - 1280);
}
template <int MODE, bool OUT8 = false>
__device__ __forceinline__ void convert_weight(const Ctx& c, const float* src0, const float* src1, int ld_src, const float* g, bf16_t* dst, int K, int Nd, int blk, int nblk) {
    LAS float* tile = (LAS float*)c.lds;
    const int tk = K / 64, ntile = tk * (Nd / 128);
    const int n4 = c.tid & 31, kr = c.tid >> 5, sc = c.tid & 7, sn = c.tid >> 3;
    f32x4 v[4];
#define CW_LOAD(t_) do { const int n0_ = ((t_) / tk) * 128, k0_ = ((t_) % tk) * 64, n_ = n0_ + 4 * n4; const float* sp_ = nullptr; \
        if (MODE == 0) sp_ = src0 + n_; \
        if (MODE == 1) { const int cc_ = in_map(n_); sp_ = cc_ >= 0 ? src0 + cc_ : nullptr; } \
        if (MODE == 2) { const int half_ = (n_ >> 7) & 1, cc_ = (n_ >> 8) * 128 + (n_ & 127); sp_ = (half_ ? src1 : src0) + cc_; } \
        _Pragma("unroll") for (int i = 0; i < 4; ++i) { const int k_ = k0_ + kr + 16 * i; v[i] = sp_ ? *(const f32x4*)(sp_ + (size_t)k_ * ld_src) : (f32x4){0.f, 0.f, 0.f, 0.f}; if (g) v[i] *= g[k_]; if (OUT8) v[i] *= 64.0f; } } while (0)
    int t = blk; if (t < ntile) CW_LOAD(t);
    for (; t < ntile; t += nblk) {
#pragma unroll
        for (int i = 0; i < 4; ++i)
#pragma unroll
            for (int e = 0; e < 4; ++e) tile[(kr + 16 * i) * 129 + 4 * n4 + e] = v[i][e];
        __syncthreads();
        const int n0 = (t / tk) * 128, k0 = (t % tk) * 64;
        if (t + nblk < ntile) CW_LOAD(t + nblk);
#pragma unroll
        for (int i = 0; i < 2; ++i) { const int nl = sn + 64 * i; float f[8];
#pragma unroll
            for (int j = 0; j < 8; ++j) f[j] = tile[(8 * sc + j) * 129 + nl];
            if (OUT8) { u32x2 w8; w8.x = pk_fp8x4(f[0], f[1], f[2], f[3]); w8.y = pk_fp8x4(f[4], f[5], f[6], f[7]); *(u32x2*)((unsigned char*)dst + (size_t)(n0 + nl) * K + k0 + 8 * sc) = w8; }
            else *(u32x4*)(dst + (size_t)(n0 + nl) * K + k0 + 8 * sc) = (u32x4){cvt_pk_bf16(f[0], f[1]), cvt_pk_bf16(f[2], f[3]), cvt_pk_bf16(f[4], f[5]), cvt_pk_bf16(f[6], f[7])}; }
        __syncthreads();
    }
#undef CW_LOAD
}

__device__ __forceinline__ void rownorm_bf16(const float* src, bf16_t* dst, int lane) {
    f32x4 v[8]; float ss = 0.f;
#pragma unroll
    for (int i = 0; i < 8; ++i) { v[i] = *(const f32x4*)(src + (i * 64 + lane) * 4); ss += v[i][0] * v[i][0] + v[i][1] * v[i][1] + v[i][2] * v[i][2] + v[i][3] * v[i][3]; }
    ss = wave_sum(ss); const float rs = rsqrtf(ss * (1.0f / DM) + RMS_EPS);
#pragma unroll
    for (int i = 0; i < 8; ++i) { u32x2 w; w.x = cvt_pk_bf16(v[i][0] * rs, v[i][1] * rs); w.y = cvt_pk_bf16(v[i][2] * rs, v[i][3] * rs); *(u32x2*)(dst + (i * 64 + lane) * 4) = w; }
}

__device__ __forceinline__ void rownorm_both(const float* src, bf16_t* dst, unsigned char* dst8, int lane) {
    f32x4 v[8]; float ss = 0.f;
#pragma unroll
    for (int i = 0; i < 8; ++i) { v[i] = *(const f32x4*)(src + (i * 64 + lane) * 4); ss += v[i][0] * v[i][0] + v[i][1] * v[i][1] + v[i][2] * v[i][2] + v[i][3] * v[i][3]; }
    ss = wave_sum(ss); const float rs = rsqrtf(ss * (1.0f / DM) + RMS_EPS), rs8 = rs * 16.0f;
#pragma unroll
    for (int i = 0; i < 8; ++i) { u32x2 w; w.x = cvt_pk_bf16(v[i][0] * rs, v[i][1] * rs); w.y = cvt_pk_bf16(v[i][2] * rs, v[i][3] * rs); *(u32x2*)(dst + (i * 64 + lane) * 4) = w;
        *(unsigned*)(dst8 + (i * 64 + lane) * 4) = pk_fp8x4(v[i][0] * rs8, v[i][1] * rs8, v[i][2] * rs8, v[i][3] * rs8); }
}
__device__ __forceinline__ void rownorm_fp8(const float* src, unsigned char* dst, int lane) {
    f32x4 v[8]; float ss = 0.f;
#pragma unroll
    for (int i = 0; i < 8; ++i) { v[i] = *(const f32x4*)(src + (i * 64 + lane) * 4); ss += v[i][0] * v[i][0] + v[i][1] * v[i][1] + v[i][2] * v[i][2] + v[i][3] * v[i][3]; }
    ss = wave_sum(ss); const float rs = rsqrtf(ss * (1.0f / DM) + RMS_EPS) * 16.0f;
#pragma unroll
    for (int i = 0; i < 8; ++i) *(unsigned*)(dst + (i * 64 + lane) * 4) = pk_fp8x4(v[i][0] * rs, v[i][1] * rs, v[i][2] * rs, v[i][3] * rs);
}
__device__ __forceinline__ void rownorm_fp8_bf(const bf16_t* src, unsigned char* dst, int lane) {
    float v[4][8]; float ss = 0.f;
#pragma unroll
    for (int i = 0; i < 4; ++i) { unpack8(*(const u32x4*)(src + (i * 64 + lane) * 8), v[i]);
#pragma unroll
        for (int e = 0; e < 8; ++e) ss += v[i][e] * v[i][e]; }
    ss = wave_sum(ss); const float rs = rsqrtf(ss * (1.0f / DM) + RMS_EPS) * 16.0f;
#pragma unroll
    for (int i = 0; i < 4; ++i) { u32x2 w8; w8.x = pk_fp8x4(v[i][0] * rs, v[i][1] * rs, v[i][2] * rs, v[i][3] * rs); w8.y = pk_fp8x4(v[i][4] * rs, v[i][5] * rs, v[i][6] * rs, v[i][7] * rs);
        *(u32x2*)(dst + (i * 64 + lane) * 8) = w8; }
}
__device__ __forceinline__ void phase_prep(const Ctx& c, KArgs* a) {
    unsigned char* ws = a->ws;
    { const float* x = (const float*)a->in[I_X]; bf16_t* xn = (bf16_t*)(ws + WS_XN);
      unsigned char* xn8 = (unsigned char*)a->out;
      for (int r = c.gw; r < NT; r += c.nw) rownorm_both(x + (size_t)r * DM, xn + (size_t)r * DM, xn8 + (size_t)r * DM, c.lane); }
    convert_weight<1, true>(c, (const float*)a->in[I_WIN], nullptr, 4192, (const float*)a->in[I_GMIX], (bf16_t*)(ws + OFF_WT_IN), 2048, ZC_R, blockIdx.x, gridDim.x);
    convert_weight<0>(c, (const float*)a->in[I_WIN] + 832, nullptr, 4192, (const float*)a->in[I_GMIX], (bf16_t*)(ws + OFF_WT_RKV), 2048, ZW - ZC_R, blockIdx.x, gridDim.x);
}
template <int PART  >
__device__ __forceinline__ void phase_prep_late(const Ctx& c, KArgs* a, int blk, int nblk) {
    unsigned char* ws = a->ws;
    if (PART != 1) {
    { const int gt = blk * 512 + c.tid, nthr = nblk * 512;
      int* cnt = (int*)(ws + CTL_CNT); for (int i = gt; i < NCHUNK * NE1; i += nthr) cnt[i] = ((i % NE1) == NEXP) ? CH_TOK : 0; }
    { float* rt = (float*)(ws + OFF_ROPE); const int* pos = (const int*)a->in[I_POS]; const int gt = blk * 512 + c.tid, nthr = nblk * 512;
      for (int i = gt; i < NT * 32; i += nthr) { const int tok = i >> 5, fi = i & 31; const float inv_f = (float)exp2(-(double)fi * (13.287712379549449 / 32.0));
          const float ang = (float)pos[tok] * inv_f; double xr = (double)ang; xr -= 6.283185307179586 * rint(xr * 0.15915494309189535); const float rr = (float)xr;
          rt[2 * i] = __cosf(rr); rt[2 * i + 1] = __sinf(rr); } }
    }
    if (PART != 1) { convert_weight<0>(c, (const float*)a->in[I_WUQ], nullptr, 1536, (const float*)a->in[I_GQA], (bf16_t*)(ws + OFF_WT_UQ), 512, 1536, blk, nblk);
    convert_weight<0>(c, (const float*)a->in[I_WUKV], nullptr, 2048, (const float*)a->in[I_GKVA], (bf16_t*)(ws + OFF_WT_UKV), 256, 2048, blk, nblk); }
    if (PART != 0) {
    convert_weight<0, true>(c, (const float*)a->in[I_WOUT], nullptr, 2048, nullptr, (bf16_t*)(ws + OFF_WT_OUT), 2048, 2048, blk, nblk);
    convert_weight<0, true>(c, (const float*)a->in[I_WPG], nullptr, 2048, (const float*)a->in[I_GPIN], (bf16_t*)(ws + OFF_WT_PG), 2048, 2048, blk, nblk);
    convert_weight<0>(c, (const float*)a->in[I_WPP], nullptr, 2048, nullptr, (bf16_t*)(ws + OFF_WT_PP), 256, 2048, blk, nblk); }
    if (PART != 1) {
    { bf16_t* wl = (bf16_t*)(ws + OFF_WT_LORA); const float* ww2 = (const float*)a->in[I_WW2]; const float* aw2 = (const float*)a->in[I_AW2]; const float* gw2 = (const float*)a->in[I_GW2];
      const int gt = blk * 512 + c.tid, nthr = nblk * 512;
      for (int i = gt; i < LORA_N * LORA_K; i += nthr) { const int n = i / LORA_K, k = i % LORA_K; float v = 0.f;
          if (n < 1024) { if (k < 64) v = ww2[k * 1024 + n]; }
          else if (n < 2048) { if (k >= 64 && k < 128) v = aw2[(k - 64) * 1024 + (n - 1024)]; }
          else { if (k >= 128 && k < 288) v = gw2[(k - 128) * 1024 + (n - 2048)]; }
          wl[i] = f2bf(v); } }
    { u32x4* wf = (u32x4*)(ws + OFF_WRF); const float* wr = (const float*)a->in[I_WR]; const float* gf = (const float*)a->in[I_GFFN];
      const int gt = blk * 512 + c.tid, nthr = nblk * 512;
      for (int i = gt; i < 64 * 4 * 64; i += nthr) { const int l = i & 63, cc = (i >> 6) & 3, s = i >> 8; const int k0 = 32 * s + 8 * (l >> 4), n = 16 * cc + (l & 15);
          float w[8], lo[8];
#pragma unroll
          for (int j = 0; j < 8; ++j) w[j] = wr[(k0 + j) * 64 + n] * gf[k0 + j];
          const u32x4 hi = packf8(w); float h[8]; unpack8(hi, h);
#pragma unroll
          for (int j = 0; j < 8; ++j) lo[j] = w[j] - h[j];
          wf[((s * 4 + cc) * 2 + 0) * 64 + l] = hi; wf[((s * 4 + cc) * 2 + 1) * 64 + l] = packf8(lo); } }
    }
}

__device__ __forceinline__ void phase_finalize_qk(const Ctx& c, KArgs* a) {
    unsigned char* ws = a->ws; bf16_t* Qb = (bf16_t*)(ws + OFF_QB); bf16_t* Kb = (bf16_t*)(ws + OFF_KB); const bf16_t* Z = (const bf16_t*)(ws + OFF_Z); const float* rt = (const float*)(ws + OFF_ROPE);
    const float* gqn = (const float*)a->in[I_GQN]; const float* gkn = (const float*)a->in[I_GKN];
    const int lane = c.lane, h = lane >> 3, sx = lane & 7; const bool lowh = sx < 4;
    float gq[3][8], gk[3][8];
#pragma unroll
    for (int p = 0; p < 3; ++p)
#pragma unroll
        for (int e = 0; e < 8; ++e) { gq[p][e] = gqn[64 * p + 8 * sx + e]; gk[p][e] = gkn[64 * p + 8 * sx + e]; }
    for (int tok = c.gw; tok < NT; tok += c.nw) {
        float cs[8], sn[8];
        { const float* rp = rt + (size_t)tok * 64 + 16 * (sx & 3);
#pragma unroll
          for (int e4 = 0; e4 < 4; ++e4) { const f32x4 t4 = *(const f32x4*)(rp + 4 * e4); cs[2 * e4] = t4[0]; sn[2 * e4] = t4[1]; cs[2 * e4 + 1] = t4[2]; sn[2 * e4 + 1] = t4[3]; } }
        bf16_t* qp = Qb + (size_t)tok * QW + h * 192 + 8 * sx; bf16_t* kp = Kb + (size_t)tok * QW + h * 192 + 8 * sx;
        const u32x4 q0 = *(const u32x4*)qp, q1 = *(const u32x4*)(qp + 64), q2 = *(const u32x4*)(qp + 128);
        const u32x4 k0 = *(const u32x4*)kp, k1 = *(const u32x4*)(kp + 64), k2 = *(const u32x4*)(Z + (size_t)tok * ZW + ZC_KPE + 8 * sx);
        float f[3][8];
        unpack8(q0, f[0]); unpack8(q1, f[1]); unpack8(q2, f[2]);
        { float ss = 0.f;
#pragma unroll
          for (int p = 0; p < 3; ++p)
#pragma unroll
              for (int e = 0; e < 8; ++e) ss += f[p][e] * f[p][e];
          ss = allred8(ss); const float rs = rsqrtf(ss * (1.0f / 192.0f) + RMS_EPS) * QSCALE;
#pragma unroll
          for (int p = 0; p < 3; ++p)
#pragma unroll
              for (int e = 0; e < 8; ++e) f[p][e] *= rs * gq[p][e];
#pragma unroll
          for (int e = 0; e < 8; ++e) { const float oth = __shfl_xor(f[2][e], 4); f[2][e] = lowh ? (f[2][e] * cs[e] - oth * sn[e]) : (f[2][e] * cs[e] + oth * sn[e]); }
          *(u32x4*)qp = packf8(f[0]); *(u32x4*)(qp + 64) = packf8(f[1]); *(u32x4*)(qp + 128) = packf8(f[2]); }
        unpack8(k0, f[0]); unpack8(k1, f[1]); unpack8(k2, f[2]);
        { float ss = 0.f;
#pragma unroll
          for (int p = 0; p < 3; ++p)
#pragma unroll
              for (int e = 0; e < 8; ++e) ss += f[p][e] * f[p][e];
          ss = allred8(ss); const float rs = rsqrtf(ss * (1.0f / 192.0f) + RMS_EPS);
#pragma unroll
          for (int p = 0; p < 3; ++p)
#pragma unroll
              for (int e = 0; e < 8; ++e) f[p][e] *= rs * gk[p][e];
#pragma unroll
          for (int e = 0; e < 8; ++e) { const float oth = __shfl_xor(f[2][e], 4); f[2][e] = lowh ? (f[2][e] * cs[e] - oth * sn[e]) : (f[2][e] * cs[e] + oth * sn[e]); }
          *(u32x4*)kp = packf8(f[0]); *(u32x4*)(kp + 64) = packf8(f[1]); *(u32x4*)(kp + 128) = packf8(f[2]); }
    }
}

__device__ __forceinline__ int crow(int r, int hi) { return (r & 3) + 8 * (r >> 2) + 4 * hi; }
__device__ __forceinline__ void phase_attn_v1(const Ctx& c, KArgs* a) {
    unsigned char* ws = a->ws; const bf16_t* Qb = (const bf16_t*)(ws + OFF_QB); const bf16_t* Kb = (const bf16_t*)(ws + OFF_KB); const bf16_t* Vb = (const bf16_t*)(ws + OFF_VB);
    bf16_t* Ym = (bf16_t*)(ws + WS_XN);
    const int lane = c.lane, r32 = lane & 31, hi = lane >> 5;
    for (int it = c.gw; it < 8192; it += c.nw) {
        const int qb = 255 - (it >> 5), bh = it & 31, b = bh >> 3, h = bh & 7, q0 = qb * 32;
        const size_t tb = (size_t)b * SEQ;
        bf16x8 qr[12];
        { const bf16_t* qp = Qb + (tb + q0 + r32) * QW + h * 192 + hi * 8;
#pragma unroll
          for (int d0 = 0; d0 < 12; ++d0) qr[d0] = *(const bf16x8*)(qp + d0 * 16); }
        float m_reg = -1e30f, l_reg = 0.f; f32x16 o[4];
#pragma unroll
        for (int d = 0; d < 4; ++d)
#pragma unroll
            for (int r = 0; r < 16; ++r) o[d][r] = 0.f;
        const int ntile = (q0 + 31) / 64 + 1;
        for (int kt = 0; kt < ntile; ++kt) {
            const int kb = kt * 64;
            f32x16 p0, p1;
#pragma unroll
            for (int r = 0; r < 16; ++r) { p0[r] = 0.f; p1[r] = 0.f; }
            { const bf16_t* kp = Kb + (tb + kb + r32) * QW + h * 192 + hi * 8;
#pragma unroll
              for (int d0 = 0; d0 < 12; ++d0) { const bf16x8 b0 = *(const bf16x8*)(kp + d0 * 16); const bf16x8 b1 = *(const bf16x8*)(kp + (size_t)32 * QW + d0 * 16);
                  p0 = __builtin_amdgcn_mfma_f32_32x32x16_bf16(b0, qr[d0], p0, 0, 0, 0); p1 = __builtin_amdgcn_mfma_f32_32x32x16_bf16(b1, qr[d0], p1, 0, 0, 0); } }
            if (kb + 63 > q0) {
                const int dq = q0 + r32 - kb - 4 * hi; const float NEG = -__builtin_inff();
#pragma unroll
                for (int r = 0; r < 16; ++r) { const int cc = (r & 3) + 8 * (r >> 2); if (dq - cc < 0) p0[r] = NEG; if (dq - cc - 32 < 0) p1[r] = NEG; }
            }
            float pmax = p0[0];
#pragma unroll
            for (int r = 1; r < 16; ++r) pmax = fmaxf(pmax, p0[r]);
#pragma unroll
            for (int r = 0; r < 16; ++r) pmax = fmaxf(pmax, p1[r]);
            pmax = fmaxf(pmax, __shfl_xor(pmax, 32));
            const float mn = fmaxf(m_reg, pmax); const float alpha = __builtin_amdgcn_exp2f(m_reg - mn); m_reg = mn;
            float ps = 0.f;
#pragma unroll
            for (int r = 0; r < 16; ++r) { p0[r] = __builtin_amdgcn_exp2f(p0[r] - mn); p1[r] = __builtin_amdgcn_exp2f(p1[r] - mn); ps += p0[r] + p1[r]; }
            ps += __shfl_xor(ps, 32);
            l_reg = l_reg * alpha + ps;
#pragma unroll
            for (int r = 0; r < 16; ++r) { const float ar = __shfl(alpha, crow(r, hi));
#pragma unroll
                for (int d = 0; d < 4; ++d) o[d][r] *= ar; }
            bf16x8 pa0, pa1, pa2, pa3;
#define PK4(P, B_, OUT) do { unsigned a0 = cvt_pk_bf16(P[B_ + 0], P[B_ + 1]), a1 = cvt_pk_bf16(P[B_ + 2], P[B_ + 3]); \
        unsigned b0 = cvt_pk_bf16(P[B_ + 4], P[B_ + 5]), b1 = cvt_pk_bf16(P[B_ + 6], P[B_ + 7]); \
        auto r0 = __builtin_amdgcn_permlane32_swap(a0, b0, false, false); auto r1 = __builtin_amdgcn_permlane32_swap(a1, b1, false, false); \
        u32x4 w = {r0[0], r1[0], r0[1], r1[1]}; OUT = *reinterpret_cast<bf16x8*>(&w); } while (0)
            PK4(p0, 0, pa0); PK4(p0, 8, pa1); PK4(p1, 0, pa2); PK4(p1, 8, pa3);
#undef PK4
            const bf16_t* vp = Vb + (tb + kb + 8 * hi) * 1024 + h * 128 + r32;
#pragma unroll
            for (int d0 = 0; d0 < 4; ++d0) {
#pragma unroll
                for (int ks = 0; ks < 4; ++ks) { bf16x8 vf;
#pragma unroll
                    for (int j = 0; j < 8; ++j) vf[j] = (short)vp[(size_t)(16 * ks + j) * 1024 + d0 * 32];
                    const bf16x8 pa = ks == 0 ? pa0 : (ks == 1 ? pa1 : (ks == 2 ? pa2 : pa3));
                    o[d0] = __builtin_amdgcn_mfma_f32_32x32x16_bf16(pa, vf, o[d0], 0, 0, 0); } }
        }
        const float li = 1.0f / l_reg;
#pragma unroll
        for (int r = 0; r < 16; ++r) { const int orow = crow(r, hi); const float lr = __shfl(li, orow);
            bf16_t* op = Ym + (tb + q0 + orow) * DM + h * 128 + r32;
#pragma unroll
            for (int d0 = 0; d0 < 4; ++d0) op[d0 * 32] = f2bf(o[d0][r] * lr); }
    }
}

constexpr int AT_SHM_V = 64 * 128 * 2, AT_SHM_K = 64 * 192 * 2, AT_OFF_K = 2 * AT_SHM_V, AT_OFF_WS = AT_OFF_K + 2 * AT_SHM_K;
#define KSWZ192(row, colB) ((row) * 384 + ((colB) ^ (((row) & 7) << 4)))
__device__ __forceinline__ int v_st(int k, int c) { const int kk = (k & ~0xC) | ((k & 4) << 1) | ((k & 8) >> 1); return ((kk >> 3) * 4 + (c >> 5)) * 512 + ((kk & 7) * 32 + (c & 31)) * 2; }
__device__ __forceinline__ int v_rd_base(int lane) { return ((lane & 3) << 3) | (((lane >> 2) & 3) << 6) | (((lane >> 4) & 1) << 5) | (((lane >> 5) & 1) << 8); }
typedef short s16x4 __attribute__((ext_vector_type(4)));
__device__ __forceinline__ void attn_qblock(LAS unsigned char* lds, const bf16_t* Qb, const bf16_t* Kb, const bf16_t* Vb, bf16_t* Ym, int b, int h, int qblk, int tid_in, int wid) {
    int tid = tid_in; asm volatile("" : "+v"(tid));
    const int lane = tid & 63, r32 = lane & 31, hi = lane >> 5;
    const size_t tb = (size_t)b * SEQ; const int q0 = qblk * 256, qlo = q0 + wid * 32;
    LAS unsigned char* V_lds = lds; LAS unsigned char* K_lds = lds + AT_OFF_K;
    LAS float* wsf = (LAS float*)(lds + AT_OFF_WS) + wid * 64;
    bf16x8 qr[12];
    { const bf16_t* qp = Qb + (tb + qlo + r32) * QW + h * 192 + hi * 8;
#pragma unroll
      for (int d0 = 0; d0 < 12; ++d0) qr[d0] = *(const bf16x8*)(qp + d0 * 16); }
    unsigned kgo[3], vgo[2];
#pragma unroll
    for (int i = 0; i < 3; ++i) { const int L = tid + 512 * i, row = L / 24, cB = ((L % 24) * 16) ^ ((row & 7) << 4); kgo[i] = (unsigned)(row * QW * 2 + cB); }
#pragma unroll
    for (int i = 0; i < 2; ++i) { const int L = tid + 512 * i, kk = (L >> 7) * 8 + ((L & 31) >> 2), k = (kk & ~0xC) | ((kk & 4) << 1) | ((kk & 8) >> 1), cc = ((L >> 5) & 3) * 32 + (L & 3) * 8; vgo[i] = (unsigned)(k * 1024 * 2 + cc * 2); }
    const char* Kg = (const char*)(Kb + tb * QW + h * 192); const char* Vg = (const char*)(Vb + tb * 1024 + h * 128);
    const int vb0 = (int)(uintptr_t)V_lds + v_rd_base(lane);
    int kb4[4];
#pragma unroll
    for (int dd = 0; dd < 4; ++dd) kb4[dd] = r32 * 384 + ((dd * 32 + hi * 16) ^ ((r32 & 7) << 4));
    const int NT_ = (q0 + 255) / 64 + 1;
#define AT_STAGE(t_, buf_) do { const size_t gk_ = (size_t)(t_) * 64 * QW * 2, gv_ = (size_t)(t_) * 64 * 1024 * 2; \
        _Pragma("unroll") for (int i = 0; i < 3; ++i) __builtin_amdgcn_global_load_lds((const unsigned*)(Kg + gk_ + kgo[i]), (LAS unsigned*)(K_lds + (buf_) * AT_SHM_K + (512 * i + wid * 64) * 16), 16, 0, 0); \
        _Pragma("unroll") for (int i = 0; i < 2; ++i) __builtin_amdgcn_global_load_lds((const unsigned*)(Vg + gv_ + vgo[i]), (LAS unsigned*)(V_lds + (buf_) * AT_SHM_V + (512 * i + wid * 64) * 16), 16, 0, 0); } while (0)
    __syncthreads();
    AT_STAGE(0, 0);
    float m_reg = -1e30f, l_reg = 0.f; f32x16 o[4];
#pragma unroll
    for (int d = 0; d < 4; ++d)
#pragma unroll
        for (int r = 0; r < 16; ++r) o[d][r] = 0.f;
    for (int t = 0; t < NT_; ++t) {
        const int buf = t & 1, kb = t * 64;
        asm volatile("s_waitcnt vmcnt(0)" ::: "memory"); __syncthreads();
        if (t + 1 < NT_) AT_STAGE(t + 1, buf ^ 1);
        f32x16 p0, p1;
#pragma unroll
        for (int r = 0; r < 16; ++r) { p0[r] = 0.f; p1[r] = 0.f; }
        { const int kab = (int)(uintptr_t)K_lds + buf * AT_SHM_K; const int ka0 = kab + kb4[0], ka1 = kab + kb4[1], ka2 = kab + kb4[2], ka3 = kab + kb4[3];
          bf16x8 kf[3][2];
#define KRD(dst, areg, off) asm volatile("ds_read_b128 %0, %1 offset:%2" : "=&v"(dst) : "v"(areg), "i"(off) : "memory")
#define KRD2(set, d0) do { if (((d0) & 3) == 0) { KRD(kf[set][0], ka0, ((d0) >> 2) * 128); KRD(kf[set][1], ka0, ((d0) >> 2) * 128 + 32 * 384); } \
                           else if (((d0) & 3) == 1) { KRD(kf[set][0], ka1, ((d0) >> 2) * 128); KRD(kf[set][1], ka1, ((d0) >> 2) * 128 + 32 * 384); } \
                           else if (((d0) & 3) == 2) { KRD(kf[set][0], ka2, ((d0) >> 2) * 128); KRD(kf[set][1], ka2, ((d0) >> 2) * 128 + 32 * 384); } \
                           else { KRD(kf[set][0], ka3, ((d0) >> 2) * 128); KRD(kf[set][1], ka3, ((d0) >> 2) * 128 + 32 * 384); } } while (0)
#define KWAIT(n) do { asm volatile("s_waitcnt lgkmcnt(" #n ")" ::: "memory"); __builtin_amdgcn_sched_barrier(0); } while (0)
#define KSTEP(d0, W) do { if ((d0) + 2 < 12) KRD2(((d0) + 2) % 3, (d0) + 2); W; \
              p0 = __builtin_amdgcn_mfma_f32_32x32x16_bf16(kf[(d0) % 3][0], qr[d0], p0, 0, 0, 0); p1 = __builtin_amdgcn_mfma_f32_32x32x16_bf16(kf[(d0) % 3][1], qr[d0], p1, 0, 0, 0); } while (0)
          KRD2(0, 0); KRD2(1, 1);
          KSTEP(0, KWAIT(4)); KSTEP(1, KWAIT(4)); KSTEP(2, KWAIT(4)); KSTEP(3, KWAIT(4)); KSTEP(4, KWAIT(4)); KSTEP(5, KWAIT(4));
          KSTEP(6, KWAIT(4)); KSTEP(7, KWAIT(4)); KSTEP(8, KWAIT(4)); KSTEP(9, KWAIT(4)); KSTEP(10, KWAIT(2)); KSTEP(11, KWAIT(0));
#undef KSTEP
#undef KWAIT
#undef KRD2
#undef KRD
        }
        if (kb + 63 > qlo) { const int dq = qlo + r32 - kb - 4 * hi; const float NEG = -__builtin_inff();
#pragma unroll
            for (int r = 0; r < 16; ++r) { const int cc = (r & 3) + 8 * (r >> 2); if (dq - cc < 0) p0[r] = NEG; if (dq - cc - 32 < 0) p1[r] = NEG; } }
        float pmax = p0[0];
#pragma unroll
        for (int r = 1; r < 16; ++r) pmax = fmaxf(pmax, p0[r]);
#pragma unroll
        for (int r = 0; r < 16; ++r) pmax = fmaxf(pmax, p1[r]);
        { auto rr = __builtin_amdgcn_permlane32_swap(__float_as_uint(pmax), __float_as_uint(pmax), false, false); pmax = fmaxf(__uint_as_float(rr[0]), __uint_as_float(rr[1])); }
        float alpha = 1.f;
        if (!__all(pmax - m_reg <= 11.5f)) { const float mn = fmaxf(m_reg, pmax); alpha = __builtin_amdgcn_exp2f(m_reg - mn); m_reg = mn; }
        float ps = 0.f;
#pragma unroll
        for (int r = 0; r < 16; ++r) { p0[r] = __builtin_amdgcn_exp2f(p0[r] - m_reg); p1[r] = __builtin_amdgcn_exp2f(p1[r] - m_reg); ps += p0[r] + p1[r]; }
        { auto rr = __builtin_amdgcn_permlane32_swap(__float_as_uint(ps), __float_as_uint(ps), false, false); ps = __uint_as_float(rr[0]) + __uint_as_float(rr[1]); }
        l_reg = l_reg * alpha + ps;
        if (__any(alpha < 1.f)) { if (hi == 0) wsf[r32] = alpha; asm volatile("s_waitcnt lgkmcnt(0)" ::: "memory");
#pragma unroll
            for (int r = 0; r < 16; ++r) { const float ar = wsf[crow(r, hi)];
#pragma unroll
                for (int d = 0; d < 4; ++d) o[d][r] *= ar; } }
        bf16x8 pa0, pa1, pa2, pa3;
#define PK4(P, B_, OUT) do { unsigned a0 = cvt_pk_bf16(P[B_ + 0], P[B_ + 1]), a1 = cvt_pk_bf16(P[B_ + 2], P[B_ + 3]); \
        unsigned b0 = cvt_pk_bf16(P[B_ + 4], P[B_ + 5]), b1 = cvt_pk_bf16(P[B_ + 6], P[B_ + 7]); \
        auto r0 = __builtin_amdgcn_permlane32_swap(a0, b0, false, false); auto r1 = __builtin_amdgcn_permlane32_swap(a1, b1, false, false); \
        u32x4 w = {r0[0], r1[0], r0[1], r1[1]}; OUT = *reinterpret_cast<bf16x8*>(&w); } while (0)
        PK4(p0, 0, pa0); PK4(p0, 8, pa1); PK4(p1, 0, pa2); PK4(p1, 8, pa3);
#undef PK4
#define TRRD(dst, off) asm volatile("ds_read_b64_tr_b16 %0, %1 offset:%2" : "=&v"(dst) : "v"(vbb), "i"(off) : "memory")
#define PV_RD(S_, d0) do { constexpr int b_ = (d0) * 512; TRRD(S_##l0, b_); TRRD(S_##h0, b_ + 2048); TRRD(S_##l1, b_ + 4096); TRRD(S_##h1, b_ + 6144); TRRD(S_##l2, b_ + 8192); TRRD(S_##h2, b_ + 10240); TRRD(S_##l3, b_ + 12288); TRRD(S_##h3, b_ + 14336); } while (0)
#define PV_MM(S_, d0) do { \
        o[d0] = __builtin_amdgcn_mfma_f32_32x32x16_bf16(pa0, (bf16x8){S_##l0[0], S_##l0[1], S_##l0[2], S_##l0[3], S_##h0[0], S_##h0[1], S_##h0[2], S_##h0[3]}, o[d0], 0, 0, 0); \
        o[d0] = __builtin_amdgcn_mfma_f32_32x32x16_bf16(pa1, (bf16x8){S_##l1[0], S_##l1[1], S_##l1[2], S_##l1[3], S_##h1[0], S_##h1[1], S_##h1[2], S_##h1[3]}, o[d0], 0, 0, 0); \
        o[d0] = __builtin_amdgcn_mfma_f32_32x32x16_bf16(pa2, (bf16x8){S_##l2[0], S_##l2[1], S_##l2[2], S_##l2[3], S_##h2[0], S_##h2[1], S_##h2[2], S_##h2[3]}, o[d0], 0, 0, 0); \
        o[d0] = __builtin_amdgcn_mfma_f32_32x32x16_bf16(pa3, (bf16x8){S_##l3[0], S_##l3[1], S_##l3[2], S_##l3[3], S_##h3[0], S_##h3[1], S_##h3[2], S_##h3[3]}, o[d0], 0, 0, 0); } while (0)
#define PV_WAIT(n) do { asm volatile("s_waitcnt lgkmcnt(" #n ")" ::: "memory"); __builtin_amdgcn_sched_barrier(0); } while (0)
        { const int vbb = vb0 + buf * AT_SHM_V; s16x4 Al0, Al1, Al2, Al3, Ah0, Ah1, Ah2, Ah3, Bl0, Bl1, Bl2, Bl3, Bh0, Bh1, Bh2, Bh3;
          PV_RD(A, 0); PV_RD(B, 1); PV_WAIT(8); PV_MM(A, 0);
          PV_RD(A, 2); PV_WAIT(8); PV_MM(B, 1);
          PV_RD(B, 3); PV_WAIT(8); PV_MM(A, 2);
          PV_WAIT(0); PV_MM(B, 3); }
#undef PV_RD
#undef PV_MM
#undef PV_WAIT
#undef TRRD
    }
#undef AT_STAGE
    if (hi == 0) wsf[32 + r32] = 1.0f / l_reg;
    asm volatile("s_waitcnt lgkmcnt(0)" ::: "memory");
    int lane_e = lane; asm volatile("" : "+v"(lane_e));
    const int r32e = lane_e & 31, hie = lane_e >> 5;
    unsigned char* Ow = (unsigned char*)Ym + (size_t)(tb + qlo) * DM + h * 128;
#pragma unroll
    for (int r = 0; r < 16; ++r) { const int orow = crow(r, hie); const float li = wsf[32 + orow] * 16.0f;
#pragma unroll
        for (int d0 = 0; d0 < 4; ++d0) { const float v = o[d0][r] * li; const float v1 = __shfl_xor(v, 1), v2 = __shfl_xor(v, 2), v3 = __shfl_xor(v1, 2);
            if ((r32e & 3) == 0) *(unsigned*)(Ow + (size_t)orow * DM + d0 * 32 + r32e) = pk_fp8x4(v, v1, v2, v3); } }
}
__device__ __forceinline__ void phase_attn_v2(const Ctx& c, KArgs* a) {
    unsigned char* ws = a->ws; const bf16_t* Qb = (const bf16_t*)(ws + OFF_QB); const bf16_t* Kb = (const bf16_t*)(ws + OFF_KB); const bf16_t* Vb = (const bf16_t*)(ws + OFF_VB);
    bf16_t* Ym = (bf16_t*)(ws + WS_XN);
    for (int it = blockIdx.x; it < 512; it += gridDim.x) {
        const int rnd = it >> 8, bb = it & 255, xcd = bb & 7, slot = bb >> 3; const int bh = rnd * 16 + xcd * 2 + (slot >> 4), y = slot & 15;
        attn_qblock(c.lds, Qb, Kb, Vb, Ym, bh >> 3, bh & 7, 31 - y, c.tid, c.wid);
        attn_qblock(c.lds, Qb, Kb, Vb, Ym, bh >> 3, bh & 7, y, c.tid, c.wid);
    }
}

__device__ __forceinline__ void phase_lora_prep(const Ctx& c, KArgs* a) {
    unsigned char* ws = a->ws; const bf16_t* Z = (const bf16_t*)(ws + OFF_Z); bf16_t* AL = (bf16_t*)(ws + OFF_ALORA); const float* mu = (const float*)a->in[I_MU];
    const int gt = blockIdx.x * 512 + c.tid, nthr = gridDim.x * 512;
    for (int i = gt; i < NT * 48; i += nthr) { const int tok = i / 48, ck = i % 48; float f[8];
        if (ck < 36) { const int k0 = 8 * ck; float cu[8], pv[8];
            unpack8(*(const u32x4*)(Z + (size_t)tok * ZW + ZC_WL + k0), cu);
            if (tok % SEQ) unpack8(*(const u32x4*)(Z + (size_t)(tok - 1) * ZW + ZC_WL + k0), pv); else {
#pragma unroll
                for (int e = 0; e < 8; ++e) pv[e] = 0.f; }
            const f32x4 m0 = *(const f32x4*)(mu + 3072 + k0), m1 = *(const f32x4*)(mu + 3072 + k0 + 4);
#pragma unroll
            for (int e = 0; e < 8; ++e) { const float x = cu[e] + (pv[e] - cu[e]) * (e < 4 ? m0[e & 3] : m1[e & 3]); f[e] = ck < 8 ? (1.0f - 2.0f * __builtin_amdgcn_rcpf(1.0f + __builtin_amdgcn_exp2f(2.885390082f * x))) : (ck < 16 ? x : sigmoidf_(x)); }
        } else {
#pragma unroll
            for (int e = 0; e < 8; ++e) f[e] = 0.f; }
        *(u32x4*)(AL + (size_t)tok * LORA_K + 8 * ck) = packf8(f); }
}
__device__ __forceinline__ void phase_scan_prep(const Ctx& c, KArgs* a) {
    unsigned char* ws = a->ws; const bf16_t* Z = (const bf16_t*)(ws + OFF_Z); const bf16_t* Lb = (const bf16_t*)(ws + OFF_LB);
    h16* D0 = (h16*)(ws + OFF_DER); const size_t DS = (size_t)NT * 1024;
    const float* mu = (const float*)a->in[I_MU]; const float* w0 = (const float*)a->in[I_W0]; const float* a0 = (const float*)a->in[I_A0];
    const float* kkp = (const float*)a->in[I_KK]; const float* kap = (const float*)a->in[I_KA];
    const int lane = c.lane, half = c.gw & 1, ch0 = (half * 8 + (lane >> 3)) * 64 + 8 * (lane & 7);
    float mur[8], muk[8], muv[8], cw0[8], ca0[8], ckk[8], cka[8];
#pragma unroll
    for (int e = 0; e < 8; ++e) { mur[e] = mu[ch0 + e]; muk[e] = mu[1024 + ch0 + e]; muv[e] = mu[2048 + ch0 + e]; cw0[e] = w0[ch0 + e]; ca0[e] = a0[ch0 + e]; ckk[e] = kkp[ch0 + e]; cka[e] = kap[ch0 + e]; }
    u32x4 nxa[8], nxb[8];
#define SP_LOAD(nx, it_) do { const int tk_ = (it_) >> 1; const bf16_t* zr_ = Z + (size_t)tk_ * ZW + ch0; const bf16_t* zp_ = (tk_ % SEQ) == 0 ? zr_ : zr_ - ZW; \
        nx[0] = *(const u32x4*)(zr_ + ZC_R); nx[1] = *(const u32x4*)(zr_ + ZC_K); nx[2] = *(const u32x4*)(zr_ + ZC_V); nx[3] = *(const u32x4*)(zp_ + ZC_R); nx[4] = *(const u32x4*)(zp_ + ZC_K); nx[5] = *(const u32x4*)(zp_ + ZC_V); \
        nx[6] = *(const u32x4*)(Lb + (size_t)tk_ * LORA_N + ch0); nx[7] = *(const u32x4*)(Lb + (size_t)tk_ * LORA_N + 1024 + ch0); } while (0)
    if (c.gw < NT * 2) SP_LOAD(nxa, c.gw);
    if (c.gw + c.nw < NT * 2) SP_LOAD(nxb, c.gw + c.nw);
#define SP_ITEM(nx, it) do { const int tok = (it) >> 1; \
        const bool first = (tok % SEQ) == 0; \
        float rc[8], kc[8], vc[8], rp[8], kp[8], vp[8], lw[8], la[8]; \
        unpack8(nx[0], rc); unpack8(nx[1], kc); unpack8(nx[2], vc); unpack8(nx[3], rp); unpack8(nx[4], kp); unpack8(nx[5], vp); unpack8(nx[6], lw); unpack8(nx[7], la); \
        if ((it) + 2 * c.nw < NT * 2) SP_LOAD(nx, (it) + 2 * c.nw); \
        sp_item(tok, first, rc, kc, vc, rp, kp, vp, lw, la); } while (0)
    auto sp_item = [&](int tok, bool first, const float (&rc)[8], const float (&kc)[8], const float (&vc)[8], const float (&rp)[8], const float (&kp)[8], const float (&vp)[8], const float (&lw)[8], const float (&la)[8]) __attribute__((always_inline)) {
        h16x8 o_ld, o_kk, o_b, o_km, o_r, o_v; float kt[8], av[8], ss = 0.f;
#pragma unroll
        for (int e = 0; e < 8; ++e) { const float pr = first ? 0.f : rp[e], pk = first ? 0.f : kp[e], pvv = first ? 0.f : vp[e];
            const float r = rc[e] + (pr - rc[e]) * mur[e], k = kc[e] + (pk - kc[e]) * muk[e], v = vc[e] + (pvv - vc[e]) * muv[e];
            const float xw = -(cw0[e] + lw[e]); const float spl = fmaxf(xw, 0.f) + 0.69314718f * __builtin_amdgcn_logf(1.0f + __builtin_amdgcn_exp2f(-1.44269504f * fabsf(xw)));
            const float ld = -__builtin_amdgcn_exp2f((-spl - 0.5f) * 1.44269504f);
            av[e] = sigmoidf_(ca0[e] + la[e]); kt[e] = k * ckk[e]; ss += kt[e] * kt[e];
            o_ld[e] = (h16)ld; o_km[e] = (h16)(k * (1.0f + (av[e] - 1.0f) * cka[e])); o_r[e] = (h16)r; o_v[e] = (h16)v; }
        ss = allred8(ss); const float rn = ss > 1e-24f ? __builtin_amdgcn_rsqf(ss) : 1e12f;
#pragma unroll
        for (int e = 0; e < 8; ++e) { const float kk = kt[e] * rn; o_kk[e] = (h16)kk; o_b[e] = (h16)(kk * av[e]); }
        const size_t o = (size_t)tok * 1024 + ch0;
        *(h16x8*)(D0 + o) = o_ld; *(h16x8*)(D0 + DS + o) = o_kk; *(h16x8*)(D0 + 2 * DS + o) = o_b; *(h16x8*)(D0 + 3 * DS + o) = o_km; *(h16x8*)(D0 + 4 * DS + o) = o_r; *(h16x8*)(D0 + 5 * DS + o) = o_v; };
    for (int it = c.gw; it < NT * 2; it += 2 * c.nw) { SP_ITEM(nxa, it); if (it + c.nw < NT * 2) SP_ITEM(nxb, it + c.nw); }
#undef SP_ITEM
#undef SP_LOAD
}
constexpr int SC_L = 256, SC_NC = SEQ / SC_L;
constexpr size_t OFF_YRAW = OFF_Z;
constexpr size_t OFF_PM = OFF_Z + 128 * MiB;
constexpr size_t OFF_HM = OFF_PM + 32 * MiB;
constexpr size_t OFF_ST = OFF_HM + 32 * MiB;
static_assert(OFF_ST + 32 * MiB <= OFF_R1, "scan buffers overflow Z region");
constexpr size_t OFF_Q16 = OFF_Z;
constexpr size_t OFF_Y016 = OFF_Z + 64 * MiB;
struct ScanRaw { h16x8 ld, kk, bb, km, r, v; };
__device__ __forceinline__ ScanRaw scan_load(const h16* pj, const h16* pi, size_t DS, int t) {
    ScanRaw q; const size_t o = (size_t)t * 1024;
    q.ld = *(const h16x8*)(pj + o); q.kk = *(const h16x8*)(pj + DS + o); q.bb = *(const h16x8*)(pj + 2 * DS + o);
    q.km = *(const h16x8*)(pj + 3 * DS + o); q.r = *(const h16x8*)(pj + 4 * DS + o); q.v = *(const h16x8*)(pi + o);
    return q;
}
__device__ __forceinline__ void phase_scan_p1(const Ctx& c, KArgs* a) {
    unsigned char* ws = a->ws; const h16* D0 = (const h16*)(ws + OFF_DER); const size_t DS = (size_t)NT * 1024; float* Pm = (float*)(ws + OFF_PM); float* Hm = (float*)(ws + OFF_HM);
    h16* Q16 = (h16*)(ws + OFF_Q16); h16* Y016 = (h16*)(ws + OFF_Y016);
    const int lane = c.lane, la = lane >> 3, lb = lane & 7;
    for (int it = c.gw; it < 64 * SC_NC; it += c.nw) {
        const int bh = it & 63, ch = it >> 6, b = bh >> 4, h = bh & 15;
        const size_t tok0 = (size_t)b * SEQ + (size_t)ch * SC_L;
        float SP[8][8], SH[8][8];
#pragma unroll
        for (int i = 0; i < 8; ++i)
#pragma unroll
            for (int j = 0; j < 8; ++j) { SP[i][j] = (la == lb && i == j) ? 1.f : 0.f; SH[i][j] = 0.f; }
        h16* qo = Q16 + tok0 * 1024 + h * 64 + 8 * la; h16* yo = Y016 + tok0 * 1024 + h * 64 + 8 * la;
        LAS unsigned char* ring = c.lds + c.wid * 4096;
        const h16* gsrc = D0 + (size_t)((lane >> 3) < 5 ? (lane >> 3) : 5) * DS + tok0 * 1024 + h * 64 + 8 * (lane & 7);
#define SC_DMA(t_) __builtin_amdgcn_global_load_lds((const unsigned*)(gsrc + (size_t)((t_) < SC_L ? (t_) : SC_L - 1) * 1024), (LAS unsigned*)(ring + ((t_) & 3) * 1024), 16, 0, 0)
        SC_DMA(0); SC_DMA(1); SC_DMA(2);
#pragma unroll 1
        for (int t = 0; t < SC_L; ++t) {
            if (t < 3) asm volatile("s_waitcnt vmcnt(0)" ::: "memory"); else asm volatile("s_waitcnt vmcnt(8)" ::: "memory");
            SC_DMA(t + 3);
            ScanRaw cr; { const LAS unsigned char* sl = ring + (t & 3) * 1024;
                cr.ld = *(const LAS h16x8*)(sl + 16 * lb); cr.kk = *(const LAS h16x8*)(sl + 128 + 16 * lb); cr.bb = *(const LAS h16x8*)(sl + 256 + 16 * lb);
                cr.km = *(const LAS h16x8*)(sl + 384 + 16 * lb); cr.r = *(const LAS h16x8*)(sl + 512 + 16 * lb); cr.v = *(const LAS h16x8*)(sl + 640 + 16 * la); }
            float w[8], kk[8], bb[8];
#pragma unroll
            for (int j = 0; j < 8; ++j) { w[j] = __expf((float)cr.ld[j]); kk[j] = (float)cr.kk[j]; bb[j] = (float)cr.bb[j]; }
            float dp[8], dh[8];
#pragma unroll
            for (int i = 0; i < 8; ++i) { float s0 = 0.f, s1 = 0.f;
#pragma unroll
                for (int j = 0; j < 8; ++j) { s0 += SP[i][j] * kk[j]; s1 += SH[i][j] * kk[j]; }
                dp[i] = s0; dh[i] = s1; }
#pragma unroll
            for (int i = 0; i < 8; ++i) { dp[i] = -allred8(dp[i]); dh[i] = -allred8(dh[i]); }
            float qv[8], yv[8];
#pragma unroll
            for (int i = 0; i < 8; ++i) { const float vi = (float)cr.v[i]; float s0 = 0.f, s1 = 0.f;
#pragma unroll
                for (int j = 0; j < 8; ++j) { const float rj = (float)cr.r[j];
                    SP[i][j] = SP[i][j] * w[j] + dp[i] * bb[j]; SH[i][j] = SH[i][j] * w[j] + (dh[i] * bb[j] + vi * (float)cr.km[j]);
                    s0 += SP[i][j] * rj; s1 += SH[i][j] * rj; }
                qv[i] = s0; yv[i] = s1; }
#pragma unroll
            for (int i = 0; i < 8; ++i) { qv[i] = allred8(qv[i]); yv[i] = allred8(yv[i]); }
            if (lb == 0) { h16x8 hq, hy;
#pragma unroll
                for (int i = 0; i < 8; ++i) { hq[i] = (h16)qv[i]; hy[i] = (h16)yv[i]; }
                *(h16x8*)(qo + (size_t)t * 1024) = hq; *(h16x8*)(yo + (size_t)t * 1024) = hy; }
        }
#undef SC_DMA
        asm volatile("s_waitcnt vmcnt(0)" ::: "memory");
        { float* dst = Hm + ((size_t)bh * SC_NC + ch) * 4096 + ((((la >> 1) * 4 + (lb >> 1)) * 64 + 2 * (lb & 1) * 16 + 8 * (la & 1)) * 4);
#pragma unroll
          for (int i = 0; i < 8; ++i)
#pragma unroll
              for (int j = 0; j < 8; ++j) dst[((j >> 2) * 16 + i) * 4 + (j & 3)] = SH[i][j]; }
        { float* dst = Pm + ((size_t)bh * SC_NC + ch) * 4096 + ((((lb >> 1) * 4 + (la >> 1)) * 64 + 2 * (la & 1) * 16 + 8 * (lb & 1)) * 4);
#pragma unroll
          for (int i = 0; i < 8; ++i)
#pragma unroll
              for (int j = 0; j < 8; ++j) dst[((i >> 2) * 16 + j) * 4 + (i & 3)] = SP[i][j]; }
    }
}
typedef short s16x4_t __attribute__((ext_vector_type(4)));
#define P1M_MFMA16(a, b, c) __builtin_amdgcn_mfma_f32_16x16x16f16((a), (b), (c), 0, 0, 0)
#define P1M_MFMA32(a, b, c) __builtin_amdgcn_mfma_f32_16x16x32_f16((a), (b), (c), 0, 0, 0)
__device__ __forceinline__ h16x4 cvt_h4(const f32x4 v) { return (h16x4){(h16)v[0], (h16)v[1], (h16)v[2], (h16)v[3]}; }
__device__ __forceinline__ float row_pfx(float x) {
    x += __int_as_float(__builtin_amdgcn_update_dpp(0, __float_as_int(x), 0x111, 0xF, 0xF, false));
    x += __int_as_float(__builtin_amdgcn_update_dpp(0, __float_as_int(x), 0x112, 0xF, 0xF, false));
    x += __int_as_float(__builtin_amdgcn_update_dpp(0, __float_as_int(x), 0x114, 0xF, 0xF, false));
    x += __int_as_float(__builtin_amdgcn_update_dpp(0, __float_as_int(x), 0x118, 0xF, 0xF, false));
    return x; }
__device__ __forceinline__ float row_sum16(float x) {
    x = DPP_ADD(x, 0xB1); x = DPP_ADD(x, 0x4E); x = DPP_ADD(x, 0x141); x = DPP_ADD(x, 0x140); return x; }
#define P1M_TR(dst, addr) asm volatile("ds_read_b64_tr_b16 %0, %1" : "=v"(dst) : "v"(addr) : "memory")
#define P1M_WAITL() do { asm volatile("s_waitcnt lgkmcnt(0)" ::: "memory"); __builtin_amdgcn_sched_barrier(0); } while (0)
__device__ __forceinline__ void phase_scan_p1m(const Ctx& c, KArgs* a) {
    unsigned char* ws = a->ws; const h16* D0 = (const h16*)(ws + OFF_DER); const size_t DS = (size_t)NT * 1024; float* Pm = (float*)(ws + OFF_PM); float* Hm = (float*)(ws + OFF_HM);
    h16* Q16 = (h16*)(ws + OFF_Q16); h16* Y016 = (h16*)(ws + OFF_Y016);
    const int lane = c.lane;
    LAS unsigned char* wl = c.lds + c.wid * 16640;
    const int wb = (int)(uintptr_t)wl;
    constexpr int IMG_KT = 0, IMG_BH = 2048, IMG_KH = 4096, IMG_RT = 6144, IMG_BB = 8192, IMG_KB = 10240, IMG_V = 12288, SM_M = 14336, SM_TT = 15360, SM_NT = 15872;
    constexpr int SM_ARB = IMG_BH, SM_ARK = IMG_BH + 512, SM_GAM = 16384, IMG_RP = IMG_KH, STG_Q = IMG_KT, STG_Y = IMG_RT;
    for (int itk = c.gw; itk < 64 * SC_NC; itk += c.nw) {
        const int bh = itk & 63, ch = itk >> 6, b = bh >> 4, h = bh & 15;
        const size_t tok0 = (size_t)b * SEQ + (size_t)ch * SC_L;
        f32x4 PT[4][4], SHT[4][4];
        { int lz = lane; asm volatile("" : "+v"(lz));
#pragma unroll
          for (int kt = 0; kt < 4; ++kt)
#pragma unroll
              for (int ct = 0; ct < 4; ++ct) { SHT[kt][ct] = (f32x4){0.f, 0.f, 0.f, 0.f};
#pragma unroll
                  for (int rg = 0; rg < 4; ++rg) PT[kt][ct][rg] = (kt == ct && 4 * (lz >> 4) + rg == (lz & 15)) ? 1.f : 0.f; } }
#pragma unroll 1
        for (int sc = 0; sc < SC_L / 16; ++sc) {
            int lq = lane; asm volatile("" : "+v"(lq)); const int r16 = lq & 15, gq = lq >> 4;
            const size_t go = (tok0 + 16 * sc + r16) * 1024 + h * 64 + 16 * gq;
            { const h16x8 v0 = *(const h16x8*)(D0 + 5 * DS + go), v1 = *(const h16x8*)(D0 + 5 * DS + go + 8);
              *(LAS h16x8*)(wl + IMG_V + gq * 512 + r16 * 32) = v0; *(LAS h16x8*)(wl + IMG_V + gq * 512 + r16 * 32 + 16) = v1; }
#pragma unroll
            for (int p = 0; p < 2; ++p) { float ep[8], em[8], ex[8], eb[8];
                { const h16x8 a0 = *(const h16x8*)(D0 + go + 8 * p);
#pragma unroll
                  for (int e = 0; e < 8; ++e) { const float ld = (float)a0[e]; const float lw = row_pfx(ld), tot = row_sum16(ld); if (r16 == 15) *(LAS float*)(wl + SM_GAM + (16 * gq + 8 * p + e) * 4) = __expf(tot);
                      ep[e] = __expf(lw); em[e] = __expf(-lw); ex[e] = __expf(lw - ld); eb[e] = __expf(tot - lw); } }
                const int io = gq * 512 + r16 * 32 + 16 * p;
                { const h16x8 x = *(const h16x8*)(D0 + DS + go + 8 * p); h16x8 o;
#pragma unroll
                  for (int e = 0; e < 8; ++e) o[e] = (h16)((float)x[e] * ex[e]);
                  *(LAS h16x8*)(wl + IMG_KT + io) = o; }
                { const h16x8 x = *(const h16x8*)(D0 + 2 * DS + go + 8 * p); h16x8 o, o2;
#pragma unroll
                  for (int e = 0; e < 8; ++e) { o[e] = (h16)((float)x[e] * em[e]); o2[e] = (h16)((float)x[e] * eb[e]); }
                  *(LAS h16x8*)(wl + IMG_BH + io) = o; *(LAS h16x8*)(wl + IMG_BB + io) = o2; }
                { const h16x8 x = *(const h16x8*)(D0 + 3 * DS + go + 8 * p); h16x8 o, o2;
#pragma unroll
                  for (int e = 0; e < 8; ++e) { o[e] = (h16)((float)x[e] * em[e]); o2[e] = (h16)((float)x[e] * eb[e]); }
                  *(LAS h16x8*)(wl + IMG_KH + io) = o; *(LAS h16x8*)(wl + IMG_KB + io) = o2; }
                { const h16x8 x = *(const h16x8*)(D0 + 4 * DS + go + 8 * p); h16x8 o;
#pragma unroll
                  for (int e = 0; e < 8; ++e) o[e] = (h16)((float)x[e] * ep[e]);
                  *(LAS h16x8*)(wl + IMG_RT + io) = o; } }
            asm volatile("s_waitcnt lgkmcnt(0)" ::: "memory");
            { f32x4 m_ = {0.f, 0.f, 0.f, 0.f}, n_ = m_, rb = m_, rk = m_;
#pragma unroll
              for (int kk2 = 0; kk2 < 2; ++kk2) { const int ro = (2 * kk2 + (gq >> 1)) * 512 + r16 * 32 + (gq & 1) * 16;
                  const h16x8 aK = *(const LAS h16x8*)(wl + IMG_KT + ro), aR = *(const LAS h16x8*)(wl + IMG_RT + ro), bB = *(const LAS h16x8*)(wl + IMG_BH + ro), bK = *(const LAS h16x8*)(wl + IMG_KH + ro);
                  m_ = P1M_MFMA32(aK, bB, m_); n_ = P1M_MFMA32(aK, bK, n_); rb = P1M_MFMA32(aR, bB, rb); rk = P1M_MFMA32(aR, bK, rk); }
              h16x4 nT, rbT, rkT;
#pragma unroll
              for (int rg = 0; rg < 4; ++rg) { const int t = 4 * gq + rg; const bool lo = t > r16, le = t >= r16;
                  *(LAS float*)(wl + SM_M + (t * 16 + r16) * 4) = lo ? m_[rg] : 0.f; nT[rg] = (h16)(lo ? n_[rg] : 0.f); rbT[rg] = (h16)(le ? rb[rg] : 0.f); rkT[rg] = (h16)(le ? rk[rg] : 0.f); }
              *(LAS h16x4*)(wl + SM_NT + r16 * 32 + gq * 8) = nT; *(LAS h16x4*)(wl + SM_ARB + r16 * 32 + gq * 8) = rbT; *(LAS h16x4*)(wl + SM_ARK + r16 * 32 + gq * 8) = rkT;
            }
            asm volatile("s_waitcnt lgkmcnt(0)" ::: "memory");
            { float x[16];
#pragma unroll
              for (int t = 0; t < 16; ++t) { float acc = (t == r16) ? 1.f : 0.f;
#pragma unroll
                  for (int s4 = 0; s4 < (t + 3) / 4; ++s4) { const f32x4 mr = *(const LAS f32x4*)(wl + SM_M + (t * 16 + 4 * s4) * 4);
#pragma unroll
                      for (int e = 0; e < 4; ++e) if (4 * s4 + e < t) acc -= mr[e] * x[4 * s4 + e]; }
                  x[t] = acc; }
              h16x8 t0, t1;
#pragma unroll
              for (int e = 0; e < 8; ++e) { t0[e] = (h16)x[e]; t1[e] = (h16)x[8 + e]; }
              if (gq == 0) { *(LAS h16x8*)(wl + SM_TT + r16 * 32) = t0; *(LAS h16x8*)(wl + SM_TT + r16 * 32 + 16) = t1; } }
            asm volatile("s_waitcnt lgkmcnt(0)" ::: "memory");
            const int la8 = wb + 8 * lq;
            s16x4_t rT, rN, rArb, rArk, rK[4], rV[4];
            P1M_TR(rT, la8 + SM_TT); P1M_TR(rN, la8 + SM_NT); P1M_TR(rArb, la8 + SM_ARB); P1M_TR(rArk, la8 + SM_ARK);
#pragma unroll
            for (int j4 = 0; j4 < 4; ++j4) { P1M_TR(rK[j4], la8 + IMG_KT + j4 * 512); P1M_TR(rV[j4], la8 + IMG_V + j4 * 512); }
            P1M_WAITL();
            const h16x4 aT = *(h16x4*)&rT, aN = *(h16x4*)&rN, aArb = *(h16x4*)&rArb, aArk = *(h16x4*)&rArk;
            h16x4 kcH[4], zH[4], bV[4];
            const f32x4 zero4 = {0.f, 0.f, 0.f, 0.f};
#pragma unroll
            for (int j4 = 0; j4 < 4; ++j4) { bV[j4] = *(h16x4*)&rV[j4];
                kcH[j4] = cvt_h4(P1M_MFMA16(aT, *(h16x4*)&rK[j4], zero4));
                const h16x4 nvH = cvt_h4(P1M_MFMA16(aN, bV[j4], zero4)); zH[j4] = cvt_h4(P1M_MFMA16(aT, nvH, zero4)); }
            { s16x4_t rR[4];
#pragma unroll
              for (int j4 = 0; j4 < 4; ++j4) P1M_TR(rR[j4], la8 + IMG_RT + j4 * 512);
              P1M_WAITL();
#pragma unroll
              for (int j4 = 0; j4 < 4; ++j4) { const h16x4 rt = *(h16x4*)&rR[j4]; const f32x4 ak = P1M_MFMA16(aArb, kcH[j4], zero4);
                  const f32x4 rp = (f32x4){(float)rt[0], (float)rt[1], (float)rt[2], (float)rt[3]} - ak;
                  *(LAS h16x4*)(wl + IMG_RP + j4 * 512 + r16 * 32 + gq * 8) = cvt_h4(rp); } }
            { s16x4_t rRp[4];
              asm volatile("s_waitcnt lgkmcnt(0)" ::: "memory");
#pragma unroll
              for (int j4 = 0; j4 < 4; ++j4) P1M_TR(rRp[j4], la8 + IMG_RP + j4 * 512);
              P1M_WAITL();
#pragma unroll
              for (int ct = 0; ct < 4; ++ct) { f32x4 qv = zero4, yv = P1M_MFMA16(aArk, bV[ct], zero4) - P1M_MFMA16(aArb, zH[ct], zero4);
#pragma unroll
                  for (int kt = 0; kt < 4; ++kt) { const h16x4 aR = *(h16x4*)&rRp[kt]; qv = P1M_MFMA16(aR, cvt_h4(PT[kt][ct]), qv); yv = P1M_MFMA16(aR, cvt_h4(SHT[kt][ct]), yv); }
#pragma unroll
                  for (int rg = 0; rg < 4; ++rg) { *(LAS h16*)(wl + STG_Q + (4 * gq + rg) * 128 + (16 * ct + r16) * 2) = (h16)qv[rg]; *(LAS h16*)(wl + STG_Y + (4 * gq + rg) * 128 + (16 * ct + r16) * 2) = (h16)yv[rg]; } } }
            { h16x4 GT[4][4];
              s16x4_t rBB[4], rKB[4];
#pragma unroll
              for (int j4 = 0; j4 < 4; ++j4) { P1M_TR(rBB[j4], la8 + IMG_BB + j4 * 512); P1M_TR(rKB[j4], la8 + IMG_KB + j4 * 512); }
              float gdiag[4];
#pragma unroll
              for (int j4 = 0; j4 < 4; ++j4) gdiag[j4] = *(const LAS float*)(wl + SM_GAM + (16 * j4 + r16) * 4);
              P1M_WAITL();
#pragma unroll
              for (int ta = 0; ta < 4; ++ta)
#pragma unroll
                  for (int tb = 0; tb < 4; ++tb) { f32x4 g4 = P1M_MFMA16(kcH[ta], *(h16x4*)&rBB[tb], zero4);
#pragma unroll
                      for (int rg = 0; rg < 4; ++rg) g4[rg] = ((ta == tb && 4 * gq + rg == r16) ? gdiag[tb] : 0.f) - g4[rg];
                      GT[ta][tb] = cvt_h4(g4); }
#pragma unroll
              for (int ct = 0; ct < 4; ++ct) { h16x4 pH[4], sH[4];
#pragma unroll
                  for (int kt = 0; kt < 4; ++kt) { pH[kt] = cvt_h4(PT[kt][ct]); sH[kt] = cvt_h4(SHT[kt][ct]); }
#pragma unroll
                  for (int tb = 0; tb < 4; ++tb) { f32x4 hs = P1M_MFMA16(*(h16x4*)&rKB[tb], bV[ct], zero4) - P1M_MFMA16(*(h16x4*)&rBB[tb], zH[ct], zero4); f32x4 pp = zero4;
#pragma unroll
                      for (int ta = 0; ta < 4; ++ta) { pp = P1M_MFMA16(GT[ta][tb], pH[ta], pp); hs = P1M_MFMA16(GT[ta][tb], sH[ta], hs); }
                      PT[tb][ct] = pp; SHT[tb][ct] = hs; } } }
            asm volatile("s_waitcnt lgkmcnt(0)" ::: "memory");
#pragma unroll
            for (int p = 0; p < 2; ++p) { const int id = lq + 64 * p, row = id >> 3, part = id & 7; const size_t o = (tok0 + 16 * sc + row) * 1024 + h * 64 + part * 8;
                *(h16x8*)(Q16 + o) = *(const LAS h16x8*)(wl + STG_Q + id * 16); *(h16x8*)(Y016 + o) = *(const LAS h16x8*)(wl + STG_Y + id * 16); }
            asm volatile("s_waitcnt lgkmcnt(0)" ::: "memory");
        }
        { int lz = lane; asm volatile("" : "+v"(lz)); const int r16z = lz & 15, gqz = lz >> 4;
          float* hd = Hm + ((size_t)bh * SC_NC + ch) * 4096 + lz * 4; float* pb = Pm + ((size_t)bh * SC_NC + ch) * 4096 + ((r16z >> 2) * 16 + 4 * gqz) * 4 + (r16z & 3);
#pragma unroll
          for (int kt = 0; kt < 4; ++kt)
#pragma unroll
              for (int ct = 0; ct < 4; ++ct) { *(f32x4*)(hd + (ct * 4 + kt) * 256) = SHT[kt][ct];
#pragma unroll
                  for (int rg = 0; rg < 4; ++rg) pb[(kt * 4 + ct) * 256 + rg * 4] = PT[kt][ct][rg]; } }
    }
}

__device__ __forceinline__ void phase_scan_p2(const Ctx& c, KArgs* a) {
    if (c.wid != 0) return;
    unsigned char* ws = a->ws; const float* Pm = (const float*)(ws + OFF_PM); const float* Hm = (const float*)(ws + OFF_HM); float* ST = (float*)(ws + OFF_ST);
    const int lane = c.lane, q = lane >> 4, cc = lane & 15;
    for (int w = blockIdx.x; w < 256; w += gridDim.x) { const int bh = w >> 2, itl = w & 3;
        f32x4 st[4];
#pragma unroll
        for (int jt = 0; jt < 4; ++jt) st[jt] = (f32x4){0.f, 0.f, 0.f, 0.f};
        for (int ch = 0; ch < SC_NC; ++ch) {
            float* sp = ST + ((size_t)bh * SC_NC + ch) * 4096;
#pragma unroll
            for (int jt = 0; jt < 4; ++jt)
#pragma unroll
                for (int rg = 0; rg < 4; ++rg) sp[(16 * jt + 4 * q + rg) * 64 + 16 * itl + cc] = st[jt][rg];
            if (ch == SC_NC - 1) break;
            const float* pp = Pm + ((size_t)bh * SC_NC + ch) * 4096; const float* hp = Hm + ((size_t)bh * SC_NC + ch) * 4096;
            f32x4 nw[4];
#pragma unroll
            for (int jtp = 0; jtp < 4; ++jtp) nw[jtp] = *(const f32x4*)(hp + ((itl * 4 + jtp) * 64 + lane) * 4);
#pragma unroll
            for (int jtp = 0; jtp < 4; ++jtp)
#pragma unroll
                for (int jt = 0; jt < 4; ++jt) { const f32x4 av = *(const f32x4*)(pp + ((jtp * 4 + jt) * 64 + lane) * 4);
                    nw[jtp] = __builtin_amdgcn_mfma_f32_16x16x16f16(cvt_h4(av), cvt_h4(st[jt]), nw[jtp], 0, 0, 0); }
#pragma unroll
            for (int jt = 0; jt < 4; ++jt) st[jt] = nw[jt];
        }
    }
}
__device__ __forceinline__ float red_kq(float x) { x += __shfl_xor(x, 16); x += __shfl_xor(x, 32); return x; }
__device__ __forceinline__ void phase_scan_p3(const Ctx& c, KArgs* a) {
    unsigned char* ws = a->ws; const h16* D0 = (const h16*)(ws + OFF_DER); const size_t DS = (size_t)NT * 1024; const float* ST = (const float*)(ws + OFF_ST);
    const h16* Q16 = (const h16*)(ws + OFF_Q16); const h16* Y016 = (const h16*)(ws + OFF_Y016); const bf16_t* Lb = (const bf16_t*)(ws + OFF_LB); bf16_t* Ym = (bf16_t*)(ws + WS_XN);
    const float* rk = (const float*)a->in[I_RK]; const float* lnw = (const float*)a->in[I_LNW]; const float* lnb = (const float*)a->in[I_LNB];
    const int lane = c.lane, kq = lane >> 4, cc = lane & 15;
    for (int itk = c.gw; itk < 64 * SC_NC; itk += c.nw) {
        const int bh = itk & 63, ch = itk >> 6, b = bh >> 4, h = bh & 15;
        const size_t tok0 = (size_t)b * SEQ + (size_t)ch * SC_L;
        const float* sp = ST + ((size_t)bh * SC_NC + ch) * 4096;
        h16x4 sa[4][4];
#pragma unroll
        for (int itl = 0; itl < 4; ++itl)
#pragma unroll
            for (int s4 = 0; s4 < 4; ++s4)
#pragma unroll
                for (int e = 0; e < 4; ++e) sa[itl][s4][e] = (h16)sp[(16 * s4 + 4 * kq + e) * 64 + 16 * itl + cc];
        float crk[4][4], clw[4][4], clb[4][4];
#pragma unroll
        for (int itl = 0; itl < 4; ++itl)
#pragma unroll
            for (int e = 0; e < 4; ++e) { const int chn = h * 64 + 16 * itl + 4 * kq + e; crk[itl][e] = rk[chn]; clw[itl][e] = lnw[chn]; clb[itl][e] = lnb[chn]; }
#pragma unroll 1
        for (int tt = 0; tt < SC_L / 16; ++tt) { const size_t tok = tok0 + 16 * tt + cc; const size_t ob = tok * 1024 + h * 64 + 4 * kq;
            f32x4 acc[4]; h16x4 qa[4];
#pragma unroll
            for (int s4 = 0; s4 < 4; ++s4) qa[s4] = *(const h16x4*)(Q16 + ob + 16 * s4);
#pragma unroll
            for (int itl = 0; itl < 4; ++itl) { const h16x4 t4 = *(const h16x4*)(Y016 + ob + 16 * itl); acc[itl] = (f32x4){(float)t4[0], (float)t4[1], (float)t4[2], (float)t4[3]}; }
#pragma unroll
            for (int s4 = 0; s4 < 4; ++s4)
#pragma unroll
                for (int itl = 0; itl < 4; ++itl) acc[itl] = __builtin_amdgcn_mfma_f32_16x16x16f16(sa[itl][s4], qa[s4], acc[itl], 0, 0, 0);
            float sm = 0.f, bd = 0.f; h16x4 hv[4]; float g[4][4];
#pragma unroll
            for (int itl = 0; itl < 4; ++itl) { const h16x4 hr = *(const h16x4*)(D0 + 4 * DS + ob + 16 * itl), hk = *(const h16x4*)(D0 + 3 * DS + ob + 16 * itl); hv[itl] = *(const h16x4*)(D0 + 5 * DS + ob + 16 * itl);
                const u32x2 gw = *(const u32x2*)(Lb + tok * LORA_N + 2048 + h * 64 + 4 * kq + 16 * itl); g[itl][0] = bflo(gw.x); g[itl][1] = bfhi(gw.x); g[itl][2] = bflo(gw.y); g[itl][3] = bfhi(gw.y);
#pragma unroll
                for (int e = 0; e < 4; ++e) { sm += acc[itl][e]; bd += (float)hr[e] * (float)hk[e] * crk[itl][e]; } }
            sm = red_kq(sm); bd = red_kq(bd); const float mean = sm * (1.0f / 64.0f); float vs = 0.f;
#pragma unroll
            for (int itl = 0; itl < 4; ++itl)
#pragma unroll
                for (int e = 0; e < 4; ++e) { acc[itl][e] -= mean; vs += acc[itl][e] * acc[itl][e]; }
            vs = red_kq(vs); const float rstd = rsqrtf(vs * (1.0f / 64.0f) + 64e-5f);
#pragma unroll
            for (int itl = 0; itl < 4; ++itl) { float f[4];
#pragma unroll
                for (int e = 0; e < 4; ++e) f[e] = (acc[itl][e] * rstd * clw[itl][e] + clb[itl][e] + bd * (float)hv[itl][e]) * g[itl][e];
                *(unsigned*)((unsigned char*)Ym + (size_t)tok * DM + 1024 + h * 64 + 4 * kq + 16 * itl) = pk_fp8x4(f[0] * 16.0f, f[1] * 16.0f, f[2] * 16.0f, f[3] * 16.0f); }
        }
    }
}

__device__ __forceinline__ void phase_router(const Ctx& c, KArgs* a) {
    unsigned char* ws = a->ws; float* H = a->out; bf16_t* xn2 = (bf16_t*)(ws + WS_XN); const u32x4* wf = (const u32x4*)(ws + OFF_WRF);
    const float* rbias = (const float*)a->in[I_RBIAS]; float* topw = (float*)(ws + OFF_TOPW); int* list = (int*)(ws + OFF_LIST); int* cnt = (int*)(ws + CTL_CNT);
    const int lane = c.lane, r16 = lane & 15, q = lane >> 4;
    LAS float* lg = (LAS float*)(c.lds) + c.wid * 1088;
    const float bias_e = rbias[lane];
    for (int it = c.gw; it < NT / 16; it += c.nw) { const int tok0 = it * 16;
        f32x4 acc[4];
#pragma unroll
        for (int cc = 0; cc < 4; ++cc) acc[cc] = (f32x4){0.f, 0.f, 0.f, 0.f};
        float ss = 0.f; const bf16_t* hp = hrow(H, (size_t)(tok0 + r16)) + 8 * q;
#pragma unroll 2
        for (int s = 0; s < 64; ++s) { const u32x4 ahi = *(const u32x4*)(hp + 32 * s); float h[8]; unpack8(ahi, h);
            ss += h[0] * h[0] + h[1] * h[1] + h[2] * h[2] + h[3] * h[3] + h[4] * h[4] + h[5] * h[5] + h[6] * h[6] + h[7] * h[7];
            const bf16x8 ah = __builtin_bit_cast(bf16x8, ahi);
            const u32x4* wp = wf + (size_t)s * 512 + lane;
#pragma unroll
            for (int cc = 0; cc < 4; ++cc) { const bf16x8 bh = __builtin_bit_cast(bf16x8, wp[(cc * 2 + 0) * 64]), bl = __builtin_bit_cast(bf16x8, wp[(cc * 2 + 1) * 64]);
                acc[cc] = __builtin_amdgcn_mfma_f32_16x16x32_bf16(ah, bh, acc[cc], 0, 0, 0); acc[cc] = __builtin_amdgcn_mfma_f32_16x16x32_bf16(ah, bl, acc[cc], 0, 0, 0); } }
        ss += __shfl_xor(ss, 16); ss += __shfl_xor(ss, 32);
        if (q == 0) lg[1024 + r16] = ss;
#pragma unroll
        for (int cc = 0; cc < 4; ++cc)
#pragma unroll
            for (int rg = 0; rg < 4; ++rg) lg[(4 * q + rg) * 64 + 16 * cc + r16] = acc[cc][rg];
        asm volatile("s_waitcnt lgkmcnt(0)" ::: "memory");
#pragma unroll 4
        for (int tt = 0; tt < 16; ++tt) { const int tok = tok0 + tt; const int chunk = tok / CH_TOK, tl = tok % CH_TOK;
            const float rs = rsqrtf(lg[1024 + tt] * (1.0f / DM) + RMS_EPS);
            const float sc = sigmoidf_(lg[tt * 64 + lane] * rs); const float bs = sc + bias_e;
            float m1 = bs; m1 = fmaxf(m1, __shfl_xor(m1, 1)); m1 = fmaxf(m1, __shfl_xor(m1, 2)); m1 = fmaxf(m1, __shfl_xor(m1, 4));
            const unsigned long long eq = __ballot(bs == m1); const unsigned grp = (unsigned)(eq >> (lane & ~7)) & 0xffu; const int first = (lane & ~7) + (__ffs(grp) - 1);
            float m2 = (lane == first) ? -__builtin_inff() : bs; m2 = fmaxf(m2, __shfl_xor(m2, 1)); m2 = fmaxf(m2, __shfl_xor(m2, 2)); m2 = fmaxf(m2, __shfl_xor(m2, 4));
            const float gs = m1 + m2; const int g = lane >> 3; int grank = 0;
#pragma unroll
            for (int gp = 0; gp < 8; ++gp) { const float o = rlane(gs, gp * 8); grank += (o > gs || (o == gs && gp < g)) ? 1 : 0; }
            const float mv = grank < 4 ? bs : -__builtin_inff(); int rank = 0;
#pragma unroll
            for (int e = 0; e < 64; ++e) { const float o = rlane(mv, e); rank += (o > mv || (o == mv && e < lane)) ? 1 : 0; }
            const bool sel = (grank < 4) && (rank < 8);
            const float wsum = wave_sum(sel ? sc : 0.f);
            if (sel) { topw[(size_t)tok * 8 + rank] = sc / wsum * 2.5f;
                const int p = atomicAdd(cnt + chunk * NE1 + lane, 1); list[((size_t)chunk * NE1 + lane) * CH_TOK + p] = tl * 8 + rank; }
        }
        asm volatile("s_waitcnt lgkmcnt(0)" ::: "memory");
        for (int tt = 0; tt < 16; ++tt) rownorm_fp8_bf(hrow(H, (size_t)(tok0 + tt)), (unsigned char*)xn2 + (size_t)(tok0 + tt) * DM, lane);
    }
}
__device__ __forceinline__ void phase_expert_weights(const Ctx& c, KArgs* a) {
    unsigned char* ws = a->ws; const float* gf = (const float*)a->in[I_GFFN];
    bf16_t* we1 = (bf16_t*)(ws + OFF_WE1); bf16_t* we2 = (bf16_t*)(ws + OFF_WE2);
    { LAS float* tile = (LAS float*)c.lds; const int n4 = c.tid & 31, kr = c.tid >> 5, sc = c.tid & 7, sn = c.tid >> 3; const int ntile = NE1 * 384;
      const float* wgp = (const float*)a->in[I_WG]; const float* wup = (const float*)a->in[I_WU]; const float* wdp = (const float*)a->in[I_WD];
      const float* sgp = (const float*)a->in[I_SG]; const float* sup = (const float*)a->in[I_SU]; const float* sdp = (const float*)a->in[I_SD];
      f32x4 va[4], vb[4];
#define EW_LOAD(v, T_) do { const int e_ = (T_) / 384, r_ = (T_) % 384; \
        if (r_ < 256) { const int n_ = (r_ >> 5) * 128 + 4 * n4, k0_ = (r_ & 31) * 64, half_ = (n_ >> 7) & 1, cc_ = (n_ >> 8) * 128 + (n_ & 127); \
            const float* sp_ = (e_ < NEXP ? (half_ ? wup : wgp) + (size_t)e_ * 2048 * 512 : (half_ ? sup : sgp)) + cc_; \
            _Pragma("unroll") for (int i = 0; i < 4; ++i) { const int k_ = k0_ + kr + 16 * i; v[i] = *(const f32x4*)(sp_ + (size_t)k_ * 512) * (gf[k_] * 64.0f); } } \
        else { const int t2_ = r_ - 256, n_ = (t2_ >> 3) * 128 + 4 * n4, k0_ = (t2_ & 7) * 64; const float* sp_ = (e_ < NEXP ? wdp + (size_t)e_ * 512 * 2048 : sdp) + n_; \
            _Pragma("unroll") for (int i = 0; i < 4; ++i) v[i] = *(const f32x4*)(sp_ + (size_t)(k0_ + kr + 16 * i) * 2048) * 64.0f; } } while (0)
#define EW_STEP(v, T_) do { \
          _Pragma("unroll") for (int i = 0; i < 4; ++i) _Pragma("unroll") for (int e = 0; e < 4; ++e) tile[(kr + 16 * i) * 129 + 4 * n4 + e] = v[i][e]; \
          __syncthreads(); \
          const int e_ = (T_) / 384, r_ = (T_) % 384; const bool up = r_ < 256; const int t2 = r_ - 256; \
          const int n0 = up ? (r_ >> 5) * 128 : (t2 >> 3) * 128, k0 = up ? (r_ & 31) * 64 : (t2 & 7) * 64, Kd = up ? 2048 : 512; \
          unsigned char* dst = up ? (unsigned char*)we1 + (size_t)e_ * 1024 * 2048 : (unsigned char*)we2 + (size_t)e_ * 2048 * 512; \
          if ((T_) + 2 * (int)gridDim.x < ntile) EW_LOAD(v, (T_) + 2 * (int)gridDim.x); \
          _Pragma("unroll") for (int i = 0; i < 2; ++i) { const int nl = sn + 64 * i; float f[8]; \
              _Pragma("unroll") for (int j = 0; j < 8; ++j) f[j] = tile[(8 * sc + j) * 129 + nl]; \
              u32x2 w8; w8.x = pk_fp8x4(f[0], f[1], f[2], f[3]); w8.y = pk_fp8x4(f[4], f[5], f[6], f[7]); *(u32x2*)(dst + (size_t)(n0 + nl) * Kd + k0 + 8 * sc) = w8; } \
          __syncthreads(); } while (0)
      int T = blockIdx.x; if (T < ntile) EW_LOAD(va, T); if (T + (int)gridDim.x < ntile) EW_LOAD(vb, T + (int)gridDim.x);
      for (; T < ntile; T += 2 * gridDim.x) { EW_STEP(va, T); if (T + (int)gridDim.x < ntile) EW_STEP(vb, T + (int)gridDim.x); }
#undef EW_STEP
#undef EW_LOAD
    }
    { const float* p = (const float*)a->in[I_P]; bf16_t* pb = (bf16_t*)(ws + OFF_PB); const int gt = blockIdx.x * 512 + c.tid, nthr = gridDim.x * 512;
      for (size_t i = gt; i < (size_t)NT * 256 / 4; i += nthr) { const f32x4 v = *(const f32x4*)(p + i * 4); u32x2 w; w.x = cvt_pk_bf16(v[0], v[1]); w.y = cvt_pk_bf16(v[2], v[3]); *(u32x2*)(pb + i * 4) = w; } }
}
__device__ __forceinline__ void phase_combine(const Ctx& c, KArgs* a, int chunk) {
    unsigned char* ws = a->ws; float* H = a->out; const bf16_t* Y = (const bf16_t*)(ws + OFF_YPART + (size_t)(chunk & 1) * YPART_BYTES); bf16_t* xn3 = (bf16_t*)(ws + OFF_XN3);
    const int lane = c.lane;
    for (int tl = c.gw; tl < CH_TOK; tl += c.nw) { const int tok = chunk * CH_TOK + tl; bf16_t* hp = hrow(H, (size_t)tok);
        float v[4][8];
#pragma unroll
        for (int i = 0; i < 4; ++i) unpack8(*(const u32x4*)(hp + (i * 64 + lane) * 8), v[i]);
#pragma unroll 3
        for (int k = 0; k < 9; ++k) { const unsigned char* yp = (const unsigned char*)Y + (k < 8 ? (size_t)tl * 8 + k : (size_t)YP_SHARED + tl) * DM;
#pragma unroll
            for (int i = 0; i < 4; ++i) { const u32x2 w8 = *(const u32x2*)(yp + (i * 64 + lane) * 8);
                const auto f0 = __builtin_amdgcn_cvt_pk_f32_fp8((int)w8.x, false), f1 = __builtin_amdgcn_cvt_pk_f32_fp8((int)w8.x, true), f2 = __builtin_amdgcn_cvt_pk_f32_fp8((int)w8.y, false), f3 = __builtin_amdgcn_cvt_pk_f32_fp8((int)w8.y, true);
                v[i][0] += f0[0] * (1.0f / 16.0f); v[i][1] += f0[1] * (1.0f / 16.0f); v[i][2] += f1[0] * (1.0f / 16.0f); v[i][3] += f1[1] * (1.0f / 16.0f);
                v[i][4] += f2[0] * (1.0f / 16.0f); v[i][5] += f2[1] * (1.0f / 16.0f); v[i][6] += f3[0] * (1.0f / 16.0f); v[i][7] += f3[1] * (1.0f / 16.0f); } }
        float ss = 0.f;
#pragma unroll
        for (int i = 0; i < 4; ++i) { *(u32x4*)(hp + (i * 64 + lane) * 8) = packf8(v[i]);
#pragma unroll
            for (int e = 0; e < 8; ++e) ss += v[i][e] * v[i][e]; }
        ss = wave_sum(ss); const float rs = rsqrtf(ss * (1.0f / DM) + RMS_EPS) * 16.0f; unsigned char* xp = (unsigned char*)xn3 + (size_t)tok * DM;
#pragma unroll
        for (int i = 0; i < 4; ++i) { u32x2 w8; w8.x = pk_fp8x4(v[i][0] * rs, v[i][1] * rs, v[i][2] * rs, v[i][3] * rs); w8.y = pk_fp8x4(v[i][4] * rs, v[i][5] * rs, v[i][6] * rs, v[i][7] * rs);
            *(u32x2*)(xp + (i * 64 + lane) * 8) = w8; } }
}
__device__ __forceinline__ void phase_final(const Ctx& c, KArgs* a, int tok0, int tok1) {
    unsigned char* ws = a->ws; float* H = a->out; const bf16_t* U = (const bf16_t*)(ws + OFF_U); const float* ssq = (const float*)(ws + OFF_SSQU); const float* gp = (const float*)a->in[I_GPOUT];
    const int lane = c.lane;
    for (int tok = tok0 + c.gw; tok < tok1; tok += c.nw) { const float rs = rsqrtf(wave_sum(lane < 32 ? ssq[(size_t)tok * 32 + lane] : 0.f) * (1.0f / DM) + RMS_EPS); float* op = H + (size_t)tok * DM; const bf16_t* hp = hrow(H, (size_t)tok); const bf16_t* up = U + (size_t)tok * DM;
        u32x4 hraw[4];
#pragma unroll
        for (int i = 0; i < 4; ++i) hraw[i] = *(const u32x4*)(hp + (i * 64 + lane) * 8);
        asm volatile("s_waitcnt vmcnt(0)" : "+v"(hraw[0]), "+v"(hraw[1]), "+v"(hraw[2]), "+v"(hraw[3]) :: "memory");
#pragma unroll
        for (int i = 0; i < 4; ++i) { const int cc = (i * 64 + lane) * 8; float hf[8]; unpack8(hraw[i], hf); const f32x4 g0 = *(const f32x4*)(gp + cc), g1 = *(const f32x4*)(gp + cc + 4);
            float f[8]; unpack8(*(const u32x4*)(up + cc), f);
            const f32x4 o0 = (f32x4){hf[0] + f[0] * rs * g0[0], hf[1] + f[1] * rs * g0[1], hf[2] + f[2] * rs * g0[2], hf[3] + f[3] * rs * g0[3]};
            const f32x4 o1 = (f32x4){hf[4] + f[4] * rs * g1[0], hf[5] + f[5] * rs * g1[1], hf[6] + f[6] * rs * g1[2], hf[7] + f[7] * rs * g1[3]};
            *(f32x4*)(op + cc) = o0; *(f32x4*)(op + cc + 4) = o1; } }
}

constexpr int LDS_STAGE = pg8::STAGE_BYTES;
constexpr int LDS_MISC = LDS_STAGE;
constexpr int LDS_BYTES = LDS_STAGE + 12288;
enum { PH_PREP = 0, PH_PROJ, PH_UP, PH_FINQK, PH_ATTN, PH_LORA, PH_SCANPREP, PH_SCAN1, PH_SCAN2, PH_SCAN3, PH_WOUT, PH_ROUTER, PH_MOE0  , PH_GATE = PH_MOE0 + 2 + NCHUNK  , PH_FINAL, PH_COUNT };

__device__ __forceinline__ int tile_expert(const LAS int* starts, int t) { int lo = 0, hi = NE1; while (hi - lo > 1) { const int mid = (lo + hi) >> 1; if (starts[mid] <= t) lo = mid; else hi = mid; } return lo; }
__device__ __forceinline__ void moe_tables(const Ctx& c, KArgs* a, bool build_rinfo) {
    LAS int* tb = (LAS int*)(c.lds + LDS_MISC); const int* cnt = (const int*)(a->ws + CTL_CNT);
    __syncthreads();
    for (int i = c.tid; i < NCHUNK * NE1; i += 512) { int v = cnt[i]; v = v < 0 ? 0 : (v > CH_TOK ? CH_TOK : v); tb[512 * (i / NE1) + 72 + (i % NE1)] = v; }
    __syncthreads();
    if (c.wid <= NCHUNK) {
        int n = 0, n64 = 0;
        if (c.wid < NCHUNK) { n = tb[512 * c.wid + 72 + c.lane]; n64 = tb[512 * c.wid + 72 + NEXP]; }
        else { for (int k = 0; k < NCHUNK; ++k) { n += tb[512 * k + 72 + c.lane]; n64 += tb[512 * k + 72 + NEXP]; } }
        const int t = (n + 255) >> 8; int incl = t;
#pragma unroll
        for (int o = 1; o < 64; o <<= 1) { const int v = __shfl_up(incl, o); if (c.lane >= o) incl += v; }
        const int tot = __shfl(incl, 63); LAS int* st = c.wid < NCHUNK ? tb + 512 * c.wid : tb + pg8::GT_INT;
        st[c.lane] = incl - t; if (c.lane == 0) { st[NEXP] = tot; st[NE1] = tot + ((n64 + 255) >> 8); } }
    __syncthreads();
    if (c.tid == 0) { int s = 0; for (int k = 0; k < NCHUNK; ++k) { tb[2048 + k] = s; s += tb[512 * k + NE1]; } tb[2048 + NCHUNK] = s; }
    if (build_rinfo) for (int t = c.tid; t < pg8::GT_MAX; t += 512) if (t < tb[pg8::GT_INT + NE1]) ((LAS unsigned char*)tb)[pg8::GM_BYTE + t] = (unsigned char)tile_expert(tb + pg8::GT_INT, t);
    for (int i = c.tid; i < NCHUNK * MAXT; i += 512) { const int k = i / MAXT, t = i % MAXT; const LAS int* tk = tb + 512 * k; if (t < tk[NE1]) tb[512 * k + 144 + t] = tile_expert(tk, t); }
    __syncthreads();
    if (build_rinfo) {
        int2* ri = (int2*)(a->ws + OFF_RINFO); const int* list = (const int*)(a->ws + OFF_LIST); const float* topw = (const float*)(a->ws + OFF_TOPW);
        const int ntall = tb[2048 + NCHUNK];
        for (int idx = blockIdx.x * 512 + c.tid; idx < ntall * 256; idx += gridDim.x * 512) { const int tg = idx >> 8; int k = 0; while (k + 1 < NCHUNK && tb[2048 + k + 1] <= tg) ++k;
            const LAS int* tk = tb + 512 * k; const int ti = tg - tb[2048 + k], e = tk[144 + ti], pos = (ti - tk[e]) * 256 + (idx & 255); int2 v; v.x = CH_TOK * 8; v.y = 0;
            if (pos < tk[72 + e]) { if (e == NEXP) { v.x = YP_SHARED + pos; v.y = __float_as_int(1.0f / 256.0f); }
                else { const int ent = list[((size_t)k * NE1 + e) * CH_TOK + pos]; v.x = ent; v.y = __float_as_int(topw[(size_t)k * CH_TOK * 8 + ent] * (1.0f / 256.0f)); } }
            ri[idx] = v; }
    }
}

__global__ void __launch_bounds__(512, 2) fwd(Args a_in) {
    extern __shared__ __attribute__((aligned(16))) unsigned char lds_raw[];
    const int G = gridDim.x, bid = blockIdx.x;
#define KARG ({ KArgs* kp_ = (KArgs*)__builtin_amdgcn_kernarg_segment_ptr(); asm volatile("" : "+s"(kp_)); kp_; })
#define XBW ((volatile LAS unsigned*)((LAS unsigned char*)lds_raw + LDS_MISC + 12272))
    { KArgs* k0 = KARG; if (k0->ph_hi - k0->ph_lo > 1) { if (threadIdx.x == 0) { XBW[0] = 0u; XBW[1] = 0u; XBW[2] = 0u; XBW[3] = 0u; } __syncthreads(); (void)xcd_barrier_post((unsigned*)(k0->ws + CTL_BAR), XBW); } }
#define GRID_BAR_NOW() do { KArgs* kb_ = KARG; XcdBarrier bar_; bar_.bar = (unsigned*)(kb_->ws + CTL_BAR); bar_.x = xb_xcc_id(); bar_.st = XBW; xcd_barrier(bar_); } while (0)
#ifndef PROBE_MASK
#define PROBE_MASK 0ull
#endif
#ifndef PROBE_EW
#define PROBE_EW 0
#endif
#define DUP(k) ((int)((PROBE_MASK >> (k)) & 1ull))
#define GRID_BAR(k) do { KArgs* kq_ = KARG; if ((k) + 1 < kq_->ph_hi && kq_->ph_lo <= (k)) GRID_BAR_NOW(); } while (0)
#define PHASE_ARGS KArgs* ap_ = (KArgs*)__builtin_amdgcn_kernarg_segment_ptr(); asm volatile("" : "+s"(ap_)); KArgs* a = ap_; unsigned char* ws = a->ws; (void)ws; Ctx c; { int t_ = threadIdx.x; asm volatile("" : "+v"(t_)); c.tid = t_; } c.lane = c.tid & 63; c.wid = __builtin_amdgcn_readfirstlane(c.tid >> 6); c.gw = blockIdx.x * 8 + c.wid; c.nw = gridDim.x * 8; c.lds = (LAS unsigned char*)lds_raw
#ifndef PH_ONLY
#define PH_ONLY -1
#endif
#define IN(k) ((PH_ONLY < 0 || PH_ONLY == (k) || (PH_ONLY == 100 && (k) >= PH_MOE0 && (k) < PH_GATE)) && KARG->ph_lo <= (k) && (k) < KARG->ph_hi)
    for (int rep_ = 0; rep_ <= DUP(PH_PREP); ++rep_) { if (rep_) GRID_BAR_NOW(); if (IN(PH_PREP)) { PHASE_ARGS; phase_prep(c, a); __syncthreads(); if ((NT / 256) * (ZW / 256) % G == 0) phase_prep_late<2>(c, a, bid, G); else phase_prep_late<0>(c, a, bid, G); }
    } GRID_BAR(PH_PREP);
    for (int rep_ = 0; rep_ <= DUP(PH_PROJ); ++rep_) { if (rep_) GRID_BAR_NOW(); if (IN(PH_PROJ)) {
        { PHASE_ARGS; pg8::Gemm g{(const bf16_t*)(ws + WS_XN), (const bf16_t*)(ws + OFF_WT_RKV), DM, DM, DM}; pg8::DenseOrder S; S.init(NT, ZW - ZC_R, G, bid);
          EpiPlain E{(bf16_t*)(ws + OFF_Z) + ZC_R, ZW}; pg8::gemm_phase(c.lds, g, S, E); }
        { PHASE_ARGS; pg8::Gemm g{(const bf16_t*)a->out, (const bf16_t*)(ws + OFF_WT_IN), DM / 2, DM / 2, DM / 2}; pg8::DenseOrder S; S.init(NT, ZC_R, G, bid);
          EpiProj E{(bf16_t*)(ws + OFF_Z), (float*)(ws + OFF_SSQP)}; pg8::gemm_phase(c.lds, g, S, E); } }
        if (IN(PH_PROJ) && rep_ == 0) { const int nrem = (NT / 256) * (ZC_R / 256) % G; if (nrem > 0 && bid >= nrem) { PHASE_ARGS; phase_prep_late<1>(c, a, bid - nrem, G - nrem); } }
    } GRID_BAR(PH_PROJ);
    for (int rep_ = 0; rep_ <= DUP(PH_UP); ++rep_) { if (rep_) GRID_BAR_NOW(); if (IN(PH_UP)) { PHASE_ARGS;
        { pg8::Gemm g{(const bf16_t*)(ws + OFF_Z), (const bf16_t*)(ws + OFF_WT_UQ), ZW, 512, 512}; pg8::DenseOrder S; S.init(NT, QW, G, bid);
          EpiQup E{(bf16_t*)(ws + OFF_QB), (const float*)(ws + OFF_SSQP)}; pg8::gemm_phase(c.lds, g, S, E); }
        { pg8::Gemm g{(const bf16_t*)(ws + OFF_Z) + 512, (const bf16_t*)(ws + OFF_WT_UKV), ZW, 256, 256}; pg8::DenseOrder S; S.init(NT, 2048, G, bid);
          EpiKV E{(bf16_t*)(ws + OFF_KB), (bf16_t*)(ws + OFF_VB), (const float*)(ws + OFF_SSQP)}; pg8::gemm_phase(c.lds, g, S, E); }
    }
    } GRID_BAR(PH_UP);
    for (int rep_ = 0; rep_ <= DUP(PH_FINQK); ++rep_) { if (rep_) GRID_BAR_NOW(); if (IN(PH_FINQK)) { PHASE_ARGS; phase_finalize_qk(c, a); phase_lora_prep(c, a); }
    } GRID_BAR(PH_FINQK);
    for (int rep_ = 0; rep_ <= DUP(PH_ATTN); ++rep_) { if (rep_) GRID_BAR_NOW(); if (IN(PH_ATTN)) { PHASE_ARGS; phase_attn_v2(c, a); }
    } GRID_BAR(PH_ATTN);
    for (int rep_ = 0; rep_ <= DUP(PH_LORA); ++rep_) { if (rep_) GRID_BAR_NOW(); if (IN(PH_LORA)) { PHASE_ARGS; pg8::Gemm g{(const bf16_t*)(ws + OFF_ALORA), (const bf16_t*)(ws + OFF_WT_LORA), LORA_K, LORA_K, LORA_K}; pg8::DenseOrder S; S.init(NT, LORA_N, G, bid);
        EpiPlain E{(bf16_t*)(ws + OFF_LB), LORA_N}; pg8::gemm_phase(c.lds, g, S, E); }
    } GRID_BAR(PH_LORA);
    for (int rep_ = 0; rep_ <= DUP(PH_SCANPREP); ++rep_) { if (rep_) GRID_BAR_NOW(); if (IN(PH_SCANPREP)) { PHASE_ARGS; phase_scan_prep(c, a); }
    } GRID_BAR(PH_SCANPREP);
    for (int rep_ = 0; rep_ <= DUP(PH_SCAN1); ++rep_) { if (rep_) GRID_BAR_NOW(); if (IN(PH_SCAN1)) { PHASE_ARGS; phase_scan_p1m(c, a); }
    } GRID_BAR(PH_SCAN1);
    for (int rep_ = 0; rep_ <= DUP(PH_SCAN2); ++rep_) { if (rep_) GRID_BAR_NOW(); if (IN(PH_SCAN2)) { PHASE_ARGS; phase_scan_p2(c, a); }
    } GRID_BAR(PH_SCAN2);
    for (int rep_ = 0; rep_ <= DUP(PH_SCAN3); ++rep_) { if (rep_) GRID_BAR_NOW(); if (IN(PH_SCAN3)) { PHASE_ARGS; phase_scan_p3(c, a); }
    } GRID_BAR(PH_SCAN3);
    for (int rep_ = 0; rep_ <= DUP(PH_WOUT); ++rep_) { if (rep_) GRID_BAR_NOW(); if (IN(PH_WOUT)) { PHASE_ARGS; pg8::Gemm g{(const bf16_t*)(ws + WS_XN), (const bf16_t*)(ws + OFF_WT_OUT), DM / 2, DM / 2, DM / 2}; pg8::DenseOrder S; S.init(NT, DM, G, bid);
        EpiWout E{(const float*)a->in[I_X], a->out}; g.noepi = rep_; pg8::gemm_phase(c.lds, g, S, E); }
    } GRID_BAR(PH_WOUT);
    for (int rep_ = 0; rep_ <= DUP(PH_ROUTER); ++rep_) { if (rep_) GRID_BAR_NOW(); if (IN(PH_ROUTER)) { PHASE_ARGS;
        if ((bid >> 3) & 1) { phase_expert_weights(c, a); __syncthreads(); phase_router(c, a); } else { phase_router(c, a); __syncthreads(); phase_expert_weights(c, a); } if (PROBE_EW) { __syncthreads(); phase_expert_weights(c, a); } }
    } GRID_BAR(PH_ROUTER);
    for (int rep_ = 0; rep_ <= DUP(PH_MOE0); ++rep_) { if (rep_) GRID_BAR_NOW(); if (IN(PH_MOE0)) { PHASE_ARGS; moe_tables(c, a, true);
            pg8::Gemm g{(const bf16_t*)(ws + WS_XN), (const bf16_t*)(ws + OFF_WE1), DM / 2, DM / 2, DM / 2};
            pg8::MoeOrderG1 S{(const LAS int*)(c.lds + LDS_MISC), (const int*)(ws + OFF_LIST), G, bid, 1024};
            EpiMoe1 E{(unsigned char*)(ws + OFF_HMID)}; g.noepi = rep_; pg8::gemm_phase(c.lds, g, S, E);
            { pg8::Gemm g2{(const bf16_t*)(ws + OFF_PB), (const bf16_t*)(ws + OFF_WT_PP), 256, 256, 256}; pg8::DenseOrder S2; S2.init(NT, DM, G, bid);
              EpiPlain E2{(bf16_t*)(ws + OFF_PP), DM}; pg8::gemm_phase(c.lds, g2, S2, E2); } }
    } GRID_BAR(PH_MOE0);
#define MOE_DOWN(ch) do { pg8::Gemm g{(const bf16_t*)(ws + OFF_HMID), (const bf16_t*)(ws + OFF_WE2), 256, 256, 256}; \
            pg8::MoeOrder<false> S{(const LAS int*)(c.lds + LDS_MISC), (const int*)(ws + OFF_LIST), 8, G, bid, ch, ch + 1, 2048, 0}; \
            EpiMoe2 E{(unsigned char*)(ws + OFF_YPART + (size_t)((ch) & 1) * YPART_BYTES), (const i32x2*)(ws + OFF_RINFO), a->out, ch, 0}; pg8::gemm_phase(c.lds, g, S, E); } while (0)
    if (IN(PH_MOE0 + 1)) { PHASE_ARGS; MOE_DOWN(0); }
    GRID_BAR(PH_MOE0 + 1);
#define MOE_MERGED(ch) do { if (IN(PH_MOE0 + 1 + ch)) {        \
            if ((bid >> 3) & 1) { { PHASE_ARGS; phase_combine(c, a, ch - 1); } __syncthreads(); { PHASE_ARGS; MOE_DOWN(ch); } } \
            else { { PHASE_ARGS; MOE_DOWN(ch); } __syncthreads(); { PHASE_ARGS; phase_combine(c, a, ch - 1); } } } \
        GRID_BAR(PH_MOE0 + 1 + ch); } while (0)
    static_assert(NCHUNK == 4, "phase program below is written out for four chunks");
    MOE_MERGED(1); MOE_MERGED(2); MOE_MERGED(3);
#define GATE_ROWS(r0, r1) do { PHASE_ARGS; pg8::Gemm g{(const bf16_t*)(ws + OFF_XN3 + (size_t)(r0) * DM), (const bf16_t*)(ws + OFF_WT_PG), DM / 2, DM / 2, DM / 2}; pg8::DenseOrder S; S.init((r1) - (r0), DM, G, bid); \
        EpiGate E{(const bf16_t*)(ws + OFF_PP) + (size_t)(r0) * DM, (const float*)a->in[I_BPG], (bf16_t*)(ws + OFF_U) + (size_t)(r0) * DM, (float*)(ws + OFF_SSQU) + (size_t)(r0) * 32, 0}; pg8::gemm_phase(c.lds, g, S, E); } while (0)
    constexpr int R3 = (NCHUNK - 1) * CH_TOK;
    if (IN(PH_MOE0 + 1 + NCHUNK)) { if ((bid >> 3) & 1) { { PHASE_ARGS; phase_combine(c, a, NCHUNK - 1); } __syncthreads(); GATE_ROWS(0, R3); } else { GATE_ROWS(0, R3); __syncthreads(); { PHASE_ARGS; phase_combine(c, a, NCHUNK - 1); } } }
    GRID_BAR(PH_MOE0 + 1 + NCHUNK);
#undef MOE_MERGED
#undef MOE_DOWN
    if (IN(PH_GATE)) { if ((bid >> 3) & 1) { { PHASE_ARGS; phase_final(c, a, 0, R3); } __syncthreads(); GATE_ROWS(R3, NT); } else { GATE_ROWS(R3, NT); __syncthreads(); { PHASE_ARGS; phase_final(c, a, 0, R3); } } }
    GRID_BAR(PH_GATE);
    if (IN(PH_FINAL)) { PHASE_ARGS; phase_final(c, a, R3, NT); }
#undef GATE_ROWS
#undef IN
}

extern "C" void kernel_launch(void* const* d_in, const int* in_sizes, int n_in, void* d_out, int out_size, void* d_ws, size_t ws_size, hipStream_t stream) {
    static int grid = 0;
    if (grid == 0) {
        if (n_in != 37 || out_size != NT * DM || ws_size < WS_END) { fprintf(stderr, "kernel_launch: unexpected shapes (n_in %d out %d ws %zu need %zu)\n", n_in, out_size, ws_size, (size_t)WS_END); grid = -1; return; }
        int dev = 0, cus = 0;
        if (hipGetDevice(&dev) != hipSuccess || hipDeviceGetAttribute(&cus, hipDeviceAttributeMultiprocessorCount, dev) != hipSuccess) { grid = -1; return; }
        if (hipFuncSetAttribute((const void*)fwd, hipFuncAttributeMaxDynamicSharedMemorySize, LDS_BYTES) != hipSuccess) { fprintf(stderr, "kernel_launch: hipFuncSetAttribute failed\n"); grid = -1; return; }
        int per_cu = 0; (void)hipOccupancyMaxActiveBlocksPerMultiprocessor(&per_cu, (const void*)fwd, 512, LDS_BYTES); (void)hipGetLastError();
        grid = cus;
    }
    if (grid < 0) return;
    (void)hipMemsetAsync((char*)d_ws + WS_CTL, 0, CTL_ZERO_BYTES, stream);
    Args a{};
    for (int i = 0; i < 37; ++i) a.in[i] = d_in[i];
    a.out = (float*)d_out; a.ws = (unsigned char*)d_ws;
#if N_LAUNCH_MODE == 0
    for (int p = 0; p < PH_COUNT; ++p) { a.ph_lo = p; a.ph_hi = p + 1; hipLaunchKernelGGL(fwd, dim3(grid), dim3(512), LDS_BYTES, stream, a); }
#else
    a.ph_lo = 0; a.ph_hi = PH_COUNT; hipLaunchKernelGGL(fwd, dim3(grid), dim3(512), LDS_BYTES, stream, a);
#endif
}
```

```cpp
#include <hip/hip_runtime.h>
#include <hip/hip_bf16.h>
#include <cstdio>
#include <cstdint>

#ifndef N_LAUNCH_MODE
#define N_LAUNCH_MODE 1
#endif

#define LAS __attribute__((address_space(3)))
typedef unsigned short bf16_t;
typedef short bf16x8 __attribute__((ext_vector_type(8)));
typedef float f32x4 __attribute__((ext_vector_type(4)));
typedef float f32x16 __attribute__((ext_vector_type(16)));
typedef unsigned u32x4 __attribute__((ext_vector_type(4)));
typedef unsigned u32x2 __attribute__((ext_vector_type(2)));
typedef int i32x2 __attribute__((ext_vector_type(2)));
#ifndef PROBE_NOSTORE
#define PROBE_NOSTORE 0
#endif
typedef int i32x8 __attribute__((ext_vector_type(8)));
typedef _Float16 h16;
typedef _Float16 h16x8 __attribute__((ext_vector_type(8)));
typedef _Float16 h16x4 __attribute__((ext_vector_type(4)));

constexpr int NT = 32768, DM = 2048, SEQ = 8192, NB = 4;
constexpr int ZW = 4352;
constexpr int ZC_KPE = 768, ZC_WL = 832, ZC_AL = 896, ZC_GL = 960, ZC_R = 1280, ZC_K = 2304, ZC_V = 3328;
constexpr int QW = 1536;
constexpr int LORA_K = 384, LORA_N = 3072;
constexpr int NEXP = 64, NE1 = 65;
constexpr int NCHUNK = 4, CH_TOK = NT / NCHUNK;
static_assert(CH_TOK % 256 == 0, "shared-expert row tiles must have no padding rows");
constexpr int MAXT = CH_TOK * 8 / 256 + 64 + CH_TOK / 256;
constexpr float RMS_EPS = 1e-6f;
constexpr float QSCALE = 0.07216878364870322f * 1.4426950408889634f;

constexpr size_t MiB = 1ull << 20;
constexpr size_t WS_CTL = 0;
constexpr size_t CTL_BAR = 0;
constexpr size_t CTL_CNT = 64 * 1024;
constexpr size_t CTL_ZERO_BYTES = 128 * 1024;
constexpr size_t WS_SMALL = 1 * MiB;
constexpr size_t OFF_WT_IN = WS_SMALL;
constexpr size_t OFF_WT_UQ = OFF_WT_IN + (size_t)ZW * 2048 * 2;
constexpr size_t OFF_WT_UKV = OFF_WT_UQ + (size_t)1536 * 512 * 2;
constexpr size_t OFF_WT_LORA = OFF_WT_UKV + (size_t)2048 * 256 * 2;
constexpr size_t OFF_WT_OUT = OFF_WT_LORA + (size_t)LORA_N * LORA_K * 2;
constexpr size_t OFF_WT_PG = OFF_WT_OUT + (size_t)2048 * 2048 * 2;
constexpr size_t OFF_WT_PP = OFF_WT_PG + (size_t)2048 * 2048 * 2;
constexpr size_t OFF_WT_RKV = OFF_WT_IN + (size_t)1280 * 2048;
constexpr size_t OFF_WRF = OFF_WT_PP + (size_t)2048 * 256 * 2;
constexpr size_t OFF_SSQP = OFF_WRF + (size_t)2048 * 64 * 4;
constexpr size_t OFF_TOPW = OFF_SSQP + (size_t)NT * 12 * 4;
constexpr size_t OFF_LIST = OFF_TOPW + (size_t)NT * 8 * 4;
constexpr size_t OFF_ROPE = OFF_LIST + (size_t)NCHUNK * NE1 * CH_TOK * 4;
constexpr size_t OFF_SMALL_END = OFF_ROPE + (size_t)NT * 64 * 4;
constexpr size_t WS_XN = 64 * MiB;
static_assert(OFF_SMALL_END <= WS_XN, "small region overflow");
constexpr size_t WS_BIG = WS_XN + 128 * MiB;
constexpr size_t OFF_Z = WS_BIG;
constexpr size_t OFF_R1 = OFF_Z + 272 * MiB;
constexpr size_t OFF_QB = OFF_R1;
constexpr size_t OFF_KB = OFF_QB + (size_t)NT * QW * 2;
constexpr size_t OFF_VB = OFF_KB + (size_t)NT * QW * 2;
constexpr size_t OFF_ALORA = OFF_R1 + 256 * MiB;
constexpr size_t OFF_LB = OFF_R1;
constexpr size_t OFF_DER = OFF_R1 + 256 * MiB;
constexpr size_t DER_STRIDE = (size_t)NT * 1024 * 2;
constexpr size_t OFF_MIX_END = OFF_DER + 6 * DER_STRIDE;
constexpr size_t OFF_WE1 = WS_BIG;
constexpr size_t OFF_WE2 = OFF_WE1 + (size_t)NE1 * 1024 * 2048;
constexpr size_t OFF_XN3 = WS_XN + 64 * MiB;
constexpr size_t OFF_HMID = OFF_WE2 + (size_t)NE1 * 2048 * 512;
constexpr size_t OFF_YPART = OFF_HMID + (size_t)NCHUNK * MAXT * 256 * 512;
constexpr int YP_SHARED = CH_TOK * 8 + 16;
constexpr size_t YPART_BYTES = (size_t)(CH_TOK * 9 + 16) * 2048;
constexpr size_t OFF_PB = OFF_YPART + 2 * YPART_BYTES;
constexpr size_t OFF_PP = OFF_PB + (size_t)NT * 256 * 2;
constexpr size_t OFF_U = OFF_PP + (size_t)NT * 2048 * 2;
constexpr size_t OFF_SSQU = OFF_U + (size_t)NT * 2048 * 2;
constexpr size_t OFF_RINFO = OFF_SSQU + (size_t)NT * 32 * 4;
constexpr size_t OFF_MOE_END = OFF_RINFO + (size_t)NCHUNK * MAXT * 256 * 8;
constexpr size_t WS_END = (OFF_MIX_END > OFF_MOE_END ? OFF_MIX_END : OFF_MOE_END);
static_assert(WS_END <= 1140 * MiB, "workspace budget");

__device__ __forceinline__ unsigned cvt_pk_bf16(float lo, float hi) { unsigned r; asm volatile("v_cvt_pk_bf16_f32 %0, %1, %2" : "=v"(r) : "v"(lo), "v"(hi)); return r; }
__device__ __forceinline__ bf16_t f2bf(float f) { return (bf16_t)(cvt_pk_bf16(f, 0.f) & 0xffffu); }
__device__ __forceinline__ float bf2f(bf16_t b) { return __uint_as_float(((unsigned)b) << 16); }
__device__ __forceinline__ float bflo(unsigned w) { return __uint_as_float(w << 16); }
__device__ __forceinline__ float bfhi(unsigned w) { return __uint_as_float(w & 0xffff0000u); }
__device__ __forceinline__ u32x4 pack8(f32x4 a, f32x4 b) { return (u32x4){cvt_pk_bf16(a[0], a[1]), cvt_pk_bf16(a[2], a[3]), cvt_pk_bf16(b[0], b[1]), cvt_pk_bf16(b[2], b[3])}; }
__device__ __forceinline__ unsigned pk_fp8x4(float a, float b, float c2, float d) { unsigned w = 0; a = fminf(fmaxf(a, -448.f), 448.f); b = fminf(fmaxf(b, -448.f), 448.f); c2 = fminf(fmaxf(c2, -448.f), 448.f); d = fminf(fmaxf(d, -448.f), 448.f); w = __builtin_amdgcn_cvt_pk_fp8_f32(a, b, w, false); w = __builtin_amdgcn_cvt_pk_fp8_f32(c2, d, w, true); return w; }
__device__ __forceinline__ void unpack8(const u32x4 w, float (&f)[8]) { f[0] = bflo(w[0]); f[1] = bfhi(w[0]); f[2] = bflo(w[1]); f[3] = bfhi(w[1]); f[4] = bflo(w[2]); f[5] = bfhi(w[2]); f[6] = bflo(w[3]); f[7] = bfhi(w[3]); }
__device__ __forceinline__ u32x4 packf8(const float (&f)[8]) { return (u32x4){cvt_pk_bf16(f[0], f[1]), cvt_pk_bf16(f[2], f[3]), cvt_pk_bf16(f[4], f[5]), cvt_pk_bf16(f[6], f[7])}; }
__device__ __forceinline__ float wave_sum(float v) { for (int o = 32; o >= 1; o >>= 1) v += __shfl_xor(v, o); return v; }
__device__ __forceinline__ float rlane(float x, int j) { return __int_as_float(__builtin_amdgcn_readlane(__float_as_int(x), j)); }
__device__ __forceinline__ float sigmoidf_(float x) { return __builtin_amdgcn_rcpf(1.0f + __builtin_amdgcn_exp2f(-1.44269504f * x)); }

#define DPP_ADD(x, ctrl) ((x) + __int_as_float(__builtin_amdgcn_update_dpp(0, __float_as_int(x), (ctrl), 0xF, 0xF, true)))
__device__ __forceinline__ void reduce8_fq(const float (&s)[8], float& o0, float& o1) {
    float t[4];
#pragma unroll
    for (int i = 0; i < 4; ++i) { auto r = __builtin_amdgcn_permlane32_swap(__float_as_uint(s[i]), __float_as_uint(s[i + 4]), false, false); t[i] = __uint_as_float(r[0]) + __uint_as_float(r[1]); }
    { auto r = __builtin_amdgcn_permlane16_swap(__float_as_uint(t[0]), __float_as_uint(t[2]), false, false); o0 = __uint_as_float(r[0]) + __uint_as_float(r[1]); }
    { auto r = __builtin_amdgcn_permlane16_swap(__float_as_uint(t[1]), __float_as_uint(t[3]), false, false); o1 = __uint_as_float(r[0]) + __uint_as_float(r[1]); }
}
__device__ __forceinline__ float allred8(float x) { x = DPP_ADD(x, 0xB1); x = DPP_ADD(x, 0x4E); x = DPP_ADD(x, 0x141); return x; }

namespace pg8 {
constexpr int BM = 256, BK = 64, HALF = 128, HTB = HALF * BK * 2, STAGE_BYTES = 8 * HTB;
__host__ __device__ __forceinline__ int lds_byte(int r, int c) { const int st = (r >> 4) * 2 + (c >> 5), rr = r & 15, cc = c & 31, ob = rr * 64 + cc * 2; return st * 1024 + (ob ^ (((ob >> 9) & 1) << 5)); }
__host__ __device__ __forceinline__ void stage_rc(int b, int& R, int& C) { const int st = b / 1024, sb = b % 1024, swz = sb ^ (((sb >> 9) & 1) << 5); R = (st >> 1) * 16 + swz / 64; C = (st & 1) * 32 + (swz % 64) / 2; }
__host__ __device__ __forceinline__ int perm32(int rho) { const int n = rho >> 4, i = rho & 15; return 8 * (i >> 2) + 4 * n + (i & 3); }

constexpr int GT_INT = 2624, GM_BYTE = 10760, GT_MAX = 1280;
struct Unit { int pm, pn, e, row0, cnt, chunk, arow, b1, b2, b3; };
struct Gemm { const bf16_t* A; const bf16_t* Bt; int lda, ldb, K; int noepi = 0; };

struct DenseOrder {
    static constexpr bool GATHER = false;
    int nM, nN, nwg, G, c;
    __device__ void init(int M, int N, int G_, int c_) { nM = M / BM; nN = N / BM; nwg = nM * nN; G = G_; c = c_; }
    __device__ bool next(int i, Unit& u) const {
        const long L = (long)i * G + c; if (L >= nwg) return false;
        int wgid = (int)L; { const int q = nwg / 8, r = nwg % 8, xcd = wgid % 8, off = wgid / 8; wgid = (xcd < r ? xcd * (q + 1) : r * (q + 1) + (xcd - r) * q) + off; }
        const int nig = 8 * nN, gid = wgid / nig, fm = gid * 8, gsz = (nM - fm) < 8 ? (nM - fm) : 8;
        u.pm = fm + ((wgid % nig) % gsz); u.pn = (wgid % nig) / gsz; u.e = 0; u.row0 = 0; u.cnt = 0; u.chunk = 0; return true;
    }
    __device__ __forceinline__ unsigned a_base(const Gemm& g, const Unit& u) const { return (unsigned)u.pm * (unsigned)(BM * 2) * (unsigned)g.lda; }
    __device__ __forceinline__ unsigned b_base(const Gemm& g, const Unit& u) const { return (unsigned)u.pn * (unsigned)(BM * 2) * (unsigned)g.ldb; }
    __device__ __forceinline__ unsigned row_off(const Gemm& g, const Unit& u, int lr) const { return (unsigned)lr * (unsigned)g.lda * 2u; }
};

template <bool GATHER_> struct MoeOrder {
    static constexpr bool GATHER = GATHER_;
    const LAS int* tab; const int* list; int ncol, G, c, c0, c1, nb_rows, skip_shared;
    __device__ bool next(int i, Unit& u) const {
        const int t0 = __builtin_amdgcn_readfirstlane(tab[2048 + c0]); int ntile = __builtin_amdgcn_readfirstlane(tab[2048 + c1]) - t0; if (skip_shared) ntile = __builtin_amdgcn_readfirstlane(tab[512 * c0 + NEXP]); int ti, pn;
        if (G == 256) { const int x = c & 7, slot = c >> 3, rt = 32 / ncol; ti = i * 8 * rt + x * rt + slot / ncol; pn = slot % ncol; if (ti >= ntile) return false; }
        else { const int L = i * G + c; if (L >= ntile * ncol) return false; ti = L / ncol; pn = L % ncol; }
        const int tg = t0 + ti; int k = c0; while (k + 1 < c1 && __builtin_amdgcn_readfirstlane(tab[2048 + k + 1]) <= tg) ++k;
        const int tl = tg - __builtin_amdgcn_readfirstlane(tab[2048 + k]); const LAS int* tk = tab + 512 * k;
        const int e = __builtin_amdgcn_readfirstlane(tk[144 + tl]);
        u.pm = tg; u.pn = pn; u.e = e; u.chunk = k; u.row0 = __builtin_amdgcn_readfirstlane((tl - tk[e]) * BM); u.cnt = __builtin_amdgcn_readfirstlane(tk[72 + e]);
        if (!GATHER) { int pc = 0; for (int kk = 0; kk < k; ++kk) pc += __builtin_amdgcn_readfirstlane(tab[512 * kk + 72 + e]);
            u.arow = __builtin_amdgcn_readfirstlane(tab[GT_INT + e]) * BM + pc + u.row0; }
        return true;
    }
    __device__ __forceinline__ unsigned a_base(const Gemm& g, const Unit& u) const { return GATHER ? 0u : (unsigned)u.arow * 2u * (unsigned)g.lda; }
    __device__ __forceinline__ unsigned b_base(const Gemm& g, const Unit& u) const { return ((unsigned)u.e * (unsigned)nb_rows + (unsigned)u.pn * BM) * (unsigned)g.ldb * 2u; }
    __device__ __forceinline__ int row_ent(const Gemm& g, const Unit& u, int lr) const { return 0; }
    __device__ __forceinline__ void prefetch_rows(const Gemm&, const Unit&, int, LAS unsigned char*) const {}
    __device__ __forceinline__ int row_ent_lds(LAS unsigned char*, int) const { return 0; }
    __device__ __forceinline__ unsigned row_fin(const Gemm& g, const Unit& u, int lr, int) const { return row_off(g, u, lr); }
    __device__ __forceinline__ unsigned row_off(const Gemm& g, const Unit& u, int lr) const {
        if (!GATHER) return (unsigned)lr * (unsigned)g.lda * 2u;
        const int pos = u.row0 + lr; int tl = 0;
        if (pos < u.cnt) tl = u.e == NEXP ? pos : (list[((size_t)u.chunk * NE1 + u.e) * CH_TOK + pos] >> 3);
        const unsigned tok = (unsigned)u.chunk * CH_TOK + (unsigned)tl;
        return tok * (unsigned)g.lda * 2u;
    }
};

struct MoeOrderG1 {
    static constexpr bool GATHER = true;
    const LAS int* tab; const int* list; int G, c, nb_rows;
    __device__ bool next(int i, Unit& u) const {
        static_assert(NCHUNK == 4, "chunk boundaries b1..b3");
        const int ntile = __builtin_amdgcn_readfirstlane(tab[GT_INT + NE1]); constexpr int ncol = 4, rt = 32 / ncol; int ti, pn;
        if (G == 256) { const int x = c & 7, slot = c >> 3; ti = i * 8 * rt + x * rt + slot / ncol; pn = slot % ncol; if (ti >= ntile) return false; }
        else { const int L = i * G + c; if (L >= ntile * ncol) return false; ti = L / ncol; pn = L % ncol; }
        const int e = __builtin_amdgcn_readfirstlane((int)((const LAS unsigned char*)tab)[GM_BYTE + ti]);
        const int n0 = __builtin_amdgcn_readfirstlane(tab[72 + e]), n1 = __builtin_amdgcn_readfirstlane(tab[512 + 72 + e]), n2 = __builtin_amdgcn_readfirstlane(tab[1024 + 72 + e]), n3 = __builtin_amdgcn_readfirstlane(tab[1536 + 72 + e]);
        u.pm = ti; u.pn = pn; u.e = e; u.chunk = 0; u.row0 = (ti - __builtin_amdgcn_readfirstlane(tab[GT_INT + e])) * BM; u.b1 = n0; u.b2 = n0 + n1; u.b3 = n0 + n1 + n2; u.cnt = n0 + n1 + n2 + n3; u.arow = 0; return true;
    }
    __device__ __forceinline__ unsigned a_base(const Gemm& g, const Unit& u) const { return 0u; }
    __device__ __forceinline__ unsigned b_base(const Gemm& g, const Unit& u) const { return ((unsigned)u.e * (unsigned)nb_rows + (unsigned)u.pn * BM) * (unsigned)g.ldb * 2u; }
    __device__ __forceinline__ unsigned row_off(const Gemm& g, const Unit& u, int lr) const {
        return row_fin(g, u, lr, row_ent(g, u, lr));
    }
    __device__ __forceinline__ int row_ent(const Gemm& g, const Unit& u, int lr) const {
        const int pos = u.row0 + lr; const bool valid = pos < u.cnt;
        const int k = (pos >= u.b1) + (pos >= u.b2) + (pos >= u.b3); int base = pos >= u.b1 ? u.b1 : 0; base = pos >= u.b2 ? u.b2 : base; base = pos >= u.b3 ? u.b3 : base;
        const int idx = (valid && u.e != NEXP) ? (k * NE1 + u.e) * CH_TOK + (pos - base) : 0;
        return list[idx];
    }
    static constexpr int LDS_GL = STAGE_BYTES + 8448;
    __device__ __forceinline__ void prefetch_rows(const Gemm& g, const Unit& u, int wid, LAS unsigned char* lds) const {
        if (wid < 4) { int l_ = threadIdx.x; asm volatile("" : "+v"(l_)); const int lr = wid * 64 + (l_ & 63);
            const int pos = u.row0 + lr; const bool valid = pos < u.cnt;
            const int k = (pos >= u.b1) + (pos >= u.b2) + (pos >= u.b3); int base = pos >= u.b1 ? u.b1 : 0; base = pos >= u.b2 ? u.b2 : base; base = pos >= u.b3 ? u.b3 : base;
            const int idx = (valid && u.e != NEXP) ? (k * NE1 + u.e) * CH_TOK + (pos - base) : 0;
            const int* gp = list + idx; const unsigned ldsa = (unsigned)(size_t)(lds + LDS_GL + wid * 256);
            asm volatile("s_mov_b32 m0, %0\n\ts_nop 0\n\tglobal_load_lds_dword %1, off" :: "s"(ldsa), "v"(gp) : "memory", "m0"); } }
    __device__ __forceinline__ int row_ent_lds(LAS unsigned char* lds, int lr) const { return *(const LAS int*)(lds + LDS_GL + lr * 4); }
    __device__ __forceinline__ unsigned row_fin(const Gemm& g, const Unit& u, int lr, int ent) const {
        const int pos = u.row0 + lr; const bool valid = pos < u.cnt;
        const int k = (pos >= u.b1) + (pos >= u.b2) + (pos >= u.b3); int base = pos >= u.b1 ? u.b1 : 0; base = pos >= u.b2 ? u.b2 : base; base = pos >= u.b3 ? u.b3 : base;
        const int tl = u.e == NEXP ? pos - base : (ent >> 3);
        const unsigned tok = valid ? (unsigned)k * CH_TOK + (unsigned)tl : 0u;
        return tok * (unsigned)g.lda * 2u;
    }
};

template <class...> using void_t_ = void;
template <class E, class = void> struct EpiScale { static constexpr int A = 0x7f7f7f7f, B = 0x7f7f7f7f; };
template <class E> struct EpiScale<E, void_t_<decltype(E::SCALE_A)>> { static constexpr int A = E::SCALE_A, B = E::SCALE_B; };
template <class Epi, class Sched>
__device__ __forceinline__ void gemm_phase(LAS unsigned char* lds, const Gemm g, const Sched& S, const Epi& E) {
    int tid_ = threadIdx.x; asm volatile("" : "+v"(tid_));
    const int tid = tid_, wid = __builtin_amdgcn_readfirstlane(tid >> 6), lane = tid & 63, wr = wid >> 2, wc = wid & 3, fr = lane & 15, fq = lane >> 4;
    int K_ = g.K; asm volatile("" : "+s"(K_));
    const int K = K_, nt = K / BK;
    int Rr[2]; unsigned cA2[2], voffB[2];
#pragma unroll
    for (int i = 0; i < 2; ++i) { int R, C; stage_rc(tid * 16 + i * 8192, R, C); const int Rb = Epi::PERM == 2 ? (64 * (R >> 5) + 16 * ((R >> 2) & 3) + 4 * ((R >> 4) & 1) + (R & 3)) : Epi::PERM == 1 ? ((R & ~31) + perm32(R & 31)) : R;
        Rr[i] = R; cA2[i] = (unsigned)C * 2u; voffB[i] = (unsigned)(Rb * g.ldb + C) * 2u; }
    const unsigned kstep = (unsigned)(BK * 2);
    const unsigned hstepB = (unsigned)(Epi::PERM == 2 ? 8 : HALF) * (unsigned)g.ldb * 2u;
    const char* const Ab = (const char*)g.A; const char* const Bb = (const char*)g.Bt;
    const unsigned ldsw = (unsigned)wid * 1024u;
    const int aoff = lds_byte(wr * 64 + fr, fq * 8), boff = lds_byte(wc * 32 + fr, fq * 8);
#define PG8_SA(b, h) (((b) * 2 + (h)) * HTB)
#define PG8_SB(b, h) ((4 + (b) * 2 + (h)) * HTB)
#define PG8_STAGE_B(bufoff, gbase, h) do { _Pragma("unroll") for (int _i = 0; _i < 2; ++_i) \
        __builtin_amdgcn_global_load_lds((const unsigned*)(Bb + (size_t)((gbase) + (unsigned)(h) * hstepB + voffB[_i])), (LAS unsigned*)(lds + (bufoff) + ldsw + _i * 8192), 16, 0, 0); } while (0)
#define PG8_STAGE_A(bufoff, gbase, V, h) do { _Pragma("unroll") for (int _i = 0; _i < 2; ++_i) \
        __builtin_amdgcn_global_load_lds((const unsigned*)(Ab + (size_t)((gbase) + (V)[h][_i])), (LAS unsigned*)(lds + (bufoff) + ldsw + _i * 8192), 16, 0, 0); } while (0)
#define PG8_LDA(dst, b, h) do { _Pragma("unroll") for (int m = 0; m < 4; ++m) _Pragma("unroll") for (int k = 0; k < 2; ++k) dst[m][k] = *(const LAS bf16x8*)(lds + PG8_SA(b, h) + aoff + m * 2048 + k * 1024); } while (0)
#define PG8_LDB(dst, b, h) do { _Pragma("unroll") for (int n = 0; n < 2; ++n) _Pragma("unroll") for (int k = 0; k < 2; ++k) dst[n][k] = *(const LAS bf16x8*)(lds + PG8_SB(b, h) + boff + n * 2048 + k * 1024); } while (0)
#define PG8_MMA(ai, bj, At, Bt) do { __builtin_amdgcn_s_setprio(1); _Pragma("unroll") for (int m = 0; m < 4; ++m) _Pragma("unroll") for (int n = 0; n < 2; ++n) { \
        if constexpr (Epi::FP8) { i32x8 bv_, av_; { const u32x4 b0_ = *(const u32x4*)&Bt[n][0], b1_ = *(const u32x4*)&Bt[n][1], a0_ = *(const u32x4*)&At[m][0], a1_ = *(const u32x4*)&At[m][1]; \
                bv_ = (i32x8){(int)b0_[0], (int)b0_[1], (int)b0_[2], (int)b0_[3], (int)b1_[0], (int)b1_[1], (int)b1_[2], (int)b1_[3]}; av_ = (i32x8){(int)a0_[0], (int)a0_[1], (int)a0_[2], (int)a0_[3], (int)a1_[0], (int)a1_[1], (int)a1_[2], (int)a1_[3]}; } \
            acc[ai][bj][m][n] = __builtin_amdgcn_mfma_scale_f32_16x16x128_f8f6f4(bv_, av_, acc[ai][bj][m][n], 0, 0, 0, EpiScale<Epi>::A, 0, EpiScale<Epi>::B); } \
        else { _Pragma("unroll") for (int k = 0; k < 2; ++k) acc[ai][bj][m][n] = __builtin_amdgcn_mfma_f32_16x16x32_bf16(Bt[n][k], At[m][k], acc[ai][bj][m][n], 0, 0, 0); } } \
        __builtin_amdgcn_s_setprio(0); } while (0)
#define PG8_WAIT_V(n) asm volatile("s_waitcnt vmcnt(" #n ")" ::: "memory")
#define PG8_WAIT_L(n) asm volatile("s_waitcnt lgkmcnt(" #n ")" ::: "memory")
#define PG8_BAR __builtin_amdgcn_s_barrier()
#define PG8_SCHED __builtin_amdgcn_sched_barrier(0)
#define PG8_ROWS(V, u, FROM_LDS) do { if constexpr (Sched::GATHER) { int ent_[2][2]; \
            _Pragma("unroll") for (int _h = 0; _h < 2; ++_h) _Pragma("unroll") for (int _i = 0; _i < 2; ++_i) ent_[_h][_i] = (FROM_LDS) ? S.row_ent_lds(lds, _h * HALF + Rr[_i]) : S.row_ent(g, (u), _h * HALF + Rr[_i]); \
            asm volatile("" : "+v"(ent_[0][0]), "+v"(ent_[0][1]), "+v"(ent_[1][0]), "+v"(ent_[1][1]));        \
            _Pragma("unroll") for (int _h = 0; _h < 2; ++_h) _Pragma("unroll") for (int _i = 0; _i < 2; ++_i) (V)[_h][_i] = S.row_fin(g, (u), _h * HALF + Rr[_i], ent_[_h][_i]) + cA2[_i]; } \
        else { _Pragma("unroll") for (int _h = 0; _h < 2; ++_h) _Pragma("unroll") for (int _i = 0; _i < 2; ++_i) (V)[_h][_i] = S.row_off(g, (u), _h * HALF + Rr[_i]) + cA2[_i]; } } while (0)
    Unit cur, nxt; int ui = 0;
    if (!S.next(0, cur)) return;
    f32x4 acc[2][2][4][2];
    bf16x8 At[4][2], B0[2][2], B1[2][2];
    unsigned vA[2][2];
    PG8_ROWS(vA, cur, 0);
    unsigned cA = S.a_base(g, cur), cB = S.b_base(g, cur);
    PG8_STAGE_B(PG8_SB(0, 0), cB, 0); PG8_STAGE_A(PG8_SA(0, 0), cA, vA, 0); PG8_STAGE_B(PG8_SB(0, 1), cB, 1); PG8_STAGE_A(PG8_SA(0, 1), cA, vA, 1);
    if (wr == 1) PG8_BAR;
    PG8_WAIT_V(4); PG8_BAR;
    PG8_STAGE_B(PG8_SB(1, 0), cB + kstep, 0); PG8_STAGE_A(PG8_SA(1, 0), cA + kstep, vA, 0); PG8_STAGE_B(PG8_SB(1, 1), cB + kstep, 1);
    PG8_WAIT_V(6); PG8_BAR;
#pragma unroll
    for (int a = 0; a < 2; ++a)
#pragma unroll
        for (int b = 0; b < 2; ++b)
#pragma unroll
            for (int m = 0; m < 4; ++m)
#pragma unroll
                for (int n = 0; n < 2; ++n) acc[a][b][m][n] = (f32x4){0.f, 0.f, 0.f, 0.f};
    for (;;) {
        const bool has_next = S.next(ui + 1, nxt);
        const unsigned nA = has_next ? S.a_base(g, nxt) : cA, nB = has_next ? S.b_base(g, nxt) : cB;
#pragma nounroll
        for (int t = 0; t < nt; t += 2) {
            const bool last = (t == nt - 2);
            if constexpr (Epi::PREFETCH) { if (last) E.prefetch(cur, wid, lds); }
            if constexpr (Sched::GATHER) { if (t == 0 && has_next) S.prefetch_rows(g, nxt, wid, lds); }
            asm volatile("" : "+v"(vA[0][0]), "+v"(vA[0][1]), "+v"(vA[1][0]), "+v"(vA[1][1]), "+v"(voffB[0]), "+v"(voffB[1]));
            const unsigned a1 = cA + (unsigned)(t + 1) * kstep;
            const unsigned a2 = last ? nA : cA + (unsigned)(t + 2) * kstep, b2 = last ? nB : cB + (unsigned)(t + 2) * kstep;
            const unsigned a3 = a2 + kstep, b3 = b2 + kstep;
            PG8_LDB(B0, 0, 0); PG8_SCHED; PG8_LDA(At, 0, 0); PG8_STAGE_A(PG8_SA(1, 1), a1, vA, 1);
            if (Sched::GATHER) { if (last && has_next) PG8_ROWS(vA, nxt, 1); }
            PG8_WAIT_L(8); PG8_BAR; PG8_WAIT_L(0); PG8_MMA(0, 0, At, B0); PG8_BAR; PG8_SCHED;
            PG8_LDB(B1, 0, 1); PG8_STAGE_B(PG8_SB(0, 0), b2, 0);
            PG8_BAR; PG8_WAIT_L(0); PG8_MMA(0, 1, At, B1); PG8_BAR;
            PG8_LDA(At, 0, 1); PG8_STAGE_A(PG8_SA(0, 0), a2, vA, 0);
            PG8_BAR; PG8_WAIT_L(0); PG8_MMA(1, 0, At, B0); PG8_BAR; PG8_SCHED;
            PG8_STAGE_B(PG8_SB(0, 1), b2, 1);
            PG8_WAIT_V(6); PG8_BAR; PG8_MMA(1, 1, At, B1); PG8_BAR;
            PG8_LDB(B0, 1, 0); PG8_SCHED; PG8_LDA(At, 1, 0); PG8_STAGE_A(PG8_SA(0, 1), a2, vA, 1);
            PG8_WAIT_L(8); PG8_BAR; PG8_WAIT_L(0); PG8_MMA(0, 0, At, B0); PG8_BAR; PG8_SCHED;
            PG8_LDB(B1, 1, 1); PG8_STAGE_B(PG8_SB(1, 0), b3, 0);
            PG8_BAR; PG8_WAIT_L(0); PG8_MMA(0, 1, At, B1); PG8_BAR;
            PG8_LDA(At, 1, 1); PG8_STAGE_A(PG8_SA(1, 0), a3, vA, 0);
            PG8_BAR; PG8_WAIT_L(0); PG8_MMA(1, 0, At, B0); PG8_BAR; PG8_SCHED;
            PG8_STAGE_B(PG8_SB(1, 1), b3, 1);
            PG8_WAIT_V(6); PG8_BAR; PG8_MMA(1, 1, At, B1); PG8_BAR;
        }
        { int z_ = 0; asm volatile("" : "+v"(z_));
          if (PROBE_NOSTORE && g.noepi) { asm volatile("" :: "v"(acc[0][0][0][0]), "v"(acc[1][1][3][1]), "v"(acc[0][1][2][1]), "v"(acc[1][0][1][0])); }
          else if constexpr (Epi::PREFETCH) E.epi(acc, cur, wr, wc, fr + z_, fq + z_, lds); else E(acc, cur, wr, wc, fr + z_, fq + z_); }
        if (!has_next) break;
#pragma unroll
        for (int a = 0; a < 2; ++a)
#pragma unroll
            for (int b = 0; b < 2; ++b)
#pragma unroll
                for (int m = 0; m < 4; ++m)
#pragma unroll
                    for (int n = 0; n < 2; ++n) acc[a][b][m][n] = (f32x4){0.f, 0.f, 0.f, 0.f};
        cur = nxt; cA = nA; cB = nB; ++ui;
    }
    PG8_WAIT_V(0);
    if (wr == 0) PG8_BAR;
    PG8_BAR;
#undef PG8_SA
#undef PG8_SB
#undef PG8_STAGE_A
#undef PG8_STAGE_B
#undef PG8_LDA
#undef PG8_LDB
#undef PG8_MMA
#undef PG8_WAIT_V
#undef PG8_WAIT_L
#undef PG8_BAR
#undef PG8_SCHED
#undef PG8_ROWS
}
}
using pg8::Unit;
constexpr int LDS_STAGE_BYTES = pg8::STAGE_BYTES;
typedef f32x4 AccT[2][2][4][2];

struct EpiProj {
    static constexpr int PERM = 1; static constexpr bool FP8 = true, PREFETCH = false;
    static constexpr int SCALE_A = 0x7b7b7b7b, SCALE_B = 0x79797979;
    bf16_t* Z; float* ssqp;
    __device__ __forceinline__ void operator()(const AccT& acc, const Unit& u, int wr, int wc, int fr, int fq) const {
        const int row0 = u.pm * 256 + wr * 64 + fr, col0 = u.pn * 256 + wc * 32 + 8 * fq;
        const bool st = u.pn <= 2; const int slot = u.pn * 4 + wc;
#pragma unroll
        for (int ai = 0; ai < 2; ++ai)
#pragma unroll
            for (int m = 0; m < 4; ++m) { const int row = row0 + ai * 128 + m * 16; bf16_t* rp = Z + (size_t)row * ZW + col0;
#pragma unroll
                for (int bj = 0; bj < 2; ++bj) *(u32x4*)(rp + bj * 128) = pack8(acc[ai][bj][m][0], acc[ai][bj][m][1]); }
        if (st) { float sv[8];
#pragma unroll
            for (int ai = 0; ai < 2; ++ai)
#pragma unroll
                for (int m = 0; m < 4; ++m) { float s = 0.f;
#pragma unroll
                    for (int bj = 0; bj < 2; ++bj) { const f32x4 v0 = acc[ai][bj][m][0], v1 = acc[ai][bj][m][1];
                        s += v0[0] * v0[0] + v0[1] * v0[1] + v0[2] * v0[2] + v0[3] * v0[3] + v1[0] * v1[0] + v1[1] * v1[1] + v1[2] * v1[2] + v1[3] * v1[3]; }
                    sv[ai * 4 + m] = s; }
            float o0, o1; reduce8_fq(sv, o0, o1);
            const int r0 = 2 * fq, r1 = 2 * fq + 1;
            ssqp[(size_t)(row0 + (r0 >> 2) * 128 + (r0 & 3) * 16) * 12 + slot] = o0; ssqp[(size_t)(row0 + (r1 >> 2) * 128 + (r1 & 3) * 16) * 12 + slot] = o1; }
    }
};
struct EpiQup {
    static constexpr int PERM = 1; static constexpr bool FP8 = false, PREFETCH = false;
    bf16_t* Q; const float* ssqp;
    __device__ __forceinline__ void operator()(const AccT& acc, const Unit& u, int wr, int wc, int fr, int fq) const {
        const int row0 = u.pm * 256 + wr * 64 + fr, col0 = u.pn * 256 + wc * 32 + 8 * fq;
        float scv[2][4];
#pragma unroll
        for (int ai = 0; ai < 2; ++ai)
#pragma unroll
            for (int m = 0; m < 4; ++m) { const int row = row0 + ai * 128 + m * 16; const f32x4 p0 = *(const f32x4*)(ssqp + (size_t)row * 12), p1 = *(const f32x4*)(ssqp + (size_t)row * 12 + 4); scv[ai][m] = rsqrtf((((p0[0] + p0[1]) + (p0[2] + p0[3])) + ((p1[0] + p1[1]) + (p1[2] + p1[3]))) * (1.0f / 512.0f) + RMS_EPS); }
#pragma unroll
        for (int ai = 0; ai < 2; ++ai)
#pragma unroll
            for (int m = 0; m < 4; ++m) { const int row = row0 + ai * 128 + m * 16; const float sc = scv[ai][m]; bf16_t* rp = Q + (size_t)row * QW + col0;
#pragma unroll
                for (int bj = 0; bj < 2; ++bj) *(u32x4*)(rp + bj * 128) = pack8(acc[ai][bj][m][0] * sc, acc[ai][bj][m][1] * sc); }
    }
};
struct EpiKV {
    static constexpr int PERM = 1; static constexpr bool FP8 = false, PREFETCH = false;
    bf16_t* Kb; bf16_t* Vb; const float* ssqp;
    __device__ __forceinline__ void operator()(const AccT& acc, const Unit& u, int wr, int wc, int fr, int fq) const {
        const int row0 = u.pm * 256 + wr * 64 + fr, c0 = wc * 32 + 8 * fq;
        float scv[2][4];
#pragma unroll
        for (int ai = 0; ai < 2; ++ai)
#pragma unroll
            for (int m = 0; m < 4; ++m) { const int row = row0 + ai * 128 + m * 16; const f32x4 p2 = *(const f32x4*)(ssqp + (size_t)row * 12 + 8); scv[ai][m] = rsqrtf(((p2[0] + p2[1]) + (p2[2] + p2[3])) * (1.0f / 256.0f) + RMS_EPS); }
#pragma unroll
        for (int ai = 0; ai < 2; ++ai)
#pragma unroll
            for (int m = 0; m < 4; ++m) { const int row = row0 + ai * 128 + m * 16; const float sc = scv[ai][m];
                *(u32x4*)(Kb + (size_t)row * QW + u.pn * 192 + c0) = pack8(acc[ai][0][m][0] * sc, acc[ai][0][m][1] * sc);
                *(u32x4*)(Vb + (size_t)row * 1024 + u.pn * 128 + c0) = pack8(acc[ai][1][m][0] * sc, acc[ai][1][m][1] * sc); }
    }
};
struct EpiPlain {
    static constexpr int PERM = 1; static constexpr bool FP8 = false, PREFETCH = false;
    bf16_t* O; int ld;
    __device__ __forceinline__ void operator()(const AccT& acc, const Unit& u, int wr, int wc, int fr, int fq) const {
        const int row0 = u.pm * 256 + wr * 64 + fr, col0 = u.pn * 256 + wc * 32 + 8 * fq;
#pragma unroll
        for (int ai = 0; ai < 2; ++ai)
#pragma unroll
            for (int m = 0; m < 4; ++m) { bf16_t* rp = O + (size_t)(row0 + ai * 128 + m * 16) * ld + col0;
#pragma unroll
                for (int bj = 0; bj < 2; ++bj) *(u32x4*)(rp + bj * 128) = pack8(acc[ai][bj][m][0], acc[ai][bj][m][1]); }
    }
};
__device__ __forceinline__ bf16_t* hrow(float* out, size_t tok) { return (bf16_t*)((unsigned char*)out + tok * (size_t)(DM * 4) + (size_t)(DM * 2)); }
struct EpiWout {
    static constexpr int PERM = 1; static constexpr bool FP8 = true, PREFETCH = false;
    static constexpr int SCALE_A = 0x7b7b7b7b, SCALE_B = 0x79797979;
    const float* X; float* H;
    __device__ __forceinline__ void operator()(const AccT& acc, const Unit& u, int wr, int wc, int fr, int fq) const {
        const int row0 = u.pm * 256 + wr * 64 + fr, col0 = u.pn * 256 + wc * 32 + 8 * fq;
#pragma unroll
        for (int ai = 0; ai < 2; ++ai) { f32x4 xv[4][2][2];
#pragma unroll
            for (int m = 0; m < 4; ++m)
#pragma unroll
                for (int bj = 0; bj < 2; ++bj)
#pragma unroll
                    for (int n = 0; n < 2; ++n) xv[m][bj][n] = *(const f32x4*)(X + (size_t)(row0 + ai * 128 + m * 16) * DM + col0 + bj * 128 + n * 4);
#pragma unroll
            for (int m = 0; m < 4; ++m)
#pragma unroll
                for (int bj = 0; bj < 2; ++bj) *(u32x4*)(hrow(H, (size_t)(row0 + ai * 128 + m * 16)) + col0 + bj * 128) = pack8(xv[m][bj][0] + acc[ai][bj][m][0], xv[m][bj][1] + acc[ai][bj][m][1]); }
    }
};
struct EpiMoe1 {
    static constexpr int PERM = 1; static constexpr bool FP8 = true, PREFETCH = false;
    unsigned char* Hmid;
    __device__ __forceinline__ void operator()(const AccT& acc, const Unit& u, int wr, int wc, int fr, int fq) const {
        const int row0 = u.pm * 256 + wr * 64 + fr, c0 = u.pn * 128 + wc * 32 + 8 * fq; constexpr float SC = 1.0f / 1024.0f;
#pragma unroll
        for (int ai = 0; ai < 2; ++ai)
#pragma unroll
            for (int m = 0; m < 4; ++m) { float h0[4], h1[4];
#pragma unroll
                for (int j = 0; j < 4; ++j) { const float a0 = acc[ai][0][m][0][j], a1 = acc[ai][0][m][1][j];
                    h0[j] = a0 * acc[ai][1][m][0][j] * (SC * SC * 4.0f) * __builtin_amdgcn_rcpf(1.0f + __builtin_amdgcn_exp2f(a0 * (-SC * 1.44269504f)));
                    h1[j] = a1 * acc[ai][1][m][1][j] * (SC * SC * 4.0f) * __builtin_amdgcn_rcpf(1.0f + __builtin_amdgcn_exp2f(a1 * (-SC * 1.44269504f))); }
                u32x2 w; w.x = pk_fp8x4(h0[0], h0[1], h0[2], h0[3]); w.y = pk_fp8x4(h1[0], h1[1], h1[2], h1[3]);
                *(u32x2*)(Hmid + (size_t)(row0 + ai * 128 + m * 16) * 512 + c0) = w; }
    }
};
struct EpiMoe2 {
    static constexpr int PERM = 2; static constexpr bool FP8 = true, PREFETCH = true;
    static constexpr int LDS_RI = LDS_STAGE_BYTES + 8448;
    unsigned char* Y; const i32x2* rinfo; float* H; int chunk, nostore;
    __device__ __forceinline__ void prefetch(const Unit& u, int wid, LAS unsigned char* lds) const {
        if (wid < 2) { int l_ = threadIdx.x; asm volatile("" : "+v"(l_));
            const unsigned ldsa = (unsigned)(size_t)(lds + LDS_RI + wid * 1024); const i32x2* gb = rinfo + (size_t)u.pm * 256 + wid * 128; const unsigned vo = (unsigned)(l_ & 63) * 16u;
            asm volatile("s_mov_b32 m0, %0\n\ts_nop 0\n\tglobal_load_lds_dwordx4 %1, %2" :: "s"(ldsa), "v"(vo), "s"(gb) : "memory", "m0"); } }
    __device__ __forceinline__ void epi(const AccT& acc, const Unit& u, int wr, int wc, int fr, int fq, LAS unsigned char* lds) const {
        const int lr0 = wr * 64 + fr, col0 = u.pn * 256 + wc * 64 + 16 * fq; const LAS i32x2* rp0 = (const LAS i32x2*)(lds + LDS_RI) + lr0;
        unsigned char* Yl = Y; asm volatile("" : "+s"(Yl));
        {
#pragma unroll
            for (int ai = 0; ai < 2; ++ai)
#pragma unroll
                for (int m = 0; m < 4; ++m) { const i32x2 ri = rp0[ai * 128 + m * 16]; const float w = __int_as_float(ri.y) * 16.0f; unsigned char* rp = Yl + (size_t)ri.x * DM + col0;
                    u32x4 w8;
#pragma unroll
                    for (int bj = 0; bj < 2; ++bj) { const f32x4 y0 = acc[ai][bj][m][0] * w, y1 = acc[ai][bj][m][1] * w;
                        w8[2 * bj] = __builtin_amdgcn_cvt_pk_fp8_f32(y0[2], y0[3], __builtin_amdgcn_cvt_pk_fp8_f32(y0[0], y0[1], 0, false), true);
                        w8[2 * bj + 1] = __builtin_amdgcn_cvt_pk_fp8_f32(y1[2], y1[3], __builtin_amdgcn_cvt_pk_fp8_f32(y1[0], y1[1], 0, false), true); }
                    if (nostore && PROBE_NOSTORE) asm volatile("" :: "v"(w8)); else *(u32x4*)rp = w8; }
        }
    }
};
struct EpiGate {
    static constexpr int PERM = 1; static constexpr bool FP8 = true, PREFETCH = false;
    const bf16_t* PP; const float* bias; bf16_t* U; float* ssq_u; int noepi;
    __device__ __forceinline__ void operator()(const AccT& acc, const Unit& u, int wr, int wc, int fr, int fq) const {
        if (noepi && PROBE_NOSTORE) { asm volatile("" :: "v"(acc[0][0][0][0][0]), "v"(acc[1][1][3][1][3])); return; }
        const int row0 = u.pm * 256 + wr * 64 + fr, col0 = u.pn * 256 + wc * 32 + 8 * fq;
        float ssr[2][4];
#pragma unroll
        for (int ai = 0; ai < 2; ++ai)
#pragma unroll
            for (int m = 0; m < 4; ++m) ssr[ai][m] = 0.f;
        u32x4 ppr[2][2][4];
        f32x4 bb[2][2];
#pragma unroll
        for (int bj = 0; bj < 2; ++bj) { bb[bj][0] = *(const f32x4*)(bias + col0 + bj * 128); bb[bj][1] = *(const f32x4*)(bias + col0 + bj * 128 + 4); }
#pragma unroll
        for (int bj = 0; bj < 2; ++bj) { const f32x4 b0 = bb[bj][0], b1 = bb[bj][1];
#pragma unroll
            for (int ai = 0; ai < 2; ++ai)
#pragma unroll
                for (int m = 0; m < 4; ++m) ppr[bj][ai][m] = *(const u32x4*)(PP + (size_t)(row0 + ai * 128 + m * 16) * DM + col0 + bj * 128);
#pragma unroll
            for (int ai = 0; ai < 2; ++ai)
#pragma unroll
                for (int m = 0; m < 4; ++m) { const size_t off = (size_t)(row0 + ai * 128 + m * 16) * DM + col0 + bj * 128; float pp[8]; unpack8(ppr[bj][ai][m], pp);
                    const f32x4 a0 = acc[ai][bj][m][0] * (1.0f / 1024.0f) + b0, a1 = acc[ai][bj][m][1] * (1.0f / 1024.0f) + b1; float uu[8]; float s = 0.f;
#pragma unroll
                    for (int e = 0; e < 4; ++e) { uu[e] = pp[e] * sigmoidf_(a0[e]); uu[4 + e] = pp[4 + e] * sigmoidf_(a1[e]); }
#pragma unroll
                    for (int e = 0; e < 8; ++e) s += uu[e] * uu[e];
                    *(u32x4*)(U + off) = packf8(uu); ssr[ai][m] += s; } }
        { float sv[8];
#pragma unroll
          for (int r = 0; r < 8; ++r) sv[r] = ssr[r >> 2][r & 3];
          float o0, o1; reduce8_fq(sv, o0, o1); const int r0 = 2 * fq, r1 = 2 * fq + 1;
          ssq_u[(size_t)(row0 + (r0 >> 2) * 128 + (r0 & 3) * 16) * 32 + u.pn * 4 + wc] = o0; ssq_u[(size_t)(row0 + (r1 >> 2) * 128 + (r1 & 3) * 16) * 32 + u.pn * 4 + wc] = o1; }
    }
};

#define XB_TMO      128
#define XB_XCNT(j)  (256  + 64 * (j))
#define XB_XSUB(j)  (1280 + 64 * (j))
#define XB_XGEN(j)  (2304 + 64 * (j))
#define XB_TOP      3328
#define XB_TOPGEN   3392
#define XCD_BAR_WORDS 3456
#define XB_SPIN_CAP (1u << 22)
__device__ __forceinline__ unsigned xb_ld(unsigned* p)              { return __hip_atomic_load(p, __ATOMIC_RELAXED, __HIP_MEMORY_SCOPE_AGENT); }
__device__ __forceinline__ unsigned xb_add(unsigned* p, unsigned v) { return __hip_atomic_fetch_add(p, v, __ATOMIC_RELAXED, __HIP_MEMORY_SCOPE_AGENT); }
__device__ __forceinline__ unsigned xb_xcc_id() { return (unsigned)__builtin_amdgcn_s_getreg((3 << 11) | 20) & 0xFu; }
#define XB_SPIN(cond, bar) do { unsigned _sp = 0; while (cond) { __builtin_amdgcn_s_sleep(1); \
    if ((++_sp & 255u) == 0u) { if (xb_ld(&(bar)[XB_TMO])) break; if (_sp > XB_SPIN_CAP) { atomicAdd(&(bar)[XB_TMO], 1u); break; } } } } while (0)
struct XcdBarrier { unsigned* bar; unsigned x; volatile LAS unsigned* st; };
__device__ __forceinline__ XcdBarrier xcd_barrier_post(unsigned* bar, volatile LAS unsigned* st) {
    XcdBarrier b; b.bar = bar; b.x = xb_xcc_id(); b.st = st;
    if (threadIdx.x == 0) (void)xb_add(&bar[XB_XCNT(b.x)], 1u);
    return b;
}
__device__ __forceinline__ void xcd_barrier_complete(unsigned* bar, unsigned x, unsigned& nloc, unsigned& nx) {
    const unsigned G = gridDim.x * gridDim.y * gridDim.z;
    unsigned sum, cnt, mine, sp = 0u;
    for (;;) {
        sum = 0u; cnt = 0u; mine = 0u;
#pragma unroll
        for (unsigned j = 0; j < 16; ++j) { const unsigned c = xb_ld(&bar[XB_XCNT(j)]); sum += c; cnt += (c > 0u) ? 1u : 0u; mine = (j == x) ? c : mine; }
        if (sum == G) break;
        __builtin_amdgcn_s_sleep(1);
        if ((++sp & 255u) == 0u) { if (xb_ld(&bar[XB_TMO])) break; if (sp > XB_SPIN_CAP) { atomicAdd(&bar[XB_TMO], 1u); break; } }
    }
    nloc = mine > 0u ? mine : 1u; nx = cnt > 0u ? cnt : 1u;
}
__device__ __forceinline__ void xcd_barrier(const XcdBarrier& b) {
    asm volatile("s_waitcnt vmcnt(0)" ::: "memory");
    __syncthreads();
    if (threadIdx.x == 0) {
        unsigned* bar = b.bar;
        __builtin_amdgcn_s_waitcnt(0);
        unsigned nloc = b.st[0], nx = b.st[1];
        if (nloc == 0u) { xcd_barrier_complete(bar, b.x, nloc, nx); b.st[0] = nloc; b.st[1] = nx; }
        const unsigned old = xb_add(&bar[XB_XSUB(b.x)], 1u);
        const unsigned gen = old / nloc;
        if (old + 1u == (gen + 1u) * nloc) {
            __builtin_amdgcn_fence(__ATOMIC_RELEASE, "agent");
            asm volatile("s_waitcnt vmcnt(0)" ::: "memory");
            const unsigned og = xb_add(&bar[XB_TOP], 1u);
            const unsigned tg = og / nx;
            if (og + 1u == (tg + 1u) * nx) xb_add(&bar[XB_TOPGEN], 1u);
            else XB_SPIN(xb_ld(&bar[XB_TOPGEN]) == tg, bar);
            __builtin_amdgcn_fence(__ATOMIC_ACQUIRE, "agent");
            xb_add(&bar[XB_XGEN(b.x)], 1u);
            asm volatile("s_waitcnt vmcnt(0)" ::: "memory");
        } else {
            XB_SPIN(xb_ld(&bar[XB_XGEN(b.x)]) == gen, bar);
            __builtin_amdgcn_fence(__ATOMIC_ACQUIRE, "agent");
            asm volatile("s_waitcnt vmcnt(0)" ::: "memory");
        }
    }
    __syncthreads();
}

struct Args { const void* in[37]; float* out; unsigned char* ws; int ph_lo, ph_hi; };
enum { I_X = 0, I_P, I_POS, I_GMIX, I_WIN, I_GQA, I_WUQ, I_GKVA, I_WUKV, I_GQN, I_GKN, I_MU, I_W0, I_WW2, I_A0, I_AW2, I_GW2, I_KK, I_KA, I_RK, I_LNW, I_LNB,
       I_WOUT, I_GFFN, I_WR, I_RBIAS, I_WG, I_WU, I_WD, I_SG, I_SU, I_SD, I_GPIN, I_WPG, I_BPG, I_WPP, I_GPOUT };

typedef const __attribute__((address_space(4))) Args KArgs;
struct Ctx { int tid, lane, wid, gw, nw; LAS unsigned char* lds; };

__device__ __forceinline__ int in_map(int n) {
    if (n < 832) return n; if (n < 896) return 3904 + (n - 832); if (n < 960) return 3968 + (n - 896); if (n < 1120) return 4032 + (n - 960); if (n < 1280) return -1; return 832 + (n - 1280);
}
template <int MODE, bool OUT8 = false>
__device__ __forceinline__ void convert_weight(const Ctx& c, const float* src0, const float* src1, int ld_src, const float* g, bf16_t* dst, int K, int Nd, int blk, int nblk) {
    LAS float* tile = (LAS float*)c.lds;
    const int tk = K / 64, ntile = tk * (Nd / 128);
    const int n4 = c.tid & 31, kr = c.tid >> 5, sc = c.tid & 7, sn = c.tid >> 3;
    f32x4 v[4];
#define CW_LOAD(t_) do { const int n0_ = ((t_) / tk) * 128, k0_ = ((t_) % tk) * 64, n_ = n0_ + 4 * n4; const float* sp_ = nullptr; \
        if (MODE == 0) sp_ = src0 + n_; \
        if (MODE == 1) { const int cc_ = in_map(n_); sp_ = cc_ >= 0 ? src0 + cc_ : nullptr; } \
        if (MODE == 2) { const int half_ = (n_ >> 7) & 1, cc_ = (n_ >> 8) * 128 + (n_ & 127); sp_ = (half_ ? src1 : src0) + cc_; } \
        _Pragma("unroll") for (int i = 0; i < 4; ++i) { const int k_ = k0_ + kr + 16 * i; v[i] = sp_ ? *(const f32x4*)(sp_ + (size_t)k_ * ld_src) : (f32x4){0.f, 0.f, 0.f, 0.f}; if (g) v[i] *= g[k_]; if (OUT8) v[i] *= 64.0f; } } while (0)
    int t = blk; if (t < ntile) CW_LOAD(t);
    for (; t < ntile; t += nblk) {
#pragma unroll
        for (int i = 0; i < 4; ++i)
#pragma unroll
            for (int e = 0; e < 4; ++e) tile[(kr + 16 * i) * 129 + 4 * n4 + e] = v[i][e];
        __syncthreads();
        const int n0 = (t / tk) * 128, k0 = (t % tk) * 64;
        if (t + nblk < ntile) CW_LOAD(t + nblk);
#pragma unroll
        for (int i = 0; i < 2; ++i) { const int nl = sn + 64 * i; float f[8];
#pragma unroll
            for (int j = 0; j < 8; ++j) f[j] = tile[(8 * sc + j) * 129 + nl];
            if (OUT8) { u32x2 w8; w8.x = pk_fp8x4(f[0], f[1], f[2], f[3]); w8.y = pk_fp8x4(f[4], f[5], f[6], f[7]); *(u32x2*)((unsigned char*)dst + (size_t)(n0 + nl) * K + k0 + 8 * sc) = w8; }
            else *(u32x4*)(dst + (size_t)(n0 + nl) * K + k0 + 8 * sc) = (u32x4){cvt_pk_bf16(f[0], f[1]), cvt_pk_bf16(f[2], f[3]), cvt_pk_bf16(f[4], f[5]), cvt_pk_bf16(f[6], f[7])}; }
        __syncthreads();
    }
#undef CW_LOAD
}

__device__ __forceinline__ void rownorm_bf16(const float* src, bf16_t* dst, int lane) {
    f32x4 v[8]; float ss = 0.f;
#pragma unroll
    for (int i = 0; i < 8; ++i) { v[i] = *(const f32x4*)(src + (i * 64 + lane) * 4); ss += v[i][0] * v[i][0] + v[i][1] * v[i][1] + v[i][2] * v[i][2] + v[i][3] * v[i][3]; }
    ss = wave_sum(ss); const float rs = rsqrtf(ss * (1.0f / DM) + RMS_EPS);
#pragma unroll
    for (int i = 0; i < 8; ++i) { u32x2 w; w.x = cvt_pk_bf16(v[i][0] * rs, v[i][1] * rs); w.y = cvt_pk_bf16(v[i][2] * rs, v[i][3] * rs); *(u32x2*)(dst + (i * 64 + lane) * 4) = w; }
}

__device__ __forceinline__ void rownorm_both(const float* src, bf16_t* dst, unsigned char* dst8, int lane) {
    f32x4 v[8]; float ss = 0.f;
#pragma unroll
    for (int i = 0; i < 8; ++i) { v[i] = *(const f32x4*)(src + (i * 64 + lane) * 4); ss += v[i][0] * v[i][0] + v[i][1] * v[i][1] + v[i][2] * v[i][2] + v[i][3] * v[i][3]; }
    ss = wave_sum(ss); const float rs = rsqrtf(ss * (1.0f / DM) + RMS_EPS), rs8 = rs * 16.0f;
#pragma unroll
    for (int i = 0; i < 8; ++i) { u32x2 w; w.x = cvt_pk_bf16(v[i][0] * rs, v[i][1] * rs); w.y = cvt_pk_bf16(v[i][2] * rs, v[i][3] * rs); *(u32x2*)(dst + (i * 64 + lane) * 4) = w;
        *(unsigned*)(dst8 + (i * 64 + lane) * 4) = pk_fp8x4(v[i][0] * rs8, v[i][1] * rs8, v[i][2] * rs8, v[i][3] * rs8); }
}
__device__ __forceinline__ void rownorm_fp8(const float* src, unsigned char* dst, int lane) {
    f32x4 v[8]; float ss = 0.f;
#pragma unroll
    for (int i = 0; i < 8; ++i) { v[i] = *(const f32x4*)(src + (i * 64 + lane) * 4); ss += v[i][0] * v[i][0] + v[i][1] * v[i][1] + v[i][2] * v[i][2] + v[i][3] * v[i][3]; }
    ss = wave_sum(ss); const float rs = rsqrtf(ss * (1.0f / DM) + RMS_EPS) * 16.0f;
#pragma unroll
    for (int i = 0; i < 8; ++i) *(unsigned*)(dst + (i * 64 + lane) * 4) = pk_fp8x4(v[i][0] * rs, v[i][1] * rs, v[i][2] * rs, v[i][3] * rs);
}
__device__ __forceinline__ void rownorm_fp8_bf(const bf16_t* src, unsigned char* dst, int lane) {
    float v[4][8]; float ss = 0.f;
#pragma unroll
    for (int i = 0; i < 4; ++i) { unpack8(*(const u32x4*)(src + (i * 64 + lane) * 8), v[i]);
#pragma unroll
        for (int e = 0; e < 8; ++e) ss += v[i][e] * v[i][e]; }
    ss = wave_sum(ss); const float rs = rsqrtf(ss * (1.0f / DM) + RMS_EPS) * 16.0f;
#pragma unroll
    for (int i = 0; i < 4; ++i) { u32x2 w8; w8.x = pk_fp8x4(v[i][0] * rs, v[i][1] * rs, v[i][2] * rs, v[i][3] * rs); w8.y = pk_fp8x4(v[i][4] * rs, v[i][5] * rs, v[i][6] * rs, v[i][7] * rs);
        *(u32x2*)(dst + (i * 64 + lane) * 8) = w8; }
}
__device__ __forceinline__ void phase_prep(const Ctx& c, KArgs* a) {
    unsigned char* ws = a->ws;
    { const float* x = (const float*)a->in[I_X]; bf16_t* xn = (bf16_t*)(ws + WS_XN);
      unsigned char* xn8 = (unsigned char*)a->out;
      for (int r = c.gw; r < NT; r += c.nw) rownorm_both(x + (size_t)r * DM, xn + (size_t)r * DM, xn8 + (size_t)r * DM, c.lane); }
    convert_weight<1, true>(c, (const float*)a->in[I_WIN], nullptr, 4192, (const float*)a->in[I_GMIX], (bf16_t*)(ws + OFF_WT_IN), 2048, ZC_R, blockIdx.x, gridDim.x);
    convert_weight<0>(c, (const float*)a->in[I_WIN] + 832, nullptr, 4192, (const float*)a->in[I_GMIX], (bf16_t*)(ws + OFF_WT_RKV), 2048, ZW - ZC_R, blockIdx.x, gridDim.x);
}
template <int PART  >
__device__ __forceinline__ void phase_prep_late(const Ctx& c, KArgs* a, int blk, int nblk) {
    unsigned char* ws = a->ws;
    if (PART != 1) {
    { const int gt = blk * 512 + c.tid, nthr = nblk * 512;
      int* cnt = (int*)(ws + CTL_CNT); for (int i = gt; i < NCHUNK * NE1; i += nthr) cnt[i] = ((i % NE1) == NEXP) ? CH_TOK : 0; }
    { float* rt = (float*)(ws + OFF_ROPE); const int* pos = (const int*)a->in[I_POS]; const int gt = blk * 512 + c.tid, nthr = nblk * 512;
      for (int i = gt; i < NT * 32; i += nthr) { const int tok = i >> 5, fi = i & 31; const float inv_f = (float)exp2(-(double)fi * (13.287712379549449 / 32.0));
          const float ang = (float)pos[tok] * inv_f; double xr = (double)ang; xr -= 6.283185307179586 * rint(xr * 0.15915494309189535); const float rr = (float)xr;
          rt[2 * i] = __cosf(rr); rt[2 * i + 1] = __sinf(rr); } }
    }
    if (PART != 1) { convert_weight<0>(c, (const float*)a->in[I_WUQ], nullptr, 1536, (const float*)a->in[I_GQA], (bf16_t*)(ws + OFF_WT_UQ), 512, 1536, blk, nblk);
    convert_weight<0>(c, (const float*)a->in[I_WUKV], nullptr, 2048, (const float*)a->in[I_GKVA], (bf16_t*)(ws + OFF_WT_UKV), 256, 2048, blk, nblk); }
    if (PART != 0) {
    convert_weight<0, true>(c, (const float*)a->in[I_WOUT], nullptr, 2048, nullptr, (bf16_t*)(ws + OFF_WT_OUT), 2048, 2048, blk, nblk);
    convert_weight<0, true>(c, (const float*)a->in[I_WPG], nullptr, 2048, (const float*)a->in[I_GPIN], (bf16_t*)(ws + OFF_WT_PG), 2048, 2048, blk, nblk);
    convert_weight<0>(c, (const float*)a->in[I_WPP], nullptr, 2048, nullptr, (bf16_t*)(ws + OFF_WT_PP), 256, 2048, blk, nblk); }
    if (PART != 1) {
    { bf16_t* wl = (bf16_t*)(ws + OFF_WT_LORA); const float* ww2 = (const float*)a->in[I_WW2]; const float* aw2 = (const float*)a->in[I_AW2]; const float* gw2 = (const float*)a->in[I_GW2];
      const int gt = blk * 512 + c.tid, nthr = nblk * 512;
      for (int i = gt; i < LORA_N * LORA_K; i += nthr) { const int n = i / LORA_K, k = i % LORA_K; float v = 0.f;
          if (n < 1024) { if (k < 64) v = ww2[k * 1024 + n]; }
          else if (n < 2048) { if (k >= 64 && k < 128) v = aw2[(k - 64) * 1024 + (n - 1024)]; }
          else { if (k >= 128 && k < 288) v = gw2[(k - 128) * 1024 + (n - 2048)]; }
          wl[i] = f2bf(v); } }
    { u32x4* wf = (u32x4*)(ws + OFF_WRF); const float* wr = (const float*)a->in[I_WR]; const float* gf = (const float*)a->in[I_GFFN];
      const int gt = blk * 512 + c.tid, nthr = nblk * 512;
      for (int i = gt; i < 64 * 4 * 64; i += nthr) { const int l = i & 63, cc = (i >> 6) & 3, s = i >> 8; const int k0 = 32 * s + 8 * (l >> 4), n = 16 * cc + (l & 15);
          float w[8], lo[8];
#pragma unroll
          for (int j = 0; j < 8; ++j) w[j] = wr[(k0 + j) * 64 + n] * gf[k0 + j];
          const u32x4 hi = packf8(w); float h[8]; unpack8(hi, h);
#pragma unroll
          for (int j = 0; j < 8; ++j) lo[j] = w[j] - h[j];
          wf[((s * 4 + cc) * 2 + 0) * 64 + l] = hi; wf[((s * 4 + cc) * 2 + 1) * 64 + l] = packf8(lo); } }
    }
}

__device__ __forceinline__ void phase_finalize_qk(const Ctx& c, KArgs* a) {
    unsigned char* ws = a->ws; bf16_t* Qb = (bf16_t*)(ws + OFF_QB); bf16_t* Kb = (bf16_t*)(ws + OFF_KB); const bf16_t* Z = (const bf16_t*)(ws + OFF_Z); const float* rt = (const float*)(ws + OFF_ROPE);
    const float* gqn = (const float*)a->in[I_GQN]; const float* gkn = (const float*)a->in[I_GKN];
    const int lane = c.lane, h = lane >> 3, sx = lane & 7; const bool lowh = sx < 4;
    float gq[3][8], gk[3][8];
#pragma unroll
    for (int p = 0; p < 3; ++p)
#pragma unroll
        for (int e = 0; e < 8; ++e) { gq[p][e] = gqn[64 * p + 8 * sx + e]; gk[p][e] = gkn[64 * p + 8 * sx + e]; }
    for (int tok = c.gw; tok < NT; tok += c.nw) {
        float cs[8], sn[8];
        { const float* rp = rt + (size_t)tok * 64 + 16 * (sx & 3);
#pragma unroll
          for (int e4 = 0; e4 < 4; ++e4) { const f32x4 t4 = *(const f32x4*)(rp + 4 * e4); cs[2 * e4] = t4[0]; sn[2 * e4] = t4[1]; cs[2 * e4 + 1] = t4[2]; sn[2 * e4 + 1] = t4[3]; } }
        bf16_t* qp = Qb + (size_t)tok * QW + h * 192 + 8 * sx; bf16_t* kp = Kb + (size_t)tok * QW + h * 192 + 8 * sx;
        const u32x4 k0 = *(const u32x4*)kp, k1 = *(const u32x4*)(kp + 64), k2 = *(const u32x4*)(Z + (size_t)tok * ZW + ZC_KPE + 8 * sx);
        float f[3][8];
        unpack8(k0, f[0]); unpack8(k1, f[1]); unpack8(k2, f[2]);
        { float ss = 0.f;
#pragma unroll
          for (int p = 0; p < 3; ++p)
#pragma unroll
              for (int e = 0; e < 8; ++e) ss += f[p][e] * f[p][e];
          ss = allred8(ss); const float rs = rsqrtf(ss * (1.0f / 192.0f) + RMS_EPS);
#pragma unroll
          for (int p = 0; p < 3; ++p)
#pragma unroll
              for (int e = 0; e < 8; ++e) f[p][e] *= rs * gk[p][e];
#pragma unroll
          for (int e = 0; e < 8; ++e) { const float oth = __shfl_xor(f[2][e], 4); f[2][e] = lowh ? (f[2][e] * cs[e] - oth * sn[e]) : (f[2][e] * cs[e] + oth * sn[e]); }
          *(u32x4*)kp = packf8(f[0]); *(u32x4*)(kp + 64) = packf8(f[1]); *(u32x4*)(kp + 128) = packf8(f[2]); }
    }
}

__device__ __forceinline__ int crow(int r, int hi) { return (r & 3) + 8 * (r >> 2) + 4 * hi; }
__device__ __forceinline__ void phase_attn_v1(const Ctx& c, KArgs* a) {
    unsigned char* ws = a->ws; const bf16_t* Qb = (const bf16_t*)(ws + OFF_QB); const bf16_t* Kb = (const bf16_t*)(ws + OFF_KB); const bf16_t* Vb = (const bf16_t*)(ws + OFF_VB);
    bf16_t* Ym = (bf16_t*)(ws + WS_XN);
    const int lane = c.lane, r32 = lane & 31, hi = lane >> 5;
    for (int it = c.gw; it < 8192; it += c.nw) {
        const int qb = 255 - (it >> 5), bh = it & 31, b = bh >> 3, h = bh & 7, q0 = qb * 32;
        const size_t tb = (size_t)b * SEQ;
        bf16x8 qr[12];
        { const bf16_t* qp = Qb + (tb + q0 + r32) * QW + h * 192 + hi * 8;
#pragma unroll
          for (int d0 = 0; d0 < 12; ++d0) qr[d0] = *(const bf16x8*)(qp + d0 * 16); }
        float m_reg = -1e30f, l_reg = 0.f; f32x16 o[4];
#pragma unroll
        for (int d = 0; d < 4; ++d)
#pragma unroll
            for (int r = 0; r < 16; ++r) o[d][r] = 0.f;
        const int ntile = (q0 + 31) / 64 + 1;
        for (int kt = 0; kt < ntile; ++kt) {
            const int kb = kt * 64;
            f32x16 p0, p1;
#pragma unroll
            for (int r = 0; r < 16; ++r) { p0[r] = 0.f; p1[r] = 0.f; }
            { const bf16_t* kp = Kb + (tb + kb + r32) * QW + h * 192 + hi * 8;
#pragma unroll
              for (int d0 = 0; d0 < 12; ++d0) { const bf16x8 b0 = *(const bf16x8*)(kp + d0 * 16); const bf16x8 b1 = *(const bf16x8*)(kp + (size_t)32 * QW + d0 * 16);
                  p0 = __builtin_amdgcn_mfma_f32_32x32x16_bf16(b0, qr[d0], p0, 0, 0, 0); p1 = __builtin_amdgcn_mfma_f32_32x32x16_bf16(b1, qr[d0], p1, 0, 0, 0); } }
            if (kb + 63 > q0) {
                const int dq = q0 + r32 - kb - 4 * hi; const float NEG = -__builtin_inff();
#pragma unroll
                for (int r = 0; r < 16; ++r) { const int cc = (r & 3) + 8 * (r >> 2); if (dq - cc < 0) p0[r] = NEG; if (dq - cc - 32 < 0) p1[r] = NEG; }
            }
            float pmax = p0[0];
#pragma unroll
            for (int r = 1; r < 16; ++r) pmax = fmaxf(pmax, p0[r]);
#pragma unroll
            for (int r = 0; r < 16; ++r) pmax = fmaxf(pmax, p1[r]);
            pmax = fmaxf(pmax, __shfl_xor(pmax, 32));
            const float mn = fmaxf(m_reg, pmax); const float alpha = __builtin_amdgcn_exp2f(m_reg - mn); m_reg = mn;
            float ps = 0.f;
#pragma unroll
            for (int r = 0; r < 16; ++r) { p0[r] = __builtin_amdgcn_exp2f(p0[r] - mn); p1[r] = __builtin_amdgcn_exp2f(p1[r] - mn); ps += p0[r] + p1[r]; }
            ps += __shfl_xor(ps, 32);
            l_reg = l_reg * alpha + ps;
#pragma unroll
            for (int r = 0; r < 16; ++r) { const float ar = __shfl(alpha, crow(r, hi));
#pragma unroll
                for (int d = 0; d < 4; ++d) o[d][r] *= ar; }
            bf16x8 pa0, pa1, pa2, pa3;
#define PK4(P, B_, OUT) do { unsigned a0 = cvt_pk_bf16(P[B_ + 0], P[B_ + 1]), a1 = cvt_pk_bf16(P[B_ + 2], P[B_ + 3]); \
        unsigned b0 = cvt_pk_bf16(P[B_ + 4], P[B_ + 5]), b1 = cvt_pk_bf16(P[B_ + 6], P[B_ + 7]); \
        auto r0 = __builtin_amdgcn_permlane32_swap(a0, b0, false, false); auto r1 = __builtin_amdgcn_permlane32_swap(a1, b1, false, false); \
        u32x4 w = {r0[0], r1[0], r0[1], r1[1]}; OUT = *reinterpret_cast<bf16x8*>(&w); } while (0)
            PK4(p0, 0, pa0); PK4(p0, 8, pa1); PK4(p1, 0, pa2); PK4(p1, 8, pa3);
#undef PK4
            const bf16_t* vp = Vb + (tb + kb + 8 * hi) * 1024 + h * 128 + r32;
#pragma unroll
            for (int d0 = 0; d0 < 4; ++d0) {
#pragma unroll
                for (int ks = 0; ks < 4; ++ks) { bf16x8 vf;
#pragma unroll
                    for (int j = 0; j < 8; ++j) vf[j] = (short)vp[(size_t)(16 * ks + j) * 1024 + d0 * 32];
                    const bf16x8 pa = ks == 0 ? pa0 : (ks == 1 ? pa1 : (ks == 2 ? pa2 : pa3));
                    o[d0] = __builtin_amdgcn_mfma_f32_32x32x16_bf16(pa, vf, o[d0], 0, 0, 0); } }
        }
        const float li = 1.0f / l_reg;
#pragma unroll
        for (int r = 0; r < 16; ++r) { const int orow = crow(r, hi); const float lr = __shfl(li, orow);
            bf16_t* op = Ym + (tb + q0 + orow) * DM + h * 128 + r32;
#pragma unroll
            for (int d0 = 0; d0 < 4; ++d0) op[d0 * 32] = f2bf(o[d0][r] * lr); }
    }
}

constexpr int AT_SHM_V = 64 * 128 * 2, AT_SHM_K = 64 * 192 * 2, AT_OFF_K = 2 * AT_SHM_V, AT_OFF_WS = AT_OFF_K + 2 * AT_SHM_K;
#define KSWZ192(row, colB) ((row) * 384 + ((colB) ^ (((row) & 7) << 4)))
__device__ __forceinline__ int v_st(int k, int c) { const int kk = (k & ~0xC) | ((k & 4) << 1) | ((k & 8) >> 1); return ((kk >> 3) * 4 + (c >> 5)) * 512 + ((kk & 7) * 32 + (c & 31)) * 2; }
__device__ __forceinline__ int v_rd_base(int lane) { return ((lane & 3) << 3) | (((lane >> 2) & 3) << 6) | (((lane >> 4) & 1) << 5) | (((lane >> 5) & 1) << 8); }
typedef short s16x4 __attribute__((ext_vector_type(4)));
__device__ __forceinline__ void attn_qblock(LAS unsigned char* lds, const bf16_t* Qb, const bf16_t* Kb, const bf16_t* Vb, bf16_t* Ym, const float* gqn, const float* rt, int b, int h, int qblk, int tid_in, int wid) {
    int tid = tid_in; asm volatile("" : "+v"(tid));
    const int lane = tid & 63, r32 = lane & 31, hi = lane >> 5;
    const size_t tb = (size_t)b * SEQ; const int q0 = qblk * 256, qlo = q0 + wid * 32;
    LAS unsigned char* V_lds = lds; LAS unsigned char* K_lds = lds + AT_OFF_K;
    LAS float* wsf = (LAS float*)(lds + AT_OFF_WS) + wid * 64;
    bf16x8 qr[12];
    { const bf16_t* qp = Qb + (tb + qlo + r32) * QW + h * 192 + hi * 8;
#pragma unroll
      for (int d0 = 0; d0 < 12; ++d0) qr[d0] = *(const bf16x8*)(qp + d0 * 16); }
    { float fqv[12][8]; float ss = 0.f;
#pragma unroll
      for (int d0 = 0; d0 < 12; ++d0) { unpack8(__builtin_bit_cast(u32x4, qr[d0]), fqv[d0]);
#pragma unroll
          for (int e = 0; e < 8; ++e) ss += fqv[d0][e] * fqv[d0][e]; }
      { auto rr = __builtin_amdgcn_permlane32_swap(__float_as_uint(ss), __float_as_uint(ss), false, false); ss = __uint_as_float(rr[0]) + __uint_as_float(rr[1]); }
      const float rs = rsqrtf(ss * (1.0f / 192.0f) + RMS_EPS) * QSCALE;
#pragma unroll
      for (int d0 = 0; d0 < 12; ++d0) { const f32x4 g0 = *(const f32x4*)(gqn + 16 * d0 + 8 * hi), g1 = *(const f32x4*)(gqn + 16 * d0 + 8 * hi + 4);
#pragma unroll
          for (int e = 0; e < 4; ++e) { fqv[d0][e] *= rs * g0[e]; fqv[d0][4 + e] *= rs * g1[e]; } }
#pragma unroll
      for (int jj = 0; jj < 2; ++jj) { const float* rp = rt + (tb + qlo + r32) * 64 + 2 * (16 * jj + 8 * hi);
#pragma unroll
          for (int e4 = 0; e4 < 4; ++e4) { const f32x4 t4 = *(const f32x4*)(rp + 4 * e4);
#pragma unroll
              for (int u2 = 0; u2 < 2; ++u2) { const int e = 2 * e4 + u2; const float cs = t4[2 * u2], sn = t4[2 * u2 + 1], x = fqv[8 + jj][e], y = fqv[10 + jj][e];
                  fqv[8 + jj][e] = x * cs - y * sn; fqv[10 + jj][e] = y * cs + x * sn; } } }
#pragma unroll
      for (int d0 = 0; d0 < 12; ++d0) qr[d0] = __builtin_bit_cast(bf16x8, packf8(fqv[d0])); }
    unsigned kgo[3], vgo[2];
#pragma unroll
    for (int i = 0; i < 3; ++i) { const int L = tid + 512 * i, row = L / 24, cB = ((L % 24) * 16) ^ ((row & 7) << 4); kgo[i] = (unsigned)(row * QW * 2 + cB); }
#pragma unroll
    for (int i = 0; i < 2; ++i) { const int L = tid + 512 * i, kk = (L >> 7) * 8 + ((L & 31) >> 2), k = (kk & ~0xC) | ((kk & 4) << 1) | ((kk & 8) >> 1), cc = ((L >> 5) & 3) * 32 + (L & 3) * 8; vgo[i] = (unsigned)(k * 1024 * 2 + cc * 2); }
    const char* Kg = (const char*)(Kb + tb * QW + h * 192); const char* Vg = (const char*)(Vb + tb * 1024 + h * 128);
    const int vb0 = (int)(uintptr_t)V_lds + v_rd_base(lane);
    int kb4[4];
#pragma unroll
    for (int dd = 0; dd < 4; ++dd) kb4[dd] = r32 * 384 + ((dd * 32 + hi * 16) ^ ((r32 & 7) << 4));
    const int NT_ = (q0 + 255) / 64 + 1;
#define AT_STAGE(t_, buf_) do { const size_t gk_ = (size_t)(t_) * 64 * QW * 2, gv_ = (size_t)(t_) * 64 * 1024 * 2; \
        _Pragma("unroll") for (int i = 0; i < 3; ++i) __builtin_amdgcn_global_load_lds((const unsigned*)(Kg + gk_ + kgo[i]), (LAS unsigned*)(K_lds + (buf_) * AT_SHM_K + (512 * i + wid * 64) * 16), 16, 0, 0); \
        _Pragma("unroll") for (int i = 0; i < 2; ++i) __builtin_amdgcn_global_load_lds((const unsigned*)(Vg + gv_ + vgo[i]), (LAS unsigned*)(V_lds + (buf_) * AT_SHM_V + (512 * i + wid * 64) * 16), 16, 0, 0); } while (0)
    __syncthreads();
    AT_STAGE(0, 0);
    float m_reg = -1e30f, l_reg = 0.f; f32x16 o[4];
#pragma unroll
    for (int d = 0; d < 4; ++d)
#pragma unroll
        for (int r = 0; r < 16; ++r) o[d][r] = 0.f;
    for (int t = 0; t < NT_; ++t) {
        const int buf = t & 1, kb = t * 64;
        asm volatile("s_waitcnt vmcnt(0)" ::: "memory"); __syncthreads();
        if (t + 1 < NT_) AT_STAGE(t + 1, buf ^ 1);
        f32x16 p0, p1;
#pragma unroll
        for (int r = 0; r < 16; ++r) { p0[r] = 0.f; p1[r] = 0.f; }
        { const int kab = (int)(uintptr_t)K_lds + buf * AT_SHM_K; const int ka0 = kab + kb4[0], ka1 = kab + kb4[1], ka2 = kab + kb4[2], ka3 = kab + kb4[3];
          bf16x8 kf[3][2];
#define KRD(dst, areg, off) asm volatile("ds_read_b128 %0, %1 offset:%2" : "=&v"(dst) : "v"(areg), "i"(off) : "memory")
#define KRD2(set, d0) do { if (((d0) & 3) == 0) { KRD(kf[set][0], ka0, ((d0) >> 2) * 128); KRD(kf[set][1], ka0, ((d0) >> 2) * 128 + 32 * 384); } \
                           else if (((d0) & 3) == 1) { KRD(kf[set][0], ka1, ((d0) >> 2) * 128); KRD(kf[set][1], ka1, ((d0) >> 2) * 128 + 32 * 384); } \
                           else if (((d0) & 3) == 2) { KRD(kf[set][0], ka2, ((d0) >> 2) * 128); KRD(kf[set][1], ka2, ((d0) >> 2) * 128 + 32 * 384); } \
                           else { KRD(kf[set][0], ka3, ((d0) >> 2) * 128); KRD(kf[set][1], ka3, ((d0) >> 2) * 128 + 32 * 384); } } while (0)
#define KWAIT(n) do { asm volatile("s_waitcnt lgkmcnt(" #n ")" ::: "memory"); __builtin_amdgcn_sched_barrier(0); } while (0)
#define KSTEP(d0, W) do { if ((d0) + 2 < 12) KRD2(((d0) + 2) % 3, (d0) + 2); W; \
              p0 = __builtin_amdgcn_mfma_f32_32x32x16_bf16(kf[(d0) % 3][0], qr[d0], p0, 0, 0, 0); p1 = __builtin_amdgcn_mfma_f32_32x32x16_bf16(kf[(d0) % 3][1], qr[d0], p1, 0, 0, 0); } while (0)
          KRD2(0, 0); KRD2(1, 1);
          KSTEP(0, KWAIT(4)); KSTEP(1, KWAIT(4)); KSTEP(2, KWAIT(4)); KSTEP(3, KWAIT(4)); KSTEP(4, KWAIT(4)); KSTEP(5, KWAIT(4));
          KSTEP(6, KWAIT(4)); KSTEP(7, KWAIT(4)); KSTEP(8, KWAIT(4)); KSTEP(9, KWAIT(4)); KSTEP(10, KWAIT(2)); KSTEP(11, KWAIT(0));
#undef KSTEP
#undef KWAIT
#undef KRD2
#undef KRD
        }
        if (kb + 63 > qlo) { const int dq = qlo + r32 - kb - 4 * hi; const float NEG = -__builtin_inff();
#pragma unroll
            for (int r = 0; r < 16; ++r) { const int cc = (r & 3) + 8 * (r >> 2); if (dq - cc < 0) p0[r] = NEG; if (dq - cc - 32 < 0) p1[r] = NEG; } }
        float pmax = p0[0];
#pragma unroll
        for (int r = 1; r < 16; ++r) pmax = fmaxf(pmax, p0[r]);
#pragma unroll
        for (int r = 0; r < 16; ++r) pmax = fmaxf(pmax, p1[r]);
        { auto rr = __builtin_amdgcn_permlane32_swap(__float_as_uint(pmax), __float_as_uint(pmax), false, false); pmax = fmaxf(__uint_as_float(rr[0]), __uint_as_float(rr[1])); }
        float alpha = 1.f;
        if (!__all(pmax - m_reg <= 11.5f)) { const float mn = fmaxf(m_reg, pmax); alpha = __builtin_amdgcn_exp2f(m_reg - mn); m_reg = mn; }
        float ps = 0.f;
#pragma unroll
        for (int r = 0; r < 16; ++r) { p0[r] = __builtin_amdgcn_exp2f(p0[r] - m_reg); p1[r] = __builtin_amdgcn_exp2f(p1[r] - m_reg); ps += p0[r] + p1[r]; }
        { auto rr = __builtin_amdgcn_permlane32_swap(__float_as_uint(ps), __float_as_uint(ps), false, false); ps = __uint_as_float(rr[0]) + __uint_as_float(rr[1]); }
        l_reg = l_reg * alpha + ps;
        if (__any(alpha < 1.f)) { if (hi == 0) wsf[r32] = alpha; asm volatile("s_waitcnt lgkmcnt(0)" ::: "memory");
#pragma unroll
            for (int r = 0; r < 16; ++r) { const float ar = wsf[crow(r, hi)];
#pragma unroll
                for (int d = 0; d < 4; ++d) o[d][r] *= ar; } }
        bf16x8 pa0, pa1, pa2, pa3;
#define PK4(P, B_, OUT) do { unsigned a0 = cvt_pk_bf16(P[B_ + 0], P[B_ + 1]), a1 = cvt_pk_bf16(P[B_ + 2], P[B_ + 3]); \
        unsigned b0 = cvt_pk_bf16(P[B_ + 4], P[B_ + 5]), b1 = cvt_pk_bf16(P[B_ + 6], P[B_ + 7]); \
        auto r0 = __builtin_amdgcn_permlane32_swap(a0, b0, false, false); auto r1 = __builtin_amdgcn_permlane32_swap(a1, b1, false, false); \
        u32x4 w = {r0[0], r1[0], r0[1], r1[1]}; OUT = *reinterpret_cast<bf16x8*>(&w); } while (0)
        PK4(p0, 0, pa0); PK4(p0, 8, pa1); PK4(p1, 0, pa2); PK4(p1, 8, pa3);
#undef PK4
#define TRRD(dst, off) asm volatile("ds_read_b64_tr_b16 %0, %1 offset:%2" : "=&v"(dst) : "v"(vbb), "i"(off) : "memory")
#define PV_RD(S_, d0) do { constexpr int b_ = (d0) * 512; TRRD(S_##l0, b_); TRRD(S_##h0, b_ + 2048); TRRD(S_##l1, b_ + 4096); TRRD(S_##h1, b_ + 6144); TRRD(S_##l2, b_ + 8192); TRRD(S_##h2, b_ + 10240); TRRD(S_##l3, b_ + 12288); TRRD(S_##h3, b_ + 14336); } while (0)
#define PV_MM(S_, d0) do { \
        o[d0] = __builtin_amdgcn_mfma_f32_32x32x16_bf16(pa0, (bf16x8){S_##l0[0], S_##l0[1], S_##l0[2], S_##l0[3], S_##h0[0], S_##h0[1], S_##h0[2], S_##h0[3]}, o[d0], 0, 0, 0); \
        o[d0] = __builtin_amdgcn_mfma_f32_32x32x16_bf16(pa1, (bf16x8){S_##l1[0], S_##l1[1], S_##l1[2], S_##l1[3], S_##h1[0], S_##h1[1], S_##h1[2], S_##h1[3]}, o[d0], 0, 0, 0); \
        o[d0] = __builtin_amdgcn_mfma_f32_32x32x16_bf16(pa2, (bf16x8){S_##l2[0], S_##l2[1], S_##l2[2], S_##l2[3], S_##h2[0], S_##h2[1], S_##h2[2], S_##h2[3]}, o[d0], 0, 0, 0); \
        o[d0] = __builtin_amdgcn_mfma_f32_32x32x16_bf16(pa3, (bf16x8){S_##l3[0], S_##l3[1], S_##l3[2], S_##l3[3], S_##h3[0], S_##h3[1], S_##h3[2], S_##h3[3]}, o[d0], 0, 0, 0); } while (0)
#define PV_WAIT(n) do { asm volatile("s_waitcnt lgkmcnt(" #n ")" ::: "memory"); __builtin_amdgcn_sched_barrier(0); } while (0)
        { const int vbb = vb0 + buf * AT_SHM_V; s16x4 Al0, Al1, Al2, Al3, Ah0, Ah1, Ah2, Ah3, Bl0, Bl1, Bl2, Bl3, Bh0, Bh1, Bh2, Bh3;
          PV_RD(A, 0); PV_RD(B, 1); PV_WAIT(8); PV_MM(A, 0);
          PV_RD(A, 2); PV_WAIT(8); PV_MM(B, 1);
          PV_RD(B, 3); PV_WAIT(8); PV_MM(A, 2);
          PV_WAIT(0); PV_MM(B, 3); }
#undef PV_RD
#undef PV_MM
#undef PV_WAIT
#undef TRRD
    }
#undef AT_STAGE
    if (hi == 0) wsf[32 + r32] = 1.0f / l_reg;
    asm volatile("s_waitcnt lgkmcnt(0)" ::: "memory");
    int lane_e = lane; asm volatile("" : "+v"(lane_e));
    const int r32e = lane_e & 31, hie = lane_e >> 5;
    unsigned char* Ow = (unsigned char*)Ym + (size_t)(tb + qlo) * DM + h * 128;
#pragma unroll
    for (int r = 0; r < 16; ++r) { const int orow = crow(r, hie); const float li = wsf[32 + orow] * 16.0f;
#pragma unroll
        for (int d0 = 0; d0 < 4; ++d0) { const float v = o[d0][r] * li; const float v1 = __shfl_xor(v, 1), v2 = __shfl_xor(v, 2), v3 = __shfl_xor(v1, 2);
            if ((r32e & 3) == 0) *(unsigned*)(Ow + (size_t)orow * DM + d0 * 32 + r32e) = pk_fp8x4(v, v1, v2, v3); } }
}
__device__ __forceinline__ void phase_attn_v2(const Ctx& c, KArgs* a) {
    unsigned char* ws = a->ws; const bf16_t* Qb = (const bf16_t*)(ws + OFF_QB); const bf16_t* Kb = (const bf16_t*)(ws + OFF_KB); const bf16_t* Vb = (const bf16_t*)(ws + OFF_VB);
    bf16_t* Ym = (bf16_t*)(ws + WS_XN);
    for (int it = blockIdx.x; it < 512; it += gridDim.x) {
        const int rnd = it >> 8, bb = it & 255, xcd = bb & 7, slot = bb >> 3; const int bh = rnd * 16 + xcd * 2 + (slot >> 4), y = slot & 15;
        attn_qblock(c.lds, Qb, Kb, Vb, Ym, (const float*)a->in[I_GQN], (const float*)(ws + OFF_ROPE), bh >> 3, bh & 7, 31 - y, c.tid, c.wid);
        attn_qblock(c.lds, Qb, Kb, Vb, Ym, (const float*)a->in[I_GQN], (const float*)(ws + OFF_ROPE), bh >> 3, bh & 7, y, c.tid, c.wid);
    }
}

__device__ __forceinline__ void phase_lora_prep(const Ctx& c, KArgs* a) {
    unsigned char* ws = a->ws; const bf16_t* Z = (const bf16_t*)(ws + OFF_Z); bf16_t* AL = (bf16_t*)(ws + OFF_ALORA); const float* mu = (const float*)a->in[I_MU];
    const int gt = blockIdx.x * 512 + c.tid, nthr = gridDim.x * 512;
    for (int i = gt; i < NT * 48; i += nthr) { const int tok = i / 48, ck = i % 48; float f[8];
        if (ck < 36) { const int k0 = 8 * ck; float cu[8], pv[8];
            unpack8(*(const u32x4*)(Z + (size_t)tok * ZW + ZC_WL + k0), cu);
            if (tok % SEQ) unpack8(*(const u32x4*)(Z + (size_t)(tok - 1) * ZW + ZC_WL + k0), pv); else {
#pragma unroll
                for (int e = 0; e < 8; ++e) pv[e] = 0.f; }
            const f32x4 m0 = *(const f32x4*)(mu + 3072 + k0), m1 = *(const f32x4*)(mu + 3072 + k0 + 4);
#pragma unroll
            for (int e = 0; e < 8; ++e) { const float x = cu[e] + (pv[e] - cu[e]) * (e < 4 ? m0[e & 3] : m1[e & 3]); f[e] = ck < 8 ? (1.0f - 2.0f * __builtin_amdgcn_rcpf(1.0f + __builtin_amdgcn_exp2f(2.885390082f * x))) : (ck < 16 ? x : sigmoidf_(x)); }
        } else {
#pragma unroll
            for (int e = 0; e < 8; ++e) f[e] = 0.f; }
        *(u32x4*)(AL + (size_t)tok * LORA_K + 8 * ck) = packf8(f); }
}
__device__ __forceinline__ void phase_scan_prep(const Ctx& c, KArgs* a) {
    unsigned char* ws = a->ws; const bf16_t* Z = (const bf16_t*)(ws + OFF_Z); const bf16_t* Lb = (const bf16_t*)(ws + OFF_LB);
    h16* D0 = (h16*)(ws + OFF_DER); const size_t DS = (size_t)NT * 1024;
    const float* mu = (const float*)a->in[I_MU]; const float* w0 = (const float*)a->in[I_W0]; const float* a0 = (const float*)a->in[I_A0];
    const float* kkp = (const float*)a->in[I_KK]; const float* kap = (const float*)a->in[I_KA];
    const int lane = c.lane, half = c.gw & 1, ch0 = (half * 8 + (lane >> 3)) * 64 + 8 * (lane & 7);
    float mur[8], muk[8], muv[8], cw0[8], ca0[8], ckk[8], cka[8];
#pragma unroll
    for (int e = 0; e < 8; ++e) { mur[e] = mu[ch0 + e]; muk[e] = mu[1024 + ch0 + e]; muv[e] = mu[2048 + ch0 + e]; cw0[e] = w0[ch0 + e]; ca0[e] = a0[ch0 + e]; ckk[e] = kkp[ch0 + e]; cka[e] = kap[ch0 + e]; }
    u32x4 nxa[8], nxb[8];
#define SP_LOAD(nx, it_) do { const int tk_ = (it_) >> 1; const bf16_t* zr_ = Z + (size_t)tk_ * ZW + ch0; const bf16_t* zp_ = (tk_ % SEQ) == 0 ? zr_ : zr_ - ZW; \
        nx[0] = *(const u32x4*)(zr_ + ZC_R); nx[1] = *(const u32x4*)(zr_ + ZC_K); nx[2] = *(const u32x4*)(zr_ + ZC_V); nx[3] = *(const u32x4*)(zp_ + ZC_R); nx[4] = *(const u32x4*)(zp_ + ZC_K); nx[5] = *(const u32x4*)(zp_ + ZC_V); \
        nx[6] = *(const u32x4*)(Lb + (size_t)tk_ * LORA_N + ch0); nx[7] = *(const u32x4*)(Lb + (size_t)tk_ * LORA_N + 1024 + ch0); } while (0)
    if (c.gw < NT * 2) SP_LOAD(nxa, c.gw);
    if (c.gw + c.nw < NT * 2) SP_LOAD(nxb, c.gw + c.nw);
#define SP_ITEM(nx, it) do { const int tok = (it) >> 1; \
        const bool first = (tok % SEQ) == 0; \
        float rc[8], kc[8], vc[8], rp[8], kp[8], vp[8], lw[8], la[8]; \
        unpack8(nx[0], rc); unpack8(nx[1], kc); unpack8(nx[2], vc); unpack8(nx[3], rp); unpack8(nx[4], kp); unpack8(nx[5], vp); unpack8(nx[6], lw); unpack8(nx[7], la); \
        if ((it) + 2 * c.nw < NT * 2) SP_LOAD(nx, (it) + 2 * c.nw); \
        sp_item(tok, first, rc, kc, vc, rp, kp, vp, lw, la); } while (0)
    auto sp_item = [&](int tok, bool first, const float (&rc)[8], const float (&kc)[8], const float (&vc)[8], const float (&rp)[8], const float (&kp)[8], const float (&vp)[8], const float (&lw)[8], const float (&la)[8]) __attribute__((always_inline)) {
        h16x8 o_ld, o_kk, o_b, o_km, o_r, o_v; float kt[8], av[8], ss = 0.f;
#pragma unroll
        for (int e = 0; e < 8; ++e) { const float pr = first ? 0.f : rp[e], pk = first ? 0.f : kp[e], pvv = first ? 0.f : vp[e];
            const float r = rc[e] + (pr - rc[e]) * mur[e], k = kc[e] + (pk - kc[e]) * muk[e], v = vc[e] + (pvv - vc[e]) * muv[e];
            const float xw = -(cw0[e] + lw[e]); const float spl = fmaxf(xw, 0.f) + 0.69314718f * __builtin_amdgcn_logf(1.0f + __builtin_amdgcn_exp2f(-1.44269504f * fabsf(xw)));
            const float ld = -__builtin_amdgcn_exp2f((-spl - 0.5f) * 1.44269504f);
            av[e] = sigmoidf_(ca0[e] + la[e]); kt[e] = k * ckk[e]; ss += kt[e] * kt[e];
            o_ld[e] = (h16)ld; o_km[e] = (h16)(k * (1.0f + (av[e] - 1.0f) * cka[e])); o_r[e] = (h16)r; o_v[e] = (h16)v; }
        ss = allred8(ss); const float rn = ss > 1e-24f ? __builtin_amdgcn_rsqf(ss) : 1e12f;
#pragma unroll
        for (int e = 0; e < 8; ++e) { const float kk = kt[e] * rn; o_kk[e] = (h16)kk; o_b[e] = (h16)(kk * av[e]); }
        const size_t o = (size_t)tok * 1024 + ch0;
        *(h16x8*)(D0 + o) = o_ld; *(h16x8*)(D0 + DS + o) = o_kk; *(h16x8*)(D0 + 2 * DS + o) = o_b; *(h16x8*)(D0 + 3 * DS + o) = o_km; *(h16x8*)(D0 + 4 * DS + o) = o_r; *(h16x8*)(D0 + 5 * DS + o) = o_v; };
    for (int it = c.gw; it < NT * 2; it += 2 * c.nw) { SP_ITEM(nxa, it); if (it + c.nw < NT * 2) SP_ITEM(nxb, it + c.nw); }
#undef SP_ITEM
#undef SP_LOAD
}
constexpr int SC_L = 256, SC_NC = SEQ / SC_L;
constexpr size_t OFF_YRAW = OFF_Z;
constexpr size_t OFF_PM = OFF_Z + 128 * MiB;
constexpr size_t OFF_HM = OFF_PM + 32 * MiB;
constexpr size_t OFF_ST = OFF_HM + 32 * MiB;
static_assert(OFF_ST + 32 * MiB <= OFF_R1, "scan buffers overflow Z region");
constexpr size_t OFF_Q16 = OFF_Z;
constexpr size_t OFF_Y016 = OFF_Z + 64 * MiB;
struct ScanRaw { h16x8 ld, kk, bb, km, r, v; };
__device__ __forceinline__ ScanRaw scan_load(const h16* pj, const h16* pi, size_t DS, int t) {
    ScanRaw q; const size_t o = (size_t)t * 1024;
    q.ld = *(const h16x8*)(pj + o); q.kk = *(const h16x8*)(pj + DS + o); q.bb = *(const h16x8*)(pj + 2 * DS + o);
    q.km = *(const h16x8*)(pj + 3 * DS + o); q.r = *(const h16x8*)(pj + 4 * DS + o); q.v = *(const h16x8*)(pi + o);
    return q;
}
__device__ __forceinline__ void phase_scan_p1(const Ctx& c, KArgs* a) {
    unsigned char* ws = a->ws; const h16* D0 = (const h16*)(ws + OFF_DER); const size_t DS = (size_t)NT * 1024; float* Pm = (float*)(ws + OFF_PM); float* Hm = (float*)(ws + OFF_HM);
    h16* Q16 = (h16*)(ws + OFF_Q16); h16* Y016 = (h16*)(ws + OFF_Y016);
    const int lane = c.lane, la = lane >> 3, lb = lane & 7;
    for (int it = c.gw; it < 64 * SC_NC; it += c.nw) {
        const int bh = it & 63, ch = it >> 6, b = bh >> 4, h = bh & 15;
        const size_t tok0 = (size_t)b * SEQ + (size_t)ch * SC_L;
        float SP[8][8], SH[8][8];
#pragma unroll
        for (int i = 0; i < 8; ++i)
#pragma unroll
            for (int j = 0; j < 8; ++j) { SP[i][j] = (la == lb && i == j) ? 1.f : 0.f; SH[i][j] = 0.f; }
        h16* qo = Q16 + tok0 * 1024 + h * 64 + 8 * la; h16* yo = Y016 + tok0 * 1024 + h * 64 + 8 * la;
        LAS unsigned char* ring = c.lds + c.wid * 4096;
        const h16* gsrc = D0 + (size_t)((lane >> 3) < 5 ? (lane >> 3) : 5) * DS + tok0 * 1024 + h * 64 + 8 * (lane & 7);
#define SC_DMA(t_) __builtin_amdgcn_global_load_lds((const unsigned*)(gsrc + (size_t)((t_) < SC_L ? (t_) : SC_L - 1) * 1024), (LAS unsigned*)(ring + ((t_) & 3) * 1024), 16, 0, 0)
        SC_DMA(0); SC_DMA(1); SC_DMA(2);
#pragma unroll 1
        for (int t = 0; t < SC_L; ++t) {
            if (t < 3) asm volatile("s_waitcnt vmcnt(0)" ::: "memory"); else asm volatile("s_waitcnt vmcnt(8)" ::: "memory");
            SC_DMA(t + 3);
            ScanRaw cr; { const LAS unsigned char* sl = ring + (t & 3) * 1024;
                cr.ld = *(const LAS h16x8*)(sl + 16 * lb); cr.kk = *(const LAS h16x8*)(sl + 128 + 16 * lb); cr.bb = *(const LAS h16x8*)(sl + 256 + 16 * lb);
                cr.km = *(const LAS h16x8*)(sl + 384 + 16 * lb); cr.r = *(const LAS h16x8*)(sl + 512 + 16 * lb); cr.v = *(const LAS h16x8*)(sl + 640 + 16 * la); }
            float w[8], kk[8], bb[8];
#pragma unroll
            for (int j = 0; j < 8; ++j) { w[j] = __expf((float)cr.ld[j]); kk[j] = (float)cr.kk[j]; bb[j] = (float)cr.bb[j]; }
            float dp[8], dh[8];
#pragma unroll
            for (int i = 0; i < 8; ++i) { float s0 = 0.f, s1 = 0.f;
#pragma unroll
                for (int j = 0; j < 8; ++j) { s0 += SP[i][j] * kk[j]; s1 += SH[i][j] * kk[j]; }
                dp[i] = s0; dh[i] = s1; }
#pragma unroll
            for (int i = 0; i < 8; ++i) { dp[i] = -allred8(dp[i]); dh[i] = -allred8(dh[i]); }
            float qv[8], yv[8];
#pragma unroll
            for (int i = 0; i < 8; ++i) { const float vi = (float)cr.v[i]; float s0 = 0.f, s1 = 0.f;
#pragma unroll
                for (int j = 0; j < 8; ++j) { const float rj = (float)cr.r[j];
                    SP[i][j] = SP[i][j] * w[j] + dp[i] * bb[j]; SH[i][j] = SH[i][j] * w[j] + (dh[i] * bb[j] + vi * (float)cr.km[j]);
                    s0 += SP[i][j] * rj; s1 += SH[i][j] * rj; }
                qv[i] = s0; yv[i] = s1; }
#pragma unroll
            for (int i = 0; i < 8; ++i) { qv[i] = allred8(qv[i]); yv[i] = allred8(yv[i]); }
            if (lb == 0) { h16x8 hq, hy;
#pragma unroll
                for (int i = 0; i < 8; ++i) { hq[i] = (h16)qv[i]; hy[i] = (h16)yv[i]; }
                *(h16x8*)(qo + (size_t)t * 1024) = hq; *(h16x8*)(yo + (size_t)t * 1024) = hy; }
        }
#undef SC_DMA
        asm volatile("s_waitcnt vmcnt(0)" ::: "memory");
        { float* dst = Hm + ((size_t)bh * SC_NC + ch) * 4096 + ((((la >> 1) * 4 + (lb >> 1)) * 64 + 2 * (lb & 1) * 16 + 8 * (la & 1)) * 4);
#pragma unroll
          for (int i = 0; i < 8; ++i)
#pragma unroll
              for (int j = 0; j < 8; ++j) dst[((j >> 2) * 16 + i) * 4 + (j & 3)] = SH[i][j]; }
        { float* dst = Pm + ((size_t)bh * SC_NC + ch) * 4096 + ((((lb >> 1) * 4 + (la >> 1)) * 64 + 2 * (la & 1) * 16 + 8 * (lb & 1)) * 4);
#pragma unroll
          for (int i = 0; i < 8; ++i)
#pragma unroll
              for (int j = 0; j < 8; ++j) dst[((i >> 2) * 16 + j) * 4 + (i & 3)] = SP[i][j]; }
    }
}
typedef short s16x4_t __attribute__((ext_vector_type(4)));
#define P1M_MFMA16(a, b, c) __builtin_amdgcn_mfma_f32_16x16x16f16((a), (b), (c), 0, 0, 0)
#define P1M_MFMA32(a, b, c) __builtin_amdgcn_mfma_f32_16x16x32_f16((a), (b), (c), 0, 0, 0)
__device__ __forceinline__ h16x4 cvt_h4(const f32x4 v) { return (h16x4){(h16)v[0], (h16)v[1], (h16)v[2], (h16)v[3]}; }
__device__ __forceinline__ float row_pfx(float x) {
    x += __int_as_float(__builtin_amdgcn_update_dpp(0, __float_as_int(x), 0x111, 0xF, 0xF, false));
    x += __int_as_float(__builtin_amdgcn_update_dpp(0, __float_as_int(x), 0x112, 0xF, 0xF, false));
    x += __int_as_float(__builtin_amdgcn_update_dpp(0, __float_as_int(x), 0x114, 0xF, 0xF, false));
    x += __int_as_float(__builtin_amdgcn_update_dpp(0, __float_as_int(x), 0x118, 0xF, 0xF, false));
    return x; }
__device__ __forceinline__ float row_sum16(float x) {
    x = DPP_ADD(x, 0xB1); x = DPP_ADD(x, 0x4E); x = DPP_ADD(x, 0x141); x = DPP_ADD(x, 0x140); return x; }
#define P1M_TR(dst, addr) asm volatile("ds_read_b64_tr_b16 %0, %1" : "=v"(dst) : "v"(addr) : "memory")
#define P1M_WAITL() do { asm volatile("s_waitcnt lgkmcnt(0)" ::: "memory"); __builtin_amdgcn_sched_barrier(0); } while (0)
__device__ __forceinline__ void phase_scan_p1m(const Ctx& c, KArgs* a) {
    unsigned char* ws = a->ws; const h16* D0 = (const h16*)(ws + OFF_DER); const size_t DS = (size_t)NT * 1024; float* Pm = (float*)(ws + OFF_PM); float* Hm = (float*)(ws + OFF_HM);
    h16* Q16 = (h16*)(ws + OFF_Q16); h16* Y016 = (h16*)(ws + OFF_Y016);
    const int lane = c.lane;
    LAS unsigned char* wl = c.lds + c.wid * 16640;
    const int wb = (int)(uintptr_t)wl;
    constexpr int IMG_KT = 0, IMG_BH = 2048, IMG_KH = 4096, IMG_RT = 6144, IMG_BB = 8192, IMG_KB = 10240, IMG_V = 12288, SM_M = 14336, SM_TT = 15360, SM_NT = 15872;
    constexpr int SM_ARB = IMG_BH, SM_ARK = IMG_BH + 512, SM_GAM = 16384, IMG_RP = IMG_KH, STG_Q = IMG_KT, STG_Y = IMG_RT;
    for (int itk = c.gw; itk < 64 * SC_NC; itk += c.nw) {
        const int bh = itk & 63, ch = itk >> 6, b = bh >> 4, h = bh & 15;
        const size_t tok0 = (size_t)b * SEQ + (size_t)ch * SC_L;
        f32x4 PT[4][4], SHT[4][4];
        { int lz = lane; asm volatile("" : "+v"(lz));
#pragma unroll
          for (int kt = 0; kt < 4; ++kt)
#pragma unroll
              for (int ct = 0; ct < 4; ++ct) { SHT[kt][ct] = (f32x4){0.f, 0.f, 0.f, 0.f};
#pragma unroll
                  for (int rg = 0; rg < 4; ++rg) PT[kt][ct][rg] = (kt == ct && 4 * (lz >> 4) + rg == (lz & 15)) ? 1.f : 0.f; } }
#pragma unroll 1
        for (int sc = 0; sc < SC_L / 16; ++sc) {
            int lq = lane; asm volatile("" : "+v"(lq)); const int r16 = lq & 15, gq = lq >> 4;
            const size_t go = (tok0 + 16 * sc + r16) * 1024 + h * 64 + 16 * gq;
            { const h16x8 v0 = *(const h16x8*)(D0 + 5 * DS + go), v1 = *(const h16x8*)(D0 + 5 * DS + go + 8);
              *(LAS h16x8*)(wl + IMG_V + gq * 512 + r16 * 32) = v0; *(LAS h16x8*)(wl + IMG_V + gq * 512 + r16 * 32 + 16) = v1; }
#pragma unroll
            for (int p = 0; p < 2; ++p) { float ep[8], em[8], ex[8], eb[8];
                { const h16x8 a0 = *(const h16x8*)(D0 + go + 8 * p);
#pragma unroll
                  for (int e = 0; e < 8; ++e) { const float ld = (float)a0[e]; const float lw = row_pfx(ld), tot = row_sum16(ld); if (r16 == 15) *(LAS float*)(wl + SM_GAM + (16 * gq + 8 * p + e) * 4) = __expf(tot);
                      ep[e] = __expf(lw); em[e] = __expf(-lw); ex[e] = __expf(lw - ld); eb[e] = __expf(tot - lw); } }
                const int io = gq * 512 + r16 * 32 + 16 * p;
                { const h16x8 x = *(const h16x8*)(D0 + DS + go + 8 * p); h16x8 o;
#pragma unroll
                  for (int e = 0; e < 8; ++e) o[e] = (h16)((float)x[e] * ex[e]);
                  *(LAS h16x8*)(wl + IMG_KT + io) = o; }
                { const h16x8 x = *(const h16x8*)(D0 + 2 * DS + go + 8 * p); h16x8 o, o2;
#pragma unroll
                  for (int e = 0; e < 8; ++e) { o[e] = (h16)((float)x[e] * em[e]); o2[e] = (h16)((float)x[e] * eb[e]); }
                  *(LAS h16x8*)(wl + IMG_BH + io) = o; *(LAS h16x8*)(wl + IMG_BB + io) = o2; }
                { const h16x8 x = *(const h16x8*)(D0 + 3 * DS + go + 8 * p); h16x8 o, o2;
#pragma unroll
                  for (int e = 0; e < 8; ++e) { o[e] = (h16)((float)x[e] * em[e]); o2[e] = (h16)((float)x[e] * eb[e]); }
                  *(LAS h16x8*)(wl + IMG_KH + io) = o; *(LAS h16x8*)(wl + IMG_KB + io) = o2; }
                { const h16x8 x = *(const h16x8*)(D0 + 4 * DS + go + 8 * p); h16x8 o;
#pragma unroll
                  for (int e = 0; e < 8; ++e) o[e] = (h16)((float)x[e] * ep[e]);
                  *(LAS h16x8*)(wl + IMG_RT + io) = o; } }
            asm volatile("s_waitcnt lgkmcnt(0)" ::: "memory");
            { f32x4 m_ = {0.f, 0.f, 0.f, 0.f}, n_ = m_, rb = m_, rk = m_;
#pragma unroll
              for (int kk2 = 0; kk2 < 2; ++kk2) { const int ro = (2 * kk2 + (gq >> 1)) * 512 + r16 * 32 + (gq & 1) * 16;
                  const h16x8 aK = *(const LAS h16x8*)(wl + IMG_KT + ro), aR = *(const LAS h16x8*)(wl + IMG_RT + ro), bB = *(const LAS h16x8*)(wl + IMG_BH + ro), bK = *(const LAS h16x8*)(wl + IMG_KH + ro);
                  m_ = P1M_MFMA32(aK, bB, m_); n_ = P1M_MFMA32(aK, bK, n_); rb = P1M_MFMA32(aR, bB, rb); rk = P1M_MFMA32(aR, bK, rk); }
              h16x4 nT, rbT, rkT;
#pragma unroll
              for (int rg = 0; rg < 4; ++rg) { const int t = 4 * gq + rg; const bool lo = t > r16, le = t >= r16;
                  *(LAS float*)(wl + SM_M + (t * 16 + r16) * 4) = lo ? m_[rg] : 0.f; nT[rg] = (h16)(lo ? n_[rg] : 0.f); rbT[rg] = (h16)(le ? rb[rg] : 0.f); rkT[rg] = (h16)(le ? rk[rg] : 0.f); }
              *(LAS h16x4*)(wl + SM_NT + r16 * 32 + gq * 8) = nT; *(LAS h16x4*)(wl + SM_ARB + r16 * 32 + gq * 8) = rbT; *(LAS h16x4*)(wl + SM_ARK + r16 * 32 + gq * 8) = rkT;
            }
            asm volatile("s_waitcnt lgkmcnt(0)" ::: "memory");
            { float x[16];
#pragma unroll
              for (int t = 0; t < 16; ++t) { float acc = (t == r16) ? 1.f : 0.f;
#pragma unroll
                  for (int s4 = 0; s4 < (t + 3) / 4; ++s4) { const f32x4 mr = *(const LAS f32x4*)(wl + SM_M + (t * 16 + 4 * s4) * 4);
#pragma unroll
                      for (int e = 0; e < 4; ++e) if (4 * s4 + e < t) acc -= mr[e] * x[4 * s4 + e]; }
                  x[t] = acc; }
              h16x8 t0, t1;
#pragma unroll
              for (int e = 0; e < 8; ++e) { t0[e] = (h16)x[e]; t1[e] = (h16)x[8 + e]; }
              if (gq == 0) { *(LAS h16x8*)(wl + SM_TT + r16 * 32) = t0; *(LAS h16x8*)(wl + SM_TT + r16 * 32 + 16) = t1; } }
            asm volatile("s_waitcnt lgkmcnt(0)" ::: "memory");
            const int la8 = wb + 8 * lq;
            s16x4_t rT, rN, rArb, rArk, rK[4], rV[4];
            P1M_TR(rT, la8 + SM_TT); P1M_TR(rN, la8 + SM_NT); P1M_TR(rArb, la8 + SM_ARB); P1M_TR(rArk, la8 + SM_ARK);
#pragma unroll
            for (int j4 = 0; j4 < 4; ++j4) { P1M_TR(rK[j4], la8 + IMG_KT + j4 * 512); P1M_TR(rV[j4], la8 + IMG_V + j4 * 512); }
            P1M_WAITL();
            const h16x4 aT = *(h16x4*)&rT, aN = *(h16x4*)&rN, aArb = *(h16x4*)&rArb, aArk = *(h16x4*)&rArk;
            h16x4 kcH[4], zH[4], bV[4];
            const f32x4 zero4 = {0.f, 0.f, 0.f, 0.f};
#pragma unroll
            for (int j4 = 0; j4 < 4; ++j4) { bV[j4] = *(h16x4*)&rV[j4];
                kcH[j4] = cvt_h4(P1M_MFMA16(aT, *(h16x4*)&rK[j4], zero4));
                const h16x4 nvH = cvt_h4(P1M_MFMA16(aN, bV[j4], zero4)); zH[j4] = cvt_h4(P1M_MFMA16(aT, nvH, zero4)); }
            { s16x4_t rR[4];
#pragma unroll
              for (int j4 = 0; j4 < 4; ++j4) P1M_TR(rR[j4], la8 + IMG_RT + j4 * 512);
              P1M_WAITL();
#pragma unroll
              for (int j4 = 0; j4 < 4; ++j4) { const h16x4 rt = *(h16x4*)&rR[j4]; const f32x4 ak = P1M_MFMA16(aArb, kcH[j4], zero4);
                  const f32x4 rp = (f32x4){(float)rt[0], (float)rt[1], (float)rt[2], (float)rt[3]} - ak;
                  *(LAS h16x4*)(wl + IMG_RP + j4 * 512 + r16 * 32 + gq * 8) = cvt_h4(rp); } }
            { s16x4_t rRp[4];
              asm volatile("s_waitcnt lgkmcnt(0)" ::: "memory");
#pragma unroll
              for (int j4 = 0; j4 < 4; ++j4) P1M_TR(rRp[j4], la8 + IMG_RP + j4 * 512);
              P1M_WAITL();
#pragma unroll
              for (int ct = 0; ct < 4; ++ct) { f32x4 qv = zero4, yv = P1M_MFMA16(aArk, bV[ct], zero4) - P1M_MFMA16(aArb, zH[ct], zero4);
#pragma unroll
                  for (int kt = 0; kt < 4; ++kt) { const h16x4 aR = *(h16x4*)&rRp[kt]; qv = P1M_MFMA16(aR, cvt_h4(PT[kt][ct]), qv); yv = P1M_MFMA16(aR, cvt_h4(SHT[kt][ct]), yv); }
#pragma unroll
                  for (int rg = 0; rg < 4; ++rg) { *(LAS h16*)(wl + STG_Q + (4 * gq + rg) * 128 + (16 * ct + r16) * 2) = (h16)qv[rg]; *(LAS h16*)(wl + STG_Y + (4 * gq + rg) * 128 + (16 * ct + r16) * 2) = (h16)yv[rg]; } } }
            { h16x4 GT[4][4];
              s16x4_t rBB[4], rKB[4];
#pragma unroll
              for (int j4 = 0; j4 < 4; ++j4) { P1M_TR(rBB[j4], la8 + IMG_BB + j4 * 512); P1M_TR(rKB[j4], la8 + IMG_KB + j4 * 512); }
              float gdiag[4];
#pragma unroll
              for (int j4 = 0; j4 < 4; ++j4) gdiag[j4] = *(const LAS float*)(wl + SM_GAM + (16 * j4 + r16) * 4);
              P1M_WAITL();
#pragma unroll
              for (int ta = 0; ta < 4; ++ta)
#pragma unroll
                  for (int tb = 0; tb < 4; ++tb) { f32x4 g4 = P1M_MFMA16(kcH[ta], *(h16x4*)&rBB[tb], zero4);
#pragma unroll
                      for (int rg = 0; rg < 4; ++rg) g4[rg] = ((ta == tb && 4 * gq + rg == r16) ? gdiag[tb] : 0.f) - g4[rg];
                      GT[ta][tb] = cvt_h4(g4); }
#pragma unroll
              for (int ct = 0; ct < 4; ++ct) { h16x4 pH[4], sH[4];
#pragma unroll
                  for (int kt = 0; kt < 4; ++kt) { pH[kt] = cvt_h4(PT[kt][ct]); sH[kt] = cvt_h4(SHT[kt][ct]); }
#pragma unroll
                  for (int tb = 0; tb < 4; ++tb) { f32x4 hs = P1M_MFMA16(*(h16x4*)&rKB[tb], bV[ct], zero4) - P1M_MFMA16(*(h16x4*)&rBB[tb], zH[ct], zero4); f32x4 pp = zero4;
#pragma unroll
                      for (int ta = 0; ta < 4; ++ta) { pp = P1M_MFMA16(GT[ta][tb], pH[ta], pp); hs = P1M_MFMA16(GT[ta][tb], sH[ta], hs); }
                      PT[tb][ct] = pp; SHT[tb][ct] = hs; } } }
            asm volatile("s_waitcnt lgkmcnt(0)" ::: "memory");
#pragma unroll
            for (int p = 0; p < 2; ++p) { const int id = lq + 64 * p, row = id >> 3, part = id & 7; const size_t o = (tok0 + 16 * sc + row) * 1024 + h * 64 + part * 8;
                *(h16x8*)(Q16 + o) = *(const LAS h16x8*)(wl + STG_Q + id * 16); *(h16x8*)(Y016 + o) = *(const LAS h16x8*)(wl + STG_Y + id * 16); }
            asm volatile("s_waitcnt lgkmcnt(0)" ::: "memory");
        }
        { int lz = lane; asm volatile("" : "+v"(lz)); const int r16z = lz & 15, gqz = lz >> 4;
          float* hd = Hm + ((size_t)bh * SC_NC + ch) * 4096 + lz * 4; float* pb = Pm + ((size_t)bh * SC_NC + ch) * 4096 + ((r16z >> 2) * 16 + 4 * gqz) * 4 + (r16z & 3);
#pragma unroll
          for (int kt = 0; kt < 4; ++kt)
#pragma unroll
              for (int ct = 0; ct < 4; ++ct) { *(f32x4*)(hd + (ct * 4 + kt) * 256) = SHT[kt][ct];
#pragma unroll
                  for (int rg = 0; rg < 4; ++rg) pb[(kt * 4 + ct) * 256 + rg * 4] = PT[kt][ct][rg]; } }
    }
}

__device__ __forceinline__ void phase_scan_p2(const Ctx& c, KArgs* a) {
    if (c.wid != 0) return;
    unsigned char* ws = a->ws; const float* Pm = (const float*)(ws + OFF_PM); const float* Hm = (const float*)(ws + OFF_HM); float* ST = (float*)(ws + OFF_ST);
    const int lane = c.lane, q = lane >> 4, cc = lane & 15;
    for (int w = blockIdx.x; w < 256; w += gridDim.x) { const int bh = w >> 2, itl = w & 3;
        f32x4 st[4];
#pragma unroll
        for (int jt = 0; jt < 4; ++jt) st[jt] = (f32x4){0.f, 0.f, 0.f, 0.f};
        for (int ch = 0; ch < SC_NC; ++ch) {
            float* sp = ST + ((size_t)bh * SC_NC + ch) * 4096;
#pragma unroll
            for (int jt = 0; jt < 4; ++jt)
#pragma unroll
                for (int rg = 0; rg < 4; ++rg) sp[(16 * jt + 4 * q + rg) * 64 + 16 * itl + cc] = st[jt][rg];
            if (ch == SC_NC - 1) break;
            const float* pp = Pm + ((size_t)bh * SC_NC + ch) * 4096; const float* hp = Hm + ((size_t)bh * SC_NC + ch) * 4096;
            f32x4 nw[4];
#pragma unroll
            for (int jtp = 0; jtp < 4; ++jtp) nw[jtp] = *(const f32x4*)(hp + ((itl * 4 + jtp) * 64 + lane) * 4);
#pragma unroll
            for (int jtp = 0; jtp < 4; ++jtp)
#pragma unroll
                for (int jt = 0; jt < 4; ++jt) { const f32x4 av = *(const f32x4*)(pp + ((jtp * 4 + jt) * 64 + lane) * 4);
                    nw[jtp] = __builtin_amdgcn_mfma_f32_16x16x16f16(cvt_h4(av), cvt_h4(st[jt]), nw[jtp], 0, 0, 0); }
#pragma unroll
            for (int jt = 0; jt < 4; ++jt) st[jt] = nw[jt];
        }
    }
}
__device__ __forceinline__ float red_kq(float x) { x += __shfl_xor(x, 16); x += __shfl_xor(x, 32); return x; }
__device__ __forceinline__ void phase_scan_p3(const Ctx& c, KArgs* a) {
    unsigned char* ws = a->ws; const h16* D0 = (const h16*)(ws + OFF_DER); const size_t DS = (size_t)NT * 1024; const float* ST = (const float*)(ws + OFF_ST);
    const h16* Q16 = (const h16*)(ws + OFF_Q16); const h16* Y016 = (const h16*)(ws + OFF_Y016); const bf16_t* Lb = (const bf16_t*)(ws + OFF_LB); bf16_t* Ym = (bf16_t*)(ws + WS_XN);
    const float* rk = (const float*)a->in[I_RK]; const float* lnw = (const float*)a->in[I_LNW]; const float* lnb = (const float*)a->in[I_LNB];
    const int lane = c.lane, kq = lane >> 4, cc = lane & 15;
    for (int itk = c.gw; itk < 64 * SC_NC; itk += c.nw) {
        const int bh = itk & 63, ch = itk >> 6, b = bh >> 4, h = bh & 15;
        const size_t tok0 = (size_t)b * SEQ + (size_t)ch * SC_L;
        const float* sp = ST + ((size_t)bh * SC_NC + ch) * 4096;
        h16x4 sa[4][4];
#pragma unroll
        for (int itl = 0; itl < 4; ++itl)
#pragma unroll
            for (int s4 = 0; s4 < 4; ++s4)
#pragma unroll
                for (int e = 0; e < 4; ++e) sa[itl][s4][e] = (h16)sp[(16 * s4 + 4 * kq + e) * 64 + 16 * itl + cc];
        float crk[4][4], clw[4][4], clb[4][4];
#pragma unroll
        for (int itl = 0; itl < 4; ++itl)
#pragma unroll
            for (int e = 0; e < 4; ++e) { const int chn = h * 64 + 16 * itl + 4 * kq + e; crk[itl][e] = rk[chn]; clw[itl][e] = lnw[chn]; clb[itl][e] = lnb[chn]; }
#pragma unroll 1
        for (int tt = 0; tt < SC_L / 16; ++tt) { const size_t tok = tok0 + 16 * tt + cc; const size_t ob = tok * 1024 + h * 64 + 4 * kq;
            f32x4 acc[4]; h16x4 qa[4];
#pragma unroll
            for (int s4 = 0; s4 < 4; ++s4) qa[s4] = *(const h16x4*)(Q16 + ob + 16 * s4);
#pragma unroll
            for (int itl = 0; itl < 4; ++itl) { const h16x4 t4 = *(const h16x4*)(Y016 + ob + 16 * itl); acc[itl] = (f32x4){(float)t4[0], (float)t4[1], (float)t4[2], (float)t4[3]}; }
#pragma unroll
            for (int s4 = 0; s4 < 4; ++s4)
#pragma unroll
                for (int itl = 0; itl < 4; ++itl) acc[itl] = __builtin_amdgcn_mfma_f32_16x16x16f16(sa[itl][s4], qa[s4], acc[itl], 0, 0, 0);
            float sm = 0.f, bd = 0.f; h16x4 hv[4]; float g[4][4];
#pragma unroll
            for (int itl = 0; itl < 4; ++itl) { const h16x4 hr = *(const h16x4*)(D0 + 4 * DS + ob + 16 * itl), hk = *(const h16x4*)(D0 + 3 * DS + ob + 16 * itl); hv[itl] = *(const h16x4*)(D0 + 5 * DS + ob + 16 * itl);
                const u32x2 gw = *(const u32x2*)(Lb + tok * LORA_N + 2048 + h * 64 + 4 * kq + 16 * itl); g[itl][0] = bflo(gw.x); g[itl][1] = bfhi(gw.x); g[itl][2] = bflo(gw.y); g[itl][3] = bfhi(gw.y);
#pragma unroll
                for (int e = 0; e < 4; ++e) { sm += acc[itl][e]; bd += (float)hr[e] * (float)hk[e] * crk[itl][e]; } }
            sm = red_kq(sm); bd = red_kq(bd); const float mean = sm * (1.0f / 64.0f); float vs = 0.f;
#pragma unroll
            for (int itl = 0; itl < 4; ++itl)
#pragma unroll
                for (int e = 0; e < 4; ++e) { acc[itl][e] -= mean; vs += acc[itl][e] * acc[itl][e]; }
            vs = red_kq(vs); const float rstd = rsqrtf(vs * (1.0f / 64.0f) + 64e-5f);
#pragma unroll
            for (int itl = 0; itl < 4; ++itl) { float f[4];
#pragma unroll
                for (int e = 0; e < 4; ++e) f[e] = (acc[itl][e] * rstd * clw[itl][e] + clb[itl][e] + bd * (float)hv[itl][e]) * g[itl][e];
                *(unsigned*)((unsigned char*)Ym + (size_t)tok * DM + 1024 + h * 64 + 4 * kq + 16 * itl) = pk_fp8x4(f[0] * 16.0f, f[1] * 16.0f, f[2] * 16.0f, f[3] * 16.0f); }
        }
    }
}

__device__ __forceinline__ void phase_router(const Ctx& c, KArgs* a) {
    unsigned char* ws = a->ws; float* H = a->out; bf16_t* xn2 = (bf16_t*)(ws + WS_XN); const u32x4* wf = (const u32x4*)(ws + OFF_WRF);
    const float* rbias = (const float*)a->in[I_RBIAS]; float* topw = (float*)(ws + OFF_TOPW); int* list = (int*)(ws + OFF_LIST); int* cnt = (int*)(ws + CTL_CNT);
    const int lane = c.lane, r16 = lane & 15, q = lane >> 4;
    LAS float* lg = (LAS float*)(c.lds) + c.wid * 1088;
    const float bias_e = rbias[lane];
    for (int it = c.gw; it < NT / 16; it += c.nw) { const int tok0 = it * 16;
        f32x4 acc[4];
#pragma unroll
        for (int cc = 0; cc < 4; ++cc) acc[cc] = (f32x4){0.f, 0.f, 0.f, 0.f};
        float ss = 0.f; const bf16_t* hp = hrow(H, (size_t)(tok0 + r16)) + 8 * q;
#pragma unroll 2
        for (int s = 0; s < 64; ++s) { const u32x4 ahi = *(const u32x4*)(hp + 32 * s); float h[8]; unpack8(ahi, h);
            ss += h[0] * h[0] + h[1] * h[1] + h[2] * h[2] + h[3] * h[3] + h[4] * h[4] + h[5] * h[5] + h[6] * h[6] + h[7] * h[7];
            const bf16x8 ah = __builtin_bit_cast(bf16x8, ahi);
            const u32x4* wp = wf + (size_t)s * 512 + lane;
#pragma unroll
            for (int cc = 0; cc < 4; ++cc) { const bf16x8 bh = __builtin_bit_cast(bf16x8, wp[(cc * 2 + 0) * 64]), bl = __builtin_bit_cast(bf16x8, wp[(cc * 2 + 1) * 64]);
                acc[cc] = __builtin_amdgcn_mfma_f32_16x16x32_bf16(ah, bh, acc[cc], 0, 0, 0); acc[cc] = __builtin_amdgcn_mfma_f32_16x16x32_bf16(ah, bl, acc[cc], 0, 0, 0); } }
        ss += __shfl_xor(ss, 16); ss += __shfl_xor(ss, 32);
        if (q == 0) lg[1024 + r16] = ss;
#pragma unroll
        for (int cc = 0; cc < 4; ++cc)
#pragma unroll
            for (int rg = 0; rg < 4; ++rg) lg[(4 * q + rg) * 64 + 16 * cc + r16] = acc[cc][rg];
        asm volatile("s_waitcnt lgkmcnt(0)" ::: "memory");
#pragma unroll 4
        for (int tt = 0; tt < 16; ++tt) { const int tok = tok0 + tt; const int chunk = tok / CH_TOK, tl = tok % CH_TOK;
            const float rs = rsqrtf(lg[1024 + tt] * (1.0f / DM) + RMS_EPS);
            const float sc = sigmoidf_(lg[tt * 64 + lane] * rs); const float bs = sc + bias_e;
            float m1 = bs; m1 = fmaxf(m1, __shfl_xor(m1, 1)); m1 = fmaxf(m1, __shfl_xor(m1, 2)); m1 = fmaxf(m1, __shfl_xor(m1, 4));
            const unsigned long long eq = __ballot(bs == m1); const unsigned grp = (unsigned)(eq >> (lane & ~7)) & 0xffu; const int first = (lane & ~7) + (__ffs(grp) - 1);
            float m2 = (lane == first) ? -__builtin_inff() : bs; m2 = fmaxf(m2, __shfl_xor(m2, 1)); m2 = fmaxf(m2, __shfl_xor(m2, 2)); m2 = fmaxf(m2, __shfl_xor(m2, 4));
            const float gs = m1 + m2; const int g = lane >> 3; int grank = 0;
#pragma unroll
            for (int gp = 0; gp < 8; ++gp) { const float o = rlane(gs, gp * 8); grank += (o > gs || (o == gs && gp < g)) ? 1 : 0; }
            const float mv = grank < 4 ? bs : -__builtin_inff(); int rank = 0;
#pragma unroll
            for (int e = 0; e < 64; ++e) { const float o = rlane(mv, e); rank += (o > mv || (o == mv && e < lane)) ? 1 : 0; }
            const bool sel = (grank < 4) && (rank < 8);
            const float wsum = wave_sum(sel ? sc : 0.f);
            if (sel) { topw[(size_t)tok * 8 + rank] = sc / wsum * 2.5f;
                const int p = atomicAdd(cnt + chunk * NE1 + lane, 1); list[((size_t)chunk * NE1 + lane) * CH_TOK + p] = tl * 8 + rank; }
        }
        asm volatile("s_waitcnt lgkmcnt(0)" ::: "memory");
        for (int tt = 0; tt < 16; ++tt) rownorm_fp8_bf(hrow(H, (size_t)(tok0 + tt)), (unsigned char*)xn2 + (size_t)(tok0 + tt) * DM, lane);
    }
}
__device__ __forceinline__ void phase_expert_weights(const Ctx& c, KArgs* a) {
    unsigned char* ws = a->ws; const float* gf = (const float*)a->in[I_GFFN];
    bf16_t* we1 = (bf16_t*)(ws + OFF_WE1); bf16_t* we2 = (bf16_t*)(ws + OFF_WE2);
    { LAS float* tile = (LAS float*)c.lds; const int n4 = c.tid & 31, kr = c.tid >> 5, sc = c.tid & 7, sn = c.tid >> 3; const int ntile = NE1 * 384;
      const float* wgp = (const float*)a->in[I_WG]; const float* wup = (const float*)a->in[I_WU]; const float* wdp = (const float*)a->in[I_WD];
      const float* sgp = (const float*)a->in[I_SG]; const float* sup = (const float*)a->in[I_SU]; const float* sdp = (const float*)a->in[I_SD];
      f32x4 va[4], vb[4];
#define EW_LOAD(v, T_) do { const int e_ = (T_) / 384, r_ = (T_) % 384; \
        if (r_ < 256) { const int n_ = (r_ >> 5) * 128 + 4 * n4, k0_ = (r_ & 31) * 64, half_ = (n_ >> 7) & 1, cc_ = (n_ >> 8) * 128 + (n_ & 127); \
            const float* sp_ = (e_ < NEXP ? (half_ ? wup : wgp) + (size_t)e_ * 2048 * 512 : (half_ ? sup : sgp)) + cc_; \
            _Pragma("unroll") for (int i = 0; i < 4; ++i) { const int k_ = k0_ + kr + 16 * i; v[i] = *(const f32x4*)(sp_ + (size_t)k_ * 512) * (gf[k_] * 64.0f); } } \
        else { const int t2_ = r_ - 256, n_ = (t2_ >> 3) * 128 + 4 * n4, k0_ = (t2_ & 7) * 64; const float* sp_ = (e_ < NEXP ? wdp + (size_t)e_ * 512 * 2048 : sdp) + n_; \
            _Pragma("unroll") for (int i = 0; i < 4; ++i) v[i] = *(const f32x4*)(sp_ + (size_t)(k0_ + kr + 16 * i) * 2048) * 64.0f; } } while (0)
#define EW_STEP(v, T_) do { \
          _Pragma("unroll") for (int i = 0; i < 4; ++i) _Pragma("unroll") for (int e = 0; e < 4; ++e) tile[(kr + 16 * i) * 129 + 4 * n4 + e] = v[i][e]; \
          __syncthreads(); \
          const int e_ = (T_) / 384, r_ = (T_) % 384; const bool up = r_ < 256; const int t2 = r_ - 256; \
          const int n0 = up ? (r_ >> 5) * 128 : (t2 >> 3) * 128, k0 = up ? (r_ & 31) * 64 : (t2 & 7) * 64, Kd = up ? 2048 : 512; \
          unsigned char* dst = up ? (unsigned char*)we1 + (size_t)e_ * 1024 * 2048 : (unsigned char*)we2 + (size_t)e_ * 2048 * 512; \
          if ((T_) + 2 * (int)gridDim.x < ntile) EW_LOAD(v, (T_) + 2 * (int)gridDim.x); \
          _Pragma("unroll") for (int i = 0; i < 2; ++i) { const int nl = sn + 64 * i; float f[8]; \
              _Pragma("unroll") for (int j = 0; j < 8; ++j) f[j] = tile[(8 * sc + j) * 129 + nl]; \
              u32x2 w8; w8.x = pk_fp8x4(f[0], f[1], f[2], f[3]); w8.y = pk_fp8x4(f[4], f[5], f[6], f[7]); *(u32x2*)(dst + (size_t)(n0 + nl) * Kd + k0 + 8 * sc) = w8; } \
          __syncthreads(); } while (0)
      int T = blockIdx.x; if (T < ntile) EW_LOAD(va, T); if (T + (int)gridDim.x < ntile) EW_LOAD(vb, T + (int)gridDim.x);
      for (; T < ntile; T += 2 * gridDim.x) { EW_STEP(va, T); if (T + (int)gridDim.x < ntile) EW_STEP(vb, T + (int)gridDim.x); }
#undef EW_STEP
#undef EW_LOAD
    }
    { const float* p = (const float*)a->in[I_P]; bf16_t* pb = (bf16_t*)(ws + OFF_PB); const int gt = blockIdx.x * 512 + c.tid, nthr = gridDim.x * 512;
      for (size_t i = gt; i < (size_t)NT * 256 / 4; i += nthr) { const f32x4 v = *(const f32x4*)(p + i * 4); u32x2 w; w.x = cvt_pk_bf16(v[0], v[1]); w.y = cvt_pk_bf16(v[2], v[3]); *(u32x2*)(pb + i * 4) = w; } }
}
__device__ __forceinline__ void phase_combine(const Ctx& c, KArgs* a, int chunk) {
    unsigned char* ws = a->ws; float* H = a->out; const bf16_t* Y = (const bf16_t*)(ws + OFF_YPART + (size_t)(chunk & 1) * YPART_BYTES); bf16_t* xn3 = (bf16_t*)(ws + OFF_XN3);
    const int lane = c.lane;
    for (int tl = c.gw; tl < CH_TOK; tl += c.nw) { const int tok = chunk * CH_TOK + tl; bf16_t* hp = hrow(H, (size_t)tok);
        float v[4][8];
#pragma unroll
        for (int i = 0; i < 4; ++i) unpack8(*(const u32x4*)(hp + (i * 64 + lane) * 8), v[i]);
#pragma unroll 3
        for (int k = 0; k < 9; ++k) { const unsigned char* yp = (const unsigned char*)Y + (k < 8 ? (size_t)tl * 8 + k : (size_t)YP_SHARED + tl) * DM;
#pragma unroll
            for (int i = 0; i < 4; ++i) { const u32x2 w8 = *(const u32x2*)(yp + (i * 64 + lane) * 8);
                const auto f0 = __builtin_amdgcn_cvt_pk_f32_fp8((int)w8.x, false), f1 = __builtin_amdgcn_cvt_pk_f32_fp8((int)w8.x, true), f2 = __builtin_amdgcn_cvt_pk_f32_fp8((int)w8.y, false), f3 = __builtin_amdgcn_cvt_pk_f32_fp8((int)w8.y, true);
                v[i][0] += f0[0] * (1.0f / 16.0f); v[i][1] += f0[1] * (1.0f / 16.0f); v[i][2] += f1[0] * (1.0f / 16.0f); v[i][3] += f1[1] * (1.0f / 16.0f);
                v[i][4] += f2[0] * (1.0f / 16.0f); v[i][5] += f2[1] * (1.0f / 16.0f); v[i][6] += f3[0] * (1.0f / 16.0f); v[i][7] += f3[1] * (1.0f / 16.0f); } }
        float ss = 0.f;
#pragma unroll
        for (int i = 0; i < 4; ++i) { *(u32x4*)(hp + (i * 64 + lane) * 8) = packf8(v[i]);
#pragma unroll
            for (int e = 0; e < 8; ++e) ss += v[i][e] * v[i][e]; }
        ss = wave_sum(ss); const float rs = rsqrtf(ss * (1.0f / DM) + RMS_EPS) * 16.0f; unsigned char* xp = (unsigned char*)xn3 + (size_t)tok * DM;
#pragma unroll
        for (int i = 0; i < 4; ++i) { u32x2 w8; w8.x = pk_fp8x4(v[i][0] * rs, v[i][1] * rs, v[i][2] * rs, v[i][3] * rs); w8.y = pk_fp8x4(v[i][4] * rs, v[i][5] * rs, v[i][6] * rs, v[i][7] * rs);
            *(u32x2*)(xp + (i * 64 + lane) * 8) = w8; } }
}
__device__ __forceinline__ void phase_final(const Ctx& c, KArgs* a, int tok0, int tok1) {
    unsigned char* ws = a->ws; float* H = a->out; const bf16_t* U = (const bf16_t*)(ws + OFF_U); const float* ssq = (const float*)(ws + OFF_SSQU); const float* gp = (const float*)a->in[I_GPOUT];
    const int lane = c.lane;
    for (int tok = tok0 + c.gw; tok < tok1; tok += c.nw) { const float rs = rsqrtf(wave_sum(lane < 32 ? ssq[(size_t)tok * 32 + lane] : 0.f) * (1.0f / DM) + RMS_EPS); float* op = H + (size_t)tok * DM; const bf16_t* hp = hrow(H, (size_t)tok); const bf16_t* up = U + (size_t)tok * DM;
        u32x4 hraw[4];
#pragma unroll
        for (int i = 0; i < 4; ++i) hraw[i] = *(const u32x4*)(hp + (i * 64 + lane) * 8);
        asm volatile("s_waitcnt vmcnt(0)" : "+v"(hraw[0]), "+v"(hraw[1]), "+v"(hraw[2]), "+v"(hraw[3]) :: "memory");
#pragma unroll
        for (int i = 0; i < 4; ++i) { const int cc = (i * 64 + lane) * 8; float hf[8]; unpack8(hraw[i], hf); const f32x4 g0 = *(const f32x4*)(gp + cc), g1 = *(const f32x4*)(gp + cc + 4);
            float f[8]; unpack8(*(const u32x4*)(up + cc), f);
            const f32x4 o0 = (f32x4){hf[0] + f[0] * rs * g0[0], hf[1] + f[1] * rs * g0[1], hf[2] + f[2] * rs * g0[2], hf[3] + f[3] * rs * g0[3]};
            const f32x4 o1 = (f32x4){hf[4] + f[4] * rs * g1[0], hf[5] + f[5] * rs * g1[1], hf[6] + f[6] * rs * g1[2], hf[7] + f[7] * rs * g1[3]};
            *(f32x4*)(op + cc) = o0; *(f32x4*)(op + cc + 4) = o1; } }
}

constexpr int LDS_STAGE = pg8::STAGE_BYTES;
constexpr int LDS_MISC = LDS_STAGE;
constexpr int LDS_BYTES = LDS_STAGE + 12288;
enum { PH_PREP = 0, PH_PROJ, PH_UP, PH_FINQK, PH_ATTN, PH_LORA, PH_SCANPREP, PH_SCAN1, PH_SCAN2, PH_SCAN3, PH_WOUT, PH_ROUTER, PH_MOE0  , PH_GATE = PH_MOE0 + 2 + NCHUNK  , PH_FINAL, PH_COUNT };

__device__ __forceinline__ int tile_expert(const LAS int* starts, int t) { int lo = 0, hi = NE1; while (hi - lo > 1) { const int mid = (lo + hi) >> 1; if (starts[mid] <= t) lo = mid; else hi = mid; } return lo; }
__device__ __forceinline__ void moe_tables(const Ctx& c, KArgs* a, bool build_rinfo) {
    LAS int* tb = (LAS int*)(c.lds + LDS_MISC); const int* cnt = (const int*)(a->ws + CTL_CNT);
    __syncthreads();
    for (int i = c.tid; i < NCHUNK * NE1; i += 512) { int v = cnt[i]; v = v < 0 ? 0 : (v > CH_TOK ? CH_TOK : v); tb[512 * (i / NE1) + 72 + (i % NE1)] = v; }
    __syncthreads();
    if (c.wid <= NCHUNK) {
        int n = 0, n64 = 0;
        if (c.wid < NCHUNK) { n = tb[512 * c.wid + 72 + c.lane]; n64 = tb[512 * c.wid + 72 + NEXP]; }
        else { for (int k = 0; k < NCHUNK; ++k) { n += tb[512 * k + 72 + c.lane]; n64 += tb[512 * k + 72 + NEXP]; } }
        const int t = (n + 255) >> 8; int incl = t;
#pragma unroll
        for (int o = 1; o < 64; o <<= 1) { const int v = __shfl_up(incl, o); if (c.lane >= o) incl += v; }
        const int tot = __shfl(incl, 63); LAS int* st = c.wid < NCHUNK ? tb + 512 * c.wid : tb + pg8::GT_INT;
        st[c.lane] = incl - t; if (c.lane == 0) { st[NEXP] = tot; st[NE1] = tot + ((n64 + 255) >> 8); } }
    __syncthreads();
    if (c.tid == 0) { int s = 0; for (int k = 0; k < NCHUNK; ++k) { tb[2048 + k] = s; s += tb[512 * k + NE1]; } tb[2048 + NCHUNK] = s; }
    if (build_rinfo) for (int t = c.tid; t < pg8::GT_MAX; t += 512) if (t < tb[pg8::GT_INT + NE1]) ((LAS unsigned char*)tb)[pg8::GM_BYTE + t] = (unsigned char)tile_expert(tb + pg8::GT_INT, t);
    for (int i = c.tid; i < NCHUNK * MAXT; i += 512) { const int k = i / MAXT, t = i % MAXT; const LAS int* tk = tb + 512 * k; if (t < tk[NE1]) tb[512 * k + 144 + t] = tile_expert(tk, t); }
    __syncthreads();
    if (build_rinfo) {
        int2* ri = (int2*)(a->ws + OFF_RINFO); const int* list = (const int*)(a->ws + OFF_LIST); const float* topw = (const float*)(a->ws + OFF_TOPW);
        const int ntall = tb[2048 + NCHUNK];
        for (int idx = blockIdx.x * 512 + c.tid; idx < ntall * 256; idx += gridDim.x * 512) { const int tg = idx >> 8; int k = 0; while (k + 1 < NCHUNK && tb[2048 + k + 1] <= tg) ++k;
            const LAS int* tk = tb + 512 * k; const int ti = tg - tb[2048 + k], e = tk[144 + ti], pos = (ti - tk[e]) * 256 + (idx & 255); int2 v; v.x = CH_TOK * 8; v.y = 0;
            if (pos < tk[72 + e]) { if (e == NEXP) { v.x = YP_SHARED + pos; v.y = __float_as_int(1.0f / 256.0f); }
                else { const int ent = list[((size_t)k * NE1 + e) * CH_TOK + pos]; v.x = ent; v.y = __float_as_int(topw[(size_t)k * CH_TOK * 8 + ent] * (1.0f / 256.0f)); } }
            ri[idx] = v; }
    }
}

__global__ void __launch_bounds__(512, 2) fwd(Args a_in) {
    extern __shared__ __attribute__((aligned(16))) unsigned char lds_raw[];
    const int G = gridDim.x, bid = blockIdx.x;
#define KARG ({ KArgs* kp_ = (KArgs*)__builtin_amdgcn_kernarg_segment_ptr(); asm volatile("" : "+s"(kp_)); kp_; })
#define XBW ((volatile LAS unsigned*)((LAS unsigned char*)lds_raw + LDS_MISC + 12272))
    { KArgs* k0 = KARG; if (k0->ph_hi - k0->ph_lo > 1) { if (threadIdx.x == 0) { XBW[0] = 0u; XBW[1] = 0u; XBW[2] = 0u; XBW[3] = 0u; } __syncthreads(); (void)xcd_barrier_post((unsigned*)(k0->ws + CTL_BAR), XBW); } }
#define GRID_BAR_NOW() do { KArgs* kb_ = KARG; XcdBarrier bar_; bar_.bar = (unsigned*)(kb_->ws + CTL_BAR); bar_.x = xb_xcc_id(); bar_.st = XBW; xcd_barrier(bar_); } while (0)
#ifndef PROBE_MASK
#define PROBE_MASK 0ull
#endif
#ifndef PROBE_EW
#define PROBE_EW 0
#endif
#define DUP(k) ((int)((PROBE_MASK >> (k)) & 1ull))
#define GRID_BAR(k) do { KArgs* kq_ = KARG; if ((k) + 1 < kq_->ph_hi && kq_->ph_lo <= (k)) GRID_BAR_NOW(); } while (0)
#define PHASE_ARGS KArgs* ap_ = (KArgs*)__builtin_amdgcn_kernarg_segment_ptr(); asm volatile("" : "+s"(ap_)); KArgs* a = ap_; unsigned char* ws = a->ws; (void)ws; Ctx c; { int t_ = threadIdx.x; asm volatile("" : "+v"(t_)); c.tid = t_; } c.lane = c.tid & 63; c.wid = __builtin_amdgcn_readfirstlane(c.tid >> 6); c.gw = blockIdx.x * 8 + c.wid; c.nw = gridDim.x * 8; c.lds = (LAS unsigned char*)lds_raw
#ifndef PH_ONLY
#define PH_ONLY -1
#endif
#define IN(k) ((PH_ONLY < 0 || PH_ONLY == (k) || (PH_ONLY == 100 && (k) >= PH_MOE0 && (k) < PH_GATE)) && KARG->ph_lo <= (k) && (k) < KARG->ph_hi)
    for (int rep_ = 0; rep_ <= DUP(PH_PREP); ++rep_) { if (rep_) GRID_BAR_NOW(); if (IN(PH_PREP)) { PHASE_ARGS; phase_prep(c, a); __syncthreads(); if ((NT / 256) * (ZW / 256) % G == 0) phase_prep_late<2>(c, a, bid, G); else phase_prep_late<0>(c, a, bid, G); }
    } GRID_BAR(PH_PREP);
    for (int rep_ = 0; rep_ <= DUP(PH_PROJ); ++rep_) { if (rep_) GRID_BAR_NOW(); if (IN(PH_PROJ)) {
        { PHASE_ARGS; pg8::Gemm g{(const bf16_t*)(ws + WS_XN), (const bf16_t*)(ws + OFF_WT_RKV), DM, DM, DM}; pg8::DenseOrder S; S.init(NT, ZW - ZC_R, G, bid);
          EpiPlain E{(bf16_t*)(ws + OFF_Z) + ZC_R, ZW}; pg8::gemm_phase(c.lds, g, S, E); }
        { PHASE_ARGS; pg8::Gemm g{(const bf16_t*)a->out, (const bf16_t*)(ws + OFF_WT_IN), DM / 2, DM / 2, DM / 2}; pg8::DenseOrder S; S.init(NT, ZC_R, G, bid);
          EpiProj E{(bf16_t*)(ws + OFF_Z), (float*)(ws + OFF_SSQP)}; pg8::gemm_phase(c.lds, g, S, E); } }
        if (IN(PH_PROJ) && rep_ == 0) { const int nrem = (NT / 256) * (ZC_R / 256) % G; if (nrem > 0 && bid >= nrem) { PHASE_ARGS; phase_prep_late<1>(c, a, bid - nrem, G - nrem); } }
    } GRID_BAR(PH_PROJ);
    for (int rep_ = 0; rep_ <= DUP(PH_UP); ++rep_) { if (rep_) GRID_BAR_NOW(); if (IN(PH_UP)) { PHASE_ARGS;
        { pg8::Gemm g{(const bf16_t*)(ws + OFF_Z), (const bf16_t*)(ws + OFF_WT_UQ), ZW, 512, 512}; pg8::DenseOrder S; S.init(NT, QW, G, bid);
          EpiQup E{(bf16_t*)(ws + OFF_QB), (const float*)(ws + OFF_SSQP)}; pg8::gemm_phase(c.lds, g, S, E); }
        { pg8::Gemm g{(const bf16_t*)(ws + OFF_Z) + 512, (const bf16_t*)(ws + OFF_WT_UKV), ZW, 256, 256}; pg8::DenseOrder S; S.init(NT, 2048, G, bid);
          EpiKV E{(bf16_t*)(ws + OFF_KB), (bf16_t*)(ws + OFF_VB), (const float*)(ws + OFF_SSQP)}; pg8::gemm_phase(c.lds, g, S, E); }
    }
    } GRID_BAR(PH_UP);
    for (int rep_ = 0; rep_ <= DUP(PH_FINQK); ++rep_) { if (rep_) GRID_BAR_NOW(); if (IN(PH_FINQK)) { PHASE_ARGS; phase_finalize_qk(c, a); phase_lora_prep(c, a); }
    } GRID_BAR(PH_FINQK);
    for (int rep_ = 0; rep_ <= DUP(PH_ATTN); ++rep_) { if (rep_) GRID_BAR_NOW(); if (IN(PH_ATTN)) { PHASE_ARGS; phase_attn_v2(c, a); }
    } GRID_BAR(PH_ATTN);
    for (int rep_ = 0; rep_ <= DUP(PH_LORA); ++rep_) { if (rep_) GRID_BAR_NOW(); if (IN(PH_LORA)) { PHASE_ARGS; pg8::Gemm g{(const bf16_t*)(ws + OFF_ALORA), (const bf16_t*)(ws + OFF_WT_LORA), LORA_K, LORA_K, LORA_K}; pg8::DenseOrder S; S.init(NT, LORA_N, G, bid);
        EpiPlain E{(bf16_t*)(ws + OFF_LB), LORA_N}; pg8::gemm_phase(c.lds, g, S, E); }
    } GRID_BAR(PH_LORA);
    for (int rep_ = 0; rep_ <= DUP(PH_SCANPREP); ++rep_) { if (rep_) GRID_BAR_NOW(); if (IN(PH_SCANPREP)) { PHASE_ARGS; phase_scan_prep(c, a); }
    } GRID_BAR(PH_SCANPREP);
    for (int rep_ = 0; rep_ <= DUP(PH_SCAN1); ++rep_) { if (rep_) GRID_BAR_NOW(); if (IN(PH_SCAN1)) { PHASE_ARGS; phase_scan_p1m(c, a); }
    } GRID_BAR(PH_SCAN1);
    for (int rep_ = 0; rep_ <= DUP(PH_SCAN2); ++rep_) { if (rep_) GRID_BAR_NOW(); if (IN(PH_SCAN2)) { PHASE_ARGS; phase_scan_p2(c, a); }
    } GRID_BAR(PH_SCAN2);
    for (int rep_ = 0; rep_ <= DUP(PH_SCAN3); ++rep_) { if (rep_) GRID_BAR_NOW(); if (IN(PH_SCAN3)) { PHASE_ARGS; phase_scan_p3(c, a); }
    } GRID_BAR(PH_SCAN3);
    for (int rep_ = 0; rep_ <= DUP(PH_WOUT); ++rep_) { if (rep_) GRID_BAR_NOW(); if (IN(PH_WOUT)) { PHASE_ARGS; pg8::Gemm g{(const bf16_t*)(ws + WS_XN), (const bf16_t*)(ws + OFF_WT_OUT), DM / 2, DM / 2, DM / 2}; pg8::DenseOrder S; S.init(NT, DM, G, bid);
        EpiWout E{(const float*)a->in[I_X], a->out}; g.noepi = rep_; pg8::gemm_phase(c.lds, g, S, E); }
    } GRID_BAR(PH_WOUT);
    for (int rep_ = 0; rep_ <= DUP(PH_ROUTER); ++rep_) { if (rep_) GRID_BAR_NOW(); if (IN(PH_ROUTER)) { PHASE_ARGS;
        if ((bid >> 3) & 1) { phase_expert_weights(c, a); __syncthreads(); phase_router(c, a); } else { phase_router(c, a); __syncthreads(); phase_expert_weights(c, a); } if (PROBE_EW) { __syncthreads(); phase_expert_weights(c, a); } }
    } GRID_BAR(PH_ROUTER);
    for (int rep_ = 0; rep_ <= DUP(PH_MOE0); ++rep_) { if (rep_) GRID_BAR_NOW(); if (IN(PH_MOE0)) { PHASE_ARGS; moe_tables(c, a, true);
            pg8::Gemm g{(const bf16_t*)(ws + WS_XN), (const bf16_t*)(ws + OFF_WE1), DM / 2, DM / 2, DM / 2};
            pg8::MoeOrderG1 S{(const LAS int*)(c.lds + LDS_MISC), (const int*)(ws + OFF_LIST), G, bid, 1024};
            EpiMoe1 E{(unsigned char*)(ws + OFF_HMID)}; g.noepi = rep_; pg8::gemm_phase(c.lds, g, S, E);
            { pg8::Gemm g2{(const bf16_t*)(ws + OFF_PB), (const bf16_t*)(ws + OFF_WT_PP), 256, 256, 256}; pg8::DenseOrder S2; S2.init(NT, DM, G, bid);
              EpiPlain E2{(bf16_t*)(ws + OFF_PP), DM}; pg8::gemm_phase(c.lds, g2, S2, E2); } }
    } GRID_BAR(PH_MOE0);
#define MOE_DOWN(ch) do { pg8::Gemm g{(const bf16_t*)(ws + OFF_HMID), (const bf16_t*)(ws + OFF_WE2), 256, 256, 256}; \
            pg8::MoeOrder<false> S{(const LAS int*)(c.lds + LDS_MISC), (const int*)(ws + OFF_LIST), 8, G, bid, ch, ch + 1, 2048, 0}; \
            EpiMoe2 E{(unsigned char*)(ws + OFF_YPART + (size_t)((ch) & 1) * YPART_BYTES), (const i32x2*)(ws + OFF_RINFO), a->out, ch, 0}; pg8::gemm_phase(c.lds, g, S, E); } while (0)
    if (IN(PH_MOE0 + 1)) { PHASE_ARGS; MOE_DOWN(0); }
    GRID_BAR(PH_MOE0 + 1);
#define MOE_MERGED(ch) do { if (IN(PH_MOE0 + 1 + ch)) {        \
            if ((bid >> 3) & 1) { { PHASE_ARGS; phase_combine(c, a, ch - 1); } __syncthreads(); { PHASE_ARGS; MOE_DOWN(ch); } } \
            else { { PHASE_ARGS; MOE_DOWN(ch); } __syncthreads(); { PHASE_ARGS; phase_combine(c, a, ch - 1); } } } \
        GRID_BAR(PH_MOE0 + 1 + ch); } while (0)
    static_assert(NCHUNK == 4, "phase program below is written out for four chunks");
    MOE_MERGED(1); MOE_MERGED(2); MOE_MERGED(3);
#define GATE_ROWS(r0, r1) do { PHASE_ARGS; pg8::Gemm g{(const bf16_t*)(ws + OFF_XN3 + (size_t)(r0) * DM), (const bf16_t*)(ws + OFF_WT_PG), DM / 2, DM / 2, DM / 2}; pg8::DenseOrder S; S.init((r1) - (r0), DM, G, bid); \
        EpiGate E{(const bf16_t*)(ws + OFF_PP) + (size_t)(r0) * DM, (const float*)a->in[I_BPG], (bf16_t*)(ws + OFF_U) + (size_t)(r0) * DM, (float*)(ws + OFF_SSQU) + (size_t)(r0) * 32, 0}; pg8::gemm_phase(c.lds, g, S, E); } while (0)
    constexpr int R3 = (NCHUNK - 1) * CH_TOK;
    if (IN(PH_MOE0 + 1 + NCHUNK)) { if ((bid >> 3) & 1) { { PHASE_ARGS; phase_combine(c, a, NCHUNK - 1); } __syncthreads(); GATE_ROWS(0, R3); } else { GATE_ROWS(0, R3); __syncthreads(); { PHASE_ARGS; phase_combine(c, a, NCHUNK - 1); } } }
    GRID_BAR(PH_MOE0 + 1 + NCHUNK);
#undef MOE_MERGED
#undef MOE_DOWN
    if (IN(PH_GATE)) { if ((bid >> 3) & 1) { { PHASE_ARGS; phase_final(c, a, 0, R3); } __syncthreads(); GATE_ROWS(R3, NT); } else { GATE_ROWS(R3, NT); __syncthreads(); { PHASE_ARGS; phase_final(c, a, 0, R3); } } }
    GRID_BAR(PH_GATE);
    if (IN(PH_FINAL)) { PHASE_ARGS; phase_final(c, a, R3, NT); }
#undef GATE_ROWS
#undef IN
}

extern "C" void kernel_launch(void* const* d_in, const int* in_sizes, int n_in, void* d_out, int out_size, void* d_ws, size_t ws_size, hipStream_t stream) {
    static int grid = 0;
    if (grid == 0) {
        if (n_in != 37 || out_size != NT * DM || ws_size < WS_END) { fprintf(stderr, "kernel_launch: unexpected shapes (n_in %d out %d ws %zu need %zu)\n", n_in, out_size, ws_size, (size_t)WS_END); grid = -1; return; }
        int dev = 0, cus = 0;
        if (hipGetDevice(&dev) != hipSuccess || hipDeviceGetAttribute(&cus, hipDeviceAttributeMultiprocessorCount, dev) != hipSuccess) { grid = -1; return; }
        if (hipFuncSetAttribute((const void*)fwd, hipFuncAttributeMaxDynamicSharedMemorySize, LDS_BYTES) != hipSuccess) { fprintf(stderr, "kernel_launch: hipFuncSetAttribute failed\n"); grid = -1; return; }
        int per_cu = 0; (void)hipOccupancyMaxActiveBlocksPerMultiprocessor(&per_cu, (const void*)fwd, 512, LDS_BYTES); (void)hipGetLastError();
        grid = cus;
    }
    if (grid < 0) return;
    (void)hipMemsetAsync((char*)d_ws + WS_CTL, 0, CTL_ZERO_BYTES, stream);
    Args a{};
    for (int i = 0; i < 37; ++i) a.in[i] = d_in[i];
    a.out = (float*)d_out; a.ws = (unsigned char*)d_ws;
#if N_LAUNCH_MODE == 0
    for (int p = 0; p < PH_COUNT; ++p) { a.ph_lo = p; a.ph_hi = p + 1; hipLaunchKernelGGL(fwd, dim3(grid), dim3(512), LDS_BYTES, stream, a); }
#else
    a.ph_lo = 0; a.ph_hi = PH_COUNT; hipLaunchKernelGGL(fwd, dim3(grid), dim3(512), LDS_BYTES, stream, a);
#endif
}
```
